# Optimizing an MI355X kernel written in HIP

```python
import jax, jax.numpy as jnp
from jax import lax
import numpy as np

D_MODEL = 1024
BATCH = 4
SEQ = 4096
DEPTH = 2

N_MIXERS = 2
CONV_WIDTH = 3
MLA_HEADS = 8
Q_LORA = 384
KV_LORA = 256
QK_NOPE = 128
QK_ROPE = 64
QK_HEAD = QK_NOPE + QK_ROPE
V_HEAD = 128
ROPE_THETA = 10000.0
ATTN_BLOCK = 128
PEER_HEADS = 8
PEER_KEYS = 128
PEER_EXPERTS = PEER_KEYS * PEER_KEYS
PEER_DKEY = 256
PEER_HALF = PEER_DKEY // 2
PEER_TOPK = 16
PEER_CHUNK = 128
NORM_EPS = 1e-6

kernel_name = "hybrid_shortconv_mla_peer_adaln"


def rms_norm(x, g):
    xf = x.astype(jnp.float32)
    y = xf * lax.rsqrt(jnp.mean(xf * xf, axis=-1, keepdims=True) + NORM_EPS)
    return (y * g.astype(jnp.float32)).astype(x.dtype)


def modulate(x, g, shift, scale):
    return rms_norm(x, g) * (1 + scale[:, None, :]) + shift[:, None, :]


def short_conv_mixer(h, w_in, w_conv, w_out):
    b_gate, c_gate, v = jnp.split(h @ w_in, 3, axis=-1)
    u = c_gate * v
    conv = lax.conv_general_dilated(
        u, w_conv[:, None, :].astype(u.dtype), window_strides=(1,),
        padding=[(CONV_WIDTH - 1, 0)], dimension_numbers=("NWC", "WIO", "NWC"),
        feature_group_count=D_MODEL)
    return (b_gate * conv) @ w_out


def apply_rope(x, cos, sin):
    half = x.shape[-1] // 2
    x1, x2 = x[..., :half], x[..., half:]
    return jnp.concatenate([x1 * cos - x2 * sin, x1 * sin + x2 * cos], axis=-1)


def mla_mixer(h, positions, w_in, q_a_g, kv_a_g, w_qb, w_kvb, q_g, k_g, w_out):
    B, S, _ = h.shape
    q_lat, kv_lat, k_rope = jnp.split(h @ w_in, [Q_LORA, Q_LORA + KV_LORA], axis=-1)
    q = (rms_norm(q_lat, q_a_g) @ w_qb).reshape(B, S, MLA_HEADS, QK_HEAD)
    kv = (rms_norm(kv_lat, kv_a_g) @ w_kvb).reshape(B, S, MLA_HEADS, QK_NOPE + V_HEAD)
    k_nope, v = kv[..., :QK_NOPE], kv[..., QK_NOPE:]
    k = jnp.concatenate(
        [k_nope, jnp.broadcast_to(k_rope[:, :, None, :], (B, S, MLA_HEADS, QK_ROPE))], axis=-1)
    q = rms_norm(q, q_g)
    k = rms_norm(k, k_g)
    inv_freq = ROPE_THETA ** (-jnp.arange(0, QK_ROPE, 2, dtype=jnp.float32) / QK_ROPE)
    ang = positions[..., None].astype(jnp.float32) * inv_freq
    cos = jnp.cos(ang)[:, :, None, :].astype(h.dtype)
    sin = jnp.sin(ang)[:, :, None, :].astype(h.dtype)
    q = jnp.concatenate([q[..., :QK_NOPE], apply_rope(q[..., QK_NOPE:], cos, sin)], axis=-1)
    k = jnp.concatenate([k[..., :QK_NOPE], apply_rope(k[..., QK_NOPE:], cos, sin)], axis=-1)
    scale = QK_HEAD ** -0.5
    outs = []
    for start in range(0, S, ATTN_BLOCK):
        end = start + ATTN_BLOCK
        s = jnp.einsum("bqhd,bkhd->bhqk", q[:, start:end], k[:, :end]).astype(jnp.float32) * scale
        mask = (start + jnp.arange(ATTN_BLOCK))[:, None] >= jnp.arange(end)[None, :]
        p = jax.nn.softmax(jnp.where(mask, s, -jnp.inf), axis=-1).astype(v.dtype)
        outs.append(jnp.einsum("bhqk,bkhd->bqhd", p, v[:, :end]))
    o = jnp.concatenate(outs, axis=1).reshape(B, S, MLA_HEADS * V_HEAD)
    return o @ w_out


def peer_mixer(h, w_q, subkeys, u_tab, v_tab):
    B, S, D = h.shape
    tokens = h.reshape(-1, PEER_CHUNK, D)

    def chunk_fn(xc):
        C = xc.shape[0]
        q = (xc @ w_q).reshape(C, PEER_HEADS, 2, PEER_HALF)
        s = jnp.einsum("chpd,hpnd->chpn", q, subkeys).astype(jnp.float32)
        top_s, top_i = lax.top_k(s, PEER_TOPK)
        cand = top_s[:, :, 0, :, None] + top_s[:, :, 1, None, :]
        best_s, best_pos = lax.top_k(cand.reshape(C, PEER_HEADS, PEER_TOPK * PEER_TOPK), PEER_TOPK)
        ia = jnp.take_along_axis(top_i[:, :, 0], best_pos // PEER_TOPK, axis=-1)
        ib = jnp.take_along_axis(top_i[:, :, 1], best_pos % PEER_TOPK, axis=-1)
        expert = ia * PEER_KEYS + ib
        g = jax.nn.softmax(best_s, axis=-1).astype(xc.dtype)
        act = jax.nn.gelu(jnp.einsum("chkd,cd->chk", u_tab[expert], xc), approximate=False) * g
        return jnp.einsum("chk,chkd->cd", act, v_tab[expert])

    return lax.map(chunk_fn, tokens).reshape(B, S, D)


def setup_inputs(seed: int = 0) -> dict:
    key = jax.random.key(seed)
    ks = jax.random.split(key, 24)
    f32 = jnp.float32
    n_conv = (DEPTH + N_MIXERS - 1) // N_MIXERS
    n_mla = DEPTH // N_MIXERS
    D = D_MODEL

    def nrm(k, shape, std):
        return jax.random.normal(k, shape, f32) * std

    def gain(k, shape):
        return 1.0 + 0.02 * jax.random.normal(k, shape, f32)

    x = jax.random.normal(ks[0], (BATCH, SEQ, D), f32)
    c = jax.random.normal(ks[1], (BATCH, D), f32)
    positions = jnp.broadcast_to(jnp.arange(SEQ, dtype=jnp.int32)[None, :], (BATCH, SEQ))
    return {
        "x": x,
        "c": c,
        "positions": positions,
        "tok_norm": gain(ks[2], (DEPTH, D)),
        "ch_norm": gain(ks[3], (DEPTH, D)),
        "ada_w": nrm(ks[4], (DEPTH, D, 6 * D), 0.5 * D ** -0.5),
        "ada_b": nrm(ks[5], (DEPTH, 6 * D), 0.02),
        "conv_in_w": nrm(ks[6], (n_conv, D, 3 * D), D ** -0.5),
        "conv_w": nrm(ks[7], (n_conv, CONV_WIDTH, D), CONV_WIDTH ** -0.5),
        "conv_out_w": nrm(ks[8], (n_conv, D, D), D ** -0.5),
        "mla_in_w": nrm(ks[9], (n_mla, D, Q_LORA + KV_LORA + QK_ROPE), D ** -0.5),
        "q_a_norm": gain(ks[10], (n_mla, Q_LORA)),
        "kv_a_norm": gain(ks[11], (n_mla, KV_LORA)),
        "q_b_w": nrm(ks[12], (n_mla, Q_LORA, MLA_HEADS * QK_HEAD), Q_LORA ** -0.5),
        "kv_b_w": nrm(ks[13], (n_mla, KV_LORA, MLA_HEADS * (QK_NOPE + V_HEAD)), KV_LORA ** -0.5),
        "q_norm": gain(ks[14], (n_mla, QK_HEAD)),
        "k_norm": gain(ks[15], (n_mla, QK_HEAD)),
        "mla_out_w": nrm(ks[16], (n_mla, MLA_HEADS * V_HEAD, D), (MLA_HEADS * V_HEAD) ** -0.5),
        "peer_q_w": nrm(ks[17], (DEPTH, D, PEER_HEADS * PEER_DKEY), D ** -0.5),
        "peer_subkeys": nrm(ks[18], (DEPTH, PEER_HEADS, 2, PEER_KEYS, PEER_HALF), PEER_HALF ** -0.5),
        "peer_u": nrm(ks[19], (DEPTH, PEER_EXPERTS, D), D ** -0.5),
        "peer_v": nrm(ks[20], (DEPTH, PEER_EXPERTS, D), 0.5),
    }


def reference(x, c, positions, tok_norm, ch_norm, ada_w, ada_b, conv_in_w, conv_w, conv_out_w,
              mla_in_w, q_a_norm, kv_a_norm, q_b_w, kv_b_w, q_norm, k_norm, mla_out_w,
              peer_q_w, peer_subkeys, peer_u, peer_v):
    c_act = jax.nn.silu(c)
    for i in range(DEPTH):
        mod = c_act @ ada_w[i] + ada_b[i]
        sh1, sc1, g1, sh2, sc2, g2 = jnp.split(mod, 6, axis=-1)
        h = modulate(x, tok_norm[i], sh1, sc1)
        j = i // N_MIXERS
        if i % N_MIXERS == 0:
            y = short_conv_mixer(h, conv_in_w[j], conv_w[j], conv_out_w[j])
        else:
            y = mla_mixer(h, positions, mla_in_w[j], q_a_norm[j], kv_a_norm[j], q_b_w[j],
                          kv_b_w[j], q_norm[j], k_norm[j], mla_out_w[j])
        x = x + g1[:, None, :] * y
        h = modulate(x, ch_norm[i], sh2, sc2)
        x = x + g2[:, None, :] * peer_mixer(h, peer_q_w[i], peer_subkeys[i], peer_u[i], peer_v[i])
    return x
```

```cpp
#include <hip/hip_runtime.h>
#include <cstdio>
#include <cstdint>
#define GAS __attribute__((address_space(1)))
#define LAS __attribute__((address_space(3)))
namespace pg8 {
#define PG8_LAS __attribute__((address_space(3)))
typedef unsigned short bf16_t;
typedef short bf16x8 __attribute__((ext_vector_type(8)));
typedef float f32x4 __attribute__((ext_vector_type(4)));
typedef unsigned u32x4 __attribute__((ext_vector_type(4)));
constexpr int BM = 256, BK = 64, HALF = 128, HTB = HALF * BK * 2  , STAGE_BYTES = 8 * HTB, NXCD = 8, WGM = 8;

__host__ __device__ __forceinline__ int lds_byte(int r, int c) { const int st = (r >> 4) * 2 + (c >> 5), rr = r & 15, cc = c & 31, ob = rr * 64 + cc * 2; return st * 1024 + (ob ^ (((ob >> 9) & 1) << 5)); }
__host__ __device__ __forceinline__ void stage_rc(int b, int& R, int& C) { const int st = b / 1024, sb = b % 1024, swz = sb ^ (((sb >> 9) & 1) << 5); R = (st >> 1) * 16 + swz / 64; C = (st & 1) * 32 + (swz % 64) / 2; }
__host__ __device__ __forceinline__ int perm32(int rho) { const int n = rho >> 4, i = rho & 15; return 8 * (i >> 2) + 4 * n + (i & 3); }

struct Unit { int pm, pn; };
struct Gemm { const bf16_t* A; const bf16_t* Bt; int M, N, K; };

struct StaticOrder {
    int nM, nN, nwg, G, c;
    __host__ __device__ void init(int M, int N, int G_, int c_) { nM = M / BM; nN = N / BM; nwg = nM * nN; G = G_; c = c_; }
    __host__ __device__ bool next(int i, Unit& u) const {
        const long L = (long)i * G + c; if (L >= nwg) return false;
        int wgid = (int)L; { const int q = nwg / NXCD, r = nwg % NXCD, xcd = wgid % NXCD, off = wgid / NXCD; wgid = (xcd < r ? xcd * (q + 1) : r * (q + 1) + (xcd - r) * q) + off; }
        const int nig = WGM * nN, gid = wgid / nig, fm = gid * WGM, gsz = (nM - fm) < WGM ? (nM - fm) : WGM;
        u.pm = fm + ((wgid % nig) % gsz); u.pn = (wgid % nig) / gsz; return true;
    }
    __device__ __forceinline__ void a_ready(const Unit&) const {}
    __device__ __forceinline__ void done(const Unit&) const {}
};

__device__ __forceinline__ unsigned cvt_pk_bf16(float lo, float hi) { unsigned r; asm volatile("v_cvt_pk_bf16_f32 %0, %1, %2" : "=v"(r) : "v"(lo), "v"(hi)); return r; }
typedef float f32x2 __attribute__((ext_vector_type(2)));
__device__ __forceinline__ f32x2 gelu_pk(f32x2 v) {
    const f32x2 av = __builtin_elementwise_abs(v), d = av * 0.2316418882f + 1.0f;
    f32x2 t; t.x = __builtin_amdgcn_rcpf(d.x); t.y = __builtin_amdgcn_rcpf(d.y);
    f32x2 q = t * 0.5307027145f + (-0.7265760135f); q = q * t + 0.7107068705f; q = q * t + (-0.142248368f); q = q * t + 0.127414796f; q = q * t;
    const f32x2 s = (v * v) * (-0.72134752044f);
    f32x2 e; e.x = __builtin_amdgcn_exp2f(s.x); e.y = __builtin_amdgcn_exp2f(s.y);
    const f32x2 m = v * (q * e), r = v - m;
    f32x2 o; o.x = v.x < 0.f ? m.x : r.x; o.y = v.y < 0.f ? m.y : r.y; return o;
}

template <int ACT  > struct EpiBf16 {
    static constexpr bool PERM = true, AFTER_DRAIN = false; static_assert(ACT == 0 || ACT == 1, "EpiBf16: ACT is 0 (none) or 1 (gelu_pk)");
    bf16_t* O; int ldc; const float* bias; int split_cols; size_t split_stride; float scale0;
    __device__ __forceinline__ void operator()(const f32x4 (&acc)[2][2][4][2], const Unit& u, int wr, int wc, int fr, int fq) const {
        const int row0 = u.pm * BM + wr * 64 + fr; int colt = u.pn * BM; bf16_t* base = O;
        float sc = 1.f; if (split_cols) { const int t = colt / split_cols; base += (size_t)t * split_stride; colt -= t * split_cols; if (t == 0) sc = scale0; }
        const int col0 = colt + wc * 32 + 8 * fq, bcol0 = u.pn * BM + wc * 32 + 8 * fq;
        f32x4 bv[2][2];
#pragma unroll
        for (int bj = 0; bj < 2; ++bj)
#pragma unroll
            for (int n = 0; n < 2; ++n) bv[bj][n] = bias ? *(const f32x4*)(bias + bcol0 + bj * HALF + 4 * n) : (f32x4){0.f, 0.f, 0.f, 0.f};
#pragma unroll
        for (int ai = 0; ai < 2; ++ai)
#pragma unroll
            for (int m = 0; m < 4; ++m) { bf16_t* rowp = base + (size_t)(row0 + ai * HALF + m * 16) * ldc + col0;
#pragma unroll
                for (int bj = 0; bj < 2; ++bj) { f32x4 v0 = acc[ai][bj][m][0] + bv[bj][0], v1 = acc[ai][bj][m][1] + bv[bj][1];
                    if (ACT == 1) { f32x2 a = gelu_pk((f32x2){v0[0], v0[1]}), b = gelu_pk((f32x2){v0[2], v0[3]}), c = gelu_pk((f32x2){v1[0], v1[1]}), d = gelu_pk((f32x2){v1[2], v1[3]});
                        v0 = (f32x4){a.x, a.y, b.x, b.y}; v1 = (f32x4){c.x, c.y, d.x, d.y}; }
                    v0 = v0 * sc; v1 = v1 * sc; u32x4 w; w.x = cvt_pk_bf16(v0[0], v0[1]); w.y = cvt_pk_bf16(v0[2], v0[3]); w.z = cvt_pk_bf16(v1[0], v1[1]); w.w = cvt_pk_bf16(v1[2], v1[3]);
                    *(u32x4*)(rowp + bj * HALF) = w; } }
    }
};

template <class Epi, class Sched, bool ALIGN_EPI = false, bool SP2 = false>
__device__ __forceinline__ void gemm_phase(PG8_LAS unsigned char* lds, const Gemm g, const Sched& S, const Epi& E) {
    const int tid = threadIdx.x, wid = __builtin_amdgcn_readfirstlane(tid >> 6), lane = tid & 63, wr = wid >> 2, wc = wid & 3, fr = lane & 15, fq = lane >> 4;
    const int K = g.K, nt = K / BK;
    unsigned voffA[2], voffB[2];
#pragma unroll
    for (int i = 0; i < 2; ++i) { int R, C; stage_rc(tid * 16 + i * 8192, R, C); const int Rb = Epi::PERM ? ((R & ~31) + perm32(R & 31)) : R;
        voffA[i] = (unsigned)(R * K + C) * 2u; voffB[i] = (unsigned)(Rb * K + C) * 2u; }
    const size_t kstep = (size_t)(BK * 2);
    const size_t hstep = (size_t)HALF * K * 2;
    const size_t tstep = 2 * hstep;
    const unsigned ldsw = (unsigned)wid * 1024u;
    const int aoff = lds_byte(wr * 64 + fr, fq * 8), boff = lds_byte(wc * 32 + fr, fq * 8);
#define PG8_SA(b, h) (((b) * 2 + (h)) * HTB)
#define PG8_SB(b, h) ((4 + (b) * 2 + (h)) * HTB)
#define PG8_STAGE(bufoff, gbase, voff) do { _Pragma("unroll") for (int _i = 0; _i < 2; ++_i) \
        __builtin_amdgcn_global_load_lds((const unsigned*)((const char*)(gbase) + (voff)[_i]), (PG8_LAS unsigned*)(lds + (bufoff) + ldsw + _i * 8192), 16, 0, 0); } while (0)
#define PG8_LDA(dst, b, h) do { _Pragma("unroll") for (int m = 0; m < 4; ++m) _Pragma("unroll") for (int k = 0; k < 2; ++k) dst[m][k] = *(const PG8_LAS bf16x8*)(lds + PG8_SA(b, h) + aoff + m * 2048 + k * 1024); } while (0)
#define PG8_LDB(dst, b, h) do { _Pragma("unroll") for (int n = 0; n < 2; ++n) _Pragma("unroll") for (int k = 0; k < 2; ++k) dst[n][k] = *(const PG8_LAS bf16x8*)(lds + PG8_SB(b, h) + boff + n * 2048 + k * 1024); } while (0)
#define PG8_MMA(ai, bj, At, Bt) do { __builtin_amdgcn_s_setprio(1); _Pragma("unroll") for (int m = 0; m < 4; ++m) _Pragma("unroll") for (int n = 0; n < 2; ++n) _Pragma("unroll") for (int k = 0; k < 2; ++k) \
        acc[ai][bj][m][n] = __builtin_amdgcn_mfma_f32_16x16x32_bf16(Bt[n][k], At[m][k], acc[ai][bj][m][n], 0, 0, 0); __builtin_amdgcn_s_setprio(0); } while (0)
#define PG8_WAIT_V(n) asm volatile("s_waitcnt vmcnt(" #n ")" ::: "memory")
#define PG8_WAIT_L(n) asm volatile("s_waitcnt lgkmcnt(" #n ")" ::: "memory")
#define PG8_BAR __builtin_amdgcn_s_barrier()
#define PG8_SCHED __builtin_amdgcn_sched_barrier(0)
    Unit cur, nxt; int ui = 0;
    if (!S.next(0, cur)) return;
    f32x4 acc[2][2][4][2];
#pragma unroll
    for (int a = 0; a < 2; ++a)
#pragma unroll
        for (int b = 0; b < 2; ++b)
#pragma unroll
            for (int m = 0; m < 4; ++m)
#pragma unroll
                for (int n = 0; n < 2; ++n) acc[a][b][m][n] = (f32x4){0.f, 0.f, 0.f, 0.f};
    bf16x8 At[4][2], B0[2][2], B1[2][2];
    const char* cA = (const char*)g.A + (size_t)cur.pm * tstep; const char* cB = (const char*)g.Bt + (size_t)cur.pn * tstep;
    S.a_ready(cur);
    if constexpr (SP2) {
        PG8_STAGE(PG8_SB(0, 0), cB, voffB); PG8_STAGE(PG8_SB(0, 1), cB + hstep, voffB); PG8_STAGE(PG8_SA(0, 0), cA, voffA); PG8_STAGE(PG8_SA(0, 1), cA + hstep, voffA);
        if (wr == 1) PG8_BAR;
        PG8_WAIT_V(2); PG8_BAR;
        PG8_STAGE(PG8_SB(1, 0), cB + kstep, voffB); PG8_STAGE(PG8_SA(1, 0), cA + kstep, voffA); PG8_STAGE(PG8_SB(1, 1), cB + hstep + kstep, voffB);
        PG8_WAIT_V(6); PG8_BAR;
    } else {
        PG8_STAGE(PG8_SB(0, 0), cB, voffB); PG8_STAGE(PG8_SA(0, 0), cA, voffA); PG8_STAGE(PG8_SB(0, 1), cB + hstep, voffB); PG8_STAGE(PG8_SA(0, 1), cA + hstep, voffA);
        if (wr == 1) PG8_BAR;
        PG8_WAIT_V(4); PG8_BAR;
        PG8_STAGE(PG8_SB(1, 0), cB + kstep, voffB); PG8_STAGE(PG8_SA(1, 0), cA + kstep, voffA); PG8_STAGE(PG8_SB(1, 1), cB + hstep + kstep, voffB);
        PG8_WAIT_V(6); PG8_BAR;
    }
    for (;;) {
        const bool has_next = S.next(ui + 1, nxt);
        const char* nA = has_next ? (const char*)g.A + (size_t)nxt.pm * tstep : cA; const char* nB = has_next ? (const char*)g.Bt + (size_t)nxt.pn * tstep : cB;
        for (int t = 0; t < nt; t += 2) {
            const bool last = (t == nt - 2);
            const char* a1 = cA + (size_t)(t + 1) * kstep;
            const char* a2 = last ? nA : cA + (size_t)(t + 2) * kstep; const char* b2 = last ? nB : cB + (size_t)(t + 2) * kstep;
            const char* a3 = a2 + kstep; const char* b3 = b2 + kstep;
            if (last && has_next) S.a_ready(nxt);
            if constexpr (SP2) {
            PG8_LDB(B0, 0, 0); PG8_LDB(B1, 0, 1); PG8_SCHED; PG8_LDA(At, 0, 0); PG8_STAGE(PG8_SA(1, 1), a1 + hstep, voffA);
            PG8_WAIT_V(8); PG8_WAIT_L(0); PG8_BAR; PG8_MMA(0, 0, At, B0); PG8_MMA(0, 1, At, B1); PG8_BAR; PG8_SCHED;
            PG8_LDA(At, 0, 1); PG8_STAGE(PG8_SB(0, 0), b2, voffB); PG8_STAGE(PG8_SB(0, 1), b2 + hstep, voffB); PG8_STAGE(PG8_SA(0, 0), a2, voffA);
            PG8_WAIT_V(8); PG8_WAIT_L(0); PG8_BAR; PG8_MMA(1, 0, At, B0); PG8_MMA(1, 1, At, B1); PG8_BAR; PG8_SCHED;
            PG8_LDB(B0, 1, 0); PG8_LDB(B1, 1, 1); PG8_SCHED; PG8_LDA(At, 1, 0); PG8_STAGE(PG8_SA(0, 1), a2 + hstep, voffA);
            PG8_WAIT_V(8); PG8_WAIT_L(0); PG8_BAR; PG8_MMA(0, 0, At, B0); PG8_MMA(0, 1, At, B1); PG8_BAR; PG8_SCHED;
            PG8_LDA(At, 1, 1); PG8_STAGE(PG8_SB(1, 0), b3, voffB); PG8_STAGE(PG8_SB(1, 1), b3 + hstep, voffB); PG8_STAGE(PG8_SA(1, 0), a3, voffA);
            PG8_WAIT_V(8); PG8_WAIT_L(0); PG8_BAR; PG8_MMA(1, 0, At, B0); PG8_MMA(1, 1, At, B1); PG8_BAR; PG8_SCHED;
            } else {
            PG8_LDB(B0, 0, 0); PG8_SCHED; PG8_LDA(At, 0, 0); PG8_STAGE(PG8_SA(1, 1), a1 + hstep, voffA);
            PG8_WAIT_L(8); PG8_BAR; PG8_WAIT_L(0); PG8_MMA(0, 0, At, B0); PG8_BAR; PG8_SCHED;
            PG8_LDB(B1, 0, 1); PG8_STAGE(PG8_SB(0, 0), b2, voffB);
            PG8_BAR; PG8_WAIT_L(0); PG8_MMA(0, 1, At, B1); PG8_BAR;
            PG8_LDA(At, 0, 1); PG8_STAGE(PG8_SA(0, 0), a2, voffA);
            PG8_BAR; PG8_WAIT_L(0); PG8_MMA(1, 0, At, B0); PG8_BAR; PG8_SCHED;
            PG8_STAGE(PG8_SB(0, 1), b2 + hstep, voffB);
            PG8_WAIT_V(6); PG8_BAR; PG8_MMA(1, 1, At, B1); PG8_BAR;
            PG8_LDB(B0, 1, 0); PG8_SCHED; PG8_LDA(At, 1, 0); PG8_STAGE(PG8_SA(0, 1), a2 + hstep, voffA);
            PG8_WAIT_L(8); PG8_BAR; PG8_WAIT_L(0); PG8_MMA(0, 0, At, B0); PG8_BAR; PG8_SCHED;
            PG8_LDB(B1, 1, 1); PG8_STAGE(PG8_SB(1, 0), b3, voffB);
            PG8_BAR; PG8_WAIT_L(0); PG8_MMA(0, 1, At, B1); PG8_BAR;
            PG8_LDA(At, 1, 1); PG8_STAGE(PG8_SA(1, 0), a3, voffA);
            PG8_BAR; PG8_WAIT_L(0); PG8_MMA(1, 0, At, B0); PG8_BAR; PG8_SCHED;
            PG8_STAGE(PG8_SB(1, 1), b3 + hstep, voffB);
            PG8_WAIT_V(6); PG8_BAR; PG8_MMA(1, 1, At, B1); PG8_BAR;
            }
        }
        if constexpr (ALIGN_EPI) { if (wr == 0) PG8_BAR; }
        if constexpr (!Epi::AFTER_DRAIN) { E(acc, cur, wr, wc, fr, fq); S.done(cur); }
        if (!has_next) break;
#pragma unroll
        for (int a = 0; a < 2; ++a)
#pragma unroll
            for (int b = 0; b < 2; ++b)
#pragma unroll
                for (int m = 0; m < 4; ++m)
#pragma unroll
                    for (int n = 0; n < 2; ++n) acc[a][b][m][n] = (f32x4){0.f, 0.f, 0.f, 0.f};
        cur = nxt; cA = nA; cB = nB; ++ui;
        if constexpr (ALIGN_EPI) { if (wr == 1) PG8_BAR; }
    }
    PG8_WAIT_V(0);
    if constexpr (!ALIGN_EPI) { if (wr == 0) PG8_BAR; }
    PG8_BAR;
    if constexpr (Epi::AFTER_DRAIN) { E.fused(acc, cur, wr, wc, fr, fq, lds, wid, lane); S.done(cur); }
#undef PG8_SA
#undef PG8_SB
#undef PG8_STAGE
#undef PG8_LDA
#undef PG8_LDB
#undef PG8_MMA
#undef PG8_WAIT_V
#undef PG8_WAIT_L
#undef PG8_BAR
#undef PG8_SCHED
}
}
#define XB_TMO      128
#define XB_XCNT(j)  (256  + 64 * (j))
#define XB_XSUB(j)  (1280 + 64 * (j))
#define XB_XGEN(j)  (2304 + 64 * (j))
#define XB_TOP      3328
#define XB_TOPGEN   3392
#define XCD_BAR_WORDS 3456
#define XB_SPIN_CAP (1u << 18)

__device__ __forceinline__ unsigned xb_ld(unsigned* p)              { return __hip_atomic_load(p, __ATOMIC_RELAXED, __HIP_MEMORY_SCOPE_AGENT); }
__device__ __forceinline__ unsigned xb_add(unsigned* p, unsigned v) { return __hip_atomic_fetch_add(p, v, __ATOMIC_RELAXED, __HIP_MEMORY_SCOPE_AGENT); }
__device__ __forceinline__ unsigned xb_xcc_id() { return (unsigned)__builtin_amdgcn_s_getreg((3 << 11) | 20) & 0xFu; }
#define XB_SPIN(cond, bar) do { unsigned _sp = 0; while (cond) { __builtin_amdgcn_s_sleep(1); \
    if ((++_sp & 255u) == 0u) { if (xb_ld(&(bar)[XB_TMO])) break; if (_sp > XB_SPIN_CAP) { atomicAdd(&(bar)[XB_TMO], 1u); break; } } } } while (0)

struct XcdBarrier {
    unsigned* bar; unsigned x;
    volatile LAS unsigned* st;
};

__device__ __forceinline__ XcdBarrier xcd_barrier_post(unsigned* bar, volatile LAS unsigned* st) {
    XcdBarrier b; b.bar = bar; b.x = xb_xcc_id(); b.st = st;
    if (threadIdx.x == 0) (void)xb_add(&bar[XB_XCNT(b.x)], 1u);
    return b;
}
__device__ __forceinline__ void xcd_barrier_complete(unsigned* bar, unsigned x, unsigned& nloc, unsigned& nx) {
    const unsigned G = gridDim.x * gridDim.y * gridDim.z;
    unsigned sum, cnt, mine, sp = 0u;
    for (;;) {
        sum = 0u; cnt = 0u; mine = 0u;
#pragma unroll
        for (unsigned j = 0; j < 16; ++j) { const unsigned c = xb_ld(&bar[XB_XCNT(j)]); sum += c; cnt += (c > 0u) ? 1u : 0u; mine = (j == x) ? c : mine; }
        if (sum == G) break;
        __builtin_amdgcn_s_sleep(1);
        if ((++sp & 255u) == 0u) { if (xb_ld(&bar[XB_TMO])) break; if (sp > XB_SPIN_CAP) { atomicAdd(&bar[XB_TMO], 1u); break; } }
    }
    nloc = mine > 0u ? mine : 1u; nx = cnt > 0u ? cnt : 1u;
}

__device__ __forceinline__ void xcd_barrier(const XcdBarrier& b) {
    asm volatile("s_waitcnt vmcnt(0)" ::: "memory");
    __syncthreads();
    if (threadIdx.x == 0) {
        unsigned* bar = b.bar;
        __builtin_amdgcn_s_waitcnt(0);
        unsigned nloc = b.st[0], nx = b.st[1];
        if (nloc == 0u) { xcd_barrier_complete(bar, b.x, nloc, nx); b.st[0] = nloc; b.st[1] = nx; }
        const unsigned old = xb_add(&bar[XB_XSUB(b.x)], 1u);
        const unsigned gen = old / nloc;
        if (old + 1u == (gen + 1u) * nloc) {
            __builtin_amdgcn_fence(__ATOMIC_RELEASE, "agent");
            asm volatile("s_waitcnt vmcnt(0)" ::: "memory");
            const unsigned og = xb_add(&bar[XB_TOP], 1u);
            const unsigned tg = og / nx;
            if (og + 1u == (tg + 1u) * nx) xb_add(&bar[XB_TOPGEN], 1u);
            else XB_SPIN(xb_ld(&bar[XB_TOPGEN]) == tg, bar);
            __builtin_amdgcn_fence(__ATOMIC_ACQUIRE, "agent");
            xb_add(&bar[XB_XGEN(b.x)], 1u);
            asm volatile("s_waitcnt vmcnt(0)" ::: "memory");
        } else {
            XB_SPIN(xb_ld(&bar[XB_XGEN(b.x)]) == gen, bar);
            __builtin_amdgcn_fence(__ATOMIC_ACQUIRE, "agent");
            asm volatile("s_waitcnt vmcnt(0)" ::: "memory");
        }
    }
    __syncthreads();
}

constexpr int DM = 1024, NB = 4, SEQ = 4096, MTOK = NB * SEQ;
constexpr int QLORA = 384, KVLORA = 256, ROPE = 64, NOPE = 128, QKH = 192, VH = 128, NH = 8;
constexpr int MLA_IN = 704, MLA_IN_PAD = 768;
constexpr int NEXP = 16384;
constexpr float NORM_EPS = 1e-6f;
constexpr float QSCALE = 0.07216878364870322f * 1.4426950408889634f;

#ifndef MK_N_LAUNCHES
#define MK_N_LAUNCHES 1
#endif
constexpr int NPHASES = 19;
#ifndef PHMASK
#define PHMASK 0xFFFFFFu
#endif
#define EN(k) (((PHMASK) >> (k)) & 1u)
constexpr int NWAVES = 8;

constexpr size_t MiB = 1u << 20;
constexpr size_t WS_CTL = 0, CTL_ZERO_BYTES = 64 * 1024;
constexpr size_t WS_MOD = 1 * MiB;
constexpr size_t WS_WCIN = 2 * MiB;
constexpr size_t WS_WCOUT = 8 * MiB;
constexpr size_t WS_WPQ0 = 10 * MiB, WS_WPQ1 = 14 * MiB;
constexpr size_t WS_WMIN = 18 * MiB;
constexpr size_t WS_WQB = 20 * MiB;
constexpr size_t WS_WKVB = 22 * MiB;
constexpr size_t WS_WMOUT = 24 * MiB;
constexpr size_t WS_SUBK = 26 * MiB;
constexpr size_t WS_PU = 32 * MiB;
constexpr size_t WS_PV = 96 * MiB;
constexpr size_t WS_XN = 160 * MiB;
constexpr size_t WS_VT = 160 * MiB;
constexpr size_t WS_BCV = 192 * MiB;
constexpr size_t WS_LAT = 192 * MiB;
constexpr size_t WS_O = 192 * MiB;
constexpr size_t WS_QN = 216 * MiB;
constexpr size_t WS_KVN = 228 * MiB;
constexpr size_t WS_QRAW = 236 * MiB;
constexpr size_t WS_Z = 288 * MiB;
constexpr size_t WS_KVRAW = 288 * MiB;
constexpr size_t WS_PQ = 288 * MiB;
constexpr size_t WS_QF = 352 * MiB;
constexpr size_t WS_KF = 400 * MiB;
constexpr size_t WS_IDS = 448 * MiB;
constexpr size_t WS_GATES = 456 * MiB;
constexpr size_t WS_END = 464 * MiB;
constexpr int CW_BAR = 1024;

constexpr int RING_BYTES = 131072;
constexpr int LDSCTL_OFF = RING_BYTES, MISC_OFF = LDSCTL_OFF + 320;
constexpr int LDS_BYTES = 147456;


typedef unsigned short bf16;
typedef unsigned u32x4 __attribute__((ext_vector_type(4)));
typedef unsigned u32x2 __attribute__((ext_vector_type(2)));
typedef float f32x4 __attribute__((ext_vector_type(4)));
typedef float f32x16 __attribute__((ext_vector_type(16)));
typedef short s16x8 __attribute__((ext_vector_type(8)));
typedef short s16x4 __attribute__((ext_vector_type(4)));
#define LDS_WAIT() asm volatile("s_waitcnt lgkmcnt(0)" ::: "memory")
#define VM_WAIT() asm volatile("s_waitcnt vmcnt(0)" ::: "memory")
#define DI __device__ __forceinline__

DI unsigned f2bf(float f) { unsigned u = __builtin_bit_cast(unsigned, f); return (u + 0x7fffu + ((u >> 16) & 1u)) >> 16; }
DI unsigned pk2(float lo, float hi) { return f2bf(lo) | (f2bf(hi) << 16); }
DI float bflo(unsigned u) { return __uint_as_float(u << 16); }
DI float bfhi(unsigned u) { return __uint_as_float(u & 0xffff0000u); }
DI float bf1(bf16 b) { return __uint_as_float((unsigned)b << 16); }
DI float wave_sum(float v) {
#pragma unroll
    for (int o = 32; o > 0; o >>= 1) v += __shfl_xor(v, o);
    return v;
}
DI int crow(int r, int hi) { return (r & 3) + 8 * (r >> 2) + 4 * hi; }

struct Args { const void* in[22]; float* out; unsigned char* ws; int ph_lo, ph_hi; };

DI void transpose_item(const float* W, int K, int N, bf16* WT, LAS float* scr, int item, int lane) {
    const int nblk = N / 32, kb = item / nblk, nb = item % nblk, k0 = 64 * kb, n0 = 32 * nb;
#pragma unroll 8
    for (int i = 0; i < 32; ++i) { const int kk = 2 * i + (lane >> 5); scr[kk * 33 + (lane & 31)] = W[(size_t)(k0 + kk) * N + n0 + (lane & 31)]; }
    LDS_WAIT(); asm volatile("" ::: "memory");
    const int c = lane & 7;
#pragma unroll
    for (int j = 0; j < 4; ++j) { const int n = (lane >> 3) + 8 * j; const LAS float* s = scr + (8 * c) * 33 + n;
        u32x4 o; o.x = pk2(s[0 * 33], s[1 * 33]); o.y = pk2(s[2 * 33], s[3 * 33]); o.z = pk2(s[4 * 33], s[5 * 33]); o.w = pk2(s[6 * 33], s[7 * 33]);
        *(u32x4*)(WT + (size_t)(n0 + n) * K + k0 + 8 * c) = o; }
    LDS_WAIT(); asm volatile("" ::: "memory");
}
DI void cvt_f32_bf16(const float* src, bf16* dst, size_t n8, size_t gt, size_t GT) {
#pragma unroll 4
    for (size_t i = gt; i < n8; i += GT) {
        const f32x4 a = ((const f32x4*)src)[2 * i], b = ((const f32x4*)src)[2 * i + 1];
        u32x4 o; o.x = pk2(a.x, a.y); o.y = pk2(a.z, a.w); o.z = pk2(b.x, b.y); o.w = pk2(b.z, b.w);
        ((u32x4*)dst)[i] = o; }
}
DI void ph_prologue(const Args& a, LAS unsigned char* lds, int tid, int lane, int wave, int vcu, int G) {
    {
        const float* c = (const float*)a.in[1]; const float* ada_w = (const float*)a.in[5]; const float* ada_b = (const float*)a.in[6];
        float* mod = (float*)(a.ws + WS_MOD);
        LAS float* cact = (LAS float*)lds; LAS float* red = cact + 4096;
        for (int it = blockIdx.x; it < 192; it += G) {
            const int i = it / 96, n0 = (it % 96) * 64;
            for (int e = tid; e < 4096; e += 512) { const float v = c[e]; cact[e] = v / (1.f + expf(-v)); }
            __syncthreads();
            const float* W = ada_w + (size_t)i * 1024 * 6144 + n0 + lane;
            float a0 = 0.f, a1 = 0.f, a2 = 0.f, a3 = 0.f;
            const int k0 = wave * 128;
#pragma unroll 8
            for (int k = k0; k < k0 + 128; ++k) { const float w = W[(size_t)k * 6144]; a0 += cact[k] * w; a1 += cact[1024 + k] * w; a2 += cact[2048 + k] * w; a3 += cact[3072 + k] * w; }
            red[(wave * 4 + 0) * 64 + lane] = a0; red[(wave * 4 + 1) * 64 + lane] = a1; red[(wave * 4 + 2) * 64 + lane] = a2; red[(wave * 4 + 3) * 64 + lane] = a3;
            __syncthreads();
            if (tid < 256) { const int b = tid >> 6; float s = 0.f;
#pragma unroll
                for (int w = 0; w < 8; ++w) s += red[(w * 4 + b) * 64 + lane];
                mod[(size_t)(i * 4 + b) * 6144 + n0 + lane] = s + ada_b[i * 6144 + n0 + lane]; }
            __syncthreads();
        }
    }
    {
        LAS float* scr = (LAS float*)(lds + 32768 + wave * 8704);
        const int gw = vcu * NWAVES + wave, NGW = G * NWAVES;
        unsigned char* ws = a.ws;
        constexpr int I_CIN = 16 * 96, I_COUT = 16 * 32, I_PQ = 16 * 64, I_MIN = 16 * 22, I_QB = 6 * 48, I_KVB = 4 * 64, I_MOUT = 16 * 32;
        constexpr int NITEMS = I_CIN + I_COUT + 2 * I_PQ + I_MIN + I_QB + I_KVB + I_MOUT;
        for (int it = gw; it < NITEMS; it += NGW) {
            int r = it;
            if (r < I_CIN) { transpose_item((const float*)a.in[7], 1024, 3072, (bf16*)(ws + WS_WCIN), scr, r, lane); continue; } r -= I_CIN;
            if (r < I_COUT) { transpose_item((const float*)a.in[9], 1024, 1024, (bf16*)(ws + WS_WCOUT), scr, r, lane); continue; } r -= I_COUT;
            if (r < I_PQ) { transpose_item((const float*)a.in[18], 1024, 2048, (bf16*)(ws + WS_WPQ0), scr, r, lane); continue; } r -= I_PQ;
            if (r < I_PQ) { transpose_item((const float*)a.in[18] + (size_t)1024 * 2048, 1024, 2048, (bf16*)(ws + WS_WPQ1), scr, r, lane); continue; } r -= I_PQ;
            if (r < I_MIN) { transpose_item((const float*)a.in[10], 1024, MLA_IN, (bf16*)(ws + WS_WMIN), scr, r, lane); continue; } r -= I_MIN;
            if (r < I_QB) { transpose_item((const float*)a.in[13], 384, 1536, (bf16*)(ws + WS_WQB), scr, r, lane); continue; } r -= I_QB;
            if (r < I_KVB) { transpose_item((const float*)a.in[14], 256, 2048, (bf16*)(ws + WS_WKVB), scr, r, lane); continue; } r -= I_KVB;
            transpose_item((const float*)a.in[17], 1024, 1024, (bf16*)(ws + WS_WMOUT), scr, r, lane);
        }
        const size_t gt = (size_t)vcu * 512 + tid, GT = (size_t)G * 512;
        for (size_t i = gt; i < (size_t)(MLA_IN_PAD - MLA_IN) * 1024 / 8; i += GT) ((u32x4*)(ws + WS_WMIN + (size_t)MLA_IN * 1024 * 2))[i] = (u32x4){0u, 0u, 0u, 0u};
        cvt_f32_bf16((const float*)a.in[19], (bf16*)(ws + WS_SUBK), (size_t)2 * 8 * 2 * 128 * 128 / 8, gt, GT);
        cvt_f32_bf16((const float*)a.in[20], (bf16*)(ws + WS_PU), (size_t)2 * NEXP * 1024 / 8, gt, GT);
        cvt_f32_bf16((const float*)a.in[21], (bf16*)(ws + WS_PV), (size_t)2 * NEXP * 1024 / 8, gt, GT);
    }
}

DI void ph_modulate(const float* x, bf16* xn, const float* gain, const float* modl, int sh_off, int sc_off, int gw, int NGW, int lane) {
    for (int m = gw; m < MTOK; m += NGW) {
        const float* mb = modl + (size_t)(m >> 12) * 6144;
        const f32x4* xr = (const f32x4*)(x + (size_t)m * DM) + lane;
        f32x4 v[4]; float s = 0.f;
#pragma unroll
        for (int j = 0; j < 4; ++j) { v[j] = xr[64 * j]; s += (v[j].x * v[j].x + v[j].y * v[j].y) + (v[j].z * v[j].z + v[j].w * v[j].w); }
        const float rstd = rsqrtf(wave_sum(s) * (1.f / DM) + NORM_EPS);
        u32x2* o8 = (u32x2*)(xn + (size_t)m * DM) + lane;
#pragma unroll
        for (int j = 0; j < 4; ++j) {
            const f32x4 g = ((const f32x4*)gain)[lane + 64 * j], sh = ((const f32x4*)(mb + sh_off))[lane + 64 * j], sc = ((const f32x4*)(mb + sc_off))[lane + 64 * j];
            const f32x4 y = v[j] * rstd * g * (sc + 1.f) + sh;
            u32x2 w; w.x = pk2(y.x, y.y); w.y = pk2(y.z, y.w); o8[64 * j] = w; }
    }
}

DI void ph_conv(const bf16* bcv, const float* cw, bf16* z, size_t gt, size_t GT) {
    for (size_t it = gt; it < (size_t)MTOK * 128; it += GT) {
        const int t = (int)(it >> 7), ch = (int)(it & 127) * 8, s = t & (SEQ - 1);
        const bf16* row = bcv + (size_t)t * 3072 + ch;
        const u32x4 zero = (u32x4){0u, 0u, 0u, 0u};
        const u32x4 bq = *(const u32x4*)row;
        const u32x4 c0 = *(const u32x4*)(row + 1024), v0 = *(const u32x4*)(row + 2048);
        const u32x4 c1 = s >= 1 ? *(const u32x4*)(row - 3072 + 1024) : zero, v1 = s >= 1 ? *(const u32x4*)(row - 3072 + 2048) : zero;
        const u32x4 c2 = s >= 2 ? *(const u32x4*)(row - 6144 + 1024) : zero, v2 = s >= 2 ? *(const u32x4*)(row - 6144 + 2048) : zero;
        const f32x4 w0a = *(const f32x4*)(cw + ch), w0b = *(const f32x4*)(cw + ch + 4);
        const f32x4 w1a = *(const f32x4*)(cw + 1024 + ch), w1b = *(const f32x4*)(cw + 1024 + ch + 4);
        const f32x4 w2a = *(const f32x4*)(cw + 2048 + ch), w2b = *(const f32x4*)(cw + 2048 + ch + 4);
        float r[8];
#pragma unroll
        for (int e = 0; e < 4; ++e) {
            const float w0l = e < 2 ? w0a[2 * e] : w0b[2 * e - 4], w0h = e < 2 ? w0a[2 * e + 1] : w0b[2 * e - 3];
            const float w1l = e < 2 ? w1a[2 * e] : w1b[2 * e - 4], w1h = e < 2 ? w1a[2 * e + 1] : w1b[2 * e - 3];
            const float w2l = e < 2 ? w2a[2 * e] : w2b[2 * e - 4], w2h = e < 2 ? w2a[2 * e + 1] : w2b[2 * e - 3];
            const float ut_l = bflo(c0[e]) * bflo(v0[e]), ut_h = bfhi(c0[e]) * bfhi(v0[e]);
            const float u1_l = bflo(c1[e]) * bflo(v1[e]), u1_h = bfhi(c1[e]) * bfhi(v1[e]);
            const float u2_l = bflo(c2[e]) * bflo(v2[e]), u2_h = bfhi(c2[e]) * bfhi(v2[e]);
            r[2 * e] = bflo(bq[e]) * (w0l * u2_l + w1l * u1_l + w2l * ut_l);
            r[2 * e + 1] = bfhi(bq[e]) * (w0h * u2_h + w1h * u1_h + w2h * ut_h);
        }
        u32x4 o; o.x = pk2(r[0], r[1]); o.y = pk2(r[2], r[3]); o.z = pk2(r[4], r[5]); o.w = pk2(r[6], r[7]);
        *(u32x4*)(z + (size_t)t * DM + ch) = o;
    }
}

struct EpiResGate {
    static constexpr bool PERM = false, AFTER_DRAIN = false;
    const float* base; float* out; const float* gate;
    __device__ __forceinline__ void operator()(const pg8::f32x4 (&acc)[2][2][4][2], const pg8::Unit& u, int wr, int wc, int fr, int fq) const {
        const int row0 = u.pm * 256 + wr * 64 + fr, col0 = u.pn * 256 + wc * 32 + 4 * fq;
        const float* gp = gate + (size_t)(u.pm >> 4) * 6144 + col0;
        pg8::f32x4 gv[2][2];
#pragma unroll
        for (int bj = 0; bj < 2; ++bj)
#pragma unroll
            for (int n = 0; n < 2; ++n) gv[bj][n] = *(const pg8::f32x4*)(gp + bj * 128 + n * 16);
#pragma unroll
        for (int ai = 0; ai < 2; ++ai)
#pragma unroll
            for (int m = 0; m < 4; ++m) { const size_t off = (size_t)(row0 + ai * 128 + m * 16) * DM + col0;
#pragma unroll
                for (int bj = 0; bj < 2; ++bj)
#pragma unroll
                    for (int n = 0; n < 2; ++n) { const pg8::f32x4 bs = *(const pg8::f32x4*)(base + off + bj * 128 + n * 16);
                        *(pg8::f32x4*)(out + off + bj * 128 + n * 16) = bs + gv[bj][n] * acc[ai][bj][m][n]; } }
    }
};

DI unsigned f2key(float f) { const unsigned u = __float_as_uint(f); return u ^ ((unsigned)((int)u >> 31) | 0x80000000u); }
DI float key2f(unsigned k) { const unsigned u = (k & 0x80000000u) ? (k ^ 0x80000000u) : ~k; return __uint_as_float(u); }
DI unsigned umax_(unsigned a, unsigned b) { return a > b ? a : b; }
DI unsigned umin_(unsigned a, unsigned b) { return a < b ? a : b; }
template <int N> DI void bitonic_sort_desc(unsigned (&v)[N]) {
#pragma unroll
    for (int k = 2; k <= N; k <<= 1) {
#pragma unroll
        for (int j = k >> 1; j > 0; j >>= 1) {
#pragma unroll
            for (int i = 0; i < N; ++i) { const int l = i ^ j;
                if (l > i) { const bool desc = ((i & k) == 0); const unsigned x = v[i], y = v[l], mx = umax_(x, y), mn = umin_(x, y); v[i] = desc ? mx : mn; v[l] = desc ? mn : mx; } }
        }
    }
}
template <int N> DI void bitonic_merge_desc(unsigned (&v)[N]) {
#pragma unroll
    for (int j = N >> 1; j > 0; j >>= 1) {
#pragma unroll
        for (int i = 0; i < N; ++i) { const int l = i ^ j;
            if (l > i) { const unsigned x = v[i], y = v[l]; v[i] = umax_(x, y); v[l] = umin_(x, y); } }
    }
}
DI void top16_merge(unsigned (&t)[16], unsigned (&n)[16]) {
#pragma unroll
    for (int i = 0; i < 16; ++i) t[i] = umax_(t[i], n[15 - i]);
    bitonic_merge_desc<16>(t);
}

DI void topk_task(const bf16* PQ, const bf16* SK  , int* IDS, float* GATES, LAS unsigned short* tab  , int tok0, int h, int lane) {
    const int r32 = lane & 31, hi = lane >> 5;
    s16x8 qf[16];
    const bf16* qp = PQ + (size_t)(tok0 + r32) * 2048 + 256 * h + 8 * hi;
#pragma unroll
    for (int ks = 0; ks < 16; ++ks) qf[ks] = *(const s16x8*)(qp + 16 * ks);
    const int p = (r32 >> 2) & 1, keyl = (r32 & 3) + 4 * (r32 >> 3);
    const bf16* kp0 = SK + ((size_t)(h * 2 + p) * 128 + keyl) * 128 + 8 * hi;
    const s16x8 zero8 = (s16x8){0, 0, 0, 0, 0, 0, 0, 0};
    unsigned top[16];
#pragma unroll
    for (int i = 0; i < 16; ++i) top[i] = 0u;
#pragma unroll 1
    for (int rb = 0; rb < 8; ++rb) {
        const bf16* kp = kp0 + (size_t)rb * 16 * 128;
        f32x16 acc;
#pragma unroll
        for (int r = 0; r < 16; ++r) acc[r] = 0.f;
#pragma unroll
        for (int ks = 0; ks < 8; ++ks) {
            const s16x8 kf = *(const s16x8*)(kp + 16 * ks);
            const s16x8 a0 = p == 0 ? kf : zero8, a1 = p == 1 ? kf : zero8;
            acc = __builtin_amdgcn_mfma_f32_32x32x16_bf16(a0, qf[ks], acc, 0, 0, 0);
            acc = __builtin_amdgcn_mfma_f32_32x32x16_bf16(a1, qf[ks + 8], acc, 0, 0, 0);
        }
        unsigned nw[16];
#pragma unroll
        for (int r = 0; r < 16; ++r) nw[r] = (f2key(acc[r]) & ~127u) | (unsigned)(127 - (16 * rb + r));
        bitonic_sort_desc<16>(nw);
        top16_merge(top, nw);
    }
    unsigned LA[16], LB[16];
#pragma unroll
    for (int i = 0; i < 16; ++i) { const unsigned other = (unsigned)__shfl_xor((int)top[i], 32); LA[i] = hi ? other : top[i]; LB[i] = hi ? top[i] : other; }
#pragma unroll
    for (int i = 0; i < 16; ++i) { tab[i * 64 + lane] = (unsigned short)(127u - (LA[i] & 127u)); tab[(16 + i) * 64 + lane] = (unsigned short)(127u - (LB[i] & 127u)); }
    float av[16], bv[16];
#pragma unroll
    for (int i = 0; i < 16; ++i) { av[i] = key2f(LA[i] & ~127u); bv[i] = key2f(LB[i] & ~127u); }
    unsigned cg[4][16];
#pragma unroll
    for (int g = 0; g < 4; ++g)
#pragma unroll
        for (int e = 0; e < 16; ++e) cg[g][e] = 0u;
    {
        int cnt = 0;
#pragma unroll
        for (int i = 0; i < 16; ++i)
#pragma unroll
            for (int j = 0; j < 16; ++j)
                if ((i + 1) * (j + 1) <= 16) { cg[cnt >> 4][cnt & 15] = (f2key(av[i] + bv[j]) & ~255u) | (unsigned)(255 - (16 * i + j)); ++cnt; }
    }
    bitonic_sort_desc<16>(cg[0]); bitonic_sort_desc<16>(cg[1]); bitonic_sort_desc<16>(cg[2]); bitonic_sort_desc<16>(cg[3]);
    top16_merge(cg[0], cg[1]); top16_merge(cg[0], cg[2]); top16_merge(cg[0], cg[3]);
    LDS_WAIT(); asm volatile("" ::: "memory");
    float sv[16]; int ex[16];
#pragma unroll
    for (int k = 0; k < 16; ++k) { const unsigned key = cg[0][k]; const int pos = 255 - (int)(key & 255u); sv[k] = key2f(key & ~255u);
        const int ia = tab[(pos >> 4) * 64 + lane], ib = tab[(16 + (pos & 15)) * 64 + lane]; ex[k] = ia * 128 + ib; }
    LDS_WAIT(); asm volatile("" ::: "memory");
    const float mx = sv[0]; float sum = 0.f;
#pragma unroll
    for (int k = 0; k < 16; ++k) { sv[k] = expf(sv[k] - mx); sum += sv[k]; }
    const float inv = 1.f / sum;
    if (hi == 0) {
        int* ip = IDS + (size_t)(tok0 + r32) * 128 + h * 16; float* gp = GATES + (size_t)(tok0 + r32) * 128 + h * 16;
#pragma unroll
        for (int k = 0; k < 16; k += 4) { *(u32x4*)(ip + k) = (u32x4){(unsigned)ex[k], (unsigned)ex[k + 1], (unsigned)ex[k + 2], (unsigned)ex[k + 3]};
            *(f32x4*)(gp + k) = (f32x4){sv[k] * inv, sv[k + 1] * inv, sv[k + 2] * inv, sv[k + 3] * inv}; }
    }
}
DI void ph_topk(const bf16* PQ, const bf16* SK, int* IDS, float* GATES, LAS unsigned char* lds, int gw, int NGW, int wave, int lane) {
    LAS unsigned short* tab = (LAS unsigned short*)(lds + wave * 4096);
    for (int task = gw; task < (MTOK / 32) * 8; task += NGW) topk_task(PQ, SK, IDS, GATES, tab, (task >> 3) * 32, task & 7, lane);
}

DI float gelu_erf(float x) { return 0.5f * x * (1.f + erff(x * 0.70710678118654752f)); }
DI float dot16(const u32x4& ua, const u32x4& ub, const float (&hA)[8], const float (&hB)[8]) {
    float d = 0.f;
#pragma unroll
    for (int e = 0; e < 4; ++e) { d += bflo(ua[e]) * hA[2 * e] + bfhi(ua[e]) * hA[2 * e + 1]; d += bflo(ub[e]) * hB[2 * e] + bfhi(ub[e]) * hB[2 * e + 1]; }
    return d;
}
template <bool NEXT> DI void ph_peer(const bf16* U, const bf16* V, const int* IDS, const float* GATES, bf16* XN, float* X  ,
                                     const float* g2  , const float* ngain, const float* nmod  , int gw, int NGW, int lane) {
    for (int t = gw; t < MTOK; t += NGW) {
        const int b = t >> 12;
        float hA[8], hB[8];
        { const u32x4 xa = ((const u32x4*)(XN + (size_t)t * DM))[lane], xb = ((const u32x4*)(XN + (size_t)t * DM))[64 + lane];
#pragma unroll
          for (int e = 0; e < 4; ++e) { hA[2 * e] = bflo(xa[e]); hA[2 * e + 1] = bfhi(xa[e]); hB[2 * e] = bflo(xb[e]); hB[2 * e + 1] = bfhi(xb[e]); } }
        const int e_lo = IDS[(size_t)t * 128 + lane], e_hi = IDS[(size_t)t * 128 + 64 + lane];
        const float g_lo = GATES[(size_t)t * 128 + lane], g_hi = GATES[(size_t)t * 128 + 64 + lane];
        float act_lo = 0.f, act_hi = 0.f;
#pragma unroll 1
        for (int half = 0; half < 2; ++half) {
            const int ev = half ? e_hi : e_lo; const float gv = half ? g_hi : g_lo; float actv = 0.f;
#pragma unroll 1
            for (int j0 = 0; j0 < 64; j0 += 8) {
                u32x4 ua[8], ub[8];
#pragma unroll
                for (int q = 0; q < 8; ++q) { const int e = __builtin_amdgcn_readlane(ev, j0 + q); const u32x4* row = (const u32x4*)(U + (size_t)e * DM); ua[q] = row[lane]; ub[q] = row[64 + lane]; }
#pragma unroll
                for (int q = 0; q < 8; ++q) { const float d = wave_sum(dot16(ua[q], ub[q], hA, hB)); const float av = gelu_erf(d) * gv; if (lane == j0 + q) actv = av; }
            }
            if (half) act_hi = actv; else act_lo = actv;
        }
        float oA[8], oB[8];
#pragma unroll
        for (int e = 0; e < 8; ++e) { oA[e] = 0.f; oB[e] = 0.f; }
#pragma unroll 1
        for (int half = 0; half < 2; ++half) {
            const int ev = half ? e_hi : e_lo; const float actv = half ? act_hi : act_lo;
#pragma unroll 1
            for (int j0 = 0; j0 < 64; j0 += 8) {
                u32x4 va[8], vb[8];
#pragma unroll
                for (int q = 0; q < 8; ++q) { const int e = __builtin_amdgcn_readlane(ev, j0 + q); const u32x4* row = (const u32x4*)(V + (size_t)e * DM); va[q] = row[lane]; vb[q] = row[64 + lane]; }
#pragma unroll
                for (int q = 0; q < 8; ++q) { const float aw = __uint_as_float((unsigned)__builtin_amdgcn_readlane((int)__float_as_uint(actv), j0 + q));
#pragma unroll
                    for (int e = 0; e < 4; ++e) { oA[2 * e] += aw * bflo(va[q][e]); oA[2 * e + 1] += aw * bfhi(va[q][e]); oB[2 * e] += aw * bflo(vb[q][e]); oB[2 * e + 1] += aw * bfhi(vb[q][e]); } }
            }
        }
        float* xr = X + (size_t)t * DM; const float* gp = g2 + (size_t)b * 6144;
        f32x4 xa0 = *(const f32x4*)(xr + 8 * lane), xa1 = *(const f32x4*)(xr + 8 * lane + 4), xb0 = *(const f32x4*)(xr + 512 + 8 * lane), xb1 = *(const f32x4*)(xr + 512 + 8 * lane + 4);
        const f32x4 ga0 = *(const f32x4*)(gp + 8 * lane), ga1 = *(const f32x4*)(gp + 8 * lane + 4), gb0 = *(const f32x4*)(gp + 512 + 8 * lane), gb1 = *(const f32x4*)(gp + 512 + 8 * lane + 4);
        xa0 += ga0 * (f32x4){oA[0], oA[1], oA[2], oA[3]}; xa1 += ga1 * (f32x4){oA[4], oA[5], oA[6], oA[7]};
        xb0 += gb0 * (f32x4){oB[0], oB[1], oB[2], oB[3]}; xb1 += gb1 * (f32x4){oB[4], oB[5], oB[6], oB[7]};
        *(f32x4*)(xr + 8 * lane) = xa0; *(f32x4*)(xr + 8 * lane + 4) = xa1; *(f32x4*)(xr + 512 + 8 * lane) = xb0; *(f32x4*)(xr + 512 + 8 * lane + 4) = xb1;
        if (NEXT) {
            float s = (xa0.x * xa0.x + xa0.y * xa0.y) + (xa0.z * xa0.z + xa0.w * xa0.w) + (xa1.x * xa1.x + xa1.y * xa1.y) + (xa1.z * xa1.z + xa1.w * xa1.w)
                    + (xb0.x * xb0.x + xb0.y * xb0.y) + (xb0.z * xb0.z + xb0.w * xb0.w) + (xb1.x * xb1.x + xb1.y * xb1.y) + (xb1.z * xb1.z + xb1.w * xb1.w);
            const float rstd = rsqrtf(wave_sum(s) * (1.f / DM) + NORM_EPS);
            const float* mb = nmod + (size_t)b * 6144;
            f32x4 y[4]; const f32x4 xs[4] = {xa0, xa1, xb0, xb1};
#pragma unroll
            for (int q = 0; q < 4; ++q) { const int d0 = (q >> 1) * 512 + 8 * lane + (q & 1) * 4;
                const f32x4 g = *(const f32x4*)(ngain + d0), sh = *(const f32x4*)(mb + d0), sc = *(const f32x4*)(mb + 1024 + d0);
                y[q] = xs[q] * rstd * g * (sc + 1.f) + sh; }
            u32x4 wa, wb; wa.x = pk2(y[0].x, y[0].y); wa.y = pk2(y[0].z, y[0].w); wa.z = pk2(y[1].x, y[1].y); wa.w = pk2(y[1].z, y[1].w);
            wb.x = pk2(y[2].x, y[2].y); wb.y = pk2(y[2].z, y[2].w); wb.z = pk2(y[3].x, y[3].y); wb.w = pk2(y[3].z, y[3].w);
            ((u32x4*)(XN + (size_t)t * DM))[lane] = wa; ((u32x4*)(XN + (size_t)t * DM))[64 + lane] = wb;
        }
    }
}

DI void ph_latnorm(const bf16* LAT, const float* qg, const float* kvg, bf16* QN, bf16* KVN, int gw, int NGW, int lane) {
    for (int t = gw; t < MTOK; t += NGW) {
        const unsigned* lr = (const unsigned*)(LAT + (size_t)t * MLA_IN_PAD);
        unsigned q[3], k[2]; float sq = 0.f, sk = 0.f;
#pragma unroll
        for (int j = 0; j < 3; ++j) { q[j] = lr[lane + 64 * j]; sq += bflo(q[j]) * bflo(q[j]) + bfhi(q[j]) * bfhi(q[j]); }
#pragma unroll
        for (int j = 0; j < 2; ++j) { k[j] = lr[192 + lane + 64 * j]; sk += bflo(k[j]) * bflo(k[j]) + bfhi(k[j]) * bfhi(k[j]); }
        const float rq = rsqrtf(wave_sum(sq) * (1.f / QLORA) + NORM_EPS), rk = rsqrtf(wave_sum(sk) * (1.f / KVLORA) + NORM_EPS);
        unsigned* qo = (unsigned*)(QN + (size_t)t * QLORA); unsigned* ko = (unsigned*)(KVN + (size_t)t * KVLORA);
#pragma unroll
        for (int j = 0; j < 3; ++j) { const int c = 2 * (lane + 64 * j); qo[lane + 64 * j] = pk2(bflo(q[j]) * rq * qg[c], bfhi(q[j]) * rq * qg[c + 1]); }
#pragma unroll
        for (int j = 0; j < 2; ++j) { const int c = 2 * (lane + 64 * j); ko[lane + 64 * j] = pk2(bflo(k[j]) * rk * kvg[c], bfhi(k[j]) * rk * kvg[c + 1]); }
    }
}

DI void ph_qkprep(const bf16* QRAW, const bf16* KVRAW, const bf16* LAT, const int* positions, const float* qg, const float* kg,
                  bf16* Qf, bf16* Kf, bf16* Vt, int gw, int NGW, int lane) {
    const int f = lane & 31;
    const float invf = exp2f(-(float)f * (13.287712379549449f / 32.f));
    const float qg0 = qg[lane], qg1 = qg[64 + lane], qg2 = qg[128 + lane], kg0 = kg[lane], kg1 = kg[64 + lane], kg2 = kg[128 + lane];
    for (int task = gw; task < MTOK / 8; task += NGW) {
        const int t0 = task * 8, b = t0 >> 12, s0 = t0 & (SEQ - 1);
#pragma unroll 1
        for (int tt = 0; tt < 8; ++tt) {
            const int t = t0 + tt, s = s0 + tt;
            const float ang = (float)positions[t] * invf;
            double rev = (double)ang * 0.15915494309189535; rev -= floor(rev);
            const float rv = (float)rev, sn = __builtin_amdgcn_sinf(rv), cs = __builtin_amdgcn_cosf(rv);
            const float kr = bf1(LAT[(size_t)t * MLA_IN_PAD + 640 + lane]);
#pragma unroll 1
            for (int h = 0; h < NH; ++h) {
                { const bf16* qp = QRAW + (size_t)t * 1536 + QKH * h;
                  const float x0 = bf1(qp[lane]), x1 = bf1(qp[64 + lane]), x2 = bf1(qp[128 + lane]);
                  const float rstd = rsqrtf(wave_sum(x0 * x0 + x1 * x1 + x2 * x2) * (1.f / QKH) + NORM_EPS);
                  const float y0 = x0 * rstd * qg0, y1 = x1 * rstd * qg1, y2 = x2 * rstd * qg2, pr = __shfl_xor(y2, 32);
                  const float r2 = lane < 32 ? y2 * cs - pr * sn : pr * sn + y2 * cs;
                  bf16* o = Qf + ((size_t)(b * NH + h) * SEQ + s) * QKH;
                  o[lane] = (bf16)f2bf(y0 * QSCALE); o[64 + lane] = (bf16)f2bf(y1 * QSCALE); o[128 + lane] = (bf16)f2bf(r2 * QSCALE); }
                { const bf16* kp = KVRAW + (size_t)t * 2048 + 256 * h;
                  const float x0 = bf1(kp[lane]), x1 = bf1(kp[64 + lane]), x2 = kr;
                  const float rstd = rsqrtf(wave_sum(x0 * x0 + x1 * x1 + x2 * x2) * (1.f / QKH) + NORM_EPS);
                  const float y0 = x0 * rstd * kg0, y1 = x1 * rstd * kg1, y2 = x2 * rstd * kg2, pr = __shfl_xor(y2, 32);
                  const float r2 = lane < 32 ? y2 * cs - pr * sn : pr * sn + y2 * cs;
                  bf16* o = Kf + ((size_t)(b * NH + h) * SEQ + s) * QKH;
                  o[lane] = (bf16)f2bf(y0); o[64 + lane] = (bf16)f2bf(y1); o[128 + lane] = (bf16)f2bf(r2); }
            }
        }
#pragma unroll 1
        for (int h = 0; h < NH; ++h)
#pragma unroll
            for (int dd = 0; dd < 128; dd += 64) {
                const bf16* vp = KVRAW + (size_t)t0 * 2048 + 256 * h + 128 + dd + lane;
                unsigned w[4];
#pragma unroll
                for (int i = 0; i < 4; ++i) w[i] = (unsigned)vp[(size_t)(2 * i) * 2048] | ((unsigned)vp[(size_t)(2 * i + 1) * 2048] << 16);
                *(u32x4*)(Vt + ((size_t)(b * NH + h) * VH + dd + lane) * SEQ + s0) = (u32x4){w[0], w[1], w[2], w[3]};
            }
    }
}

typedef float f32x2_t __attribute__((ext_vector_type(2))); typedef __bf16 bf16x2_t __attribute__((ext_vector_type(2)));
DI unsigned cvtpk(float lo, float hi) { f32x2_t v = {lo, hi}; bf16x2_t b = __builtin_convertvector(v, bf16x2_t); return __builtin_bit_cast(unsigned, b); }
DI void attn_unit(const bf16* Qf, const bf16* Kf, const bf16* Vt, bf16* O, int bh, int qb, int wave, int lane) {
    const int r32 = lane & 31, hi = lane >> 5;
    const int q0 = qb * 256 + wave * 32;
    s16x8 qf[12];
    { const bf16* Qp = Qf + ((size_t)bh * SEQ + q0 + r32) * QKH + 8 * hi;
#pragma unroll
      for (int ks = 0; ks < 12; ++ks) qf[ks] = *(const s16x8*)(Qp + 16 * ks); }
    f32x16 o[4];
#pragma unroll
    for (int d = 0; d < 4; ++d)
#pragma unroll
        for (int r = 0; r < 16; ++r) o[d][r] = 0.f;
    float m = -1e30f, l = 0.f;
    const bf16* Kp = Kf + ((size_t)bh * SEQ + r32) * QKH + 8 * hi;
    const bf16* Vp = Vt + ((size_t)bh * VH + r32) * SEQ + 4 * hi;
    const int nkt = q0 / 32 + 1;
#pragma unroll 1
    for (int kt = 0; kt < nkt; ++kt) {
        f32x16 sc;
#pragma unroll
        for (int r = 0; r < 16; ++r) sc[r] = 0.f;
        const bf16* kp = Kp + (size_t)kt * 32 * QKH;
#pragma unroll
        for (int ks = 0; ks < 12; ++ks) sc = __builtin_amdgcn_mfma_f32_32x32x16_bf16(*(const s16x8*)(kp + 16 * ks), qf[ks], sc, 0, 0, 0);
        if (kt == nkt - 1) {
#pragma unroll
            for (int r = 0; r < 16; ++r) if (crow(r, hi) > r32) sc[r] = -INFINITY;
        }
        float mt = sc[0];
#pragma unroll
        for (int r = 1; r < 16; ++r) mt = fmaxf(mt, sc[r]);
        mt = fmaxf(mt, __shfl_xor(mt, 32));
        const float mn = fmaxf(m, mt), alpha = __builtin_amdgcn_exp2f(m - mn);
        m = mn; l *= alpha;
#pragma unroll
        for (int d = 0; d < 4; ++d)
#pragma unroll
            for (int r = 0; r < 16; ++r) o[d][r] *= alpha;
        float ps = 0.f;
#pragma unroll
        for (int r = 0; r < 16; ++r) { sc[r] = __builtin_amdgcn_exp2f(sc[r] - mn); ps += sc[r]; }
        l += ps;
#pragma unroll
        for (int s = 0; s < 2; ++s) {
            u32x4 pw; pw.x = cvtpk(sc[8 * s], sc[8 * s + 1]); pw.y = cvtpk(sc[8 * s + 2], sc[8 * s + 3]); pw.z = cvtpk(sc[8 * s + 4], sc[8 * s + 5]); pw.w = cvtpk(sc[8 * s + 6], sc[8 * s + 7]);
            const s16x8 pb = __builtin_bit_cast(s16x8, pw);
#pragma unroll
            for (int d = 0; d < 4; ++d) {
                const bf16* vp = Vp + (size_t)d * 32 * SEQ + kt * 32 + 16 * s;
                const s16x4 lo = *(const s16x4*)vp, hh = *(const s16x4*)(vp + 8);
                const s16x8 va = __builtin_shufflevector(lo, hh, 0, 1, 2, 3, 4, 5, 6, 7);
                o[d] = __builtin_amdgcn_mfma_f32_32x32x16_bf16(va, pb, o[d], 0, 0, 0);
            }
        }
    }
    l += __shfl_xor(l, 32);
    const float inv = 1.f / l;
    bf16* Op = O + ((size_t)((bh >> 3) * SEQ + q0 + r32)) * DM + (bh & 7) * VH + 4 * hi;
#pragma unroll
    for (int d = 0; d < 4; ++d)
#pragma unroll
        for (int g = 0; g < 4; ++g) { u32x2 w; w.x = cvtpk(o[d][4 * g] * inv, o[d][4 * g + 1] * inv); w.y = cvtpk(o[d][4 * g + 2] * inv, o[d][4 * g + 3] * inv);
            *(u32x2*)(Op + 32 * d + 8 * g) = w; }
}
DI void ph_attn(const bf16* Qf, const bf16* Kf, const bf16* Vt, bf16* O, int vcu, int G, int wave, int lane) {
    for (int p = vcu; p < 256; p += G) {
        const int bh = p >> 3, s8 = p & 7;
        attn_unit(Qf, Kf, Vt, O, bh, 15 - s8, wave, lane);
        attn_unit(Qf, Kf, Vt, O, bh, s8, wave, lane);
    }
}

__global__ void __launch_bounds__(NWAVES * 64, 2) mk_fwd(Args args) {
    extern __shared__ __attribute__((aligned(16))) unsigned char lds_raw[];
    LAS unsigned char* lds = (LAS unsigned char*)lds_raw;
    const int tid = threadIdx.x, lane = tid & 63, wave = __builtin_amdgcn_readfirstlane(tid >> 6);
    const int G = gridDim.x, bx = blockIdx.x, vcu = (G % 8 == 0) ? (bx % 8) * (G / 8) + bx / 8 : bx;
    const int gw = vcu * NWAVES + wave, NGW = G * NWAVES;
    const size_t gt = (size_t)vcu * 512 + tid, GT = (size_t)G * 512;
    unsigned char* ws = args.ws;
    for (int u = tid; u < (LDS_BYTES - LDSCTL_OFF) / 4; u += NWAVES * 64) ((LAS unsigned*)(lds + LDSCTL_OFF))[u] = 0u;
    __syncthreads();
    const bool multi = (args.ph_hi - args.ph_lo) > 1;
    XcdBarrier bar; bar.bar = (unsigned*)(ws + WS_CTL) + CW_BAR; bar.x = 0; bar.st = (volatile LAS unsigned*)(lds + MISC_OFF) + 8;
    if (multi) bar = xcd_barrier_post((unsigned*)(ws + WS_CTL) + CW_BAR, (volatile LAS unsigned*)(lds + MISC_OFF) + 8);

    float* X = args.out;
    const float* mod = (const float*)(ws + WS_MOD);
    bf16* XN = (bf16*)(ws + WS_XN);

    const int lo = args.ph_lo, hi = args.ph_hi;
#define IN(k) (EN(k) && lo <= (k) && (k) < hi)
#define SEAM(k) do { if (lo <= (k) && (k) + 1 < hi) xcd_barrier(bar); } while (0)
#define GEMM_BF16(Aptr, Bptr, NN, KK, Optr, LDC) do { pg8::Gemm g{(const bf16*)(Aptr), (const bf16*)(Bptr), MTOK, (NN), (KK)}; pg8::StaticOrder S; S.init(MTOK, (NN), G, bx); \
        pg8::EpiBf16<0> E{(bf16*)(Optr), (LDC), nullptr, 0, 0, 1.f}; pg8::gemm_phase<pg8::EpiBf16<0>, pg8::StaticOrder, true, true>(lds, g, S, E); } while (0)
#define GEMM_RES(Aptr, Bptr, BASE, GATE) do { pg8::Gemm g{(const bf16*)(Aptr), (const bf16*)(Bptr), MTOK, DM, DM}; pg8::StaticOrder S; S.init(MTOK, DM, G, bx); \
        EpiResGate E{(BASE), X, (GATE)}; pg8::gemm_phase<EpiResGate, pg8::StaticOrder, true, true>(lds, g, S, E); } while (0)

    if (IN(0)) ph_prologue(args, lds, tid, lane, wave, vcu, G);
    SEAM(0);
    if (IN(1)) ph_modulate((const float*)args.in[0], XN, (const float*)args.in[3], mod, 0, 1024, gw, NGW, lane);
    SEAM(1);
    if (IN(2)) GEMM_BF16(XN, ws + WS_WCIN, 3072, 1024, ws + WS_BCV, 3072);
    SEAM(2);
    if (IN(3)) ph_conv((const bf16*)(ws + WS_BCV), (const float*)args.in[8], (bf16*)(ws + WS_Z), gt, GT);
    SEAM(3);
    if (IN(4)) GEMM_RES(ws + WS_Z, ws + WS_WCOUT, (const float*)args.in[0], mod + 2048);
    SEAM(4);
    if (IN(5)) ph_modulate(X, XN, (const float*)args.in[4], mod, 3072, 4096, gw, NGW, lane);
    SEAM(5);
    if (IN(6)) GEMM_BF16(XN, ws + WS_WPQ0, 2048, 1024, ws + WS_PQ, 2048);
    SEAM(6);
    if (IN(7)) ph_topk((const bf16*)(ws + WS_PQ), (const bf16*)(ws + WS_SUBK), (int*)(ws + WS_IDS), (float*)(ws + WS_GATES), lds, gw, NGW, wave, lane);
    SEAM(7);
    if (IN(8)) ph_peer<true>((const bf16*)(ws + WS_PU), (const bf16*)(ws + WS_PV), (const int*)(ws + WS_IDS), (const float*)(ws + WS_GATES), XN, X,
                             mod + 5120, (const float*)args.in[3] + DM, mod + (size_t)4 * 6144, gw, NGW, lane);
    SEAM(8);
    if (IN(9)) GEMM_BF16(XN, ws + WS_WMIN, MLA_IN_PAD, 1024, ws + WS_LAT, MLA_IN_PAD);
    SEAM(9);
    if (IN(10)) ph_latnorm((const bf16*)(ws + WS_LAT), (const float*)args.in[11], (const float*)args.in[12], (bf16*)(ws + WS_QN), (bf16*)(ws + WS_KVN), gw, NGW, lane);
    SEAM(10);
    if (IN(11)) { GEMM_BF16(ws + WS_QN, ws + WS_WQB, 1536, QLORA, ws + WS_QRAW, 1536); GEMM_BF16(ws + WS_KVN, ws + WS_WKVB, 2048, KVLORA, ws + WS_KVRAW, 2048); }
    SEAM(11);
    if (IN(12)) ph_qkprep((const bf16*)(ws + WS_QRAW), (const bf16*)(ws + WS_KVRAW), (const bf16*)(ws + WS_LAT), (const int*)args.in[2], (const float*)args.in[15], (const float*)args.in[16],
                          (bf16*)(ws + WS_QF), (bf16*)(ws + WS_KF), (bf16*)(ws + WS_VT), gw, NGW, lane);
    SEAM(12);
    if (IN(13)) ph_attn((const bf16*)(ws + WS_QF), (const bf16*)(ws + WS_KF), (const bf16*)(ws + WS_VT), (bf16*)(ws + WS_O), vcu, G, wave, lane);
    SEAM(13);
    if (IN(14)) GEMM_RES(ws + WS_O, ws + WS_WMOUT, (const float*)X, mod + (size_t)4 * 6144 + 2048);
    SEAM(14);
    if (IN(15)) ph_modulate(X, XN, (const float*)args.in[4] + DM, mod + (size_t)4 * 6144, 3072, 4096, gw, NGW, lane);
    SEAM(15);
    if (IN(16)) GEMM_BF16(XN, ws + WS_WPQ1, 2048, 1024, ws + WS_PQ, 2048);
    SEAM(16);
    if (IN(17)) ph_topk((const bf16*)(ws + WS_PQ), (const bf16*)(ws + WS_SUBK) + (size_t)8 * 2 * 128 * 128, (int*)(ws + WS_IDS), (float*)(ws + WS_GATES), lds, gw, NGW, wave, lane);
    SEAM(17);
    if (IN(18)) ph_peer<false>((const bf16*)(ws + WS_PU) + (size_t)NEXP * DM, (const bf16*)(ws + WS_PV) + (size_t)NEXP * DM, (const int*)(ws + WS_IDS), (const float*)(ws + WS_GATES), XN, X,
                               mod + (size_t)4 * 6144 + 5120, nullptr, nullptr, gw, NGW, lane);
}

extern "C" void kernel_launch(void* const* d_in, const int* in_sizes, int n_in, void* d_out, int out_size, void* d_ws, size_t ws_size, hipStream_t stream) {
    static int grid = 0;
    if (grid == 0) {
        if (n_in != 22 || out_size != MTOK * DM || ws_size < WS_END) { fprintf(stderr, "kernel_launch: unexpected shapes: n_in %d out %d ws %zu (need %zu)\n", n_in, out_size, ws_size, (size_t)WS_END); grid = -1; return; }
        int dev = 0, cus = 0;
        if (hipGetDevice(&dev) != hipSuccess || hipDeviceGetAttribute(&cus, hipDeviceAttributeMultiprocessorCount, dev) != hipSuccess) { grid = -1; return; }
        if (hipFuncSetAttribute((const void*)mk_fwd, hipFuncAttributeMaxDynamicSharedMemorySize, LDS_BYTES) != hipSuccess) { fprintf(stderr, "kernel_launch: hipFuncSetAttribute failed\n"); grid = -1; return; }
        int per_cu = 0;
        if (hipOccupancyMaxActiveBlocksPerMultiprocessor(&per_cu, (const void*)mk_fwd, NWAVES * 64, LDS_BYTES) != hipSuccess || per_cu < 1) fprintf(stderr, "kernel_launch: occupancy query says %d\n", per_cu);
        (void)hipGetLastError();
        grid = cus;
    }
    if (grid < 0) return;
    (void)hipMemsetAsync((char*)d_ws + WS_CTL, 0, CTL_ZERO_BYTES, stream);
    Args a{};
    for (int i = 0; i < 22; ++i) a.in[i] = d_in[i];
    a.out = (float*)d_out; a.ws = (unsigned char*)d_ws;
#if MK_N_LAUNCHES == 1
    a.ph_lo = 0; a.ph_hi = NPHASES;
    hipLaunchKernelGGL(mk_fwd, dim3(grid), dim3(NWAVES * 64), LDS_BYTES, stream, a);
#else
    for (int ph = 0; ph < NPHASES; ++ph) { a.ph_lo = ph; a.ph_hi = ph + 1; hipLaunchKernelGGL(mk_fwd, dim3(grid), dim3(NWAVES * 64), LDS_BYTES, stream, a); }
#endif
}
```

```cpp
#include <hip/hip_runtime.h>
#include <cstdio>
#include <cstdint>
#define GAS __attribute__((address_space(1)))
#define LAS __attribute__((address_space(3)))
namespace pg8 {
#define PG8_LAS __attribute__((address_space(3)))
typedef unsigned short bf16_t;
typedef short bf16x8 __attribute__((ext_vector_type(8)));
typedef float f32x4 __attribute__((ext_vector_type(4)));
typedef unsigned u32x4 __attribute__((ext_vector_type(4)));
constexpr int BM = 256, BK = 64, HALF = 128, HTB = HALF * BK * 2  , STAGE_BYTES = 8 * HTB, NXCD = 8, WGM = 8;

__host__ __device__ __forceinline__ int lds_byte(int r, int c) { const int st = (r >> 4) * 2 + (c >> 5), rr = r & 15, cc = c & 31, ob = rr * 64 + cc * 2; return st * 1024 + (ob ^ (((ob >> 9) & 1) << 5)); }
__host__ __device__ __forceinline__ void stage_rc(int b, int& R, int& C) { const int st = b / 1024, sb = b % 1024, swz = sb ^ (((sb >> 9) & 1) << 5); R = (st >> 1) * 16 + swz / 64; C = (st & 1) * 32 + (swz % 64) / 2; }
__host__ __device__ __forceinline__ int perm32(int rho) { const int n = rho >> 4, i = rho & 15; return 8 * (i >> 2) + 4 * n + (i & 3); }

struct Unit { int pm, pn; };
struct Gemm { const bf16_t* A; const bf16_t* Bt; int M, N, K; };

struct StaticOrder {
    int nM, nN, nwg, G, c;
    __host__ __device__ void init(int M, int N, int G_, int c_) { nM = M / BM; nN = N / BM; nwg = nM * nN; G = G_; c = c_; }
    __host__ __device__ bool next(int i, Unit& u) const {
        const long L = (long)i * G + c; if (L >= nwg) return false;
        int wgid = (int)L; { const int q = nwg / NXCD, r = nwg % NXCD, xcd = wgid % NXCD, off = wgid / NXCD; wgid = (xcd < r ? xcd * (q + 1) : r * (q + 1) + (xcd - r) * q) + off; }
        const int nig = WGM * nN, gid = wgid / nig, fm = gid * WGM, gsz = (nM - fm) < WGM ? (nM - fm) : WGM;
        u.pm = fm + ((wgid % nig) % gsz); u.pn = (wgid % nig) / gsz; return true;
    }
    __device__ __forceinline__ void a_ready(const Unit&) const {}
    __device__ __forceinline__ void done(const Unit&) const {}
};

__device__ __forceinline__ unsigned cvt_pk_bf16(float lo, float hi) { unsigned r; asm volatile("v_cvt_pk_bf16_f32 %0, %1, %2" : "=v"(r) : "v"(lo), "v"(hi)); return r; }
typedef float f32x2 __attribute__((ext_vector_type(2)));
__device__ __forceinline__ f32x2 gelu_pk(f32x2 v) {
    const f32x2 av = __builtin_elementwise_abs(v), d = av * 0.2316418882f + 1.0f;
    f32x2 t; t.x = __builtin_amdgcn_rcpf(d.x); t.y = __builtin_amdgcn_rcpf(d.y);
    f32x2 q = t * 0.5307027145f + (-0.7265760135f); q = q * t + 0.7107068705f; q = q * t + (-0.142248368f); q = q * t + 0.127414796f; q = q * t;
    const f32x2 s = (v * v) * (-0.72134752044f);
    f32x2 e; e.x = __builtin_amdgcn_exp2f(s.x); e.y = __builtin_amdgcn_exp2f(s.y);
    const f32x2 m = v * (q * e), r = v - m;
    f32x2 o; o.x = v.x < 0.f ? m.x : r.x; o.y = v.y < 0.f ? m.y : r.y; return o;
}

template <int ACT  > struct EpiBf16 {
    static constexpr bool PERM = true, AFTER_DRAIN = false; static_assert(ACT == 0 || ACT == 1, "EpiBf16: ACT is 0 (none) or 1 (gelu_pk)");
    bf16_t* O; int ldc; const float* bias; int split_cols; size_t split_stride; float scale0;
    __device__ __forceinline__ void operator()(const f32x4 (&acc)[2][2][4][2], const Unit& u, int wr, int wc, int fr, int fq) const {
        const int row0 = u.pm * BM + wr * 64 + fr; int colt = u.pn * BM; bf16_t* base = O;
        float sc = 1.f; if (split_cols) { const int t = colt / split_cols; base += (size_t)t * split_stride; colt -= t * split_cols; if (t == 0) sc = scale0; }
        const int col0 = colt + wc * 32 + 8 * fq, bcol0 = u.pn * BM + wc * 32 + 8 * fq;
        f32x4 bv[2][2];
#pragma unroll
        for (int bj = 0; bj < 2; ++bj)
#pragma unroll
            for (int n = 0; n < 2; ++n) bv[bj][n] = bias ? *(const f32x4*)(bias + bcol0 + bj * HALF + 4 * n) : (f32x4){0.f, 0.f, 0.f, 0.f};
#pragma unroll
        for (int ai = 0; ai < 2; ++ai)
#pragma unroll
            for (int m = 0; m < 4; ++m) { bf16_t* rowp = base + (size_t)(row0 + ai * HALF + m * 16) * ldc + col0;
#pragma unroll
                for (int bj = 0; bj < 2; ++bj) { f32x4 v0 = acc[ai][bj][m][0] + bv[bj][0], v1 = acc[ai][bj][m][1] + bv[bj][1];
                    if (ACT == 1) { f32x2 a = gelu_pk((f32x2){v0[0], v0[1]}), b = gelu_pk((f32x2){v0[2], v0[3]}), c = gelu_pk((f32x2){v1[0], v1[1]}), d = gelu_pk((f32x2){v1[2], v1[3]});
                        v0 = (f32x4){a.x, a.y, b.x, b.y}; v1 = (f32x4){c.x, c.y, d.x, d.y}; }
                    v0 = v0 * sc; v1 = v1 * sc; u32x4 w; w.x = cvt_pk_bf16(v0[0], v0[1]); w.y = cvt_pk_bf16(v0[2], v0[3]); w.z = cvt_pk_bf16(v1[0], v1[1]); w.w = cvt_pk_bf16(v1[2], v1[3]);
                    *(u32x4*)(rowp + bj * HALF) = w; } }
    }
};

template <class Epi, class Sched, bool ALIGN_EPI = false, bool SP2 = false>
__device__ __forceinline__ void gemm_phase(PG8_LAS unsigned char* lds, const Gemm g, const Sched& S, const Epi& E) {
    int tid_raw = threadIdx.x; asm volatile("" : "+v"(tid_raw));
    const int tid = tid_raw, wid = __builtin_amdgcn_readfirstlane(tid >> 6), lane = tid & 63, wr = wid >> 2, wc = wid & 3, fr = lane & 15, fq = lane >> 4;
    const int K = g.K, nt = K / BK;
    unsigned voffA[2], voffB[2];
#pragma unroll
    for (int i = 0; i < 2; ++i) { int R, C; stage_rc(tid * 16 + i * 8192, R, C); const int Rb = Epi::PERM ? ((R & ~31) + perm32(R & 31)) : R;
        voffA[i] = (unsigned)(R * K + C) * 2u; voffB[i] = (unsigned)(Rb * K + C) * 2u; }
    const size_t kstep = (size_t)(BK * 2);
    const size_t hstep = (size_t)HALF * K * 2;
    const size_t tstep = 2 * hstep;
    const unsigned ldsw = (unsigned)wid * 1024u;
    const int aoff = lds_byte(wr * 64 + fr, fq * 8), boff = lds_byte(wc * 32 + fr, fq * 8);
#define PG8_SA(b, h) (((b) * 2 + (h)) * HTB)
#define PG8_SB(b, h) ((4 + (b) * 2 + (h)) * HTB)
#define PG8_STAGE(bufoff, gbase, voff) do { _Pragma("unroll") for (int _i = 0; _i < 2; ++_i) \
        __builtin_amdgcn_global_load_lds((const unsigned*)((const char*)(gbase) + (voff)[_i]), (PG8_LAS unsigned*)(lds + (bufoff) + ldsw + _i * 8192), 16, 0, 0); } while (0)
#define PG8_LDA(dst, b, h) do { _Pragma("unroll") for (int m = 0; m < 4; ++m) _Pragma("unroll") for (int k = 0; k < 2; ++k) dst[m][k] = *(const PG8_LAS bf16x8*)(lds + PG8_SA(b, h) + aoff + m * 2048 + k * 1024); } while (0)
#define PG8_LDB(dst, b, h) do { _Pragma("unroll") for (int n = 0; n < 2; ++n) _Pragma("unroll") for (int k = 0; k < 2; ++k) dst[n][k] = *(const PG8_LAS bf16x8*)(lds + PG8_SB(b, h) + boff + n * 2048 + k * 1024); } while (0)
#define PG8_MMA(ai, bj, At, Bt) do { __builtin_amdgcn_s_setprio(1); _Pragma("unroll") for (int m = 0; m < 4; ++m) _Pragma("unroll") for (int n = 0; n < 2; ++n) _Pragma("unroll") for (int k = 0; k < 2; ++k) \
        acc[ai][bj][m][n] = __builtin_amdgcn_mfma_f32_16x16x32_bf16(Bt[n][k], At[m][k], acc[ai][bj][m][n], 0, 0, 0); __builtin_amdgcn_s_setprio(0); } while (0)
#define PG8_WAIT_V(n) asm volatile("s_waitcnt vmcnt(" #n ")" ::: "memory")
#define PG8_WAIT_L(n) asm volatile("s_waitcnt lgkmcnt(" #n ")" ::: "memory")
#define PG8_BAR __builtin_amdgcn_s_barrier()
#define PG8_SCHED __builtin_amdgcn_sched_barrier(0)
    Unit cur, nxt; int ui = 0;
    if (!S.next(0, cur)) return;
    f32x4 acc[2][2][4][2];
#pragma unroll
    for (int a = 0; a < 2; ++a)
#pragma unroll
        for (int b = 0; b < 2; ++b)
#pragma unroll
            for (int m = 0; m < 4; ++m)
#pragma unroll
                for (int n = 0; n < 2; ++n) acc[a][b][m][n] = (f32x4){0.f, 0.f, 0.f, 0.f};
    bf16x8 At[4][2], B0[2][2], B1[2][2];
    const char* cA = (const char*)g.A + (size_t)cur.pm * tstep; const char* cB = (const char*)g.Bt + (size_t)cur.pn * tstep;
    S.a_ready(cur);
    if constexpr (SP2) {
        PG8_STAGE(PG8_SB(0, 0), cB, voffB); PG8_STAGE(PG8_SB(0, 1), cB + hstep, voffB); PG8_STAGE(PG8_SA(0, 0), cA, voffA); PG8_STAGE(PG8_SA(0, 1), cA + hstep, voffA);
        if (wr == 1) PG8_BAR;
        PG8_WAIT_V(2); PG8_BAR;
        PG8_STAGE(PG8_SB(1, 0), cB + kstep, voffB); PG8_STAGE(PG8_SA(1, 0), cA + kstep, voffA); PG8_STAGE(PG8_SB(1, 1), cB + hstep + kstep, voffB);
        PG8_WAIT_V(6); PG8_BAR;
    } else {
        PG8_STAGE(PG8_SB(0, 0), cB, voffB); PG8_STAGE(PG8_SA(0, 0), cA, voffA); PG8_STAGE(PG8_SB(0, 1), cB + hstep, voffB); PG8_STAGE(PG8_SA(0, 1), cA + hstep, voffA);
        if (wr == 1) PG8_BAR;
        PG8_WAIT_V(4); PG8_BAR;
        PG8_STAGE(PG8_SB(1, 0), cB + kstep, voffB); PG8_STAGE(PG8_SA(1, 0), cA + kstep, voffA); PG8_STAGE(PG8_SB(1, 1), cB + hstep + kstep, voffB);
        PG8_WAIT_V(6); PG8_BAR;
    }
    for (;;) {
        const bool has_next = S.next(ui + 1, nxt);
        const char* nA = has_next ? (const char*)g.A + (size_t)nxt.pm * tstep : cA; const char* nB = has_next ? (const char*)g.Bt + (size_t)nxt.pn * tstep : cB;
        for (int t = 0; t < nt; t += 2) {
            const bool last = (t == nt - 2);
            const char* a1 = cA + (size_t)(t + 1) * kstep;
            const char* a2 = last ? nA : cA + (size_t)(t + 2) * kstep; const char* b2 = last ? nB : cB + (size_t)(t + 2) * kstep;
            const char* a3 = a2 + kstep; const char* b3 = b2 + kstep;
            if (last && has_next) S.a_ready(nxt);
            if constexpr (SP2) {
            PG8_LDB(B0, 0, 0); PG8_LDB(B1, 0, 1); PG8_SCHED; PG8_LDA(At, 0, 0); PG8_STAGE(PG8_SA(1, 1), a1 + hstep, voffA);
            PG8_WAIT_V(8); PG8_WAIT_L(0); PG8_BAR; PG8_MMA(0, 0, At, B0); PG8_MMA(0, 1, At, B1); PG8_BAR; PG8_SCHED;
            PG8_LDA(At, 0, 1); PG8_STAGE(PG8_SB(0, 0), b2, voffB); PG8_STAGE(PG8_SB(0, 1), b2 + hstep, voffB); PG8_STAGE(PG8_SA(0, 0), a2, voffA);
            PG8_WAIT_V(8); PG8_WAIT_L(0); PG8_BAR; PG8_MMA(1, 0, At, B0); PG8_MMA(1, 1, At, B1); PG8_BAR; PG8_SCHED;
            PG8_LDB(B0, 1, 0); PG8_LDB(B1, 1, 1); PG8_SCHED; PG8_LDA(At, 1, 0); PG8_STAGE(PG8_SA(0, 1), a2 + hstep, voffA);
            PG8_WAIT_V(8); PG8_WAIT_L(0); PG8_BAR; PG8_MMA(0, 0, At, B0); PG8_MMA(0, 1, At, B1); PG8_BAR; PG8_SCHED;
            PG8_LDA(At, 1, 1); PG8_STAGE(PG8_SB(1, 0), b3, voffB); PG8_STAGE(PG8_SB(1, 1), b3 + hstep, voffB); PG8_STAGE(PG8_SA(1, 0), a3, voffA);
            PG8_WAIT_V(8); PG8_WAIT_L(0); PG8_BAR; PG8_MMA(1, 0, At, B0); PG8_MMA(1, 1, At, B1); PG8_BAR; PG8_SCHED;
            } else {
            PG8_LDB(B0, 0, 0); PG8_SCHED; PG8_LDA(At, 0, 0); PG8_STAGE(PG8_SA(1, 1), a1 + hstep, voffA);
            PG8_WAIT_L(8); PG8_BAR; PG8_WAIT_L(0); PG8_MMA(0, 0, At, B0); PG8_BAR; PG8_SCHED;
            PG8_LDB(B1, 0, 1); PG8_STAGE(PG8_SB(0, 0), b2, voffB);
            PG8_BAR; PG8_WAIT_L(0); PG8_MMA(0, 1, At, B1); PG8_BAR;
            PG8_LDA(At, 0, 1); PG8_STAGE(PG8_SA(0, 0), a2, voffA);
            PG8_BAR; PG8_WAIT_L(0); PG8_MMA(1, 0, At, B0); PG8_BAR; PG8_SCHED;
            PG8_STAGE(PG8_SB(0, 1), b2 + hstep, voffB);
            PG8_WAIT_V(6); PG8_BAR; PG8_MMA(1, 1, At, B1); PG8_BAR;
            PG8_LDB(B0, 1, 0); PG8_SCHED; PG8_LDA(At, 1, 0); PG8_STAGE(PG8_SA(0, 1), a2 + hstep, voffA);
            PG8_WAIT_L(8); PG8_BAR; PG8_WAIT_L(0); PG8_MMA(0, 0, At, B0); PG8_BAR; PG8_SCHED;
            PG8_LDB(B1, 1, 1); PG8_STAGE(PG8_SB(1, 0), b3, voffB);
            PG8_BAR; PG8_WAIT_L(0); PG8_MMA(0, 1, At, B1); PG8_BAR;
            PG8_LDA(At, 1, 1); PG8_STAGE(PG8_SA(1, 0), a3, voffA);
            PG8_BAR; PG8_WAIT_L(0); PG8_MMA(1, 0, At, B0); PG8_BAR; PG8_SCHED;
            PG8_STAGE(PG8_SB(1, 1), b3 + hstep, voffB);
            PG8_WAIT_V(6); PG8_BAR; PG8_MMA(1, 1, At, B1); PG8_BAR;
            }
        }
        if constexpr (ALIGN_EPI) { if (wr == 0) PG8_BAR; }
        if constexpr (!Epi::AFTER_DRAIN) { E(acc, cur, wr, wc, fr, fq); S.done(cur); }
        if (!has_next) break;
#pragma unroll
        for (int a = 0; a < 2; ++a)
#pragma unroll
            for (int b = 0; b < 2; ++b)
#pragma unroll
                for (int m = 0; m < 4; ++m)
#pragma unroll
                    for (int n = 0; n < 2; ++n) acc[a][b][m][n] = (f32x4){0.f, 0.f, 0.f, 0.f};
        cur = nxt; cA = nA; cB = nB; ++ui;
        if constexpr (ALIGN_EPI) { if (wr == 1) PG8_BAR; }
    }
    PG8_WAIT_V(0);
    if constexpr (!ALIGN_EPI) { if (wr == 0) PG8_BAR; }
    PG8_BAR;
    if constexpr (Epi::AFTER_DRAIN) { E.fused(acc, cur, wr, wc, fr, fq, lds, wid, lane); S.done(cur); }
#undef PG8_SA
#undef PG8_SB
#undef PG8_STAGE
#undef PG8_LDA
#undef PG8_LDB
#undef PG8_MMA
#undef PG8_WAIT_V
#undef PG8_WAIT_L
#undef PG8_BAR
#undef PG8_SCHED
}
}
#define XB_TMO      128
#define XB_XCNT(j)  (256  + 64 * (j))
#define XB_XSUB(j)  (1280 + 64 * (j))
#define XB_XGEN(j)  (2304 + 64 * (j))
#define XB_TOP      3328
#define XB_TOPGEN   3392
#define XCD_BAR_WORDS 3456
#define XB_SPIN_CAP (1u << 18)

__device__ __forceinline__ unsigned xb_ld(unsigned* p)              { return __hip_atomic_load(p, __ATOMIC_RELAXED, __HIP_MEMORY_SCOPE_AGENT); }
__device__ __forceinline__ unsigned xb_add(unsigned* p, unsigned v) { return __hip_atomic_fetch_add(p, v, __ATOMIC_RELAXED, __HIP_MEMORY_SCOPE_AGENT); }
__device__ __forceinline__ unsigned xb_xcc_id() { return (unsigned)__builtin_amdgcn_s_getreg((3 << 11) | 20) & 0xFu; }
#define XB_SPIN(cond, bar) do { unsigned _sp = 0; while (cond) { __builtin_amdgcn_s_sleep(1); \
    if ((++_sp & 255u) == 0u) { if (xb_ld(&(bar)[XB_TMO])) break; if (_sp > XB_SPIN_CAP) { atomicAdd(&(bar)[XB_TMO], 1u); break; } } } } while (0)

struct XcdBarrier {
    unsigned* bar; unsigned x;
    volatile LAS unsigned* st;
};

__device__ __forceinline__ XcdBarrier xcd_barrier_post(unsigned* bar, volatile LAS unsigned* st) {
    XcdBarrier b; b.bar = bar; b.x = xb_xcc_id(); b.st = st;
    if (threadIdx.x == 0) (void)xb_add(&bar[XB_XCNT(b.x)], 1u);
    return b;
}
__device__ __forceinline__ void xcd_barrier_complete(unsigned* bar, unsigned x, unsigned& nloc, unsigned& nx) {
    const unsigned G = gridDim.x * gridDim.y * gridDim.z;
    unsigned sum, cnt, mine, sp = 0u;
    for (;;) {
        sum = 0u; cnt = 0u; mine = 0u;
#pragma unroll
        for (unsigned j = 0; j < 16; ++j) { const unsigned c = xb_ld(&bar[XB_XCNT(j)]); sum += c; cnt += (c > 0u) ? 1u : 0u; mine = (j == x) ? c : mine; }
        if (sum == G) break;
        __builtin_amdgcn_s_sleep(1);
        if ((++sp & 255u) == 0u) { if (xb_ld(&bar[XB_TMO])) break; if (sp > XB_SPIN_CAP) { atomicAdd(&bar[XB_TMO], 1u); break; } }
    }
    nloc = mine > 0u ? mine : 1u; nx = cnt > 0u ? cnt : 1u;
}

__device__ __forceinline__ void xcd_barrier(const XcdBarrier& b) {
    asm volatile("s_waitcnt vmcnt(0)" ::: "memory");
    __syncthreads();
    if (threadIdx.x == 0) {
        unsigned* bar = b.bar;
        __builtin_amdgcn_s_waitcnt(0);
        unsigned nloc = b.st[0], nx = b.st[1];
        if (nloc == 0u) { xcd_barrier_complete(bar, b.x, nloc, nx); b.st[0] = nloc; b.st[1] = nx; }
        const unsigned old = xb_add(&bar[XB_XSUB(b.x)], 1u);
        const unsigned gen = old / nloc;
        if (old + 1u == (gen + 1u) * nloc) {
            __builtin_amdgcn_fence(__ATOMIC_RELEASE, "agent");
            asm volatile("s_waitcnt vmcnt(0)" ::: "memory");
            const unsigned og = xb_add(&bar[XB_TOP], 1u);
            const unsigned tg = og / nx;
            if (og + 1u == (tg + 1u) * nx) xb_add(&bar[XB_TOPGEN], 1u);
            else XB_SPIN(xb_ld(&bar[XB_TOPGEN]) == tg, bar);
            __builtin_amdgcn_fence(__ATOMIC_ACQUIRE, "agent");
            xb_add(&bar[XB_XGEN(b.x)], 1u);
            asm volatile("s_waitcnt vmcnt(0)" ::: "memory");
        } else {
            XB_SPIN(xb_ld(&bar[XB_XGEN(b.x)]) == gen, bar);
            __builtin_amdgcn_fence(__ATOMIC_ACQUIRE, "agent");
            asm volatile("s_waitcnt vmcnt(0)" ::: "memory");
        }
    }
    __syncthreads();
}

constexpr int DM = 1024, NB = 4, SEQ = 4096, MTOK = NB * SEQ;
constexpr int QLORA = 384, KVLORA = 256, ROPE = 64, NOPE = 128, QKH = 192, VH = 128, NH = 8;
constexpr int MLA_IN = 704, MLA_IN_PAD = 768;
constexpr int NEXP = 16384;
constexpr float NORM_EPS = 1e-6f;
constexpr float U8_SCALE = 256.f, V8_SCALE = 16.f;
constexpr float QSCALE = 0.07216878364870322f * 1.4426950408889634f;

#ifndef MK_N_LAUNCHES
#define MK_N_LAUNCHES 1
#endif
constexpr int NPHASES = 22;
#ifndef PHMASK
#define PHMASK 0xFFFFFFu
#endif
#define EN(k) (((PHMASK) >> (k)) & 1u)
constexpr int NWAVES = 8;

constexpr size_t MiB = 1u << 20;
constexpr size_t WS_CTL = 0, CTL_ZERO_BYTES = 64 * 1024;
constexpr size_t WS_MOD = 1 * MiB;
constexpr size_t WS_WCIN = 2 * MiB;
constexpr size_t WS_WCOUT = 8 * MiB;
constexpr size_t WS_WPQ0 = 10 * MiB, WS_WPQ1 = 14 * MiB;
constexpr size_t WS_WMIN = 18 * MiB;
constexpr size_t WS_WQB = 20 * MiB;
constexpr size_t WS_WKVB = 22 * MiB;
constexpr size_t WS_WMOUT = 24 * MiB;
constexpr size_t WS_SUBK = 26 * MiB;
constexpr size_t WS_PU = 32 * MiB;
constexpr size_t WS_PV = 96 * MiB;
constexpr size_t WS_XN = 160 * MiB;
constexpr size_t WS_VT = 160 * MiB;
constexpr size_t WS_BCV = 192 * MiB;
constexpr size_t WS_LAT = 192 * MiB;
constexpr size_t WS_O = 192 * MiB;
constexpr size_t WS_QN = 216 * MiB;
constexpr size_t WS_KVN = 228 * MiB;
constexpr size_t WS_QRAW = 236 * MiB;
constexpr size_t WS_Z = 288 * MiB;
constexpr size_t WS_KVRAW = 288 * MiB;
constexpr size_t WS_PQ = 288 * MiB;
constexpr size_t WS_QF = 352 * MiB;
constexpr size_t WS_KF = 400 * MiB;
constexpr size_t WS_IDS = 448 * MiB;
constexpr size_t WS_GATES = 456 * MiB;
constexpr size_t WS_ACT = 464 * MiB;
constexpr size_t WS_END = 472 * MiB;
constexpr int CW_BAR = 1024;

constexpr int RING_BYTES = 131072;
constexpr int LDSCTL_OFF = RING_BYTES, MISC_OFF = LDSCTL_OFF + 320;
constexpr int LDS_BYTES = 147456;


typedef unsigned short bf16;
typedef unsigned u32x4 __attribute__((ext_vector_type(4)));
typedef unsigned u32x2 __attribute__((ext_vector_type(2)));
typedef float f32x4 __attribute__((ext_vector_type(4)));
typedef float f32x16 __attribute__((ext_vector_type(16)));
typedef short s16x8 __attribute__((ext_vector_type(8)));
typedef short s16x4 __attribute__((ext_vector_type(4)));
#define LDS_WAIT() asm volatile("s_waitcnt lgkmcnt(0)" ::: "memory")
#define VM_WAIT() asm volatile("s_waitcnt vmcnt(0)" ::: "memory")
#define DI __device__ __forceinline__

DI unsigned f2bf(float f) { unsigned u = __builtin_bit_cast(unsigned, f); return (u + 0x7fffu + ((u >> 16) & 1u)) >> 16; }
DI unsigned pk2(float lo, float hi) { return f2bf(lo) | (f2bf(hi) << 16); }
DI float bflo(unsigned u) { return __uint_as_float(u << 16); }
DI float bfhi(unsigned u) { return __uint_as_float(u & 0xffff0000u); }
DI float bf1(bf16 b) { return __uint_as_float((unsigned)b << 16); }
DI float wave_sum(float v) {
#pragma unroll
    for (int o = 32; o > 0; o >>= 1) v += __shfl_xor(v, o);
    return v;
}
DI int crow(int r, int hi) { return (r & 3) + 8 * (r >> 2) + 4 * hi; }

struct Args { const void* in[22]; float* out; unsigned char* ws; int ph_lo, ph_hi; };

DI void transpose_item(const float* W, int K, int N, bf16* WT, LAS float* scr, int item, int lane) {
    const int nblk = N / 32, kb = item / nblk, nb = item % nblk, k0 = 64 * kb, n0 = 32 * nb;
#pragma unroll 8
    for (int i = 0; i < 32; ++i) { const int kk = 2 * i + (lane >> 5); scr[kk * 33 + (lane & 31)] = W[(size_t)(k0 + kk) * N + n0 + (lane & 31)]; }
    LDS_WAIT(); asm volatile("" ::: "memory");
    const int c = lane & 7;
#pragma unroll
    for (int j = 0; j < 4; ++j) { const int n = (lane >> 3) + 8 * j; const LAS float* s = scr + (8 * c) * 33 + n;
        u32x4 o; o.x = pk2(s[0 * 33], s[1 * 33]); o.y = pk2(s[2 * 33], s[3 * 33]); o.z = pk2(s[4 * 33], s[5 * 33]); o.w = pk2(s[6 * 33], s[7 * 33]);
        *(u32x4*)(WT + (size_t)(n0 + n) * K + k0 + 8 * c) = o; }
    LDS_WAIT(); asm volatile("" ::: "memory");
}
DI void cvt_f32_bf16(const float* src, bf16* dst, size_t n8, size_t gt, size_t GT) {
#pragma unroll 4
    for (size_t i = gt; i < n8; i += GT) {
        const f32x4 a = ((const f32x4*)src)[2 * i], b = ((const f32x4*)src)[2 * i + 1];
        u32x4 o; o.x = pk2(a.x, a.y); o.y = pk2(a.z, a.w); o.z = pk2(b.x, b.y); o.w = pk2(b.z, b.w);
        ((u32x4*)dst)[i] = o; }
}

typedef float f32x2v __attribute__((ext_vector_type(2)));
DI unsigned pack4_fp8(float a, float b, float c, float d, float sc) {
    a = fminf(fmaxf(a * sc, -448.f), 448.f); b = fminf(fmaxf(b * sc, -448.f), 448.f); c = fminf(fmaxf(c * sc, -448.f), 448.f); d = fminf(fmaxf(d * sc, -448.f), 448.f);
    int w = __builtin_amdgcn_cvt_pk_fp8_f32(a, b, 0, false); w = __builtin_amdgcn_cvt_pk_fp8_f32(c, d, w, true); return (unsigned)w;
}
DI void cvt_tables_fp8(const float* u, const float* v, unsigned char* u8, unsigned char* v8, size_t gt, size_t GT) {
    const size_t n16 = (size_t)2 * NEXP * 1024 / 16;
#pragma unroll 2
    for (size_t i = gt; i < n16; i += GT) {
        const f32x4* s = (const f32x4*)(u + i * 16); const f32x4 a = s[0], b = s[1], c = s[2], d = s[3];
        u32x4 o; o.x = pack4_fp8(a.x, a.y, a.z, a.w, U8_SCALE); o.y = pack4_fp8(b.x, b.y, b.z, b.w, U8_SCALE); o.z = pack4_fp8(c.x, c.y, c.z, c.w, U8_SCALE); o.w = pack4_fp8(d.x, d.y, d.z, d.w, U8_SCALE);
        *(u32x4*)(u8 + i * 16) = o; }
#pragma unroll 2
    for (size_t i = gt; i < n16; i += GT) {
        const f32x4* s = (const f32x4*)(v + i * 16); const f32x4 a = s[0], b = s[1], c = s[2], d = s[3];
        u32x4 o; o.x = pack4_fp8(a.x, a.y, a.z, a.w, V8_SCALE); o.y = pack4_fp8(b.x, b.y, b.z, b.w, V8_SCALE); o.z = pack4_fp8(c.x, c.y, c.z, c.w, V8_SCALE); o.w = pack4_fp8(d.x, d.y, d.z, d.w, V8_SCALE);
        const size_t k = i & 63, row = i >> 6, e = row & (NEXP - 1), layer = row >> 14;
        *(u32x4*)(v8 + (((layer * 8 + (k >> 3)) * NEXP + e) * 128 + (k & 7) * 16)) = o; }
}
DI void ph_prologue(const Args& a, LAS unsigned char* lds, int tid, int wave, int vcu, int G) {
    const int lane = tid & 63;
    {
        const float* c = (const float*)a.in[1]; const float* ada_w = (const float*)a.in[5]; const float* ada_b = (const float*)a.in[6];
        float* mod = (float*)(a.ws + WS_MOD);
        LAS float* cact = (LAS float*)lds; LAS float* red = cact + 4096;
        for (int it = blockIdx.x; it < 192; it += G) {
            const int i = it / 96, n0 = (it % 96) * 64;
            for (int e = tid; e < 4096; e += 512) { const float v = c[e]; cact[e] = v / (1.f + expf(-v)); }
            __syncthreads();
            const float* W = ada_w + (size_t)i * 1024 * 6144 + n0 + lane;
            float a0 = 0.f, a1 = 0.f, a2 = 0.f, a3 = 0.f;
            const int k0 = wave * 128;
#pragma unroll 8
            for (int k = k0; k < k0 + 128; ++k) { const float w = W[(size_t)k * 6144]; a0 += cact[k] * w; a1 += cact[1024 + k] * w; a2 += cact[2048 + k] * w; a3 += cact[3072 + k] * w; }
            red[(wave * 4 + 0) * 64 + lane] = a0; red[(wave * 4 + 1) * 64 + lane] = a1; red[(wave * 4 + 2) * 64 + lane] = a2; red[(wave * 4 + 3) * 64 + lane] = a3;
            __syncthreads();
            if (tid < 256) { const int b = tid >> 6; float s = 0.f;
#pragma unroll
                for (int w = 0; w < 8; ++w) s += red[(w * 4 + b) * 64 + lane];
                mod[(size_t)(i * 4 + b) * 6144 + n0 + lane] = s + ada_b[i * 6144 + n0 + lane]; }
            __syncthreads();
        }
    }
    {
        LAS float* scr = (LAS float*)(lds + 32768 + wave * 8704);
        const int gw = vcu * NWAVES + wave, NGW = G * NWAVES;
        unsigned char* ws = a.ws;
        constexpr int I_CIN = 16 * 96, I_COUT = 16 * 32, I_PQ = 16 * 64, I_MIN = 16 * 22, I_QB = 6 * 48, I_KVB = 4 * 64, I_MOUT = 16 * 32;
        constexpr int NITEMS = I_CIN + I_COUT + 2 * I_PQ + I_MIN + I_QB + I_KVB + I_MOUT;
        for (int it = gw; it < NITEMS; it += NGW) {
            int r = it;
            if (r < I_CIN) { transpose_item((const float*)a.in[7], 1024, 3072, (bf16*)(ws + WS_WCIN), scr, r, lane); continue; } r -= I_CIN;
            if (r < I_COUT) { transpose_item((const float*)a.in[9], 1024, 1024, (bf16*)(ws + WS_WCOUT), scr, r, lane); continue; } r -= I_COUT;
            if (r < I_PQ) { transpose_item((const float*)a.in[18], 1024, 2048, (bf16*)(ws + WS_WPQ0), scr, r, lane); continue; } r -= I_PQ;
            if (r < I_PQ) { transpose_item((const float*)a.in[18] + (size_t)1024 * 2048, 1024, 2048, (bf16*)(ws + WS_WPQ1), scr, r, lane); continue; } r -= I_PQ;
            if (r < I_MIN) { transpose_item((const float*)a.in[10], 1024, MLA_IN, (bf16*)(ws + WS_WMIN), scr, r, lane); continue; } r -= I_MIN;
            if (r < I_QB) { transpose_item((const float*)a.in[13], 384, 1536, (bf16*)(ws + WS_WQB), scr, r, lane); continue; } r -= I_QB;
            if (r < I_KVB) { transpose_item((const float*)a.in[14], 256, 2048, (bf16*)(ws + WS_WKVB), scr, r, lane); continue; } r -= I_KVB;
            transpose_item((const float*)a.in[17], 1024, 1024, (bf16*)(ws + WS_WMOUT), scr, r, lane);
        }
        const size_t gt = (size_t)vcu * 512 + tid, GT = (size_t)G * 512;
        for (size_t i = gt; i < (size_t)(MLA_IN_PAD - MLA_IN) * 1024 / 8; i += GT) ((u32x4*)(ws + WS_WMIN + (size_t)MLA_IN * 1024 * 2))[i] = (u32x4){0u, 0u, 0u, 0u};
        cvt_f32_bf16((const float*)a.in[19], (bf16*)(ws + WS_SUBK), (size_t)2 * 8 * 2 * 128 * 128 / 8, gt, GT);
        cvt_tables_fp8((const float*)a.in[20], (const float*)a.in[21], ws + WS_PU, ws + WS_PV, gt, GT);
    }
}

DI void ph_modulate(const float* x, bf16* xn, const float* gain, const float* modl, int sh_off, int sc_off, int gw, int NGW, int lane) {
    for (int m = gw; m < MTOK; m += NGW) {
        const float* mb = modl + (size_t)(m >> 12) * 6144;
        const f32x4* xr = (const f32x4*)(x + (size_t)m * DM) + lane;
        f32x4 v[4]; float s = 0.f;
#pragma unroll
        for (int j = 0; j < 4; ++j) { v[j] = xr[64 * j]; s += (v[j].x * v[j].x + v[j].y * v[j].y) + (v[j].z * v[j].z + v[j].w * v[j].w); }
        const float rstd = rsqrtf(wave_sum(s) * (1.f / DM) + NORM_EPS);
        u32x2* o8 = (u32x2*)(xn + (size_t)m * DM) + lane;
#pragma unroll
        for (int j = 0; j < 4; ++j) {
            const f32x4 g = ((const f32x4*)gain)[lane + 64 * j], sh = ((const f32x4*)(mb + sh_off))[lane + 64 * j], sc = ((const f32x4*)(mb + sc_off))[lane + 64 * j];
            const f32x4 y = v[j] * rstd * g * (sc + 1.f) + sh;
            u32x2 w; w.x = pk2(y.x, y.y); w.y = pk2(y.z, y.w); o8[64 * j] = w; }
    }
}

DI void ph_conv(const bf16* bcv, const float* cw, bf16* z, size_t gt, size_t GT) {
    for (size_t it = gt; it < (size_t)MTOK * 128; it += GT) {
        const int t = (int)(it >> 7), ch = (int)(it & 127) * 8, s = t & (SEQ - 1);
        const bf16* row = bcv + (size_t)t * 3072 + ch;
        const u32x4 zero = (u32x4){0u, 0u, 0u, 0u};
        const u32x4 bq = *(const u32x4*)row;
        const u32x4 c0 = *(const u32x4*)(row + 1024), v0 = *(const u32x4*)(row + 2048);
        const u32x4 c1 = s >= 1 ? *(const u32x4*)(row - 3072 + 1024) : zero, v1 = s >= 1 ? *(const u32x4*)(row - 3072 + 2048) : zero;
        const u32x4 c2 = s >= 2 ? *(const u32x4*)(row - 6144 + 1024) : zero, v2 = s >= 2 ? *(const u32x4*)(row - 6144 + 2048) : zero;
        const f32x4 w0a = *(const f32x4*)(cw + ch), w0b = *(const f32x4*)(cw + ch + 4);
        const f32x4 w1a = *(const f32x4*)(cw + 1024 + ch), w1b = *(const f32x4*)(cw + 1024 + ch + 4);
        const f32x4 w2a = *(const f32x4*)(cw + 2048 + ch), w2b = *(const f32x4*)(cw + 2048 + ch + 4);
        float r[8];
#pragma unroll
        for (int e = 0; e < 4; ++e) {
            const float w0l = e < 2 ? w0a[2 * e] : w0b[2 * e - 4], w0h = e < 2 ? w0a[2 * e + 1] : w0b[2 * e - 3];
            const float w1l = e < 2 ? w1a[2 * e] : w1b[2 * e - 4], w1h = e < 2 ? w1a[2 * e + 1] : w1b[2 * e - 3];
            const float w2l = e < 2 ? w2a[2 * e] : w2b[2 * e - 4], w2h = e < 2 ? w2a[2 * e + 1] : w2b[2 * e - 3];
            const float ut_l = bflo(c0[e]) * bflo(v0[e]), ut_h = bfhi(c0[e]) * bfhi(v0[e]);
            const float u1_l = bflo(c1[e]) * bflo(v1[e]), u1_h = bfhi(c1[e]) * bfhi(v1[e]);
            const float u2_l = bflo(c2[e]) * bflo(v2[e]), u2_h = bfhi(c2[e]) * bfhi(v2[e]);
            r[2 * e] = bflo(bq[e]) * (w0l * u2_l + w1l * u1_l + w2l * ut_l);
            r[2 * e + 1] = bfhi(bq[e]) * (w0h * u2_h + w1h * u1_h + w2h * ut_h);
        }
        u32x4 o; o.x = pk2(r[0], r[1]); o.y = pk2(r[2], r[3]); o.z = pk2(r[4], r[5]); o.w = pk2(r[6], r[7]);
        *(u32x4*)(z + (size_t)t * DM + ch) = o;
    }
}

struct EpiResGate {
    static constexpr bool PERM = false, AFTER_DRAIN = false;
    const float* base; float* out; const float* gate;
    __device__ __forceinline__ void operator()(const pg8::f32x4 (&acc)[2][2][4][2], const pg8::Unit& u, int wr, int wc, int fr, int fq) const {
        const int row0 = u.pm * 256 + wr * 64 + fr, col0 = u.pn * 256 + wc * 32 + 4 * fq;
        const float* gp = gate + (size_t)(u.pm >> 4) * 6144 + col0;
        pg8::f32x4 gv[2][2];
#pragma unroll
        for (int bj = 0; bj < 2; ++bj)
#pragma unroll
            for (int n = 0; n < 2; ++n) gv[bj][n] = *(const pg8::f32x4*)(gp + bj * 128 + n * 16);
#pragma unroll
        for (int ai = 0; ai < 2; ++ai)
#pragma unroll
            for (int m = 0; m < 4; ++m) { const size_t off = (size_t)(row0 + ai * 128 + m * 16) * DM + col0;
#pragma unroll
                for (int bj = 0; bj < 2; ++bj)
#pragma unroll
                    for (int n = 0; n < 2; ++n) { const pg8::f32x4 bs = *(const pg8::f32x4*)(base + off + bj * 128 + n * 16);
                        *(pg8::f32x4*)(out + off + bj * 128 + n * 16) = bs + gv[bj][n] * acc[ai][bj][m][n]; } }
    }
};

DI unsigned f2key(float f) { const unsigned u = __float_as_uint(f); return u ^ ((unsigned)((int)u >> 31) | 0x80000000u); }
DI float key2f(unsigned k) { const unsigned u = (k & 0x80000000u) ? (k ^ 0x80000000u) : ~k; return __uint_as_float(u); }
DI unsigned umax_(unsigned a, unsigned b) { return a > b ? a : b; }
DI unsigned umin_(unsigned a, unsigned b) { return a < b ? a : b; }
template <int N> DI void bitonic_sort_desc(unsigned (&v)[N]) {
#pragma unroll
    for (int k = 2; k <= N; k <<= 1) {
#pragma unroll
        for (int j = k >> 1; j > 0; j >>= 1) {
#pragma unroll
            for (int i = 0; i < N; ++i) { const int l = i ^ j;
                if (l > i) { const bool desc = ((i & k) == 0); const unsigned x = v[i], y = v[l], mx = umax_(x, y), mn = umin_(x, y); v[i] = desc ? mx : mn; v[l] = desc ? mn : mx; } }
        }
    }
}
template <int N> DI void bitonic_merge_desc(unsigned (&v)[N]) {
#pragma unroll
    for (int j = N >> 1; j > 0; j >>= 1) {
#pragma unroll
        for (int i = 0; i < N; ++i) { const int l = i ^ j;
            if (l > i) { const unsigned x = v[i], y = v[l]; v[i] = umax_(x, y); v[l] = umin_(x, y); } }
    }
}
DI void top16_merge(unsigned (&t)[16], unsigned (&n)[16]) {
#pragma unroll
    for (int i = 0; i < 16; ++i) t[i] = umax_(t[i], n[15 - i]);
    bitonic_merge_desc<16>(t);
}

DI void topk_task(const bf16* PQ, const bf16* SK  , int* IDS, float* GATES, LAS unsigned short* tab  , int tok0, int h, int lane) {
    const int r32 = lane & 31, hi = lane >> 5;
    s16x8 qf[16];
    const bf16* qp = PQ + (size_t)(tok0 + r32) * 2048 + 256 * h + 8 * hi;
#pragma unroll
    for (int ks = 0; ks < 16; ++ks) qf[ks] = *(const s16x8*)(qp + 16 * ks);
    const int p = (r32 >> 2) & 1, keyl = (r32 & 3) + 4 * (r32 >> 3);
    const bf16* kp0 = SK + ((size_t)(h * 2 + p) * 128 + keyl) * 128 + 8 * hi;
    const s16x8 zero8 = (s16x8){0, 0, 0, 0, 0, 0, 0, 0};
    unsigned top[16];
#pragma unroll
    for (int i = 0; i < 16; ++i) top[i] = 0u;
#pragma unroll 1
    for (int rb = 0; rb < 8; ++rb) {
        const bf16* kp = kp0 + (size_t)rb * 16 * 128;
        f32x16 acc;
#pragma unroll
        for (int r = 0; r < 16; ++r) acc[r] = 0.f;
#pragma unroll
        for (int ks = 0; ks < 8; ++ks) {
            const s16x8 kf = *(const s16x8*)(kp + 16 * ks);
            const s16x8 a0 = p == 0 ? kf : zero8, a1 = p == 1 ? kf : zero8;
            acc = __builtin_amdgcn_mfma_f32_32x32x16_bf16(a0, qf[ks], acc, 0, 0, 0);
            acc = __builtin_amdgcn_mfma_f32_32x32x16_bf16(a1, qf[ks + 8], acc, 0, 0, 0);
        }
        unsigned nw[16];
#pragma unroll
        for (int r = 0; r < 16; ++r) nw[r] = (f2key(acc[r]) & ~127u) | (unsigned)(127 - (16 * rb + r));
        bitonic_sort_desc<16>(nw);
        top16_merge(top, nw);
    }
    unsigned LA[16], LB[16];
#pragma unroll
    for (int i = 0; i < 16; ++i) { const unsigned other = (unsigned)__shfl_xor((int)top[i], 32); LA[i] = hi ? other : top[i]; LB[i] = hi ? top[i] : other; }
#pragma unroll
    for (int i = 0; i < 16; ++i) { tab[i * 64 + lane] = (unsigned short)(127u - (LA[i] & 127u)); tab[(16 + i) * 64 + lane] = (unsigned short)(127u - (LB[i] & 127u)); }
    float av[16], bv[16];
#pragma unroll
    for (int i = 0; i < 16; ++i) { av[i] = key2f(LA[i] & ~127u); bv[i] = key2f(LB[i] & ~127u); }
    unsigned cg[4][16];
#pragma unroll
    for (int g = 0; g < 4; ++g)
#pragma unroll
        for (int e = 0; e < 16; ++e) cg[g][e] = 0u;
    {
        int cnt = 0;
#pragma unroll
        for (int i = 0; i < 16; ++i)
#pragma unroll
            for (int j = 0; j < 16; ++j)
                if ((i + 1) * (j + 1) <= 16) { cg[cnt >> 4][cnt & 15] = (f2key(av[i] + bv[j]) & ~255u) | (unsigned)(255 - (16 * i + j)); ++cnt; }
    }
    bitonic_sort_desc<16>(cg[0]); bitonic_sort_desc<16>(cg[1]); bitonic_sort_desc<16>(cg[2]); bitonic_sort_desc<16>(cg[3]);
    top16_merge(cg[0], cg[1]); top16_merge(cg[0], cg[2]); top16_merge(cg[0], cg[3]);
    LDS_WAIT(); asm volatile("" ::: "memory");
    float sv[16]; int ex[16];
#pragma unroll
    for (int k = 0; k < 16; ++k) { const unsigned key = cg[0][k]; const int pos = 255 - (int)(key & 255u); sv[k] = key2f(key & ~255u);
        const int ia = tab[(pos >> 4) * 64 + lane], ib = tab[(16 + (pos & 15)) * 64 + lane]; ex[k] = ia * 128 + ib; }
    LDS_WAIT(); asm volatile("" ::: "memory");
    const float mx = sv[0]; float sum = 0.f;
#pragma unroll
    for (int k = 0; k < 16; ++k) { sv[k] = expf(sv[k] - mx); sum += sv[k]; }
    const float inv = 1.f / sum;
    if (hi == 0) {
        int* ip = IDS + (size_t)(tok0 + r32) * 128 + h * 16; float* gp = GATES + (size_t)(tok0 + r32) * 128 + h * 16;
#pragma unroll
        for (int k = 0; k < 16; k += 4) { *(u32x4*)(ip + k) = (u32x4){(unsigned)ex[k], (unsigned)ex[k + 1], (unsigned)ex[k + 2], (unsigned)ex[k + 3]};
            *(f32x4*)(gp + k) = (f32x4){sv[k] * inv, sv[k + 1] * inv, sv[k + 2] * inv, sv[k + 3] * inv}; }
    }
}
DI void ph_topk(const bf16* PQ, const bf16* SK, int* IDS, float* GATES, LAS unsigned char* lds, int gw, int NGW, int wave, int lane) {
    LAS unsigned short* tab = (LAS unsigned short*)(lds + wave * 4096);
    for (int task = gw; task < (MTOK / 32) * 8; task += NGW) topk_task(PQ, SK, IDS, GATES, tab, (task >> 3) * 32, task & 7, lane);
}

DI float gelu_erf(float x) { return 0.5f * x * (1.f + erff(x * 0.70710678118654752f)); }
DI float dot16_fp8(const u32x4& w, const float (&h)[16]) {
    float d0 = 0.f, d1 = 0.f;
#pragma unroll
    for (int e = 0; e < 4; ++e) { const f32x2v lo = __builtin_amdgcn_cvt_pk_f32_fp8((int)w[e], false), hi = __builtin_amdgcn_cvt_pk_f32_fp8((int)w[e], true);
        d0 += lo.x * h[4 * e] + lo.y * h[4 * e + 1]; d1 += hi.x * h[4 * e + 2] + hi.y * h[4 * e + 3]; }
    return d0 + d1;
}
DI void ph_peer_u(const unsigned char* U8, const int* IDS, const float* GATES, const bf16* XN, float* ACT, int bx, int G, int wave, int lane) {
    const int x = bx & 7, rank = bx >> 3, nslots = ((G - x + 7) >> 3) * 8;
    const bool b5 = (lane & 32) != 0, b4 = (lane & 16) != 0, b3 = (lane & 8) != 0;
    const int grp = lane >> 3;
    for (int t = rank * 8 + wave; t < MTOK; t += nslots) {
        const int e_lo = IDS[(size_t)t * 128 + lane], e_hi = IDS[(size_t)t * 128 + 64 + lane];
        float h[16];
        { const u32x4 xa = ((const u32x4*)(XN + (size_t)t * DM))[2 * lane], xb = ((const u32x4*)(XN + (size_t)t * DM))[2 * lane + 1];
#pragma unroll
          for (int e = 0; e < 4; ++e) { h[2 * e] = bflo(xa[e]); h[2 * e + 1] = bfhi(xa[e]); h[8 + 2 * e] = bflo(xb[e]); h[8 + 2 * e + 1] = bfhi(xb[e]); } }
        unsigned long long m0 = __ballot((e_lo >> 11) == x), m1 = __ballot((e_hi >> 11) == x);
        while (m0 | m1) {
            int jj[8];
#pragma unroll
            for (int q = 0; q < 8; ++q) {
                if (m0) { jj[q] = (int)__builtin_ctzll(m0); m0 &= m0 - 1; }
                else if (m1) { jj[q] = 64 + (int)__builtin_ctzll(m1); m1 &= m1 - 1; }
                else jj[q] = -1;
            }
            u32x4 u[8];
#pragma unroll
            for (int q = 0; q < 8; ++q) {
                if (jj[q] >= 0) { const int e = __builtin_amdgcn_readlane(jj[q] < 64 ? e_lo : e_hi, jj[q] & 63); u[q] = *(const u32x4*)(U8 + (size_t)e * 1024 + 16 * lane); }
                else u[q] = (u32x4){0u, 0u, 0u, 0u};
            }
            float p[8];
#pragma unroll
            for (int q = 0; q < 8; ++q) p[q] = dot16_fp8(u[q], h);
            float v4[4], v2[2];
#pragma unroll
            for (int i = 0; i < 4; ++i) { const float keep = b5 ? p[i + 4] : p[i], give = b5 ? p[i] : p[i + 4]; v4[i] = keep + __shfl_xor(give, 32); }
#pragma unroll
            for (int i = 0; i < 2; ++i) { const float keep = b4 ? v4[i + 2] : v4[i], give = b4 ? v4[i] : v4[i + 2]; v2[i] = keep + __shfl_xor(give, 16); }
            float tot; { const float keep = b3 ? v2[1] : v2[0], give = b3 ? v2[0] : v2[1]; tot = keep + __shfl_xor(give, 8); }
            tot += __shfl_xor(tot, 1); tot += __shfl_xor(tot, 2); tot += __shfl_xor(tot, 4);
            int jg = jj[0];
#pragma unroll
            for (int q = 1; q < 8; ++q) jg = grp == q ? jj[q] : jg;
            if ((lane & 7) == 0 && jg >= 0) { const float gate = GATES[(size_t)t * 128 + jg]; ACT[(size_t)t * 128 + jg] = gelu_erf(tot * (1.f / U8_SCALE)) * gate; }
        }
    }
}
DI void ph_peer_v(const unsigned char* V8  , const int* IDS, const float* ACT, float* X, const float* g2, int bx, int G, int wave, int lane) {
    const int x = bx & 7, rank = bx >> 3, nslots = ((G - x + 7) >> 3) * 8;
    const bool b5 = (lane & 32) != 0, b4 = (lane & 16) != 0, b3 = (lane & 8) != 0;
    const int grp = lane >> 3;
    const unsigned char* Vx = V8 + (size_t)x * NEXP * 128;
    const unsigned coff = 16u * (unsigned)(lane & 7);
    for (int t = rank * 8 + wave; t < MTOK; t += nslots) {
        const int e_lo = IDS[(size_t)t * 128 + lane], e_hi = IDS[(size_t)t * 128 + 64 + lane];
        const float a_lo = ACT[(size_t)t * 128 + lane], a_hi = ACT[(size_t)t * 128 + 64 + lane];
        float acc[16];
#pragma unroll
        for (int i = 0; i < 16; ++i) acc[i] = 0.f;
#pragma unroll
        for (int hb = 0; hb < 2; ++hb) {
            u32x4 v[8]; float aw[8];
#pragma unroll
            for (int it = 0; it < 8; ++it) { const int src = 8 * it + grp; const int e = __shfl(hb ? e_hi : e_lo, src); aw[it] = __shfl(hb ? a_hi : a_lo, src);
                v[it] = *(const u32x4*)(Vx + ((unsigned)e * 128u + coff)); }
#pragma unroll
            for (int it = 0; it < 8; ++it)
#pragma unroll
                for (int e = 0; e < 4; ++e) { const f32x2v lo = __builtin_amdgcn_cvt_pk_f32_fp8((int)v[it][e], false), hi = __builtin_amdgcn_cvt_pk_f32_fp8((int)v[it][e], true);
                    acc[4 * e] += aw[it] * lo.x; acc[4 * e + 1] += aw[it] * lo.y; acc[4 * e + 2] += aw[it] * hi.x; acc[4 * e + 3] += aw[it] * hi.y;
                    if (e == 3) __builtin_amdgcn_sched_barrier(0); }
        }
        float v8[8], v4[4], v2[2];
#pragma unroll
        for (int i = 0; i < 8; ++i) { const float keep = b5 ? acc[i + 8] : acc[i], give = b5 ? acc[i] : acc[i + 8]; v8[i] = keep + __shfl_xor(give, 32); }
#pragma unroll
        for (int i = 0; i < 4; ++i) { const float keep = b4 ? v8[i + 4] : v8[i], give = b4 ? v8[i] : v8[i + 4]; v4[i] = keep + __shfl_xor(give, 16); }
#pragma unroll
        for (int i = 0; i < 2; ++i) { const float keep = b3 ? v4[i + 2] : v4[i], give = b3 ? v4[i] : v4[i + 2]; v2[i] = keep + __shfl_xor(give, 8); }
        const int dim = 128 * x + 16 * (lane & 7) + 2 * grp;
        float* xp = X + (size_t)t * DM + dim; const float* gp = g2 + (size_t)(t >> 12) * 6144 + dim;
        f32x2v xv = *(const f32x2v*)xp; const f32x2v gg = *(const f32x2v*)gp;
        xv.x += gg.x * v2[0] * (1.f / V8_SCALE); xv.y += gg.y * v2[1] * (1.f / V8_SCALE);
        *(f32x2v*)xp = xv;
    }
}

DI void ph_latnorm(const bf16* LAT, const float* qg, const float* kvg, bf16* QN, bf16* KVN, int gw, int NGW, int lane) {
    for (int t = gw; t < MTOK; t += NGW) {
        const unsigned* lr = (const unsigned*)(LAT + (size_t)t * MLA_IN_PAD);
        unsigned q[3], k[2]; float sq = 0.f, sk = 0.f;
#pragma unroll
        for (int j = 0; j < 3; ++j) { q[j] = lr[lane + 64 * j]; sq += bflo(q[j]) * bflo(q[j]) + bfhi(q[j]) * bfhi(q[j]); }
#pragma unroll
        for (int j = 0; j < 2; ++j) { k[j] = lr[192 + lane + 64 * j]; sk += bflo(k[j]) * bflo(k[j]) + bfhi(k[j]) * bfhi(k[j]); }
        const float rq = rsqrtf(wave_sum(sq) * (1.f / QLORA) + NORM_EPS), rk = rsqrtf(wave_sum(sk) * (1.f / KVLORA) + NORM_EPS);
        unsigned* qo = (unsigned*)(QN + (size_t)t * QLORA); unsigned* ko = (unsigned*)(KVN + (size_t)t * KVLORA);
#pragma unroll
        for (int j = 0; j < 3; ++j) { const int c = 2 * (lane + 64 * j); qo[lane + 64 * j] = pk2(bflo(q[j]) * rq * qg[c], bfhi(q[j]) * rq * qg[c + 1]); }
#pragma unroll
        for (int j = 0; j < 2; ++j) { const int c = 2 * (lane + 64 * j); ko[lane + 64 * j] = pk2(bflo(k[j]) * rk * kvg[c], bfhi(k[j]) * rk * kvg[c + 1]); }
    }
}

DI void ph_qkprep(const bf16* QRAW, const bf16* KVRAW, const bf16* LAT, const int* positions, const float* qg, const float* kg,
                  bf16* Qf, bf16* Kf, bf16* Vt, int gw, int NGW, int lane) {
    const int f = lane & 31;
    const float invf = exp2f(-(float)f * (13.287712379549449f / 32.f));
    const float qg0 = qg[lane], qg1 = qg[64 + lane], qg2 = qg[128 + lane], kg0 = kg[lane], kg1 = kg[64 + lane], kg2 = kg[128 + lane];
    for (int task = gw; task < MTOK / 8; task += NGW) {
        const int t0 = task * 8, b = t0 >> 12, s0 = t0 & (SEQ - 1);
#pragma unroll 1
        for (int tt = 0; tt < 8; ++tt) {
            const int t = t0 + tt, s = s0 + tt;
            const float ang = (float)positions[t] * invf;
            double rev = (double)ang * 0.15915494309189535; rev -= floor(rev);
            const float rv = (float)rev, sn = __builtin_amdgcn_sinf(rv), cs = __builtin_amdgcn_cosf(rv);
            const float kr = bf1(LAT[(size_t)t * MLA_IN_PAD + 640 + lane]);
#pragma unroll 1
            for (int h = 0; h < NH; ++h) {
                { const bf16* qp = QRAW + (size_t)t * 1536 + QKH * h;
                  const float x0 = bf1(qp[lane]), x1 = bf1(qp[64 + lane]), x2 = bf1(qp[128 + lane]);
                  const float rstd = rsqrtf(wave_sum(x0 * x0 + x1 * x1 + x2 * x2) * (1.f / QKH) + NORM_EPS);
                  const float y0 = x0 * rstd * qg0, y1 = x1 * rstd * qg1, y2 = x2 * rstd * qg2, pr = __shfl_xor(y2, 32);
                  const float r2 = lane < 32 ? y2 * cs - pr * sn : pr * sn + y2 * cs;
                  bf16* o = Qf + ((size_t)(b * NH + h) * SEQ + s) * QKH;
                  o[lane] = (bf16)f2bf(y0 * QSCALE); o[64 + lane] = (bf16)f2bf(y1 * QSCALE); o[128 + lane] = (bf16)f2bf(r2 * QSCALE); }
                { const bf16* kp = KVRAW + (size_t)t * 2048 + 256 * h;
                  const float x0 = bf1(kp[lane]), x1 = bf1(kp[64 + lane]), x2 = kr;
                  const float rstd = rsqrtf(wave_sum(x0 * x0 + x1 * x1 + x2 * x2) * (1.f / QKH) + NORM_EPS);
                  const float y0 = x0 * rstd * kg0, y1 = x1 * rstd * kg1, y2 = x2 * rstd * kg2, pr = __shfl_xor(y2, 32);
                  const float r2 = lane < 32 ? y2 * cs - pr * sn : pr * sn + y2 * cs;
                  bf16* o = Kf + ((size_t)(b * NH + h) * SEQ + s) * QKH;
                  o[lane] = (bf16)f2bf(y0); o[64 + lane] = (bf16)f2bf(y1); o[128 + lane] = (bf16)f2bf(r2); }
            }
        }
#pragma unroll 1
        for (int h = 0; h < NH; ++h)
#pragma unroll
            for (int dd = 0; dd < 128; dd += 64) {
                const bf16* vp = KVRAW + (size_t)t0 * 2048 + 256 * h + 128 + dd + lane;
                unsigned w[4];
#pragma unroll
                for (int i = 0; i < 4; ++i) w[i] = (unsigned)vp[(size_t)(2 * i) * 2048] | ((unsigned)vp[(size_t)(2 * i + 1) * 2048] << 16);
                *(u32x4*)(Vt + ((size_t)(b * NH + h) * VH + dd + lane) * SEQ + s0) = (u32x4){w[0], w[1], w[2], w[3]};
            }
    }
}

typedef float f32x2_t __attribute__((ext_vector_type(2))); typedef __bf16 bf16x2_t __attribute__((ext_vector_type(2)));
DI unsigned cvtpk(float lo, float hi) { f32x2_t v = {lo, hi}; bf16x2_t b = __builtin_convertvector(v, bf16x2_t); return __builtin_bit_cast(unsigned, b); }
DI void attn_unit(const bf16* Qf, const bf16* Kf, const bf16* Vt, bf16* O, int bh, int qb, int wave, int lane) {
    const int r32 = lane & 31, hi = lane >> 5;
    const int q0 = qb * 256 + wave * 32;
    s16x8 qf[12];
    { const bf16* Qp = Qf + ((size_t)bh * SEQ + q0 + r32) * QKH + 8 * hi;
#pragma unroll
      for (int ks = 0; ks < 12; ++ks) qf[ks] = *(const s16x8*)(Qp + 16 * ks); }
    f32x16 o[4];
#pragma unroll
    for (int d = 0; d < 4; ++d)
#pragma unroll
        for (int r = 0; r < 16; ++r) o[d][r] = 0.f;
    float m = -1e30f, l = 0.f;
    const bf16* Kp = Kf + ((size_t)bh * SEQ + r32) * QKH + 8 * hi;
    const bf16* Vp = Vt + ((size_t)bh * VH + r32) * SEQ + 4 * hi;
    const int nkt = q0 / 32 + 1;
#pragma unroll 1
    for (int kt = 0; kt < nkt; ++kt) {
        f32x16 sc;
#pragma unroll
        for (int r = 0; r < 16; ++r) sc[r] = 0.f;
        const bf16* kp = Kp + (size_t)kt * 32 * QKH;
#pragma unroll
        for (int ks = 0; ks < 12; ++ks) sc = __builtin_amdgcn_mfma_f32_32x32x16_bf16(*(const s16x8*)(kp + 16 * ks), qf[ks], sc, 0, 0, 0);
        if (kt == nkt - 1) {
#pragma unroll
            for (int r = 0; r < 16; ++r) if (crow(r, hi) > r32) sc[r] = -INFINITY;
        }
        float mt = sc[0];
#pragma unroll
        for (int r = 1; r < 16; ++r) mt = fmaxf(mt, sc[r]);
        mt = fmaxf(mt, __shfl_xor(mt, 32));
        const float mn = fmaxf(m, mt), alpha = __builtin_amdgcn_exp2f(m - mn);
        m = mn; l *= alpha;
#pragma unroll
        for (int d = 0; d < 4; ++d)
#pragma unroll
            for (int r = 0; r < 16; ++r) o[d][r] *= alpha;
        float ps = 0.f;
#pragma unroll
        for (int r = 0; r < 16; ++r) { sc[r] = __builtin_amdgcn_exp2f(sc[r] - mn); ps += sc[r]; }
        l += ps;
#pragma unroll
        for (int s = 0; s < 2; ++s) {
            u32x4 pw; pw.x = cvtpk(sc[8 * s], sc[8 * s + 1]); pw.y = cvtpk(sc[8 * s + 2], sc[8 * s + 3]); pw.z = cvtpk(sc[8 * s + 4], sc[8 * s + 5]); pw.w = cvtpk(sc[8 * s + 6], sc[8 * s + 7]);
            const s16x8 pb = __builtin_bit_cast(s16x8, pw);
#pragma unroll
            for (int d = 0; d < 4; ++d) {
                const bf16* vp = Vp + (size_t)d * 32 * SEQ + kt * 32 + 16 * s;
                const s16x4 lo = *(const s16x4*)vp, hh = *(const s16x4*)(vp + 8);
                const s16x8 va = __builtin_shufflevector(lo, hh, 0, 1, 2, 3, 4, 5, 6, 7);
                o[d] = __builtin_amdgcn_mfma_f32_32x32x16_bf16(va, pb, o[d], 0, 0, 0);
            }
        }
    }
    l += __shfl_xor(l, 32);
    const float inv = 1.f / l;
    bf16* Op = O + ((size_t)((bh >> 3) * SEQ + q0 + r32)) * DM + (bh & 7) * VH + 4 * hi;
#pragma unroll
    for (int d = 0; d < 4; ++d)
#pragma unroll
        for (int g = 0; g < 4; ++g) { u32x2 w; w.x = cvtpk(o[d][4 * g] * inv, o[d][4 * g + 1] * inv); w.y = cvtpk(o[d][4 * g + 2] * inv, o[d][4 * g + 3] * inv);
            *(u32x2*)(Op + 32 * d + 8 * g) = w; }
}
DI void ph_attn(const bf16* Qf, const bf16* Kf, const bf16* Vt, bf16* O, int vcu, int G, int wave, int lane) {
    for (int p = vcu; p < 256; p += G) {
        const int bh = p >> 3, s8 = p & 7;
        attn_unit(Qf, Kf, Vt, O, bh, 15 - s8, wave, lane);
        attn_unit(Qf, Kf, Vt, O, bh, s8, wave, lane);
    }
}

__global__ void __launch_bounds__(NWAVES * 64, 2) mk_fwd(Args args) {
    extern __shared__ __attribute__((aligned(16))) unsigned char lds_raw[];
    LAS unsigned char* lds = (LAS unsigned char*)lds_raw;
    const int tid = threadIdx.x, lane = tid & 63, wave = __builtin_amdgcn_readfirstlane(tid >> 6);
    const int G = gridDim.x, bx = blockIdx.x, vcu = (G % 8 == 0) ? (bx % 8) * (G / 8) + bx / 8 : bx;
    const int gw = vcu * NWAVES + wave, NGW = G * NWAVES;
    const size_t GT = (size_t)G * 512;
    unsigned char* ws = args.ws;
    for (int u = tid; u < (LDS_BYTES - LDSCTL_OFF) / 4; u += NWAVES * 64) ((LAS unsigned*)(lds + LDSCTL_OFF))[u] = 0u;
    __syncthreads();
    const bool multi = (args.ph_hi - args.ph_lo) > 1;
    XcdBarrier bar; bar.bar = (unsigned*)(ws + WS_CTL) + CW_BAR; bar.x = 0; bar.st = (volatile LAS unsigned*)(lds + MISC_OFF) + 8;
    if (multi) bar = xcd_barrier_post((unsigned*)(ws + WS_CTL) + CW_BAR, (volatile LAS unsigned*)(lds + MISC_OFF) + 8);

    float* X = args.out;
    const float* mod = (const float*)(ws + WS_MOD);
    bf16* XN = (bf16*)(ws + WS_XN);

    const int lo = args.ph_lo, hi = args.ph_hi;
#define IN(k) (EN(k) && lo <= (k) && (k) < hi)
    auto opq = [](int v) { asm volatile("" : "+v"(v)); return v; };
#define LN opq(lane)
#define TD opq(tid)
#define GTID ((size_t)vcu * 512 + (size_t)opq(tid))
#define SEAM(k) do { if (lo <= (k) && (k) + 1 < hi) xcd_barrier(bar); } while (0)
#define GEMM_BF16(Aptr, Bptr, NN, KK, Optr, LDC) do { pg8::Gemm g{(const bf16*)(Aptr), (const bf16*)(Bptr), MTOK, (NN), (KK)}; pg8::StaticOrder S; S.init(MTOK, (NN), G, bx); \
        pg8::EpiBf16<0> E{(bf16*)(Optr), (LDC), nullptr, 0, 0, 1.f}; pg8::gemm_phase<pg8::EpiBf16<0>, pg8::StaticOrder, true, true>(lds, g, S, E); } while (0)
#define GEMM_RES(Aptr, Bptr, BASE, GATE) do { pg8::Gemm g{(const bf16*)(Aptr), (const bf16*)(Bptr), MTOK, DM, DM}; pg8::StaticOrder S; S.init(MTOK, DM, G, bx); \
        EpiResGate E{(BASE), X, (GATE)}; pg8::gemm_phase<EpiResGate, pg8::StaticOrder, true, true>(lds, g, S, E); } while (0)

    if (IN(0)) ph_prologue(args, lds, TD, wave, vcu, G);
    SEAM(0);
    if (IN(1)) ph_modulate((const float*)args.in[0], XN, (const float*)args.in[3], mod, 0, 1024, gw, NGW, LN);
    SEAM(1);
    if (IN(2)) GEMM_BF16(XN, ws + WS_WCIN, 3072, 1024, ws + WS_BCV, 3072);
    SEAM(2);
    if (IN(3)) ph_conv((const bf16*)(ws + WS_BCV), (const float*)args.in[8], (bf16*)(ws + WS_Z), GTID, GT);
    SEAM(3);
    if (IN(4)) GEMM_RES(ws + WS_Z, ws + WS_WCOUT, (const float*)args.in[0], mod + 2048);
    SEAM(4);
    if (IN(5)) ph_modulate(X, XN, (const float*)args.in[4], mod, 3072, 4096, gw, NGW, LN);
    SEAM(5);
    if (IN(6)) GEMM_BF16(XN, ws + WS_WPQ0, 2048, 1024, ws + WS_PQ, 2048);
    SEAM(6);
    if (IN(7)) ph_topk((const bf16*)(ws + WS_PQ), (const bf16*)(ws + WS_SUBK), (int*)(ws + WS_IDS), (float*)(ws + WS_GATES), lds, gw, NGW, wave, LN);
    SEAM(7);
    if (IN(8)) ph_peer_u(ws + WS_PU, (const int*)(ws + WS_IDS), (const float*)(ws + WS_GATES), XN, (float*)(ws + WS_ACT), bx, G, wave, LN);
    SEAM(8);
    if (IN(9)) ph_peer_v(ws + WS_PV, (const int*)(ws + WS_IDS), (const float*)(ws + WS_ACT), X, mod + 5120, bx, G, wave, LN);
    SEAM(9);
    if (IN(10)) ph_modulate(X, XN, (const float*)args.in[3] + DM, mod + (size_t)4 * 6144, 0, 1024, gw, NGW, LN);
    SEAM(10);
    if (IN(11)) GEMM_BF16(XN, ws + WS_WMIN, MLA_IN_PAD, 1024, ws + WS_LAT, MLA_IN_PAD);
    SEAM(11);
    if (IN(12)) ph_latnorm((const bf16*)(ws + WS_LAT), (const float*)args.in[11], (const float*)args.in[12], (bf16*)(ws + WS_QN), (bf16*)(ws + WS_KVN), gw, NGW, LN);
    SEAM(12);
    if (IN(13)) { GEMM_BF16(ws + WS_QN, ws + WS_WQB, 1536, QLORA, ws + WS_QRAW, 1536); GEMM_BF16(ws + WS_KVN, ws + WS_WKVB, 2048, KVLORA, ws + WS_KVRAW, 2048); }
    SEAM(13);
    if (IN(14)) ph_qkprep((const bf16*)(ws + WS_QRAW), (const bf16*)(ws + WS_KVRAW), (const bf16*)(ws + WS_LAT), (const int*)args.in[2], (const float*)args.in[15], (const float*)args.in[16],
                          (bf16*)(ws + WS_QF), (bf16*)(ws + WS_KF), (bf16*)(ws + WS_VT), gw, NGW, LN);
    SEAM(14);
    if (IN(15)) ph_attn((const bf16*)(ws + WS_QF), (const bf16*)(ws + WS_KF), (const bf16*)(ws + WS_VT), (bf16*)(ws + WS_O), vcu, G, wave, LN);
    SEAM(15);
    if (IN(16)) GEMM_RES(ws + WS_O, ws + WS_WMOUT, (const float*)X, mod + (size_t)4 * 6144 + 2048);
    SEAM(16);
    if (IN(17)) ph_modulate(X, XN, (const float*)args.in[4] + DM, mod + (size_t)4 * 6144, 3072, 4096, gw, NGW, LN);
    SEAM(17);
    if (IN(18)) GEMM_BF16(XN, ws + WS_WPQ1, 2048, 1024, ws + WS_PQ, 2048);
    SEAM(18);
    if (IN(19)) ph_topk((const bf16*)(ws + WS_PQ), (const bf16*)(ws + WS_SUBK) + (size_t)8 * 2 * 128 * 128, (int*)(ws + WS_IDS), (float*)(ws + WS_GATES), lds, gw, NGW, wave, LN);
    SEAM(19);
    if (IN(20)) ph_peer_u(ws + WS_PU + (size_t)NEXP * 1024, (const int*)(ws + WS_IDS), (const float*)(ws + WS_GATES), XN, (float*)(ws + WS_ACT), bx, G, wave, LN);
    SEAM(20);
    if (IN(21)) ph_peer_v(ws + WS_PV + (size_t)8 * NEXP * 128, (const int*)(ws + WS_IDS), (const float*)(ws + WS_ACT), X, mod + (size_t)4 * 6144 + 5120, bx, G, wave, LN);
}

extern "C" void kernel_launch(void* const* d_in, const int* in_sizes, int n_in, void* d_out, int out_size, void* d_ws, size_t ws_size, hipStream_t stream) {
    static int grid = 0;
    if (grid == 0) {
        if (n_in != 22 || out_size != MTOK * DM || ws_size < WS_END) { fprintf(stderr, "kernel_launch: unexpected shapes: n_in %d out %d ws %zu (need %zu)\n", n_in, out_size, ws_size, (size_t)WS_END); grid = -1; return; }
        int dev = 0, cus = 0;
        if (hipGetDevice(&dev) != hipSuccess || hipDeviceGetAttribute(&cus, hipDeviceAttributeMultiprocessorCount, dev) != hipSuccess) { grid = -1; return; }
        if (hipFuncSetAttribute((const void*)mk_fwd, hipFuncAttributeMaxDynamicSharedMemorySize, LDS_BYTES) != hipSuccess) { fprintf(stderr, "kernel_launch: hipFuncSetAttribute failed\n"); grid = -1; return; }
        int per_cu = 0;
        if (hipOccupancyMaxActiveBlocksPerMultiprocessor(&per_cu, (const void*)mk_fwd, NWAVES * 64, LDS_BYTES) != hipSuccess || per_cu < 1) fprintf(stderr, "kernel_launch: occupancy query says %d\n", per_cu);
        (void)hipGetLastError();
        grid = cus;
    }
    if (grid < 0) return;
    (void)hipMemsetAsync((char*)d_ws + WS_CTL, 0, CTL_ZERO_BYTES, stream);
    Args a{};
    for (int i = 0; i < 22; ++i) a.in[i] = d_in[i];
    a.out = (float*)d_out; a.ws = (unsigned char*)d_ws;
#if MK_N_LAUNCHES == 1
    a.ph_lo = 0; a.ph_hi = NPHASES;
    hipLaunchKernelGGL(mk_fwd, dim3(grid), dim3(NWAVES * 64), LDS_BYTES, stream, a);
#else
    for (int ph = 0; ph < NPHASES; ++ph) { a.ph_lo = ph; a.ph_hi = ph + 1; hipLaunchKernelGGL(mk_fwd, dim3(grid), dim3(NWAVES * 64), LDS_BYTES, stream, a); }
#endif
}
```

```cpp
#include <hip/hip_runtime.h>
#include <cstdio>
#include <cstdint>
#define GAS __attribute__((address_space(1)))
#define LAS __attribute__((address_space(3)))
namespace pg8 {
#define PG8_LAS __attribute__((address_space(3)))
typedef unsigned short bf16_t;
typedef short bf16x8 __attribute__((ext_vector_type(8)));
typedef float f32x4 __attribute__((ext_vector_type(4)));
typedef unsigned u32x4 __attribute__((ext_vector_type(4)));
constexpr int BM = 256, BK = 64, HALF = 128, HTB = HALF * BK * 2  , STAGE_BYTES = 8 * HTB, NXCD = 8, WGM = 8;

__host__ __device__ __forceinline__ int lds_byte(int r, int c) { const int st = (r >> 4) * 2 + (c >> 5), rr = r & 15, cc = c & 31, ob = rr * 64 + cc * 2; return st * 1024 + (ob ^ (((ob >> 9) & 1) << 5)); }
__host__ __device__ __forceinline__ void stage_rc(int b, int& R, int& C) { const int st = b / 1024, sb = b % 1024, swz = sb ^ (((sb >> 9) & 1) << 5); R = (st >> 1) * 16 + swz / 64; C = (st & 1) * 32 + (swz % 64) / 2; }
__host__ __device__ __forceinline__ int perm32(int rho) { const int n = rho >> 4, i = rho & 15; return 8 * (i >> 2) + 4 * n + (i & 3); }

struct Unit { int pm, pn; };
struct Gemm { const bf16_t* A; const bf16_t* Bt; int M, N, K; };

struct StaticOrder {
    int nM, nN, nwg, G, c;
    __host__ __device__ void init(int M, int N, int G_, int c_) { nM = M / BM; nN = N / BM; nwg = nM * nN; G = G_; c = c_; }
    __host__ __device__ bool next(int i, Unit& u) const {
        const long L = (long)i * G + c; if (L >= nwg) return false;
        int wgid = (int)L; { const int q = nwg / NXCD, r = nwg % NXCD, xcd = wgid % NXCD, off = wgid / NXCD; wgid = (xcd < r ? xcd * (q + 1) : r * (q + 1) + (xcd - r) * q) + off; }
        const int nig = WGM * nN, gid = wgid / nig, fm = gid * WGM, gsz = (nM - fm) < WGM ? (nM - fm) : WGM;
        u.pm = fm + ((wgid % nig) % gsz); u.pn = (wgid % nig) / gsz; return true;
    }
    __device__ __forceinline__ void a_ready(const Unit&) const {}
    __device__ __forceinline__ void done(const Unit&) const {}
};

__device__ __forceinline__ unsigned cvt_pk_bf16(float lo, float hi) { unsigned r; asm volatile("v_cvt_pk_bf16_f32 %0, %1, %2" : "=v"(r) : "v"(lo), "v"(hi)); return r; }
typedef float f32x2 __attribute__((ext_vector_type(2)));
__device__ __forceinline__ f32x2 gelu_pk(f32x2 v) {
    const f32x2 av = __builtin_elementwise_abs(v), d = av * 0.2316418882f + 1.0f;
    f32x2 t; t.x = __builtin_amdgcn_rcpf(d.x); t.y = __builtin_amdgcn_rcpf(d.y);
    f32x2 q = t * 0.5307027145f + (-0.7265760135f); q = q * t + 0.7107068705f; q = q * t + (-0.142248368f); q = q * t + 0.127414796f; q = q * t;
    const f32x2 s = (v * v) * (-0.72134752044f);
    f32x2 e; e.x = __builtin_amdgcn_exp2f(s.x); e.y = __builtin_amdgcn_exp2f(s.y);
    const f32x2 m = v * (q * e), r = v - m;
    f32x2 o; o.x = v.x < 0.f ? m.x : r.x; o.y = v.y < 0.f ? m.y : r.y; return o;
}

template <int ACT  > struct EpiBf16 {
    static constexpr bool PERM = true, AFTER_DRAIN = false; static_assert(ACT == 0 || ACT == 1, "EpiBf16: ACT is 0 (none) or 1 (gelu_pk)");
    bf16_t* O; int ldc; const float* bias; int split_cols; size_t split_stride; float scale0;
    __device__ __forceinline__ void operator()(const f32x4 (&acc)[2][2][4][2], const Unit& u, int wr, int wc, int fr, int fq) const {
        const int row0 = u.pm * BM + wr * 64 + fr; int colt = u.pn * BM; bf16_t* base = O;
        float sc = 1.f; if (split_cols) { const int t = colt / split_cols; base += (size_t)t * split_stride; colt -= t * split_cols; if (t == 0) sc = scale0; }
        const int col0 = colt + wc * 32 + 8 * fq, bcol0 = u.pn * BM + wc * 32 + 8 * fq;
        f32x4 bv[2][2];
#pragma unroll
        for (int bj = 0; bj < 2; ++bj)
#pragma unroll
            for (int n = 0; n < 2; ++n) bv[bj][n] = bias ? *(const f32x4*)(bias + bcol0 + bj * HALF + 4 * n) : (f32x4){0.f, 0.f, 0.f, 0.f};
#pragma unroll
        for (int ai = 0; ai < 2; ++ai)
#pragma unroll
            for (int m = 0; m < 4; ++m) { bf16_t* rowp = base + (size_t)(row0 + ai * HALF + m * 16) * ldc + col0;
#pragma unroll
                for (int bj = 0; bj < 2; ++bj) { f32x4 v0 = acc[ai][bj][m][0] + bv[bj][0], v1 = acc[ai][bj][m][1] + bv[bj][1];
                    if (ACT == 1) { f32x2 a = gelu_pk((f32x2){v0[0], v0[1]}), b = gelu_pk((f32x2){v0[2], v0[3]}), c = gelu_pk((f32x2){v1[0], v1[1]}), d = gelu_pk((f32x2){v1[2], v1[3]});
                        v0 = (f32x4){a.x, a.y, b.x, b.y}; v1 = (f32x4){c.x, c.y, d.x, d.y}; }
                    v0 = v0 * sc; v1 = v1 * sc; u32x4 w; w.x = cvt_pk_bf16(v0[0], v0[1]); w.y = cvt_pk_bf16(v0[2], v0[3]); w.z = cvt_pk_bf16(v1[0], v1[1]); w.w = cvt_pk_bf16(v1[2], v1[3]);
                    *(u32x4*)(rowp + bj * HALF) = w; } }
    }
};

template <class Epi, class Sched, bool ALIGN_EPI = false, bool SP2 = false>
__device__ __forceinline__ void gemm_phase(PG8_LAS unsigned char* lds, const Gemm g, const Sched& S, const Epi& E) {
    int tid_raw = threadIdx.x; asm volatile("" : "+v"(tid_raw));
    const int tid = tid_raw, wid = __builtin_amdgcn_readfirstlane(tid >> 6), lane = tid & 63, wr = wid >> 2, wc = wid & 3, fr = lane & 15, fq = lane >> 4;
    const int K = g.K, nt = K / BK;
    unsigned voffA[2], voffB[2];
#pragma unroll
    for (int i = 0; i < 2; ++i) { int R, C; stage_rc(tid * 16 + i * 8192, R, C); const int Rb = Epi::PERM ? ((R & ~31) + perm32(R & 31)) : R;
        voffA[i] = (unsigned)(R * K + C) * 2u; voffB[i] = (unsigned)(Rb * K + C) * 2u; }
    const size_t kstep = (size_t)(BK * 2);
    const size_t hstep = (size_t)HALF * K * 2;
    const size_t tstep = 2 * hstep;
    const unsigned ldsw = (unsigned)wid * 1024u;
    const int aoff = lds_byte(wr * 64 + fr, fq * 8), boff = lds_byte(wc * 32 + fr, fq * 8);
#define PG8_SA(b, h) (((b) * 2 + (h)) * HTB)
#define PG8_SB(b, h) ((4 + (b) * 2 + (h)) * HTB)
#define PG8_STAGE(bufoff, gbase, voff) do { _Pragma("unroll") for (int _i = 0; _i < 2; ++_i) \
        __builtin_amdgcn_global_load_lds((const unsigned*)((const char*)(gbase) + (voff)[_i]), (PG8_LAS unsigned*)(lds + (bufoff) + ldsw + _i * 8192), 16, 0, 0); } while (0)
#define PG8_LDA(dst, b, h) do { _Pragma("unroll") for (int m = 0; m < 4; ++m) _Pragma("unroll") for (int k = 0; k < 2; ++k) dst[m][k] = *(const PG8_LAS bf16x8*)(lds + PG8_SA(b, h) + aoff + m * 2048 + k * 1024); } while (0)
#define PG8_LDB(dst, b, h) do { _Pragma("unroll") for (int n = 0; n < 2; ++n) _Pragma("unroll") for (int k = 0; k < 2; ++k) dst[n][k] = *(const PG8_LAS bf16x8*)(lds + PG8_SB(b, h) + boff + n * 2048 + k * 1024); } while (0)
#define PG8_MMA(ai, bj, At, Bt) do { __builtin_amdgcn_s_setprio(1); _Pragma("unroll") for (int m = 0; m < 4; ++m) _Pragma("unroll") for (int n = 0; n < 2; ++n) _Pragma("unroll") for (int k = 0; k < 2; ++k) \
        acc[ai][bj][m][n] = __builtin_amdgcn_mfma_f32_16x16x32_bf16(Bt[n][k], At[m][k], acc[ai][bj][m][n], 0, 0, 0); __builtin_amdgcn_s_setprio(0); } while (0)
#define PG8_WAIT_V(n) asm volatile("s_waitcnt vmcnt(" #n ")" ::: "memory")
#define PG8_WAIT_L(n) asm volatile("s_waitcnt lgkmcnt(" #n ")" ::: "memory")
#define PG8_BAR __builtin_amdgcn_s_barrier()
#define PG8_SCHED __builtin_amdgcn_sched_barrier(0)
    Unit cur, nxt; int ui = 0;
    if (!S.next(0, cur)) return;
    f32x4 acc[2][2][4][2];
#pragma unroll
    for (int a = 0; a < 2; ++a)
#pragma unroll
        for (int b = 0; b < 2; ++b)
#pragma unroll
            for (int m = 0; m < 4; ++m)
#pragma unroll
                for (int n = 0; n < 2; ++n) acc[a][b][m][n] = (f32x4){0.f, 0.f, 0.f, 0.f};
    bf16x8 At[4][2], B0[2][2], B1[2][2];
    const char* cA = (const char*)g.A + (size_t)cur.pm * tstep; const char* cB = (const char*)g.Bt + (size_t)cur.pn * tstep;
    S.a_ready(cur);
    if constexpr (SP2) {
        PG8_STAGE(PG8_SB(0, 0), cB, voffB); PG8_STAGE(PG8_SB(0, 1), cB + hstep, voffB); PG8_STAGE(PG8_SA(0, 0), cA, voffA); PG8_STAGE(PG8_SA(0, 1), cA + hstep, voffA);
        if (wr == 1) PG8_BAR;
        PG8_WAIT_V(2); PG8_BAR;
        PG8_STAGE(PG8_SB(1, 0), cB + kstep, voffB); PG8_STAGE(PG8_SA(1, 0), cA + kstep, voffA); PG8_STAGE(PG8_SB(1, 1), cB + hstep + kstep, voffB);
        PG8_WAIT_V(6); PG8_BAR;
    } else {
        PG8_STAGE(PG8_SB(0, 0), cB, voffB); PG8_STAGE(PG8_SA(0, 0), cA, voffA); PG8_STAGE(PG8_SB(0, 1), cB + hstep, voffB); PG8_STAGE(PG8_SA(0, 1), cA + hstep, voffA);
        if (wr == 1) PG8_BAR;
        PG8_WAIT_V(4); PG8_BAR;
        PG8_STAGE(PG8_SB(1, 0), cB + kstep, voffB); PG8_STAGE(PG8_SA(1, 0), cA + kstep, voffA); PG8_STAGE(PG8_SB(1, 1), cB + hstep + kstep, voffB);
        PG8_WAIT_V(6); PG8_BAR;
    }
    for (;;) {
        const bool has_next = S.next(ui + 1, nxt);
        const char* nA = has_next ? (const char*)g.A + (size_t)nxt.pm * tstep : cA; const char* nB = has_next ? (const char*)g.Bt + (size_t)nxt.pn * tstep : cB;
        for (int t = 0; t < nt; t += 2) {
            const bool last = (t == nt - 2);
            const char* a1 = cA + (size_t)(t + 1) * kstep;
            const char* a2 = last ? nA : cA + (size_t)(t + 2) * kstep; const char* b2 = last ? nB : cB + (size_t)(t + 2) * kstep;
            const char* a3 = a2 + kstep; const char* b3 = b2 + kstep;
            if (last && has_next) S.a_ready(nxt);
            if constexpr (SP2) {
            PG8_LDB(B0, 0, 0); PG8_LDB(B1, 0, 1); PG8_SCHED; PG8_LDA(At, 0, 0); PG8_STAGE(PG8_SA(1, 1), a1 + hstep, voffA);
            PG8_WAIT_V(8); PG8_WAIT_L(0); PG8_BAR; PG8_MMA(0, 0, At, B0); PG8_MMA(0, 1, At, B1); PG8_BAR; PG8_SCHED;
            PG8_LDA(At, 0, 1); PG8_STAGE(PG8_SB(0, 0), b2, voffB); PG8_STAGE(PG8_SB(0, 1), b2 + hstep, voffB); PG8_STAGE(PG8_SA(0, 0), a2, voffA);
            PG8_WAIT_V(8); PG8_WAIT_L(0); PG8_BAR; PG8_MMA(1, 0, At, B0); PG8_MMA(1, 1, At, B1); PG8_BAR; PG8_SCHED;
            PG8_LDB(B0, 1, 0); PG8_LDB(B1, 1, 1); PG8_SCHED; PG8_LDA(At, 1, 0); PG8_STAGE(PG8_SA(0, 1), a2 + hstep, voffA);
            PG8_WAIT_V(8); PG8_WAIT_L(0); PG8_BAR; PG8_MMA(0, 0, At, B0); PG8_MMA(0, 1, At, B1); PG8_BAR; PG8_SCHED;
            PG8_LDA(At, 1, 1); PG8_STAGE(PG8_SB(1, 0), b3, voffB); PG8_STAGE(PG8_SB(1, 1), b3 + hstep, voffB); PG8_STAGE(PG8_SA(1, 0), a3, voffA);
            PG8_WAIT_V(8); PG8_WAIT_L(0); PG8_BAR; PG8_MMA(1, 0, At, B0); PG8_MMA(1, 1, At, B1); PG8_BAR; PG8_SCHED;
            } else {
            PG8_LDB(B0, 0, 0); PG8_SCHED; PG8_LDA(At, 0, 0); PG8_STAGE(PG8_SA(1, 1), a1 + hstep, voffA);
            PG8_WAIT_L(8); PG8_BAR; PG8_WAIT_L(0); PG8_MMA(0, 0, At, B0); PG8_BAR; PG8_SCHED;
            PG8_LDB(B1, 0, 1); PG8_STAGE(PG8_SB(0, 0), b2, voffB);
            PG8_BAR; PG8_WAIT_L(0); PG8_MMA(0, 1, At, B1); PG8_BAR;
            PG8_LDA(At, 0, 1); PG8_STAGE(PG8_SA(0, 0), a2, voffA);
            PG8_BAR; PG8_WAIT_L(0); PG8_MMA(1, 0, At, B0); PG8_BAR; PG8_SCHED;
            PG8_STAGE(PG8_SB(0, 1), b2 + hstep, voffB);
            PG8_WAIT_V(6); PG8_BAR; PG8_MMA(1, 1, At, B1); PG8_BAR;
            PG8_LDB(B0, 1, 0); PG8_SCHED; PG8_LDA(At, 1, 0); PG8_STAGE(PG8_SA(0, 1), a2 + hstep, voffA);
            PG8_WAIT_L(8); PG8_BAR; PG8_WAIT_L(0); PG8_MMA(0, 0, At, B0); PG8_BAR; PG8_SCHED;
            PG8_LDB(B1, 1, 1); PG8_STAGE(PG8_SB(1, 0), b3, voffB);
            PG8_BAR; PG8_WAIT_L(0); PG8_MMA(0, 1, At, B1); PG8_BAR;
            PG8_LDA(At, 1, 1); PG8_STAGE(PG8_SA(1, 0), a3, voffA);
            PG8_BAR; PG8_WAIT_L(0); PG8_MMA(1, 0, At, B0); PG8_BAR; PG8_SCHED;
            PG8_STAGE(PG8_SB(1, 1), b3 + hstep, voffB);
            PG8_WAIT_V(6); PG8_BAR; PG8_MMA(1, 1, At, B1); PG8_BAR;
            }
        }
        if constexpr (ALIGN_EPI) { if (wr == 0) PG8_BAR; }
        if constexpr (!Epi::AFTER_DRAIN) { E(acc, cur, wr, wc, fr, fq); S.done(cur); }
        if (!has_next) break;
#pragma unroll
        for (int a = 0; a < 2; ++a)
#pragma unroll
            for (int b = 0; b < 2; ++b)
#pragma unroll
                for (int m = 0; m < 4; ++m)
#pragma unroll
                    for (int n = 0; n < 2; ++n) acc[a][b][m][n] = (f32x4){0.f, 0.f, 0.f, 0.f};
        cur = nxt; cA = nA; cB = nB; ++ui;
        if constexpr (ALIGN_EPI) { if (wr == 1) PG8_BAR; }
    }
    PG8_WAIT_V(0);
    if constexpr (!ALIGN_EPI) { if (wr == 0) PG8_BAR; }
    PG8_BAR;
    if constexpr (Epi::AFTER_DRAIN) { E.fused(acc, cur, wr, wc, fr, fq, lds, wid, lane); S.done(cur); }
#undef PG8_SA
#undef PG8_SB
#undef PG8_STAGE
#undef PG8_LDA
#undef PG8_LDB
#undef PG8_MMA
#undef PG8_WAIT_V
#undef PG8_WAIT_L
#undef PG8_BAR
#undef PG8_SCHED
}
}
#define XB_TMO      128
#define XB_XCNT(j)  (256  + 64 * (j))
#define XB_XSUB(j)  (1280 + 64 * (j))
#define XB_XGEN(j)  (2304 + 64 * (j))
#define XB_TOP      3328
#define XB_TOPGEN   3392
#define XCD_BAR_WORDS 3456
#define XB_SPIN_CAP (1u << 18)

__device__ __forceinline__ unsigned xb_ld(unsigned* p)              { return __hip_atomic_load(p, __ATOMIC_RELAXED, __HIP_MEMORY_SCOPE_AGENT); }
__device__ __forceinline__ unsigned xb_add(unsigned* p, unsigned v) { return __hip_atomic_fetch_add(p, v, __ATOMIC_RELAXED, __HIP_MEMORY_SCOPE_AGENT); }
__device__ __forceinline__ unsigned xb_xcc_id() { return (unsigned)__builtin_amdgcn_s_getreg((3 << 11) | 20) & 0xFu; }
#define XB_SPIN(cond, bar) do { unsigned _sp = 0; while (cond) { __builtin_amdgcn_s_sleep(1); \
    if ((++_sp & 255u) == 0u) { if (xb_ld(&(bar)[XB_TMO])) break; if (_sp > XB_SPIN_CAP) { atomicAdd(&(bar)[XB_TMO], 1u); break; } } } } while (0)

struct XcdBarrier {
    unsigned* bar; unsigned x;
    volatile LAS unsigned* st;
};

__device__ __forceinline__ XcdBarrier xcd_barrier_post(unsigned* bar, volatile LAS unsigned* st) {
    XcdBarrier b; b.bar = bar; b.x = xb_xcc_id(); b.st = st;
    if (threadIdx.x == 0) (void)xb_add(&bar[XB_XCNT(b.x)], 1u);
    return b;
}
__device__ __forceinline__ void xcd_barrier_complete(unsigned* bar, unsigned x, unsigned& nloc, unsigned& nx) {
    const unsigned G = gridDim.x * gridDim.y * gridDim.z;
    unsigned sum, cnt, mine, sp = 0u;
    for (;;) {
        sum = 0u; cnt = 0u; mine = 0u;
#pragma unroll
        for (unsigned j = 0; j < 16; ++j) { const unsigned c = xb_ld(&bar[XB_XCNT(j)]); sum += c; cnt += (c > 0u) ? 1u : 0u; mine = (j == x) ? c : mine; }
        if (sum == G) break;
        __builtin_amdgcn_s_sleep(1);
        if ((++sp & 255u) == 0u) { if (xb_ld(&bar[XB_TMO])) break; if (sp > XB_SPIN_CAP) { atomicAdd(&bar[XB_TMO], 1u); break; } }
    }
    nloc = mine > 0u ? mine : 1u; nx = cnt > 0u ? cnt : 1u;
}

__device__ __forceinline__ void xcd_barrier(const XcdBarrier& b) {
    asm volatile("s_waitcnt vmcnt(0)" ::: "memory");
    __syncthreads();
    if (threadIdx.x == 0) {
        unsigned* bar = b.bar;
        __builtin_amdgcn_s_waitcnt(0);
        unsigned nloc = b.st[0], nx = b.st[1];
        if (nloc == 0u) { xcd_barrier_complete(bar, b.x, nloc, nx); b.st[0] = nloc; b.st[1] = nx; }
        const unsigned old = xb_add(&bar[XB_XSUB(b.x)], 1u);
        const unsigned gen = old / nloc;
        if (old + 1u == (gen + 1u) * nloc) {
            __builtin_amdgcn_fence(__ATOMIC_RELEASE, "agent");
            asm volatile("s_waitcnt vmcnt(0)" ::: "memory");
            const unsigned og = xb_add(&bar[XB_TOP], 1u);
            const unsigned tg = og / nx;
            if (og + 1u == (tg + 1u) * nx) xb_add(&bar[XB_TOPGEN], 1u);
            else XB_SPIN(xb_ld(&bar[XB_TOPGEN]) == tg, bar);
            __builtin_amdgcn_fence(__ATOMIC_ACQUIRE, "agent");
            xb_add(&bar[XB_XGEN(b.x)], 1u);
            asm volatile("s_waitcnt vmcnt(0)" ::: "memory");
        } else {
            XB_SPIN(xb_ld(&bar[XB_XGEN(b.x)]) == gen, bar);
            __builtin_amdgcn_fence(__ATOMIC_ACQUIRE, "agent");
            asm volatile("s_waitcnt vmcnt(0)" ::: "memory");
        }
    }
    __syncthreads();
}

constexpr int DM = 1024, NB = 4, SEQ = 4096, MTOK = NB * SEQ;
constexpr int QLORA = 384, KVLORA = 256, ROPE = 64, NOPE = 128, QKH = 192, VH = 128, NH = 8;
constexpr int MLA_IN = 704, MLA_IN_PAD = 768;
constexpr int NEXP = 16384;
constexpr float NORM_EPS = 1e-6f;
constexpr float U8_SCALE = 256.f, V8_SCALE = 16.f;
constexpr float QSCALE = 0.07216878364870322f * 1.4426950408889634f;

#ifndef MK_N_LAUNCHES
#define MK_N_LAUNCHES 1
#endif
constexpr int NPHASES = 22;
#ifndef PHMASK
#define PHMASK 0xFFFFFFu
#endif
#define EN(k) (((PHMASK) >> (k)) & 1u)
#ifndef PROBE_PHASE
#define PROBE_PHASE -1
#endif
#ifndef PROBE_REPS
#define PROBE_REPS 2
#endif
#define NREP(k) ((k) == (PROBE_PHASE) ? (PROBE_REPS) : 1)
constexpr int NWAVES = 8;

constexpr size_t MiB = 1u << 20;
constexpr size_t WS_CTL = 0, CTL_ZERO_BYTES = 64 * 1024;
constexpr size_t WS_MOD = 1 * MiB;
constexpr size_t WS_WCIN = 2 * MiB;
constexpr size_t WS_WCOUT = 8 * MiB;
constexpr size_t WS_WPQ0 = 10 * MiB, WS_WPQ1 = 14 * MiB;
constexpr size_t WS_WMIN = 18 * MiB;
constexpr size_t WS_WQB = 20 * MiB;
constexpr size_t WS_WKVB = 22 * MiB;
constexpr size_t WS_WMOUT = 24 * MiB;
constexpr size_t WS_SUBK = 26 * MiB;
constexpr size_t WS_PU = 32 * MiB;
constexpr size_t WS_PV = 96 * MiB;
constexpr size_t WS_XN = 160 * MiB;
constexpr size_t WS_VT = 160 * MiB;
constexpr size_t WS_BCV = 192 * MiB;
constexpr size_t WS_LAT = 192 * MiB;
constexpr size_t WS_O = 192 * MiB;
constexpr size_t WS_QN = 216 * MiB;
constexpr size_t WS_KVN = 228 * MiB;
constexpr size_t WS_QRAW = 236 * MiB;
constexpr size_t WS_Z = 288 * MiB;
constexpr size_t WS_KVRAW = 288 * MiB;
constexpr size_t WS_PQ = 288 * MiB;
constexpr size_t WS_QF = 352 * MiB;
constexpr size_t WS_KF = 400 * MiB;
constexpr size_t WS_IDS = 448 * MiB;
constexpr size_t WS_GATES = 456 * MiB;
constexpr size_t WS_DUMMY = 224 * MiB;
constexpr size_t WS_ACT = 464 * MiB;
constexpr size_t WS_END = 472 * MiB;
constexpr int CW_BAR = 1024;

constexpr int RING_BYTES = 131072;
constexpr int LDSCTL_OFF = RING_BYTES, MISC_OFF = LDSCTL_OFF + 320;
constexpr int LDS_BYTES = 147456;


typedef unsigned short bf16;
typedef unsigned u32x4 __attribute__((ext_vector_type(4)));
typedef unsigned u32x2 __attribute__((ext_vector_type(2)));
typedef float f32x4 __attribute__((ext_vector_type(4)));
typedef float f32x16 __attribute__((ext_vector_type(16)));
typedef short s16x8 __attribute__((ext_vector_type(8)));
typedef short s16x4 __attribute__((ext_vector_type(4)));
#define LDS_WAIT() asm volatile("s_waitcnt lgkmcnt(0)" ::: "memory")
#define VM_WAIT() asm volatile("s_waitcnt vmcnt(0)" ::: "memory")
#define DI __device__ __forceinline__

DI unsigned f2bf(float f) { unsigned u = __builtin_bit_cast(unsigned, f); return (u + 0x7fffu + ((u >> 16) & 1u)) >> 16; }
DI unsigned pk2(float lo, float hi) { return f2bf(lo) | (f2bf(hi) << 16); }
DI float bflo(unsigned u) { return __uint_as_float(u << 16); }
DI float bfhi(unsigned u) { return __uint_as_float(u & 0xffff0000u); }
DI float bf1(bf16 b) { return __uint_as_float((unsigned)b << 16); }
DI float wave_sum(float v) {
#pragma unroll
    for (int o = 32; o > 0; o >>= 1) v += __shfl_xor(v, o);
    return v;
}
DI int crow(int r, int hi) { return (r & 3) + 8 * (r >> 2) + 4 * hi; }

struct Args { const void* in[22]; float* out; unsigned char* ws; int ph_lo, ph_hi; };

DI void transpose_item(const float* W, int K, int N, bf16* WT, LAS float* scr, int item, int lane) {
    const int nblk = N / 32, kb = item / nblk, nb = item % nblk, k0 = 64 * kb, n0 = 32 * nb;
#pragma unroll 8
    for (int i = 0; i < 32; ++i) { const int kk = 2 * i + (lane >> 5); scr[kk * 33 + (lane & 31)] = W[(size_t)(k0 + kk) * N + n0 + (lane & 31)]; }
    LDS_WAIT(); asm volatile("" ::: "memory");
    const int c = lane & 7;
#pragma unroll
    for (int j = 0; j < 4; ++j) { const int n = (lane >> 3) + 8 * j; const LAS float* s = scr + (8 * c) * 33 + n;
        u32x4 o; o.x = pk2(s[0 * 33], s[1 * 33]); o.y = pk2(s[2 * 33], s[3 * 33]); o.z = pk2(s[4 * 33], s[5 * 33]); o.w = pk2(s[6 * 33], s[7 * 33]);
        *(u32x4*)(WT + (size_t)(n0 + n) * K + k0 + 8 * c) = o; }
    LDS_WAIT(); asm volatile("" ::: "memory");
}
DI void cvt_f32_bf16(const float* src, bf16* dst, size_t n8, size_t gt, size_t GT) {
#pragma unroll 4
    for (size_t i = gt; i < n8; i += GT) {
        const f32x4 a = ((const f32x4*)src)[2 * i], b = ((const f32x4*)src)[2 * i + 1];
        u32x4 o; o.x = pk2(a.x, a.y); o.y = pk2(a.z, a.w); o.z = pk2(b.x, b.y); o.w = pk2(b.z, b.w);
        ((u32x4*)dst)[i] = o; }
}

typedef float f32x2v __attribute__((ext_vector_type(2)));
DI unsigned pack4_fp8(float a, float b, float c, float d, float sc) {
    a = fminf(fmaxf(a * sc, -448.f), 448.f); b = fminf(fmaxf(b * sc, -448.f), 448.f); c = fminf(fmaxf(c * sc, -448.f), 448.f); d = fminf(fmaxf(d * sc, -448.f), 448.f);
    int w = __builtin_amdgcn_cvt_pk_fp8_f32(a, b, 0, false); w = __builtin_amdgcn_cvt_pk_fp8_f32(c, d, w, true); return (unsigned)w;
}
DI void cvt_tables_fp8(const float* u, const float* v, unsigned char* u8, unsigned char* v8, size_t gt, size_t GT) {
    const size_t n16 = (size_t)2 * NEXP * 1024 / 16;
#pragma unroll 2
    for (size_t i = gt; i < n16; i += GT) {
        const f32x4* s = (const f32x4*)(u + i * 16); const f32x4 a = s[0], b = s[1], c = s[2], d = s[3];
        u32x4 o; o.x = pack4_fp8(a.x, a.y, a.z, a.w, U8_SCALE); o.y = pack4_fp8(b.x, b.y, b.z, b.w, U8_SCALE); o.z = pack4_fp8(c.x, c.y, c.z, c.w, U8_SCALE); o.w = pack4_fp8(d.x, d.y, d.z, d.w, U8_SCALE);
        *(u32x4*)(u8 + i * 16) = o; }
#pragma unroll 2
    for (size_t i = gt; i < n16; i += GT) {
        const f32x4* s = (const f32x4*)(v + i * 16); const f32x4 a = s[0], b = s[1], c = s[2], d = s[3];
        u32x4 o; o.x = pack4_fp8(a.x, a.y, a.z, a.w, V8_SCALE); o.y = pack4_fp8(b.x, b.y, b.z, b.w, V8_SCALE); o.z = pack4_fp8(c.x, c.y, c.z, c.w, V8_SCALE); o.w = pack4_fp8(d.x, d.y, d.z, d.w, V8_SCALE);
        const size_t k = i & 63, row = i >> 6, e = row & (NEXP - 1), layer = row >> 14;
        *(u32x4*)(v8 + (((layer * 8 + (k >> 3)) * NEXP + e) * 128 + (k & 7) * 16)) = o; }
}
DI void ph_prologue(const Args& a, LAS unsigned char* lds, int tid, int wave, int vcu, int G) {
    const int lane = tid & 63;
    {
        const float* c = (const float*)a.in[1]; const float* ada_w = (const float*)a.in[5]; const float* ada_b = (const float*)a.in[6];
        float* mod = (float*)(a.ws + WS_MOD);
        LAS float* cact = (LAS float*)lds; LAS float* red = cact + 4096;
        for (int it = blockIdx.x; it < 192; it += G) {
            const int i = it / 96, n0 = (it % 96) * 64;
            for (int e = tid; e < 4096; e += 512) { const float v = c[e]; cact[e] = v / (1.f + expf(-v)); }
            __syncthreads();
            const float* W = ada_w + (size_t)i * 1024 * 6144 + n0 + lane;
            float a0 = 0.f, a1 = 0.f, a2 = 0.f, a3 = 0.f;
            const int k0 = wave * 128;
#pragma unroll 8
            for (int k = k0; k < k0 + 128; ++k) { const float w = W[(size_t)k * 6144]; a0 += cact[k] * w; a1 += cact[1024 + k] * w; a2 += cact[2048 + k] * w; a3 += cact[3072 + k] * w; }
            red[(wave * 4 + 0) * 64 + lane] = a0; red[(wave * 4 + 1) * 64 + lane] = a1; red[(wave * 4 + 2) * 64 + lane] = a2; red[(wave * 4 + 3) * 64 + lane] = a3;
            __syncthreads();
            if (tid < 256) { const int b = tid >> 6; float s = 0.f;
#pragma unroll
                for (int w = 0; w < 8; ++w) s += red[(w * 4 + b) * 64 + lane];
                mod[(size_t)(i * 4 + b) * 6144 + n0 + lane] = s + ada_b[i * 6144 + n0 + lane]; }
            __syncthreads();
        }
    }
    {
        LAS float* scr = (LAS float*)(lds + 32768 + wave * 8704);
        const int gw = vcu * NWAVES + wave, NGW = G * NWAVES;
        unsigned char* ws = a.ws;
        constexpr int I_CIN = 16 * 96, I_COUT = 16 * 32, I_PQ = 16 * 64, I_MIN = 16 * 22, I_QB = 6 * 48, I_KVB = 4 * 64, I_MOUT = 16 * 32;
        constexpr int NITEMS = I_CIN + I_COUT + 2 * I_PQ + I_MIN + I_QB + I_KVB + I_MOUT;
        for (int it = gw; it < NITEMS; it += NGW) {
            int r = it;
            if (r < I_CIN) { transpose_item((const float*)a.in[7], 1024, 3072, (bf16*)(ws + WS_WCIN), scr, r, lane); continue; } r -= I_CIN;
            if (r < I_COUT) { transpose_item((const float*)a.in[9], 1024, 1024, (bf16*)(ws + WS_WCOUT), scr, r, lane); continue; } r -= I_COUT;
            if (r < I_PQ) { transpose_item((const float*)a.in[18], 1024, 2048, (bf16*)(ws + WS_WPQ0), scr, r, lane); continue; } r -= I_PQ;
            if (r < I_PQ) { transpose_item((const float*)a.in[18] + (size_t)1024 * 2048, 1024, 2048, (bf16*)(ws + WS_WPQ1), scr, r, lane); continue; } r -= I_PQ;
            if (r < I_MIN) { transpose_item((const float*)a.in[10], 1024, MLA_IN, (bf16*)(ws + WS_WMIN), scr, r, lane); continue; } r -= I_MIN;
            if (r < I_QB) { transpose_item((const float*)a.in[13], 384, 1536, (bf16*)(ws + WS_WQB), scr, r, lane); continue; } r -= I_QB;
            if (r < I_KVB) { transpose_item((const float*)a.in[14], 256, 2048, (bf16*)(ws + WS_WKVB), scr, r, lane); continue; } r -= I_KVB;
            transpose_item((const float*)a.in[17], 1024, 1024, (bf16*)(ws + WS_WMOUT), scr, r, lane);
        }
        const size_t gt = (size_t)vcu * 512 + tid, GT = (size_t)G * 512;
        for (size_t i = gt; i < (size_t)(MLA_IN_PAD - MLA_IN) * 1024 / 8; i += GT) ((u32x4*)(ws + WS_WMIN + (size_t)MLA_IN * 1024 * 2))[i] = (u32x4){0u, 0u, 0u, 0u};
        cvt_f32_bf16((const float*)a.in[19], (bf16*)(ws + WS_SUBK), (size_t)2 * 8 * 2 * 128 * 128 / 8, gt, GT);
        cvt_tables_fp8((const float*)a.in[20], (const float*)a.in[21], ws + WS_PU, ws + WS_PV, gt, GT);
    }
}

DI void ph_modulate(const float* x, bf16* xn, const float* gain, const float* modl, int sh_off, int sc_off, int gw, int NGW, int lane) {
    for (int m = gw; m < MTOK; m += NGW) {
        const float* mb = modl + (size_t)(m >> 12) * 6144;
        const f32x4* xr = (const f32x4*)(x + (size_t)m * DM) + lane;
        f32x4 v[4]; float s = 0.f;
#pragma unroll
        for (int j = 0; j < 4; ++j) { v[j] = xr[64 * j]; s += (v[j].x * v[j].x + v[j].y * v[j].y) + (v[j].z * v[j].z + v[j].w * v[j].w); }
        const float rstd = rsqrtf(wave_sum(s) * (1.f / DM) + NORM_EPS);
        u32x2* o8 = (u32x2*)(xn + (size_t)m * DM) + lane;
#pragma unroll
        for (int j = 0; j < 4; ++j) {
            const f32x4 g = ((const f32x4*)gain)[lane + 64 * j], sh = ((const f32x4*)(mb + sh_off))[lane + 64 * j], sc = ((const f32x4*)(mb + sc_off))[lane + 64 * j];
            const f32x4 y = v[j] * rstd * g * (sc + 1.f) + sh;
            u32x2 w; w.x = pk2(y.x, y.y); w.y = pk2(y.z, y.w); o8[64 * j] = w; }
    }
}

DI void ph_conv(const bf16* bcv, const float* cw, bf16* z, size_t gt, size_t GT) {
    for (size_t it = gt; it < (size_t)MTOK * 128; it += GT) {
        const int t = (int)(it >> 7), ch = (int)(it & 127) * 8, s = t & (SEQ - 1);
        const bf16* row = bcv + (size_t)t * 3072 + ch;
        const u32x4 zero = (u32x4){0u, 0u, 0u, 0u};
        const u32x4 bq = *(const u32x4*)row;
        const u32x4 c0 = *(const u32x4*)(row + 1024), v0 = *(const u32x4*)(row + 2048);
        const u32x4 c1 = s >= 1 ? *(const u32x4*)(row - 3072 + 1024) : zero, v1 = s >= 1 ? *(const u32x4*)(row - 3072 + 2048) : zero;
        const u32x4 c2 = s >= 2 ? *(const u32x4*)(row - 6144 + 1024) : zero, v2 = s >= 2 ? *(const u32x4*)(row - 6144 + 2048) : zero;
        const f32x4 w0a = *(const f32x4*)(cw + ch), w0b = *(const f32x4*)(cw + ch + 4);
        const f32x4 w1a = *(const f32x4*)(cw + 1024 + ch), w1b = *(const f32x4*)(cw + 1024 + ch + 4);
        const f32x4 w2a = *(const f32x4*)(cw + 2048 + ch), w2b = *(const f32x4*)(cw + 2048 + ch + 4);
        float r[8];
#pragma unroll
        for (int e = 0; e < 4; ++e) {
            const float w0l = e < 2 ? w0a[2 * e] : w0b[2 * e - 4], w0h = e < 2 ? w0a[2 * e + 1] : w0b[2 * e - 3];
            const float w1l = e < 2 ? w1a[2 * e] : w1b[2 * e - 4], w1h = e < 2 ? w1a[2 * e + 1] : w1b[2 * e - 3];
            const float w2l = e < 2 ? w2a[2 * e] : w2b[2 * e - 4], w2h = e < 2 ? w2a[2 * e + 1] : w2b[2 * e - 3];
            const float ut_l = bflo(c0[e]) * bflo(v0[e]), ut_h = bfhi(c0[e]) * bfhi(v0[e]);
            const float u1_l = bflo(c1[e]) * bflo(v1[e]), u1_h = bfhi(c1[e]) * bfhi(v1[e]);
            const float u2_l = bflo(c2[e]) * bflo(v2[e]), u2_h = bfhi(c2[e]) * bfhi(v2[e]);
            r[2 * e] = bflo(bq[e]) * (w0l * u2_l + w1l * u1_l + w2l * ut_l);
            r[2 * e + 1] = bfhi(bq[e]) * (w0h * u2_h + w1h * u1_h + w2h * ut_h);
        }
        u32x4 o; o.x = pk2(r[0], r[1]); o.y = pk2(r[2], r[3]); o.z = pk2(r[4], r[5]); o.w = pk2(r[6], r[7]);
        *(u32x4*)(z + (size_t)t * DM + ch) = o;
    }
}

struct EpiResGate {
    static constexpr bool PERM = false, AFTER_DRAIN = false;
    const float* base; float* out; const float* gate;
    __device__ __forceinline__ void operator()(const pg8::f32x4 (&acc)[2][2][4][2], const pg8::Unit& u, int wr, int wc, int fr, int fq) const {
        const int row0 = u.pm * 256 + wr * 64 + fr, col0 = u.pn * 256 + wc * 32 + 4 * fq;
        const float* gp = gate + (size_t)(u.pm >> 4) * 6144 + col0;
        pg8::f32x4 gv[2][2];
#pragma unroll
        for (int bj = 0; bj < 2; ++bj)
#pragma unroll
            for (int n = 0; n < 2; ++n) gv[bj][n] = *(const pg8::f32x4*)(gp + bj * 128 + n * 16);
#pragma unroll
        for (int ai = 0; ai < 2; ++ai)
#pragma unroll
            for (int m = 0; m < 4; ++m) { const size_t off = (size_t)(row0 + ai * 128 + m * 16) * DM + col0;
#pragma unroll
                for (int bj = 0; bj < 2; ++bj)
#pragma unroll
                    for (int n = 0; n < 2; ++n) { const pg8::f32x4 bs = *(const pg8::f32x4*)(base + off + bj * 128 + n * 16);
                        *(pg8::f32x4*)(out + off + bj * 128 + n * 16) = bs + gv[bj][n] * acc[ai][bj][m][n]; } }
    }
};

DI unsigned f2key(float f) { const unsigned u = __float_as_uint(f); return u ^ ((unsigned)((int)u >> 31) | 0x80000000u); }
DI float key2f(unsigned k) { const unsigned u = (k & 0x80000000u) ? (k ^ 0x80000000u) : ~k; return __uint_as_float(u); }
DI unsigned umax_(unsigned a, unsigned b) { return a > b ? a : b; }
DI unsigned umin_(unsigned a, unsigned b) { return a < b ? a : b; }
template <int N> DI void bitonic_sort_desc(unsigned (&v)[N]) {
#pragma unroll
    for (int k = 2; k <= N; k <<= 1) {
#pragma unroll
        for (int j = k >> 1; j > 0; j >>= 1) {
#pragma unroll
            for (int i = 0; i < N; ++i) { const int l = i ^ j;
                if (l > i) { const bool desc = ((i & k) == 0); const unsigned x = v[i], y = v[l], mx = umax_(x, y), mn = umin_(x, y); v[i] = desc ? mx : mn; v[l] = desc ? mn : mx; } }
        }
    }
}
template <int N> DI void bitonic_merge_desc(unsigned (&v)[N]) {
#pragma unroll
    for (int j = N >> 1; j > 0; j >>= 1) {
#pragma unroll
        for (int i = 0; i < N; ++i) { const int l = i ^ j;
            if (l > i) { const unsigned x = v[i], y = v[l]; v[i] = umax_(x, y); v[l] = umin_(x, y); } }
    }
}
DI void top16_merge(unsigned (&t)[16], unsigned (&n)[16]) {
#pragma unroll
    for (int i = 0; i < 16; ++i) t[i] = umax_(t[i], n[15 - i]);
    bitonic_merge_desc<16>(t);
}

DI void topk_task(const bf16* PQ, const bf16* SK  , int* IDS, float* GATES, LAS unsigned short* tab  , int tok0, int h, int lane) {
    const int r32 = lane & 31, hi = lane >> 5;
    s16x8 qf[16];
    const bf16* qp = PQ + (size_t)(tok0 + r32) * 2048 + 256 * h + 8 * hi;
#pragma unroll
    for (int ks = 0; ks < 16; ++ks) qf[ks] = *(const s16x8*)(qp + 16 * ks);
    const int p = (r32 >> 2) & 1, keyl = (r32 & 3) + 4 * (r32 >> 3);
    const bf16* kp0 = SK + ((size_t)(h * 2 + p) * 128 + keyl) * 128 + 8 * hi;
    const s16x8 zero8 = (s16x8){0, 0, 0, 0, 0, 0, 0, 0};
    unsigned top[16];
#pragma unroll
    for (int i = 0; i < 16; ++i) top[i] = 0u;
#pragma unroll 1
    for (int rb = 0; rb < 8; ++rb) {
        const bf16* kp = kp0 + (size_t)rb * 16 * 128;
        f32x16 acc;
#pragma unroll
        for (int r = 0; r < 16; ++r) acc[r] = 0.f;
#pragma unroll
        for (int ks = 0; ks < 8; ++ks) {
            const s16x8 kf = *(const s16x8*)(kp + 16 * ks);
            const s16x8 a0 = p == 0 ? kf : zero8, a1 = p == 1 ? kf : zero8;
            acc = __builtin_amdgcn_mfma_f32_32x32x16_bf16(a0, qf[ks], acc, 0, 0, 0);
            acc = __builtin_amdgcn_mfma_f32_32x32x16_bf16(a1, qf[ks + 8], acc, 0, 0, 0);
        }
        unsigned nw[16];
#pragma unroll
        for (int r = 0; r < 16; ++r) nw[r] = (f2key(acc[r]) & ~127u) | (unsigned)(127 - (16 * rb + r));
        bitonic_sort_desc<16>(nw);
        top16_merge(top, nw);
    }
    unsigned LA[16], LB[16];
#pragma unroll
    for (int i = 0; i < 16; ++i) { const unsigned other = (unsigned)__shfl_xor((int)top[i], 32); LA[i] = hi ? other : top[i]; LB[i] = hi ? top[i] : other; }
#pragma unroll
    for (int i = 0; i < 16; ++i) { tab[i * 64 + lane] = (unsigned short)(127u - (LA[i] & 127u)); tab[(16 + i) * 64 + lane] = (unsigned short)(127u - (LB[i] & 127u)); }
    float av[16], bv[16];
#pragma unroll
    for (int i = 0; i < 16; ++i) { av[i] = key2f(LA[i] & ~127u); bv[i] = key2f(LB[i] & ~127u); }
    unsigned cg[4][16];
#pragma unroll
    for (int g = 0; g < 4; ++g)
#pragma unroll
        for (int e = 0; e < 16; ++e) cg[g][e] = 0u;
    {
        int cnt = 0;
#pragma unroll
        for (int i = 0; i < 16; ++i)
#pragma unroll
            for (int j = 0; j < 16; ++j)
                if ((i + 1) * (j + 1) <= 16) { cg[cnt >> 4][cnt & 15] = (f2key(av[i] + bv[j]) & ~255u) | (unsigned)(255 - (16 * i + j)); ++cnt; }
    }
    bitonic_sort_desc<16>(cg[0]); bitonic_sort_desc<16>(cg[1]); bitonic_sort_desc<16>(cg[2]); bitonic_sort_desc<16>(cg[3]);
    top16_merge(cg[0], cg[1]); top16_merge(cg[0], cg[2]); top16_merge(cg[0], cg[3]);
    LDS_WAIT(); asm volatile("" ::: "memory");
    float sv[16]; int ex[16];
#pragma unroll
    for (int k = 0; k < 16; ++k) { const unsigned key = cg[0][k]; const int pos = 255 - (int)(key & 255u); sv[k] = key2f(key & ~255u);
        const int ia = tab[(pos >> 4) * 64 + lane], ib = tab[(16 + (pos & 15)) * 64 + lane]; ex[k] = ia * 128 + ib; }
    LDS_WAIT(); asm volatile("" ::: "memory");
    const float mx = sv[0]; float sum = 0.f;
#pragma unroll
    for (int k = 0; k < 16; ++k) { sv[k] = expf(sv[k] - mx); sum += sv[k]; }
    const float inv = 1.f / sum;
    if (hi == 0) {
        int* ip = IDS + (size_t)(tok0 + r32) * 128 + h * 16; float* gp = GATES + (size_t)(tok0 + r32) * 128 + h * 16;
#pragma unroll
        for (int k = 0; k < 16; k += 4) { *(u32x4*)(ip + k) = (u32x4){(unsigned)ex[k], (unsigned)ex[k + 1], (unsigned)ex[k + 2], (unsigned)ex[k + 3]};
            *(f32x4*)(gp + k) = (f32x4){sv[k] * inv, sv[k + 1] * inv, sv[k + 2] * inv, sv[k + 3] * inv}; }
    }
}
DI void ph_topk(const bf16* PQ, const bf16* SK, int* IDS, float* GATES, LAS unsigned char* lds, int gw, int NGW, int wave, int lane) {
    LAS unsigned short* tab = (LAS unsigned short*)(lds + wave * 4096);
    for (int task = gw; task < (MTOK / 32) * 8; task += NGW) topk_task(PQ, SK, IDS, GATES, tab, (task >> 3) * 32, task & 7, lane);
}

DI float gelu_erf(float x) { return 0.5f * x * (1.f + erff(x * 0.70710678118654752f)); }
DI float dot16_fp8(const u32x4& w, const float (&h)[16]) {
    float d0 = 0.f, d1 = 0.f;
#pragma unroll
    for (int e = 0; e < 4; ++e) { const f32x2v lo = __builtin_amdgcn_cvt_pk_f32_fp8((int)w[e], false), hi = __builtin_amdgcn_cvt_pk_f32_fp8((int)w[e], true);
        d0 += lo.x * h[4 * e] + lo.y * h[4 * e + 1]; d1 += hi.x * h[4 * e + 2] + hi.y * h[4 * e + 3]; }
    return d0 + d1;
}
DI void ph_peer_u(const unsigned char* U8, const int* IDS, const float* GATES, const bf16* XN, float* ACT, int bx, int G, int wave, int lane) {
    const int x = bx & 7, rank = bx >> 3, nslots = ((G - x + 7) >> 3) * 8;
    const bool b5 = (lane & 32) != 0, b4 = (lane & 16) != 0, b3 = (lane & 8) != 0;
    const int grp = lane >> 3;
    for (int t = rank * 8 + wave; t < MTOK; t += nslots) {
        const int e_lo = IDS[(size_t)t * 128 + lane], e_hi = IDS[(size_t)t * 128 + 64 + lane];
        float h[16];
        { const u32x4 xa = ((const u32x4*)(XN + (size_t)t * DM))[2 * lane], xb = ((const u32x4*)(XN + (size_t)t * DM))[2 * lane + 1];
#pragma unroll
          for (int e = 0; e < 4; ++e) { h[2 * e] = bflo(xa[e]); h[2 * e + 1] = bfhi(xa[e]); h[8 + 2 * e] = bflo(xb[e]); h[8 + 2 * e + 1] = bfhi(xb[e]); } }
        unsigned long long m0 = __ballot((e_lo >> 11) == x), m1 = __ballot((e_hi >> 11) == x);
        while (m0 | m1) {
            int jj[8];
#pragma unroll
            for (int q = 0; q < 8; ++q) {
                if (m0) { jj[q] = (int)__builtin_ctzll(m0); m0 &= m0 - 1; }
                else if (m1) { jj[q] = 64 + (int)__builtin_ctzll(m1); m1 &= m1 - 1; }
                else jj[q] = -1;
            }
            u32x4 u[8];
#pragma unroll
            for (int q = 0; q < 8; ++q) {
                if (jj[q] >= 0) { const int e = __builtin_amdgcn_readlane(jj[q] < 64 ? e_lo : e_hi, jj[q] & 63); u[q] = *(const u32x4*)(U8 + (size_t)e * 1024 + 16 * lane); }
                else u[q] = (u32x4){0u, 0u, 0u, 0u};
            }
            float p[8];
#pragma unroll
            for (int q = 0; q < 8; ++q) p[q] = dot16_fp8(u[q], h);
            float v4[4], v2[2];
#pragma unroll
            for (int i = 0; i < 4; ++i) { const float keep = b5 ? p[i + 4] : p[i], give = b5 ? p[i] : p[i + 4]; v4[i] = keep + __shfl_xor(give, 32); }
#pragma unroll
            for (int i = 0; i < 2; ++i) { const float keep = b4 ? v4[i + 2] : v4[i], give = b4 ? v4[i] : v4[i + 2]; v2[i] = keep + __shfl_xor(give, 16); }
            float tot; { const float keep = b3 ? v2[1] : v2[0], give = b3 ? v2[0] : v2[1]; tot = keep + __shfl_xor(give, 8); }
            tot += __shfl_xor(tot, 1); tot += __shfl_xor(tot, 2); tot += __shfl_xor(tot, 4);
            int jg = jj[0];
#pragma unroll
            for (int q = 1; q < 8; ++q) jg = grp == q ? jj[q] : jg;
            if ((lane & 7) == 0 && jg >= 0) { const float gate = GATES[(size_t)t * 128 + jg]; ACT[(size_t)t * 128 + jg] = gelu_erf(tot * (1.f / U8_SCALE)) * gate; }
        }
    }
}
DI void ph_peer_v(const unsigned char* V8  , const int* IDS, const float* ACT, const float* Xin, float* Xout, const float* g2, int bx, int G, int wave, int lane) {
    const int x = bx & 7, rank = bx >> 3, nslots = ((G - x + 7) >> 3) * 8;
    const bool b5 = (lane & 32) != 0, b4 = (lane & 16) != 0, b3 = (lane & 8) != 0;
    const int grp = lane >> 3;
    const unsigned char* Vx = V8 + (size_t)x * NEXP * 128;
    const unsigned coff = 16u * (unsigned)(lane & 7);
    for (int t = rank * 8 + wave; t < MTOK; t += nslots) {
        const int e_lo = IDS[(size_t)t * 128 + lane], e_hi = IDS[(size_t)t * 128 + 64 + lane];
        const float a_lo = ACT[(size_t)t * 128 + lane], a_hi = ACT[(size_t)t * 128 + 64 + lane];
        float acc[16];
#pragma unroll
        for (int i = 0; i < 16; ++i) acc[i] = 0.f;
#pragma unroll
        for (int hb = 0; hb < 2; ++hb) {
            u32x4 v[8]; float aw[8];
#pragma unroll
            for (int it = 0; it < 8; ++it) { const int src = 8 * it + grp; const int e = __shfl(hb ? e_hi : e_lo, src); aw[it] = __shfl(hb ? a_hi : a_lo, src);
                v[it] = *(const u32x4*)(Vx + ((unsigned)e * 128u + coff)); }
#pragma unroll
            for (int it = 0; it < 8; ++it)
#pragma unroll
                for (int e = 0; e < 4; ++e) { const f32x2v lo = __builtin_amdgcn_cvt_pk_f32_fp8((int)v[it][e], false), hi = __builtin_amdgcn_cvt_pk_f32_fp8((int)v[it][e], true);
                    acc[4 * e] += aw[it] * lo.x; acc[4 * e + 1] += aw[it] * lo.y; acc[4 * e + 2] += aw[it] * hi.x; acc[4 * e + 3] += aw[it] * hi.y;
                    if (e == 3) __builtin_amdgcn_sched_barrier(0); }
        }
        float v8[8], v4[4], v2[2];
#pragma unroll
        for (int i = 0; i < 8; ++i) { const float keep = b5 ? acc[i + 8] : acc[i], give = b5 ? acc[i] : acc[i + 8]; v8[i] = keep + __shfl_xor(give, 32); }
#pragma unroll
        for (int i = 0; i < 4; ++i) { const float keep = b4 ? v8[i + 4] : v8[i], give = b4 ? v8[i] : v8[i + 4]; v4[i] = keep + __shfl_xor(give, 16); }
#pragma unroll
        for (int i = 0; i < 2; ++i) { const float keep = b3 ? v4[i + 2] : v4[i], give = b3 ? v4[i] : v4[i + 2]; v2[i] = keep + __shfl_xor(give, 8); }
        const int dim = 128 * x + 16 * (lane & 7) + 2 * grp;
        const float* gp = g2 + (size_t)(t >> 12) * 6144 + dim;
        f32x2v xv = *(const f32x2v*)(Xin + (size_t)t * DM + dim); const f32x2v gg = *(const f32x2v*)gp;
        xv.x += gg.x * v2[0] * (1.f / V8_SCALE); xv.y += gg.y * v2[1] * (1.f / V8_SCALE);
        *(f32x2v*)(Xout + (size_t)t * DM + dim) = xv;
    }
}

DI void ph_latnorm(const bf16* LAT, const float* qg, const float* kvg, bf16* QN, bf16* KVN, int gw, int NGW, int lane) {
    for (int t = gw; t < MTOK; t += NGW) {
        const unsigned* lr = (const unsigned*)(LAT + (size_t)t * MLA_IN_PAD);
        unsigned q[3], k[2]; float sq = 0.f, sk = 0.f;
#pragma unroll
        for (int j = 0; j < 3; ++j) { q[j] = lr[lane + 64 * j]; sq += bflo(q[j]) * bflo(q[j]) + bfhi(q[j]) * bfhi(q[j]); }
#pragma unroll
        for (int j = 0; j < 2; ++j) { k[j] = lr[192 + lane + 64 * j]; sk += bflo(k[j]) * bflo(k[j]) + bfhi(k[j]) * bfhi(k[j]); }
        const float rq = rsqrtf(wave_sum(sq) * (1.f / QLORA) + NORM_EPS), rk = rsqrtf(wave_sum(sk) * (1.f / KVLORA) + NORM_EPS);
        unsigned* qo = (unsigned*)(QN + (size_t)t * QLORA); unsigned* ko = (unsigned*)(KVN + (size_t)t * KVLORA);
#pragma unroll
        for (int j = 0; j < 3; ++j) { const int c = 2 * (lane + 64 * j); qo[lane + 64 * j] = pk2(bflo(q[j]) * rq * qg[c], bfhi(q[j]) * rq * qg[c + 1]); }
#pragma unroll
        for (int j = 0; j < 2; ++j) { const int c = 2 * (lane + 64 * j); ko[lane + 64 * j] = pk2(bflo(k[j]) * rk * kvg[c], bfhi(k[j]) * rk * kvg[c + 1]); }
    }
}

DI void ph_qkprep(const bf16* QRAW, const bf16* KVRAW, const bf16* LAT, const int* positions, const float* qg, const float* kg,
                  bf16* Qf, bf16* Kf, bf16* Vt, int gw, int NGW, int lane) {
    const int f = lane & 31;
    const float invf = exp2f(-(float)f * (13.287712379549449f / 32.f));
    const float qg0 = qg[lane], qg1 = qg[64 + lane], qg2 = qg[128 + lane], kg0 = kg[lane], kg1 = kg[64 + lane], kg2 = kg[128 + lane];
    for (int task = gw; task < MTOK / 8; task += NGW) {
        const int t0 = task * 8, b = t0 >> 12, s0 = t0 & (SEQ - 1);
#pragma unroll 1
        for (int tt = 0; tt < 8; ++tt) {
            const int t = t0 + tt, s = s0 + tt;
            const float ang = (float)positions[t] * invf;
            double rev = (double)ang * 0.15915494309189535; rev -= floor(rev);
            const float rv = (float)rev, sn = __builtin_amdgcn_sinf(rv), cs = __builtin_amdgcn_cosf(rv);
            const float kr = bf1(LAT[(size_t)t * MLA_IN_PAD + 640 + lane]);
#pragma unroll 1
            for (int h = 0; h < NH; ++h) {
                { const bf16* qp = QRAW + (size_t)t * 1536 + QKH * h;
                  const float x0 = bf1(qp[lane]), x1 = bf1(qp[64 + lane]), x2 = bf1(qp[128 + lane]);
                  const float rstd = rsqrtf(wave_sum(x0 * x0 + x1 * x1 + x2 * x2) * (1.f / QKH) + NORM_EPS);
                  const float y0 = x0 * rstd * qg0, y1 = x1 * rstd * qg1, y2 = x2 * rstd * qg2, pr = __shfl_xor(y2, 32);
                  const float r2 = lane < 32 ? y2 * cs - pr * sn : pr * sn + y2 * cs;
                  bf16* o = Qf + ((size_t)(b * NH + h) * SEQ + s) * QKH;
                  o[lane] = (bf16)f2bf(y0 * QSCALE); o[64 + lane] = (bf16)f2bf(y1 * QSCALE); o[128 + lane] = (bf16)f2bf(r2 * QSCALE); }
                { const bf16* kp = KVRAW + (size_t)t * 2048 + 256 * h;
                  const float x0 = bf1(kp[lane]), x1 = bf1(kp[64 + lane]), x2 = kr;
                  const float rstd = rsqrtf(wave_sum(x0 * x0 + x1 * x1 + x2 * x2) * (1.f / QKH) + NORM_EPS);
                  const float y0 = x0 * rstd * kg0, y1 = x1 * rstd * kg1, y2 = x2 * rstd * kg2, pr = __shfl_xor(y2, 32);
                  const float r2 = lane < 32 ? y2 * cs - pr * sn : pr * sn + y2 * cs;
                  bf16* o = Kf + ((size_t)(b * NH + h) * SEQ + s) * QKH;
                  o[lane] = (bf16)f2bf(y0); o[64 + lane] = (bf16)f2bf(y1); o[128 + lane] = (bf16)f2bf(r2); }
            }
        }
#pragma unroll 1
        for (int h = 0; h < NH; ++h)
#pragma unroll
            for (int dd = 0; dd < 128; dd += 64) {
                const bf16* vp = KVRAW + (size_t)t0 * 2048 + 256 * h + 128 + dd + lane;
                unsigned w[4];
#pragma unroll
                for (int i = 0; i < 4; ++i) w[i] = (unsigned)vp[(size_t)(2 * i) * 2048] | ((unsigned)vp[(size_t)(2 * i + 1) * 2048] << 16);
                *(u32x4*)(Vt + ((size_t)(b * NH + h) * VH + dd + lane) * SEQ + s0) = (u32x4){w[0], w[1], w[2], w[3]};
            }
    }
}

typedef float f32x2_t __attribute__((ext_vector_type(2))); typedef __bf16 bf16x2_t __attribute__((ext_vector_type(2)));
DI unsigned cvtpk(float lo, float hi) { f32x2_t v = {lo, hi}; bf16x2_t b = __builtin_convertvector(v, bf16x2_t); return __builtin_bit_cast(unsigned, b); }
DI void attn_unit(const bf16* Qf, const bf16* Kf, const bf16* Vt, bf16* O, int bh, int qb, int wave, int lane) {
    const int r32 = lane & 31, hi = lane >> 5;
    const int q0 = qb * 256 + wave * 32;
    s16x8 qf[12];
    { const bf16* Qp = Qf + ((size_t)bh * SEQ + q0 + r32) * QKH + 8 * hi;
#pragma unroll
      for (int ks = 0; ks < 12; ++ks) qf[ks] = *(const s16x8*)(Qp + 16 * ks); }
    f32x16 o[4];
#pragma unroll
    for (int d = 0; d < 4; ++d)
#pragma unroll
        for (int r = 0; r < 16; ++r) o[d][r] = 0.f;
    float m = -1e30f, l = 0.f;
    const bf16* Kp = Kf + ((size_t)bh * SEQ + r32) * QKH + 8 * hi;
    const bf16* Vp = Vt + ((size_t)bh * VH + r32) * SEQ + 4 * hi;
    const int nkt = q0 / 32 + 1;
#pragma unroll 1
    for (int kt = 0; kt < nkt; ++kt) {
        f32x16 sc;
#pragma unroll
        for (int r = 0; r < 16; ++r) sc[r] = 0.f;
        const bf16* kp = Kp + (size_t)kt * 32 * QKH;
#pragma unroll
        for (int ks = 0; ks < 12; ++ks) sc = __builtin_amdgcn_mfma_f32_32x32x16_bf16(*(const s16x8*)(kp + 16 * ks), qf[ks], sc, 0, 0, 0);
        if (kt == nkt - 1) {
#pragma unroll
            for (int r = 0; r < 16; ++r) if (crow(r, hi) > r32) sc[r] = -INFINITY;
        }
        float mt = sc[0];
#pragma unroll
        for (int r = 1; r < 16; ++r) mt = fmaxf(mt, sc[r]);
        mt = fmaxf(mt, __shfl_xor(mt, 32));
        const float mn = fmaxf(m, mt), alpha = __builtin_amdgcn_exp2f(m - mn);
        m = mn; l *= alpha;
#pragma unroll
        for (int d = 0; d < 4; ++d)
#pragma unroll
            for (int r = 0; r < 16; ++r) o[d][r] *= alpha;
        float ps = 0.f;
#pragma unroll
        for (int r = 0; r < 16; ++r) { sc[r] = __builtin_amdgcn_exp2f(sc[r] - mn); ps += sc[r]; }
        l += ps;
#pragma unroll
        for (int s = 0; s < 2; ++s) {
            u32x4 pw; pw.x = cvtpk(sc[8 * s], sc[8 * s + 1]); pw.y = cvtpk(sc[8 * s + 2], sc[8 * s + 3]); pw.z = cvtpk(sc[8 * s + 4], sc[8 * s + 5]); pw.w = cvtpk(sc[8 * s + 6], sc[8 * s + 7]);
            const s16x8 pb = __builtin_bit_cast(s16x8, pw);
#pragma unroll
            for (int d = 0; d < 4; ++d) {
                const bf16* vp = Vp + (size_t)d * 32 * SEQ + kt * 32 + 16 * s;
                const s16x4 lo = *(const s16x4*)vp, hh = *(const s16x4*)(vp + 8);
                const s16x8 va = __builtin_shufflevector(lo, hh, 0, 1, 2, 3, 4, 5, 6, 7);
                o[d] = __builtin_amdgcn_mfma_f32_32x32x16_bf16(va, pb, o[d], 0, 0, 0);
            }
        }
    }
    l += __shfl_xor(l, 32);
    const float inv = 1.f / l;
    bf16* Op = O + ((size_t)((bh >> 3) * SEQ + q0 + r32)) * DM + (bh & 7) * VH + 4 * hi;
#pragma unroll
    for (int d = 0; d < 4; ++d)
#pragma unroll
        for (int g = 0; g < 4; ++g) { u32x2 w; w.x = cvtpk(o[d][4 * g] * inv, o[d][4 * g + 1] * inv); w.y = cvtpk(o[d][4 * g + 2] * inv, o[d][4 * g + 3] * inv);
            *(u32x2*)(Op + 32 * d + 8 * g) = w; }
}
constexpr int AT_KROW = 400, AT_VROW = 136, AT_KBYTES = 64 * AT_KROW, AT_VBYTES = 128 * AT_VROW, AT_STAGE = AT_KBYTES + AT_VBYTES;
DI void attn_unit_lds(const bf16* Qf, const bf16* Kf, const bf16* Vt, bf16* O, LAS unsigned char* lds, int bh, int qb, int wave, int lane) {
    const int r32 = lane & 31, hi = lane >> 5, tid = wave * 64 + lane;
    const int q0 = qb * 256 + wave * 32;
    s16x8 qf[12];
    { const bf16* Qp = Qf + ((size_t)bh * SEQ + q0 + r32) * QKH + 8 * hi;
#pragma unroll
      for (int ks = 0; ks < 12; ++ks) qf[ks] = *(const s16x8*)(Qp + 16 * ks); }
    f32x16 o[4];
#pragma unroll
    for (int d = 0; d < 4; ++d)
#pragma unroll
        for (int r = 0; r < 16; ++r) o[d][r] = 0.f;
    float m = -1e30f, l = 0.f;
    const int NT = 4 * (qb + 1);
    const __amdgpu_buffer_rsrc_t krs = __builtin_amdgcn_make_buffer_rsrc((void*)(Kf + (size_t)bh * SEQ * QKH), 0, SEQ * QKH * 2, 0x00020000);
    const __amdgpu_buffer_rsrc_t vrs = __builtin_amdgcn_make_buffer_rsrc((void*)(Vt + (size_t)bh * VH * SEQ), 0, VH * SEQ * 2, 0x00020000);
    unsigned kgo[3], kl[3], vgo[2], vl[2];
#pragma unroll
    for (int i = 0; i < 3; ++i) { const int c = tid + 512 * i, row = c / 24, col = c - row * 24; kgo[i] = (unsigned)(row * 384 + col * 16); kl[i] = (unsigned)(row * AT_KROW + col * 16); }
#pragma unroll
    for (int i = 0; i < 2; ++i) { const int c = tid + 512 * i, d = c >> 3, part = c & 7; vgo[i] = (unsigned)(d * (SEQ * 2) + part * 16); vl[i] = (unsigned)(AT_KBYTES + d * AT_VROW + part * 16); }
    u32x4 kr[3], vr[2];
#pragma unroll
    for (int i = 0; i < 3; ++i) kr[i] = __builtin_amdgcn_raw_buffer_load_b128(krs, kgo[i], 0, 0);
#pragma unroll
    for (int i = 0; i < 2; ++i) vr[i] = __builtin_amdgcn_raw_buffer_load_b128(vrs, vgo[i], 0, 0);
#pragma unroll
    for (int i = 0; i < 3; ++i) *(LAS u32x4*)(lds + kl[i]) = kr[i];
#pragma unroll
    for (int i = 0; i < 2; ++i) { *(LAS u32x2*)(lds + vl[i]) = (u32x2){vr[i].x, vr[i].y}; *(LAS u32x2*)(lds + vl[i] + 8) = (u32x2){vr[i].z, vr[i].w}; }
    __syncthreads();
    const unsigned kfo = (unsigned)(r32 * AT_KROW + 16 * hi), vfo = (unsigned)(AT_KBYTES + r32 * AT_VROW + 8 * hi);
#pragma unroll 1
    for (int t = 0; t < NT; ++t) {
        const unsigned sb = (unsigned)((t & 1) * AT_STAGE), sn = (unsigned)(((t + 1) & 1) * AT_STAGE);
        const bool more = t + 1 < NT;
        if (more) {
#pragma unroll
            for (int i = 0; i < 3; ++i) kr[i] = __builtin_amdgcn_raw_buffer_load_b128(krs, kgo[i], (t + 1) * (64 * 384), 0);
#pragma unroll
            for (int i = 0; i < 2; ++i) vr[i] = __builtin_amdgcn_raw_buffer_load_b128(vrs, vgo[i], (t + 1) * 128, 0);
        }
        const int k0 = 64 * t;
        if (k0 <= q0 + 31) {
            f32x16 s0, s1;
#pragma unroll
            for (int r = 0; r < 16; ++r) { s0[r] = 0.f; s1[r] = 0.f; }
#pragma unroll
            for (int ks = 0; ks < 12; ++ks) {
                const s16x8 ka = *(const LAS s16x8*)(lds + sb + kfo + 32 * ks), kb = *(const LAS s16x8*)(lds + sb + kfo + 32 * AT_KROW + 32 * ks);
                s0 = __builtin_amdgcn_mfma_f32_32x32x16_bf16(ka, qf[ks], s0, 0, 0, 0);
                s1 = __builtin_amdgcn_mfma_f32_32x32x16_bf16(kb, qf[ks], s1, 0, 0, 0);
                if ((ks & 3) == 3) __builtin_amdgcn_sched_barrier(0);
            }
            if (k0 + 63 > q0) {
                const int qa = q0 + r32 - k0 - 4 * hi;
#pragma unroll
                for (int r = 0; r < 16; ++r) { if (((r & 3) + 8 * (r >> 2)) > qa) s0[r] = -INFINITY; if ((32 + (r & 3) + 8 * (r >> 2)) > qa) s1[r] = -INFINITY; }
            }
            float mt = fmaxf(s0[0], s1[0]);
#pragma unroll
            for (int r = 1; r < 16; ++r) mt = fmaxf(mt, fmaxf(s0[r], s1[r]));
            mt = fmaxf(mt, __shfl_xor(mt, 32));
            const float mn = fmaxf(m, mt), alpha = __builtin_amdgcn_exp2f(m - mn);
            m = mn; l *= alpha;
#pragma unroll
            for (int d = 0; d < 4; ++d)
#pragma unroll
                for (int r = 0; r < 16; ++r) o[d][r] *= alpha;
            float ps = 0.f;
#pragma unroll
            for (int r = 0; r < 16; ++r) { s0[r] = __builtin_amdgcn_exp2f(s0[r] - mn); s1[r] = __builtin_amdgcn_exp2f(s1[r] - mn); ps += s0[r] + s1[r]; }
            l += ps;
#pragma unroll
            for (int s = 0; s < 4; ++s) {
                u32x4 pw;
                if (s < 2) { pw.x = cvtpk(s0[8 * s], s0[8 * s + 1]); pw.y = cvtpk(s0[8 * s + 2], s0[8 * s + 3]); pw.z = cvtpk(s0[8 * s + 4], s0[8 * s + 5]); pw.w = cvtpk(s0[8 * s + 6], s0[8 * s + 7]); }
                else { const int z = s - 2; pw.x = cvtpk(s1[8 * z], s1[8 * z + 1]); pw.y = cvtpk(s1[8 * z + 2], s1[8 * z + 3]); pw.z = cvtpk(s1[8 * z + 4], s1[8 * z + 5]); pw.w = cvtpk(s1[8 * z + 6], s1[8 * z + 7]); }
                const s16x8 pb = __builtin_bit_cast(s16x8, pw);
#pragma unroll
                for (int d = 0; d < 4; ++d) {
                    const unsigned va = sb + vfo + (unsigned)(d * 32 * AT_VROW + 32 * s);
                    const s16x4 lo = *(const LAS s16x4*)(lds + va), hh = *(const LAS s16x4*)(lds + va + 16);
                    const s16x8 vfrag = __builtin_shufflevector(lo, hh, 0, 1, 2, 3, 4, 5, 6, 7);
                    o[d] = __builtin_amdgcn_mfma_f32_32x32x16_bf16(vfrag, pb, o[d], 0, 0, 0);
                }
                __builtin_amdgcn_sched_barrier(0);
            }
        }
        if (more) {
#pragma unroll
            for (int i = 0; i < 3; ++i) *(LAS u32x4*)(lds + sn + kl[i]) = kr[i];
#pragma unroll
            for (int i = 0; i < 2; ++i) { *(LAS u32x2*)(lds + sn + vl[i]) = (u32x2){vr[i].x, vr[i].y}; *(LAS u32x2*)(lds + sn + vl[i] + 8) = (u32x2){vr[i].z, vr[i].w}; }
        }
        __syncthreads();
    }
    l += __shfl_xor(l, 32);
    const float inv = 1.f / l;
    bf16* Op = O + ((size_t)((bh >> 3) * SEQ + q0 + r32)) * DM + (bh & 7) * VH + 4 * hi;
#pragma unroll
    for (int d = 0; d < 4; ++d)
#pragma unroll
        for (int g = 0; g < 4; ++g) { u32x2 w; w.x = cvtpk(o[d][4 * g] * inv, o[d][4 * g + 1] * inv); w.y = cvtpk(o[d][4 * g + 2] * inv, o[d][4 * g + 3] * inv);
            *(u32x2*)(Op + 32 * d + 8 * g) = w; }
}
DI void ph_attn(const bf16* Qf, const bf16* Kf, const bf16* Vt, bf16* O, LAS unsigned char* lds, int vcu, int G, int wave, int lane) {
    for (int p = vcu; p < 256; p += G) {
        const int bh = p >> 3, s8 = p & 7;
#pragma unroll 1
        for (int u = 0; u < 2; ++u) attn_unit_lds(Qf, Kf, Vt, O, lds, bh, u ? s8 : 15 - s8, wave, lane);
    }
}

__global__ void __launch_bounds__(NWAVES * 64, 2) mk_fwd(Args args) {
    extern __shared__ __attribute__((aligned(16))) unsigned char lds_raw[];
    LAS unsigned char* lds = (LAS unsigned char*)lds_raw;
    const int tid = threadIdx.x, lane = tid & 63, wave = __builtin_amdgcn_readfirstlane(tid >> 6);
    const int G = gridDim.x, bx = blockIdx.x, vcu = (G % 8 == 0) ? (bx % 8) * (G / 8) + bx / 8 : bx;
    const int gw = vcu * NWAVES + wave, NGW = G * NWAVES;
    const size_t GT = (size_t)G * 512;
    unsigned char* ws = args.ws;
    for (int u = tid; u < (LDS_BYTES - LDSCTL_OFF) / 4; u += NWAVES * 64) ((LAS unsigned*)(lds + LDSCTL_OFF))[u] = 0u;
    __syncthreads();
    const bool multi = (args.ph_hi - args.ph_lo) > 1;
    XcdBarrier bar; bar.bar = (unsigned*)(ws + WS_CTL) + CW_BAR; bar.x = 0; bar.st = (volatile LAS unsigned*)(lds + MISC_OFF) + 8;
    if (multi) bar = xcd_barrier_post((unsigned*)(ws + WS_CTL) + CW_BAR, (volatile LAS unsigned*)(lds + MISC_OFF) + 8);

    float* X = args.out;
    const float* mod = (const float*)(ws + WS_MOD);
    bf16* XN = (bf16*)(ws + WS_XN);

    const int lo = args.ph_lo, hi = args.ph_hi;
#define IN(k) (EN(k) && lo <= (k) && (k) < hi)
    auto opq = [](int v) { asm volatile("" : "+v"(v)); return v; };
#define LN opq(lane)
#define TD opq(tid)
#define GTID ((size_t)vcu * 512 + (size_t)opq(tid))
#define SEAM(k) do { if (lo <= (k) && (k) + 1 < hi) xcd_barrier(bar); } while (0)
#define GEMM_BF16(Aptr, Bptr, NN, KK, Optr, LDC) do { pg8::Gemm g{(const bf16*)(Aptr), (const bf16*)(Bptr), MTOK, (NN), (KK)}; pg8::StaticOrder S; S.init(MTOK, (NN), G, bx); \
        pg8::EpiBf16<0> E{(bf16*)(Optr), (LDC), nullptr, 0, 0, 1.f}; pg8::gemm_phase<pg8::EpiBf16<0>, pg8::StaticOrder, true, true>(lds, g, S, E); } while (0)
#define GEMM_RES(Aptr, Bptr, BASE, OUT, GATE) do { pg8::Gemm g{(const bf16*)(Aptr), (const bf16*)(Bptr), MTOK, DM, DM}; pg8::StaticOrder S; S.init(MTOK, DM, G, bx); \
        EpiResGate E{(BASE), (OUT), (GATE)}; pg8::gemm_phase<EpiResGate, pg8::StaticOrder, true, true>(lds, g, S, E); } while (0)

    if (IN(0)) for (int r_ = 0; r_ < NREP(0); ++r_) ph_prologue(args, lds, TD, wave, vcu, G);
    SEAM(0);
    if (IN(1)) for (int r_ = 0; r_ < NREP(1); ++r_) ph_modulate((const float*)args.in[0], XN, (const float*)args.in[3], mod, 0, 1024, gw, NGW, LN);
    SEAM(1);
    if (IN(2)) for (int r_ = 0; r_ < NREP(2); ++r_) GEMM_BF16(XN, ws + WS_WCIN, 3072, 1024, ws + WS_BCV, 3072);
    SEAM(2);
    if (IN(3)) for (int r_ = 0; r_ < NREP(3); ++r_) ph_conv((const bf16*)(ws + WS_BCV), (const float*)args.in[8], (bf16*)(ws + WS_Z), GTID, GT);
    SEAM(3);
    if (IN(4)) for (int r_ = 0; r_ < NREP(4); ++r_) GEMM_RES(ws + WS_Z, ws + WS_WCOUT, (const float*)args.in[0], X, mod + 2048);
    SEAM(4);
    if (IN(5)) for (int r_ = 0; r_ < NREP(5); ++r_) ph_modulate(X, XN, (const float*)args.in[4], mod, 3072, 4096, gw, NGW, LN);
    SEAM(5);
    if (IN(6)) for (int r_ = 0; r_ < NREP(6); ++r_) GEMM_BF16(XN, ws + WS_WPQ0, 2048, 1024, ws + WS_PQ, 2048);
    SEAM(6);
    if (IN(7)) for (int r_ = 0; r_ < NREP(7); ++r_) ph_topk((const bf16*)(ws + WS_PQ), (const bf16*)(ws + WS_SUBK), (int*)(ws + WS_IDS), (float*)(ws + WS_GATES), lds, gw, NGW, wave, LN);
    SEAM(7);
    if (IN(8)) for (int r_ = 0; r_ < NREP(8); ++r_) ph_peer_u(ws + WS_PU, (const int*)(ws + WS_IDS), (const float*)(ws + WS_GATES), XN, (float*)(ws + WS_ACT), bx, G, wave, LN);
    SEAM(8);
    if (IN(9)) for (int r_ = 0; r_ < NREP(9); ++r_) ph_peer_v(ws + WS_PV, (const int*)(ws + WS_IDS), (const float*)(ws + WS_ACT), X, (r_ + 1 < NREP(9) ? (float*)(ws + WS_DUMMY) : X), mod + 5120, bx, G, wave, LN);
    SEAM(9);
    if (IN(10)) for (int r_ = 0; r_ < NREP(10); ++r_) ph_modulate(X, XN, (const float*)args.in[3] + DM, mod + (size_t)4 * 6144, 0, 1024, gw, NGW, LN);
    SEAM(10);
    if (IN(11)) for (int r_ = 0; r_ < NREP(11); ++r_) GEMM_BF16(XN, ws + WS_WMIN, MLA_IN_PAD, 1024, ws + WS_LAT, MLA_IN_PAD);
    SEAM(11);
    if (IN(12)) for (int r_ = 0; r_ < NREP(12); ++r_) ph_latnorm((const bf16*)(ws + WS_LAT), (const float*)args.in[11], (const float*)args.in[12], (bf16*)(ws + WS_QN), (bf16*)(ws + WS_KVN), gw, NGW, LN);
    SEAM(12);
    if (IN(13)) for (int r_ = 0; r_ < NREP(13); ++r_) { GEMM_BF16(ws + WS_QN, ws + WS_WQB, 1536, QLORA, ws + WS_QRAW, 1536); GEMM_BF16(ws + WS_KVN, ws + WS_WKVB, 2048, KVLORA, ws + WS_KVRAW, 2048); }
    SEAM(13);
    if (IN(14)) for (int r_ = 0; r_ < NREP(14); ++r_) ph_qkprep((const bf16*)(ws + WS_QRAW), (const bf16*)(ws + WS_KVRAW), (const bf16*)(ws + WS_LAT), (const int*)args.in[2], (const float*)args.in[15], (const float*)args.in[16],
                          (bf16*)(ws + WS_QF), (bf16*)(ws + WS_KF), (bf16*)(ws + WS_VT), gw, NGW, LN);
    SEAM(14);
    if (IN(15)) for (int r_ = 0; r_ < NREP(15); ++r_) ph_attn((const bf16*)(ws + WS_QF), (const bf16*)(ws + WS_KF), (const bf16*)(ws + WS_VT), (bf16*)(ws + WS_O), lds, vcu, G, wave, LN);
    SEAM(15);
    if (IN(16)) for (int r_ = 0; r_ < NREP(16); ++r_) GEMM_RES(ws + WS_O, ws + WS_WMOUT, (const float*)X, (r_ + 1 < NREP(16) ? (float*)(ws + WS_DUMMY) : X), mod + (size_t)4 * 6144 + 2048);
    SEAM(16);
    if (IN(17)) for (int r_ = 0; r_ < NREP(17); ++r_) ph_modulate(X, XN, (const float*)args.in[4] + DM, mod + (size_t)4 * 6144, 3072, 4096, gw, NGW, LN);
    SEAM(17);
    if (IN(18)) for (int r_ = 0; r_ < NREP(18); ++r_) GEMM_BF16(XN, ws + WS_WPQ1, 2048, 1024, ws + WS_PQ, 2048);
    SEAM(18);
    if (IN(19)) for (int r_ = 0; r_ < NREP(19); ++r_) ph_topk((const bf16*)(ws + WS_PQ), (const bf16*)(ws + WS_SUBK) + (size_t)8 * 2 * 128 * 128, (int*)(ws + WS_IDS), (float*)(ws + WS_GATES), lds, gw, NGW, wave, LN);
    SEAM(19);
    if (IN(20)) for (int r_ = 0; r_ < NREP(20); ++r_) ph_peer_u(ws + WS_PU + (size_t)NEXP * 1024, (const int*)(ws + WS_IDS), (const float*)(ws + WS_GATES), XN, (float*)(ws + WS_ACT), bx, G, wave, LN);
    SEAM(20);
    if (IN(21)) for (int r_ = 0; r_ < NREP(21); ++r_) ph_peer_v(ws + WS_PV + (size_t)8 * NEXP * 128, (const int*)(ws + WS_IDS), (const float*)(ws + WS_ACT), X, (r_ + 1 < NREP(21) ? (float*)(ws + WS_DUMMY) : X), mod + (size_t)4 * 6144 + 5120, bx, G, wave, LN);
}

extern "C" void kernel_launch(void* const* d_in, const int* in_sizes, int n_in, void* d_out, int out_size, void* d_ws, size_t ws_size, hipStream_t stream) {
    static int grid = 0;
    if (grid == 0) {
        if (n_in != 22 || out_size != MTOK * DM || ws_size < WS_END) { fprintf(stderr, "kernel_launch: unexpected shapes: n_in %d out %d ws %zu (need %zu)\n", n_in, out_size, ws_size, (size_t)WS_END); grid = -1; return; }
        int dev = 0, cus = 0;
        if (hipGetDevice(&dev) != hipSuccess || hipDeviceGetAttribute(&cus, hipDeviceAttributeMultiprocessorCount, dev) != hipSuccess) { grid = -1; return; }
        if (hipFuncSetAttribute((const void*)mk_fwd, hipFuncAttributeMaxDynamicSharedMemorySize, LDS_BYTES) != hipSuccess) { fprintf(stderr, "kernel_launch: hipFuncSetAttribute failed\n"); grid = -1; return; }
        int per_cu = 0;
        if (hipOccupancyMaxActiveBlocksPerMultiprocessor(&per_cu, (const void*)mk_fwd, NWAVES * 64, LDS_BYTES) != hipSuccess || per_cu < 1) fprintf(stderr, "kernel_launch: occupancy query says %d\n", per_cu);
        (void)hipGetLastError();
        grid = cus;
    }
    if (grid < 0) return;
    (void)hipMemsetAsync((char*)d_ws + WS_CTL, 0, CTL_ZERO_BYTES, stream);
    Args a{};
    for (int i = 0; i < 22; ++i) a.in[i] = d_in[i];
    a.out = (float*)d_out; a.ws = (unsigned char*)d_ws;
#if MK_N_LAUNCHES == 1
    a.ph_lo = 0; a.ph_hi = NPHASES;
    hipLaunchKernelGGL(mk_fwd, dim3(grid), dim3(NWAVES * 64), LDS_BYTES, stream, a);
#else
    for (int ph = 0; ph < NPHASES; ++ph) { a.ph_lo = ph; a.ph_hi = ph + 1; hipLaunchKernelGGL(mk_fwd, dim3(grid), dim3(NWAVES * 64), LDS_BYTES, stream, a); }
#endif
}
```

```cpp
#include <hip/hip_runtime.h>
#include <cstdio>
#include <cstdint>
#define GAS __attribute__((address_space(1)))
#define LAS __attribute__((address_space(3)))
namespace pg8 {
#define PG8_LAS __attribute__((address_space(3)))
typedef unsigned short bf16_t;
typedef short bf16x8 __attribute__((ext_vector_type(8)));
typedef float f32x4 __attribute__((ext_vector_type(4)));
typedef unsigned u32x4 __attribute__((ext_vector_type(4)));
constexpr int BM = 256, BK = 64, HALF = 128, HTB = HALF * BK * 2  , STAGE_BYTES = 8 * HTB, NXCD = 8, WGM = 8;

__host__ __device__ __forceinline__ int lds_byte(int r, int c) { const int st = (r >> 4) * 2 + (c >> 5), rr = r & 15, cc = c & 31, ob = rr * 64 + cc * 2; return st * 1024 + (ob ^ (((ob >> 9) & 1) << 5)); }
__host__ __device__ __forceinline__ void stage_rc(int b, int& R, int& C) { const int st = b / 1024, sb = b % 1024, swz = sb ^ (((sb >> 9) & 1) << 5); R = (st >> 1) * 16 + swz / 64; C = (st & 1) * 32 + (swz % 64) / 2; }
__host__ __device__ __forceinline__ int perm32(int rho) { const int n = rho >> 4, i = rho & 15; return 8 * (i >> 2) + 4 * n + (i & 3); }

struct Unit { int pm, pn; };
struct Gemm { const bf16_t* A; const bf16_t* Bt; int M, N, K; };

struct StaticOrder {
    int nM, nN, nwg, G, c;
    __host__ __device__ void init(int M, int N, int G_, int c_) { nM = M / BM; nN = N / BM; nwg = nM * nN; G = G_; c = c_; }
    __host__ __device__ bool next(int i, Unit& u) const {
        const long L = (long)i * G + c; if (L >= nwg) return false;
        int wgid = (int)L; { const int q = nwg / NXCD, r = nwg % NXCD, xcd = wgid % NXCD, off = wgid / NXCD; wgid = (xcd < r ? xcd * (q + 1) : r * (q + 1) + (xcd - r) * q) + off; }
        const int nig = WGM * nN, gid = wgid / nig, fm = gid * WGM, gsz = (nM - fm) < WGM ? (nM - fm) : WGM;
        u.pm = fm + ((wgid % nig) % gsz); u.pn = (wgid % nig) / gsz; return true;
    }
    __device__ __forceinline__ void a_ready(const Unit&) const {}
    __device__ __forceinline__ void done(const Unit&) const {}
};

__device__ __forceinline__ unsigned cvt_pk_bf16(float lo, float hi) { unsigned r; asm volatile("v_cvt_pk_bf16_f32 %0, %1, %2" : "=v"(r) : "v"(lo), "v"(hi)); return r; }
typedef float f32x2 __attribute__((ext_vector_type(2)));
__device__ __forceinline__ f32x2 gelu_pk(f32x2 v) {
    const f32x2 av = __builtin_elementwise_abs(v), d = av * 0.2316418882f + 1.0f;
    f32x2 t; t.x = __builtin_amdgcn_rcpf(d.x); t.y = __builtin_amdgcn_rcpf(d.y);
    f32x2 q = t * 0.5307027145f + (-0.7265760135f); q = q * t + 0.7107068705f; q = q * t + (-0.142248368f); q = q * t + 0.127414796f; q = q * t;
    const f32x2 s = (v * v) * (-0.72134752044f);
    f32x2 e; e.x = __builtin_amdgcn_exp2f(s.x); e.y = __builtin_amdgcn_exp2f(s.y);
    const f32x2 m = v * (q * e), r = v - m;
    f32x2 o; o.x = v.x < 0.f ? m.x : r.x; o.y = v.y < 0.f ? m.y : r.y; return o;
}

template <int ACT  > struct EpiBf16 {
    static constexpr bool PERM = true, AFTER_DRAIN = false; static_assert(ACT == 0 || ACT == 1, "EpiBf16: ACT is 0 (none) or 1 (gelu_pk)");
    bf16_t* O; int ldc; const float* bias; int split_cols; size_t split_stride; float scale0;
    __device__ __forceinline__ void operator()(const f32x4 (&acc)[2][2][4][2], const Unit& u, int wr, int wc, int fr, int fq) const {
        const int row0 = u.pm * BM + wr * 64 + fr; int colt = u.pn * BM; bf16_t* base = O;
        float sc = 1.f; if (split_cols) { const int t = colt / split_cols; base += (size_t)t * split_stride; colt -= t * split_cols; if (t == 0) sc = scale0; }
        const int col0 = colt + wc * 32 + 8 * fq, bcol0 = u.pn * BM + wc * 32 + 8 * fq;
        f32x4 bv[2][2];
#pragma unroll
        for (int bj = 0; bj < 2; ++bj)
#pragma unroll
            for (int n = 0; n < 2; ++n) bv[bj][n] = bias ? *(const f32x4*)(bias + bcol0 + bj * HALF + 4 * n) : (f32x4){0.f, 0.f, 0.f, 0.f};
#pragma unroll
        for (int ai = 0; ai < 2; ++ai)
#pragma unroll
            for (int m = 0; m < 4; ++m) { bf16_t* rowp = base + (size_t)(row0 + ai * HALF + m * 16) * ldc + col0;
#pragma unroll
                for (int bj = 0; bj < 2; ++bj) { f32x4 v0 = acc[ai][bj][m][0] + bv[bj][0], v1 = acc[ai][bj][m][1] + bv[bj][1];
                    if (ACT == 1) { f32x2 a = gelu_pk((f32x2){v0[0], v0[1]}), b = gelu_pk((f32x2){v0[2], v0[3]}), c = gelu_pk((f32x2){v1[0], v1[1]}), d = gelu_pk((f32x2){v1[2], v1[3]});
                        v0 = (f32x4){a.x, a.y, b.x, b.y}; v1 = (f32x4){c.x, c.y, d.x, d.y}; }
                    v0 = v0 * sc; v1 = v1 * sc; u32x4 w; w.x = cvt_pk_bf16(v0[0], v0[1]); w.y = cvt_pk_bf16(v0[2], v0[3]); w.z = cvt_pk_bf16(v1[0], v1[1]); w.w = cvt_pk_bf16(v1[2], v1[3]);
                    *(u32x4*)(rowp + bj * HALF) = w; } }
    }
};

template <class Epi, class Sched, bool ALIGN_EPI = false, bool SP2 = false>
__device__ __forceinline__ void gemm_phase(PG8_LAS unsigned char* lds, const Gemm g, const Sched& S, const Epi& E) {
    int tid_raw = threadIdx.x; asm volatile("" : "+v"(tid_raw));
    const int tid = tid_raw, wid = __builtin_amdgcn_readfirstlane(tid >> 6), lane = tid & 63, wr = wid >> 2, wc = wid & 3, fr = lane & 15, fq = lane >> 4;
    const int K = g.K, nt = K / BK;
    unsigned voffA[2], voffB[2];
#pragma unroll
    for (int i = 0; i < 2; ++i) { int R, C; stage_rc(tid * 16 + i * 8192, R, C); const int Rb = Epi::PERM ? ((R & ~31) + perm32(R & 31)) : R;
        voffA[i] = (unsigned)(R * K + C) * 2u; voffB[i] = (unsigned)(Rb * K + C) * 2u; }
    const size_t kstep = (size_t)(BK * 2);
    const size_t hstep = (size_t)HALF * K * 2;
    const size_t tstep = 2 * hstep;
    const unsigned ldsw = (unsigned)wid * 1024u;
    const int aoff = lds_byte(wr * 64 + fr, fq * 8), boff = lds_byte(wc * 32 + fr, fq * 8);
#define PG8_SA(b, h) (((b) * 2 + (h)) * HTB)
#define PG8_SB(b, h) ((4 + (b) * 2 + (h)) * HTB)
#define PG8_STAGE(bufoff, gbase, voff) do { _Pragma("unroll") for (int _i = 0; _i < 2; ++_i) \
        __builtin_amdgcn_global_load_lds((const unsigned*)((const char*)(gbase) + (voff)[_i]), (PG8_LAS unsigned*)(lds + (bufoff) + ldsw + _i * 8192), 16, 0, 0); } while (0)
#define PG8_LDA(dst, b, h) do { _Pragma("unroll") for (int m = 0; m < 4; ++m) _Pragma("unroll") for (int k = 0; k < 2; ++k) dst[m][k] = *(const PG8_LAS bf16x8*)(lds + PG8_SA(b, h) + aoff + m * 2048 + k * 1024); } while (0)
#define PG8_LDB(dst, b, h) do { _Pragma("unroll") for (int n = 0; n < 2; ++n) _Pragma("unroll") for (int k = 0; k < 2; ++k) dst[n][k] = *(const PG8_LAS bf16x8*)(lds + PG8_SB(b, h) + boff + n * 2048 + k * 1024); } while (0)
#define PG8_MMA(ai, bj, At, Bt) do { __builtin_amdgcn_s_setprio(1); _Pragma("unroll") for (int m = 0; m < 4; ++m) _Pragma("unroll") for (int n = 0; n < 2; ++n) _Pragma("unroll") for (int k = 0; k < 2; ++k) \
        acc[ai][bj][m][n] = __builtin_amdgcn_mfma_f32_16x16x32_bf16(Bt[n][k], At[m][k], acc[ai][bj][m][n], 0, 0, 0); __builtin_amdgcn_s_setprio(0); } while (0)
#define PG8_WAIT_V(n) asm volatile("s_waitcnt vmcnt(" #n ")" ::: "memory")
#define PG8_WAIT_L(n) asm volatile("s_waitcnt lgkmcnt(" #n ")" ::: "memory")
#define PG8_BAR __builtin_amdgcn_s_barrier()
#define PG8_SCHED __builtin_amdgcn_sched_barrier(0)
    Unit cur, nxt; int ui = 0;
    if (!S.next(0, cur)) return;
    f32x4 acc[2][2][4][2];
#pragma unroll
    for (int a = 0; a < 2; ++a)
#pragma unroll
        for (int b = 0; b < 2; ++b)
#pragma unroll
            for (int m = 0; m < 4; ++m)
#pragma unroll
                for (int n = 0; n < 2; ++n) acc[a][b][m][n] = (f32x4){0.f, 0.f, 0.f, 0.f};
    bf16x8 At[4][2], B0[2][2], B1[2][2];
    const char* cA = (const char*)g.A + (size_t)cur.pm * tstep; const char* cB = (const char*)g.Bt + (size_t)cur.pn * tstep;
    S.a_ready(cur);
    if constexpr (SP2) {
        PG8_STAGE(PG8_SB(0, 0), cB, voffB); PG8_STAGE(PG8_SB(0, 1), cB + hstep, voffB); PG8_STAGE(PG8_SA(0, 0), cA, voffA); PG8_STAGE(PG8_SA(0, 1), cA + hstep, voffA);
        if (wr == 1) PG8_BAR;
        PG8_WAIT_V(2); PG8_BAR;
        PG8_STAGE(PG8_SB(1, 0), cB + kstep, voffB); PG8_STAGE(PG8_SA(1, 0), cA + kstep, voffA); PG8_STAGE(PG8_SB(1, 1), cB + hstep + kstep, voffB);
        PG8_WAIT_V(6); PG8_BAR;
    } else {
        PG8_STAGE(PG8_SB(0, 0), cB, voffB); PG8_STAGE(PG8_SA(0, 0), cA, voffA); PG8_STAGE(PG8_SB(0, 1), cB + hstep, voffB); PG8_STAGE(PG8_SA(0, 1), cA + hstep, voffA);
        if (wr == 1) PG8_BAR;
        PG8_WAIT_V(4); PG8_BAR;
        PG8_STAGE(PG8_SB(1, 0), cB + kstep, voffB); PG8_STAGE(PG8_SA(1, 0), cA + kstep, voffA); PG8_STAGE(PG8_SB(1, 1), cB + hstep + kstep, voffB);
        PG8_WAIT_V(6); PG8_BAR;
    }
    for (;;) {
        const bool has_next = S.next(ui + 1, nxt);
        const char* nA = has_next ? (const char*)g.A + (size_t)nxt.pm * tstep : cA; const char* nB = has_next ? (const char*)g.Bt + (size_t)nxt.pn * tstep : cB;
        for (int t = 0; t < nt; t += 2) {
            const bool last = (t == nt - 2);
            const char* a1 = cA + (size_t)(t + 1) * kstep;
            const char* a2 = last ? nA : cA + (size_t)(t + 2) * kstep; const char* b2 = last ? nB : cB + (size_t)(t + 2) * kstep;
            const char* a3 = a2 + kstep; const char* b3 = b2 + kstep;
            if (last && has_next) S.a_ready(nxt);
            if constexpr (SP2) {
            PG8_LDB(B0, 0, 0); PG8_LDB(B1, 0, 1); PG8_SCHED; PG8_LDA(At, 0, 0); PG8_STAGE(PG8_SA(1, 1), a1 + hstep, voffA);
            PG8_WAIT_V(8); PG8_WAIT_L(0); PG8_BAR; PG8_MMA(0, 0, At, B0); PG8_MMA(0, 1, At, B1); PG8_BAR; PG8_SCHED;
            PG8_LDA(At, 0, 1); PG8_STAGE(PG8_SB(0, 0), b2, voffB); PG8_STAGE(PG8_SB(0, 1), b2 + hstep, voffB); PG8_STAGE(PG8_SA(0, 0), a2, voffA);
            PG8_WAIT_V(8); PG8_WAIT_L(0); PG8_BAR; PG8_MMA(1, 0, At, B0); PG8_MMA(1, 1, At, B1); PG8_BAR; PG8_SCHED;
            PG8_LDB(B0, 1, 0); PG8_LDB(B1, 1, 1); PG8_SCHED; PG8_LDA(At, 1, 0); PG8_STAGE(PG8_SA(0, 1), a2 + hstep, voffA);
            PG8_WAIT_V(8); PG8_WAIT_L(0); PG8_BAR; PG8_MMA(0, 0, At, B0); PG8_MMA(0, 1, At, B1); PG8_BAR; PG8_SCHED;
            PG8_LDA(At, 1, 1); PG8_STAGE(PG8_SB(1, 0), b3, voffB); PG8_STAGE(PG8_SB(1, 1), b3 + hstep, voffB); PG8_STAGE(PG8_SA(1, 0), a3, voffA);
            PG8_WAIT_V(8); PG8_WAIT_L(0); PG8_BAR; PG8_MMA(1, 0, At, B0); PG8_MMA(1, 1, At, B1); PG8_BAR; PG8_SCHED;
            } else {
            PG8_LDB(B0, 0, 0); PG8_SCHED; PG8_LDA(At, 0, 0); PG8_STAGE(PG8_SA(1, 1), a1 + hstep, voffA);
            PG8_WAIT_L(8); PG8_BAR; PG8_WAIT_L(0); PG8_MMA(0, 0, At, B0); PG8_BAR; PG8_SCHED;
            PG8_LDB(B1, 0, 1); PG8_STAGE(PG8_SB(0, 0), b2, voffB);
            PG8_BAR; PG8_WAIT_L(0); PG8_MMA(0, 1, At, B1); PG8_BAR;
            PG8_LDA(At, 0, 1); PG8_STAGE(PG8_SA(0, 0), a2, voffA);
            PG8_BAR; PG8_WAIT_L(0); PG8_MMA(1, 0, At, B0); PG8_BAR; PG8_SCHED;
            PG8_STAGE(PG8_SB(0, 1), b2 + hstep, voffB);
            PG8_WAIT_V(6); PG8_BAR; PG8_MMA(1, 1, At, B1); PG8_BAR;
            PG8_LDB(B0, 1, 0); PG8_SCHED; PG8_LDA(At, 1, 0); PG8_STAGE(PG8_SA(0, 1), a2 + hstep, voffA);
            PG8_WAIT_L(8); PG8_BAR; PG8_WAIT_L(0); PG8_MMA(0, 0, At, B0); PG8_BAR; PG8_SCHED;
            PG8_LDB(B1, 1, 1); PG8_STAGE(PG8_SB(1, 0), b3, voffB);
            PG8_BAR; PG8_WAIT_L(0); PG8_MMA(0, 1, At, B1); PG8_BAR;
            PG8_LDA(At, 1, 1); PG8_STAGE(PG8_SA(1, 0), a3, voffA);
            PG8_BAR; PG8_WAIT_L(0); PG8_MMA(1, 0, At, B0); PG8_BAR; PG8_SCHED;
            PG8_STAGE(PG8_SB(1, 1), b3 + hstep, voffB);
            PG8_WAIT_V(6); PG8_BAR; PG8_MMA(1, 1, At, B1); PG8_BAR;
            }
        }
        if constexpr (ALIGN_EPI) { if (wr == 0) PG8_BAR; }
        if constexpr (!Epi::AFTER_DRAIN) { E(acc, cur, wr, wc, fr, fq); S.done(cur); }
        if (!has_next) break;
#pragma unroll
        for (int a = 0; a < 2; ++a)
#pragma unroll
            for (int b = 0; b < 2; ++b)
#pragma unroll
                for (int m = 0; m < 4; ++m)
#pragma unroll
                    for (int n = 0; n < 2; ++n) acc[a][b][m][n] = (f32x4){0.f, 0.f, 0.f, 0.f};
        cur = nxt; cA = nA; cB = nB; ++ui;
        if constexpr (ALIGN_EPI) { if (wr == 1) PG8_BAR; }
    }
    PG8_WAIT_V(0);
    if constexpr (!ALIGN_EPI) { if (wr == 0) PG8_BAR; }
    PG8_BAR;
    if constexpr (Epi::AFTER_DRAIN) { E.fused(acc, cur, wr, wc, fr, fq, lds, wid, lane); S.done(cur); }
#undef PG8_SA
#undef PG8_SB
#undef PG8_STAGE
#undef PG8_LDA
#undef PG8_LDB
#undef PG8_MMA
#undef PG8_WAIT_V
#undef PG8_WAIT_L
#undef PG8_BAR
#undef PG8_SCHED
}
}
#define XB_TMO      128
#define XB_XCNT(j)  (256  + 64 * (j))
#define XB_XSUB(j)  (1280 + 64 * (j))
#define XB_XGEN(j)  (2304 + 64 * (j))
#define XB_TOP      3328
#define XB_TOPGEN   3392
#define XCD_BAR_WORDS 3456
#define XB_SPIN_CAP (1u << 18)

__device__ __forceinline__ unsigned xb_ld(unsigned* p)              { return __hip_atomic_load(p, __ATOMIC_RELAXED, __HIP_MEMORY_SCOPE_AGENT); }
__device__ __forceinline__ unsigned xb_add(unsigned* p, unsigned v) { return __hip_atomic_fetch_add(p, v, __ATOMIC_RELAXED, __HIP_MEMORY_SCOPE_AGENT); }
__device__ __forceinline__ unsigned xb_xcc_id() { return (unsigned)__builtin_amdgcn_s_getreg((3 << 11) | 20) & 0xFu; }
#define XB_SPIN(cond, bar) do { unsigned _sp = 0; while (cond) { __builtin_amdgcn_s_sleep(1); \
    if ((++_sp & 255u) == 0u) { if (xb_ld(&(bar)[XB_TMO])) break; if (_sp > XB_SPIN_CAP) { atomicAdd(&(bar)[XB_TMO], 1u); break; } } } } while (0)

struct XcdBarrier {
    unsigned* bar; unsigned x;
    volatile LAS unsigned* st;
};

__device__ __forceinline__ XcdBarrier xcd_barrier_post(unsigned* bar, volatile LAS unsigned* st) {
    XcdBarrier b; b.bar = bar; b.x = xb_xcc_id(); b.st = st;
    if (threadIdx.x == 0) (void)xb_add(&bar[XB_XCNT(b.x)], 1u);
    return b;
}
__device__ __forceinline__ void xcd_barrier_complete(unsigned* bar, unsigned x, unsigned& nloc, unsigned& nx) {
    const unsigned G = gridDim.x * gridDim.y * gridDim.z;
    unsigned sum, cnt, mine, sp = 0u;
    for (;;) {
        sum = 0u; cnt = 0u; mine = 0u;
#pragma unroll
        for (unsigned j = 0; j < 16; ++j) { const unsigned c = xb_ld(&bar[XB_XCNT(j)]); sum += c; cnt += (c > 0u) ? 1u : 0u; mine = (j == x) ? c : mine; }
        if (sum == G) break;
        __builtin_amdgcn_s_sleep(1);
        if ((++sp & 255u) == 0u) { if (xb_ld(&bar[XB_TMO])) break; if (sp > XB_SPIN_CAP) { atomicAdd(&bar[XB_TMO], 1u); break; } }
    }
    nloc = mine > 0u ? mine : 1u; nx = cnt > 0u ? cnt : 1u;
}

__device__ __forceinline__ void xcd_barrier(const XcdBarrier& b) {
    asm volatile("s_waitcnt vmcnt(0)" ::: "memory");
    __syncthreads();
    if (threadIdx.x == 0) {
        unsigned* bar = b.bar;
        __builtin_amdgcn_s_waitcnt(0);
        unsigned nloc = b.st[0], nx = b.st[1];
        if (nloc == 0u) { xcd_barrier_complete(bar, b.x, nloc, nx); b.st[0] = nloc; b.st[1] = nx; }
        const unsigned old = xb_add(&bar[XB_XSUB(b.x)], 1u);
        const unsigned gen = old / nloc;
        if (old + 1u == (gen + 1u) * nloc) {
            __builtin_amdgcn_fence(__ATOMIC_RELEASE, "agent");
            asm volatile("s_waitcnt vmcnt(0)" ::: "memory");
            const unsigned og = xb_add(&bar[XB_TOP], 1u);
            const unsigned tg = og / nx;
            if (og + 1u == (tg + 1u) * nx) xb_add(&bar[XB_TOPGEN], 1u);
            else XB_SPIN(xb_ld(&bar[XB_TOPGEN]) == tg, bar);
            __builtin_amdgcn_fence(__ATOMIC_ACQUIRE, "agent");
            xb_add(&bar[XB_XGEN(b.x)], 1u);
            asm volatile("s_waitcnt vmcnt(0)" ::: "memory");
        } else {
            XB_SPIN(xb_ld(&bar[XB_XGEN(b.x)]) == gen, bar);
            __builtin_amdgcn_fence(__ATOMIC_ACQUIRE, "agent");
            asm volatile("s_waitcnt vmcnt(0)" ::: "memory");
        }
    }
    __syncthreads();
}

constexpr int DM = 1024, NB = 4, SEQ = 4096, MTOK = NB * SEQ;
constexpr int QLORA = 384, KVLORA = 256, ROPE = 64, NOPE = 128, QKH = 192, VH = 128, NH = 8;
constexpr int MLA_IN = 704, MLA_IN_PAD = 768;
constexpr int NEXP = 16384;
constexpr float NORM_EPS = 1e-6f;
constexpr float U8_SCALE = 256.f, V8_SCALE = 16.f, H8_SCALE = 8.f;
constexpr float QSCALE = 0.07216878364870322f * 1.4426950408889634f;

#ifndef MK_N_LAUNCHES
#define MK_N_LAUNCHES 1
#endif
constexpr int NPHASES = 22;
#ifndef PHMASK
#define PHMASK 0xFFFFFFu
#endif
#define EN(k) (((PHMASK) >> (k)) & 1u)
#ifndef PROBE_PHASE
#define PROBE_PHASE -1
#endif
#ifndef PROBE_VAR
#define PROBE_VAR 0
#endif
#ifndef PROBE_REPS
#define PROBE_REPS 2
#endif
#define NREP(k) ((k) == (PROBE_PHASE) ? (PROBE_REPS) : 1)
constexpr int NWAVES = 8;

constexpr size_t MiB = 1u << 20;
constexpr size_t WS_CTL = 0, CTL_ZERO_BYTES = 64 * 1024;
constexpr size_t WS_MOD = 1 * MiB;
constexpr size_t WS_WCIN = 2 * MiB;
constexpr size_t WS_WCOUT = 8 * MiB;
constexpr size_t WS_WPQ0 = 10 * MiB, WS_WPQ1 = 14 * MiB;
constexpr size_t WS_WMIN = 18 * MiB;
constexpr size_t WS_WQB = 20 * MiB;
constexpr size_t WS_WKVB = 22 * MiB;
constexpr size_t WS_WMOUT = 24 * MiB;
constexpr size_t WS_SUBK = 26 * MiB;
constexpr size_t WS_PU = 32 * MiB;
constexpr size_t WS_PV = 96 * MiB;
constexpr size_t WS_XN = 160 * MiB;
constexpr size_t WS_VT = 160 * MiB;
constexpr size_t WS_BCV = 192 * MiB;
constexpr size_t WS_LAT = 192 * MiB;
constexpr size_t WS_O = 192 * MiB;
constexpr size_t WS_QN = 216 * MiB;
constexpr size_t WS_KVN = 228 * MiB;
constexpr size_t WS_QRAW = 236 * MiB;
constexpr size_t WS_Z = 288 * MiB;
constexpr size_t WS_KVRAW = 288 * MiB;
constexpr size_t WS_PQ = 288 * MiB;
constexpr size_t WS_QF = 352 * MiB;
constexpr size_t WS_KF = 400 * MiB;
constexpr size_t WS_IDS = 448 * MiB;
constexpr size_t WS_GATES = 456 * MiB;
constexpr size_t WS_DUMMY = 224 * MiB;
constexpr size_t WS_ACT = 464 * MiB;
constexpr size_t WS_XN8 = 472 * MiB;
constexpr size_t WS_END = 488 * MiB;
constexpr int CW_BAR = 1024;

constexpr int RING_BYTES = 131072;
constexpr int LDSCTL_OFF = RING_BYTES, MISC_OFF = LDSCTL_OFF + 320;
constexpr int LDS_BYTES = 147456;


typedef unsigned short bf16;
typedef unsigned u32x4 __attribute__((ext_vector_type(4)));
typedef unsigned u32x2 __attribute__((ext_vector_type(2)));
typedef float f32x4 __attribute__((ext_vector_type(4)));
typedef float f32x16 __attribute__((ext_vector_type(16)));
typedef short s16x8 __attribute__((ext_vector_type(8)));
typedef short s16x4 __attribute__((ext_vector_type(4)));
#define LDS_WAIT() asm volatile("s_waitcnt lgkmcnt(0)" ::: "memory")
#define VM_WAIT() asm volatile("s_waitcnt vmcnt(0)" ::: "memory")
#define DI __device__ __forceinline__

DI unsigned f2bf(float f) { unsigned u = __builtin_bit_cast(unsigned, f); return (u + 0x7fffu + ((u >> 16) & 1u)) >> 16; }
DI unsigned pk2(float lo, float hi) { return f2bf(lo) | (f2bf(hi) << 16); }
DI float bflo(unsigned u) { return __uint_as_float(u << 16); }
DI float bfhi(unsigned u) { return __uint_as_float(u & 0xffff0000u); }
DI float bf1(bf16 b) { return __uint_as_float((unsigned)b << 16); }
DI float wave_sum(float v) {
#pragma unroll
    for (int o = 32; o > 0; o >>= 1) v += __shfl_xor(v, o);
    return v;
}
DI int crow(int r, int hi) { return (r & 3) + 8 * (r >> 2) + 4 * hi; }

struct Args { const void* in[22]; float* out; unsigned char* ws; int ph_lo, ph_hi; };

DI void transpose_item(const float* W, int K, int N, bf16* WT, LAS float* scr, int item, int lane) {
    const int nblk = N / 32, kb = item / nblk, nb = item % nblk, k0 = 64 * kb, n0 = 32 * nb;
#pragma unroll 8
    for (int i = 0; i < 32; ++i) { const int kk = 2 * i + (lane >> 5); scr[kk * 33 + (lane & 31)] = W[(size_t)(k0 + kk) * N + n0 + (lane & 31)]; }
    LDS_WAIT(); asm volatile("" ::: "memory");
    const int c = lane & 7;
#pragma unroll
    for (int j = 0; j < 4; ++j) { const int n = (lane >> 3) + 8 * j; const LAS float* s = scr + (8 * c) * 33 + n;
        u32x4 o; o.x = pk2(s[0 * 33], s[1 * 33]); o.y = pk2(s[2 * 33], s[3 * 33]); o.z = pk2(s[4 * 33], s[5 * 33]); o.w = pk2(s[6 * 33], s[7 * 33]);
        *(u32x4*)(WT + (size_t)(n0 + n) * K + k0 + 8 * c) = o; }
    LDS_WAIT(); asm volatile("" ::: "memory");
}
DI void cvt_f32_bf16(const float* src, bf16* dst, size_t n8, size_t gt, size_t GT) {
#pragma unroll 4
    for (size_t i = gt; i < n8; i += GT) {
        const f32x4 a = ((const f32x4*)src)[2 * i], b = ((const f32x4*)src)[2 * i + 1];
        u32x4 o; o.x = pk2(a.x, a.y); o.y = pk2(a.z, a.w); o.z = pk2(b.x, b.y); o.w = pk2(b.z, b.w);
        ((u32x4*)dst)[i] = o; }
}

typedef float f32x2v __attribute__((ext_vector_type(2)));
DI unsigned pack4_fp8(float a, float b, float c, float d, float sc) {
    a = fminf(fmaxf(a * sc, -448.f), 448.f); b = fminf(fmaxf(b * sc, -448.f), 448.f); c = fminf(fmaxf(c * sc, -448.f), 448.f); d = fminf(fmaxf(d * sc, -448.f), 448.f);
    int w = __builtin_amdgcn_cvt_pk_fp8_f32(a, b, 0, false); w = __builtin_amdgcn_cvt_pk_fp8_f32(c, d, w, true); return (unsigned)w;
}
DI void cvt_tables_fp8(const float* u, const float* v, unsigned char* u8, unsigned char* v8, size_t gt, size_t GT) {
    const size_t n16 = (size_t)2 * NEXP * 1024 / 16;
#pragma unroll 2
    for (size_t i = gt; i < n16; i += GT) {
        const f32x4* s = (const f32x4*)(u + i * 16); const f32x4 a = s[0], b = s[1], c = s[2], d = s[3];
        u32x4 o; o.x = pack4_fp8(a.x, a.y, a.z, a.w, U8_SCALE); o.y = pack4_fp8(b.x, b.y, b.z, b.w, U8_SCALE); o.z = pack4_fp8(c.x, c.y, c.z, c.w, U8_SCALE); o.w = pack4_fp8(d.x, d.y, d.z, d.w, U8_SCALE);
        *(u32x4*)(u8 + i * 16) = o; }
#pragma unroll 2
    for (size_t i = gt; i < n16; i += GT) {
        const f32x4* s = (const f32x4*)(v + i * 16); const f32x4 a = s[0], b = s[1], c = s[2], d = s[3];
        u32x4 o; o.x = pack4_fp8(a.x, a.y, a.z, a.w, V8_SCALE); o.y = pack4_fp8(b.x, b.y, b.z, b.w, V8_SCALE); o.z = pack4_fp8(c.x, c.y, c.z, c.w, V8_SCALE); o.w = pack4_fp8(d.x, d.y, d.z, d.w, V8_SCALE);
        const size_t k = i & 63, row = i >> 6, e = row & (NEXP - 1), layer = row >> 14;
        *(u32x4*)(v8 + (((layer * 8 + (k >> 3)) * NEXP + e) * 128 + (k & 7) * 16)) = o; }
}
DI void ph_prologue(const Args& a, LAS unsigned char* lds, int tid, int wave, int vcu, int G) {
    const int lane = tid & 63;
    {
        const float* c = (const float*)a.in[1]; const float* ada_w = (const float*)a.in[5]; const float* ada_b = (const float*)a.in[6];
        float* mod = (float*)(a.ws + WS_MOD);
        LAS float* cact = (LAS float*)lds; LAS float* red = cact + 4096;
        for (int it = blockIdx.x; it < 192; it += G) {
            const int i = it / 96, n0 = (it % 96) * 64;
            for (int e = tid; e < 4096; e += 512) { const float v = c[e]; cact[e] = v / (1.f + expf(-v)); }
            __syncthreads();
            const float* W = ada_w + (size_t)i * 1024 * 6144 + n0 + lane;
            float a0 = 0.f, a1 = 0.f, a2 = 0.f, a3 = 0.f;
            const int k0 = wave * 128;
#pragma unroll 8
            for (int k = k0; k < k0 + 128; ++k) { const float w = W[(size_t)k * 6144]; a0 += cact[k] * w; a1 += cact[1024 + k] * w; a2 += cact[2048 + k] * w; a3 += cact[3072 + k] * w; }
            red[(wave * 4 + 0) * 64 + lane] = a0; red[(wave * 4 + 1) * 64 + lane] = a1; red[(wave * 4 + 2) * 64 + lane] = a2; red[(wave * 4 + 3) * 64 + lane] = a3;
            __syncthreads();
            if (tid < 256) { const int b = tid >> 6; float s = 0.f;
#pragma unroll
                for (int w = 0; w < 8; ++w) s += red[(w * 4 + b) * 64 + lane];
                mod[(size_t)(i * 4 + b) * 6144 + n0 + lane] = s + ada_b[i * 6144 + n0 + lane]; }
            __syncthreads();
        }
    }
    {
        LAS float* scr = (LAS float*)(lds + 32768 + wave * 8704);
        const int gw = vcu * NWAVES + wave, NGW = G * NWAVES;
        unsigned char* ws = a.ws;
        constexpr int I_CIN = 16 * 96, I_COUT = 16 * 32, I_PQ = 16 * 64, I_MIN = 16 * 22, I_QB = 6 * 48, I_KVB = 4 * 64, I_MOUT = 16 * 32;
        constexpr int NITEMS = I_CIN + I_COUT + 2 * I_PQ + I_MIN + I_QB + I_KVB + I_MOUT;
        for (int it = gw; it < NITEMS; it += NGW) {
            int r = it;
            if (r < I_CIN) { transpose_item((const float*)a.in[7], 1024, 3072, (bf16*)(ws + WS_WCIN), scr, r, lane); continue; } r -= I_CIN;
            if (r < I_COUT) { transpose_item((const float*)a.in[9], 1024, 1024, (bf16*)(ws + WS_WCOUT), scr, r, lane); continue; } r -= I_COUT;
            if (r < I_PQ) { transpose_item((const float*)a.in[18], 1024, 2048, (bf16*)(ws + WS_WPQ0), scr, r, lane); continue; } r -= I_PQ;
            if (r < I_PQ) { transpose_item((const float*)a.in[18] + (size_t)1024 * 2048, 1024, 2048, (bf16*)(ws + WS_WPQ1), scr, r, lane); continue; } r -= I_PQ;
            if (r < I_MIN) { transpose_item((const float*)a.in[10], 1024, MLA_IN, (bf16*)(ws + WS_WMIN), scr, r, lane); continue; } r -= I_MIN;
            if (r < I_QB) { transpose_item((const float*)a.in[13], 384, 1536, (bf16*)(ws + WS_WQB), scr, r, lane); continue; } r -= I_QB;
            if (r < I_KVB) { transpose_item((const float*)a.in[14], 256, 2048, (bf16*)(ws + WS_WKVB), scr, r, lane); continue; } r -= I_KVB;
            transpose_item((const float*)a.in[17], 1024, 1024, (bf16*)(ws + WS_WMOUT), scr, r, lane);
        }
        const size_t gt = (size_t)vcu * 512 + tid, GT = (size_t)G * 512;
        for (size_t i = gt; i < (size_t)(MLA_IN_PAD - MLA_IN) * 1024 / 8; i += GT) ((u32x4*)(ws + WS_WMIN + (size_t)MLA_IN * 1024 * 2))[i] = (u32x4){0u, 0u, 0u, 0u};
        cvt_f32_bf16((const float*)a.in[19], (bf16*)(ws + WS_SUBK), (size_t)2 * 8 * 2 * 128 * 128 / 8, gt, GT);
        cvt_tables_fp8((const float*)a.in[20], (const float*)a.in[21], ws + WS_PU, ws + WS_PV, gt, GT);
    }
}

DI void ph_modulate(const float* x, bf16* xn, unsigned char* xn8  , const float* gain, const float* modl, int sh_off, int sc_off, int gw, int NGW, int lane) {
    for (int m = gw; m < MTOK; m += NGW) {
        const float* mb = modl + (size_t)(m >> 12) * 6144;
        const f32x4* xr = (const f32x4*)(x + (size_t)m * DM) + lane;
        f32x4 v[4]; float s = 0.f;
#pragma unroll
        for (int j = 0; j < 4; ++j) { v[j] = xr[64 * j]; s += (v[j].x * v[j].x + v[j].y * v[j].y) + (v[j].z * v[j].z + v[j].w * v[j].w); }
        const float rstd = rsqrtf(wave_sum(s) * (1.f / DM) + NORM_EPS);
        u32x2* o8 = (u32x2*)(xn + (size_t)m * DM) + lane;
#pragma unroll
        for (int j = 0; j < 4; ++j) {
            const f32x4 g = ((const f32x4*)gain)[lane + 64 * j], sh = ((const f32x4*)(mb + sh_off))[lane + 64 * j], sc = ((const f32x4*)(mb + sc_off))[lane + 64 * j];
            const f32x4 y = v[j] * rstd * g * (sc + 1.f) + sh;
            u32x2 w; w.x = pk2(y.x, y.y); w.y = pk2(y.z, y.w); o8[64 * j] = w;
            if (xn8) ((unsigned*)(xn8 + (size_t)m * DM))[lane + 64 * j] = pack4_fp8(y.x, y.y, y.z, y.w, H8_SCALE); }
    }
}

DI void ph_conv(const bf16* bcv, const float* cw, bf16* z, size_t gt, size_t GT) {
    for (size_t it = gt; it < (size_t)MTOK * 128; it += GT) {
        const int t = (int)(it >> 7), ch = (int)(it & 127) * 8, s = t & (SEQ - 1);
        const bf16* row = bcv + (size_t)t * 3072 + ch;
        const u32x4 zero = (u32x4){0u, 0u, 0u, 0u};
        const u32x4 bq = *(const u32x4*)row;
        const u32x4 c0 = *(const u32x4*)(row + 1024), v0 = *(const u32x4*)(row + 2048);
        const u32x4 c1 = s >= 1 ? *(const u32x4*)(row - 3072 + 1024) : zero, v1 = s >= 1 ? *(const u32x4*)(row - 3072 + 2048) : zero;
        const u32x4 c2 = s >= 2 ? *(const u32x4*)(row - 6144 + 1024) : zero, v2 = s >= 2 ? *(const u32x4*)(row - 6144 + 2048) : zero;
        const f32x4 w0a = *(const f32x4*)(cw + ch), w0b = *(const f32x4*)(cw + ch + 4);
        const f32x4 w1a = *(const f32x4*)(cw + 1024 + ch), w1b = *(const f32x4*)(cw + 1024 + ch + 4);
        const f32x4 w2a = *(const f32x4*)(cw + 2048 + ch), w2b = *(const f32x4*)(cw + 2048 + ch + 4);
        float r[8];
#pragma unroll
        for (int e = 0; e < 4; ++e) {
            const float w0l = e < 2 ? w0a[2 * e] : w0b[2 * e - 4], w0h = e < 2 ? w0a[2 * e + 1] : w0b[2 * e - 3];
            const float w1l = e < 2 ? w1a[2 * e] : w1b[2 * e - 4], w1h = e < 2 ? w1a[2 * e + 1] : w1b[2 * e - 3];
            const float w2l = e < 2 ? w2a[2 * e] : w2b[2 * e - 4], w2h = e < 2 ? w2a[2 * e + 1] : w2b[2 * e - 3];
            const float ut_l = bflo(c0[e]) * bflo(v0[e]), ut_h = bfhi(c0[e]) * bfhi(v0[e]);
            const float u1_l = bflo(c1[e]) * bflo(v1[e]), u1_h = bfhi(c1[e]) * bfhi(v1[e]);
            const float u2_l = bflo(c2[e]) * bflo(v2[e]), u2_h = bfhi(c2[e]) * bfhi(v2[e]);
            r[2 * e] = bflo(bq[e]) * (w0l * u2_l + w1l * u1_l + w2l * ut_l);
            r[2 * e + 1] = bfhi(bq[e]) * (w0h * u2_h + w1h * u1_h + w2h * ut_h);
        }
        u32x4 o; o.x = pk2(r[0], r[1]); o.y = pk2(r[2], r[3]); o.z = pk2(r[4], r[5]); o.w = pk2(r[6], r[7]);
        *(u32x4*)(z + (size_t)t * DM + ch) = o;
    }
}

struct EpiResGate {
    static constexpr bool PERM = false, AFTER_DRAIN = false;
    const float* base; float* out; const float* gate;
    __device__ __forceinline__ void operator()(const pg8::f32x4 (&acc)[2][2][4][2], const pg8::Unit& u, int wr, int wc, int fr, int fq) const {
        const int row0 = u.pm * 256 + wr * 64 + fr, col0 = u.pn * 256 + wc * 32 + 4 * fq;
        const float* gp = gate + (size_t)(u.pm >> 4) * 6144 + col0;
        pg8::f32x4 gv[2][2];
#pragma unroll
        for (int bj = 0; bj < 2; ++bj)
#pragma unroll
            for (int n = 0; n < 2; ++n) gv[bj][n] = *(const pg8::f32x4*)(gp + bj * 128 + n * 16);
#pragma unroll
        for (int ai = 0; ai < 2; ++ai)
#pragma unroll
            for (int m = 0; m < 4; ++m) { const size_t off = (size_t)(row0 + ai * 128 + m * 16) * DM + col0;
#pragma unroll
                for (int bj = 0; bj < 2; ++bj)
#pragma unroll
                    for (int n = 0; n < 2; ++n) { const pg8::f32x4 bs = *(const pg8::f32x4*)(base + off + bj * 128 + n * 16);
                        *(pg8::f32x4*)(out + off + bj * 128 + n * 16) = bs + gv[bj][n] * acc[ai][bj][m][n]; } }
    }
};

DI unsigned f2key(float f) { const unsigned u = __float_as_uint(f); return u ^ ((unsigned)((int)u >> 31) | 0x80000000u); }
DI float key2f(unsigned k) { const unsigned u = (k & 0x80000000u) ? (k ^ 0x80000000u) : ~k; return __uint_as_float(u); }
DI unsigned umax_(unsigned a, unsigned b) { return a > b ? a : b; }
DI unsigned umin_(unsigned a, unsigned b) { return a < b ? a : b; }
template <int N> DI void bitonic_sort_desc(unsigned (&v)[N]) {
#pragma unroll
    for (int k = 2; k <= N; k <<= 1) {
#pragma unroll
        for (int j = k >> 1; j > 0; j >>= 1) {
#pragma unroll
            for (int i = 0; i < N; ++i) { const int l = i ^ j;
                if (l > i) { const bool desc = ((i & k) == 0); const unsigned x = v[i], y = v[l], mx = umax_(x, y), mn = umin_(x, y); v[i] = desc ? mx : mn; v[l] = desc ? mn : mx; } }
        }
    }
}
template <int N> DI void bitonic_merge_desc(unsigned (&v)[N]) {
#pragma unroll
    for (int j = N >> 1; j > 0; j >>= 1) {
#pragma unroll
        for (int i = 0; i < N; ++i) { const int l = i ^ j;
            if (l > i) { const unsigned x = v[i], y = v[l]; v[i] = umax_(x, y); v[l] = umin_(x, y); } }
    }
}
DI void top16_merge(unsigned (&t)[16], unsigned (&n)[16]) {
#pragma unroll
    for (int i = 0; i < 16; ++i) t[i] = umax_(t[i], n[15 - i]);
    bitonic_merge_desc<16>(t);
}

DI void topk_task(const bf16* PQ, const bf16* SK  , int* IDS, float* GATES, LAS unsigned short* tab  , int tok0, int h, int lane) {
    const int r32 = lane & 31, hi = lane >> 5;
    s16x8 qf[16];
    const bf16* qp = PQ + (size_t)(tok0 + r32) * 2048 + 256 * h + 8 * hi;
#pragma unroll
    for (int ks = 0; ks < 16; ++ks) qf[ks] = *(const s16x8*)(qp + 16 * ks);
    const int p = (r32 >> 2) & 1, keyl = (r32 & 3) + 4 * (r32 >> 3);
    const bf16* kp0 = SK + ((size_t)(h * 2 + p) * 128 + keyl) * 128 + 8 * hi;
    const s16x8 zero8 = (s16x8){0, 0, 0, 0, 0, 0, 0, 0};
    unsigned top[16];
#pragma unroll
    for (int i = 0; i < 16; ++i) top[i] = 0u;
#pragma unroll 1
    for (int rb = 0; rb < 8; ++rb) {
        const bf16* kp = kp0 + (size_t)rb * 16 * 128;
        f32x16 acc;
#pragma unroll
        for (int r = 0; r < 16; ++r) acc[r] = 0.f;
#pragma unroll
        for (int ks = 0; ks < 8; ++ks) {
            const s16x8 kf = *(const s16x8*)(kp + 16 * ks);
            const s16x8 a0 = p == 0 ? kf : zero8, a1 = p == 1 ? kf : zero8;
            acc = __builtin_amdgcn_mfma_f32_32x32x16_bf16(a0, qf[ks], acc, 0, 0, 0);
            acc = __builtin_amdgcn_mfma_f32_32x32x16_bf16(a1, qf[ks + 8], acc, 0, 0, 0);
        }
        unsigned nw[16];
#pragma unroll
        for (int r = 0; r < 16; ++r) nw[r] = (f2key(acc[r]) & ~127u) | (unsigned)(127 - (16 * rb + r));
        bitonic_sort_desc<16>(nw);
        top16_merge(top, nw);
    }
    unsigned LA[16], LB[16];
#pragma unroll
    for (int i = 0; i < 16; ++i) { const unsigned other = (unsigned)__shfl_xor((int)top[i], 32); LA[i] = hi ? other : top[i]; LB[i] = hi ? top[i] : other; }
#pragma unroll
    for (int i = 0; i < 16; ++i) { tab[i * 64 + lane] = (unsigned short)(127u - (LA[i] & 127u)); tab[(16 + i) * 64 + lane] = (unsigned short)(127u - (LB[i] & 127u)); }
    float av[16], bv[16];
#pragma unroll
    for (int i = 0; i < 16; ++i) { av[i] = key2f(LA[i] & ~127u); bv[i] = key2f(LB[i] & ~127u); }
    unsigned cg[4][16];
#pragma unroll
    for (int g = 0; g < 4; ++g)
#pragma unroll
        for (int e = 0; e < 16; ++e) cg[g][e] = 0u;
    {
        int cnt = 0;
#pragma unroll
        for (int i = 0; i < 16; ++i)
#pragma unroll
            for (int j = 0; j < 16; ++j)
                if ((i + 1) * (j + 1) <= 16) { cg[cnt >> 4][cnt & 15] = (f2key(av[i] + bv[j]) & ~255u) | (unsigned)(255 - (16 * i + j)); ++cnt; }
    }
    bitonic_sort_desc<16>(cg[0]); bitonic_sort_desc<16>(cg[1]); bitonic_sort_desc<16>(cg[2]); bitonic_sort_desc<16>(cg[3]);
    top16_merge(cg[0], cg[1]); top16_merge(cg[0], cg[2]); top16_merge(cg[0], cg[3]);
    LDS_WAIT(); asm volatile("" ::: "memory");
    float sv[16]; int ex[16];
#pragma unroll
    for (int k = 0; k < 16; ++k) { const unsigned key = cg[0][k]; const int pos = 255 - (int)(key & 255u); sv[k] = key2f(key & ~255u);
        const int ia = tab[(pos >> 4) * 64 + lane], ib = tab[(16 + (pos & 15)) * 64 + lane]; ex[k] = ia * 128 + ib; }
    LDS_WAIT(); asm volatile("" ::: "memory");
    const float mx = sv[0]; float sum = 0.f;
#pragma unroll
    for (int k = 0; k < 16; ++k) { sv[k] = expf(sv[k] - mx); sum += sv[k]; }
    const float inv = 1.f / sum;
    if (hi == 0) {
        int* ip = IDS + (size_t)(tok0 + r32) * 128 + h * 16; float* gp = GATES + (size_t)(tok0 + r32) * 128 + h * 16;
#pragma unroll
        for (int k = 0; k < 16; k += 4) { *(u32x4*)(ip + k) = (u32x4){(unsigned)ex[k], (unsigned)ex[k + 1], (unsigned)ex[k + 2], (unsigned)ex[k + 3]};
            *(f32x4*)(gp + k) = (f32x4){sv[k] * inv, sv[k + 1] * inv, sv[k + 2] * inv, sv[k + 3] * inv}; }
    }
}
DI void ph_topk(const bf16* PQ, const bf16* SK, int* IDS, float* GATES, LAS unsigned char* lds, int gw, int NGW, int wave, int lane) {
    LAS unsigned short* tab = (LAS unsigned short*)(lds + wave * 4096);
    for (int task = gw; task < (MTOK / 32) * 8; task += NGW) topk_task(PQ, SK, IDS, GATES, tab, (task >> 3) * 32, task & 7, lane);
}

DI float gelu_erf(float x) { return 0.5f * x * (1.f + erff(x * 0.70710678118654752f)); }
DI float dot16_fp8(const u32x4& w, const float (&h)[16]) {
    float d0 = 0.f, d1 = 0.f;
#pragma unroll
    for (int e = 0; e < 4; ++e) { const f32x2v lo = __builtin_amdgcn_cvt_pk_f32_fp8((int)w[e], false), hi = __builtin_amdgcn_cvt_pk_f32_fp8((int)w[e], true);
        d0 += lo.x * h[4 * e] + lo.y * h[4 * e + 1]; d1 += hi.x * h[4 * e + 2] + hi.y * h[4 * e + 3]; }
    return d0 + d1;
}
DI float gelu_fast(float v) {
    const float av = fabsf(v), d = av * 0.2316418882f + 1.0f, t = __builtin_amdgcn_rcpf(d);
    float q = t * 0.5307027145f + (-0.7265760135f); q = q * t + 0.7107068705f; q = q * t + (-0.142248368f); q = q * t + 0.127414796f; q = q * t;
    const float e = __builtin_amdgcn_exp2f((v * v) * (-0.72134752044f)), mm = v * (q * e);
    return v < 0.f ? mm : v - mm;
}
DI long lo64(const u32x4& w) { return (long)(((unsigned long long)w.y << 32) | w.x); }
DI long hi64(const u32x4& w) { return (long)(((unsigned long long)w.w << 32) | w.z); }
template <int VAR> DI void ph_peer_u(const unsigned char* U8, const int* IDS, const float* GATES, const unsigned char* XN8, float* ACT, int bx, int G, int wave, int lane) {
    const int x = bx & 7, rank = bx >> 3, nslots = ((G - x + 7) >> 3) * 8;
    const int r8 = lane & 7;
    const unsigned aoff = 16u * (unsigned)(lane >> 3);
    const unsigned boff = 32u * (unsigned)(lane >> 4) + 16u * (unsigned)((lane >> 3) & 1);
    int t = rank * 8 + wave;
    int e_lo = 0, e_hi = 0; float g_lo = 0.f, g_hi = 0.f; u32x4 hb[8];
#pragma unroll
    for (int i = 0; i < 8; ++i) hb[i] = (u32x4){0u, 0u, 0u, 0u};
    if (t < MTOK) { e_lo = IDS[(size_t)t * 128 + lane]; e_hi = IDS[(size_t)t * 128 + 64 + lane]; g_lo = GATES[(size_t)t * 128 + lane]; g_hi = GATES[(size_t)t * 128 + 64 + lane];
#pragma unroll
        for (int i = 0; i < 8; ++i) hb[i] = *(const u32x4*)(XN8 + (size_t)t * DM + 128 * i + boff); }
    float ps_val[3] = {0.f, 0.f, 0.f}; int ps_idx[3] = {-1, -1, -1}; int ps_t = 0;
#pragma unroll 1
    for (; t < MTOK; t += nslots) {
        unsigned long long m0 = __ballot((e_lo >> 11) == x), m1 = __ballot((e_hi >> 11) == x);
        const int tn = t + nslots;
        int ne_lo = 0, ne_hi = 0; float ng_lo = 0.f, ng_hi = 0.f; u32x4 nhb[8];
#pragma unroll
        for (int i = 0; i < 8; ++i) nhb[i] = hb[i];
        bool first = true;
        do {
            int jj[24];
#pragma unroll
            for (int q = 0; q < 24; ++q) {
                if (m0) { jj[q] = (int)__builtin_ctzll(m0); m0 &= m0 - 1; }
                else if (m1) { jj[q] = 64 + (int)__builtin_ctzll(m1); m1 &= m1 - 1; }
                else jj[q] = -1;
            }
#pragma unroll
            for (int b = 0; b < 3; ++b) { if (ps_idx[b] >= 0) ACT[(size_t)ps_t * 128 + ps_idx[b]] = ps_val[b]; ps_idx[b] = -1; }
            int jm[3]; u32x4 a[3][8];
#pragma unroll
            for (int b = 0; b < 3; ++b) {
                jm[b] = jj[8 * b];
#pragma unroll
                for (int q = 1; q < 8; ++q) jm[b] = r8 == q ? jj[8 * b + q] : jm[b];
                if (jj[8 * b] >= 0) {
                    const int src = jm[b] < 0 ? 0 : (jm[b] & 63);
                    const int el = __shfl(e_lo, src), eh = __shfl(e_hi, src);
                    const int e = jm[b] < 0 ? 2048 * x : (jm[b] < 64 ? el : eh);
                    const unsigned char* rp = U8 + ((size_t)e * 1024 + aoff);
#pragma unroll
                    for (int i = 0; i < 8; ++i) { if (VAR == 1) a[b][i] = (u32x4){(unsigned)e, aoff, 0x38383838u, 0x40404040u}; else a[b][i] = *(const u32x4*)(rp + 128 * i); }
                } else {
#pragma unroll
                    for (int i = 0; i < 8; ++i) a[b][i] = (u32x4){0u, 0u, 0u, 0u};
                }
            }
            if (first && tn < MTOK) {
                ne_lo = IDS[(size_t)tn * 128 + lane]; ne_hi = IDS[(size_t)tn * 128 + 64 + lane]; ng_lo = GATES[(size_t)tn * 128 + lane]; ng_hi = GATES[(size_t)tn * 128 + 64 + lane];
#pragma unroll
                for (int i = 0; i < 8; ++i) nhb[i] = *(const u32x4*)(XN8 + (size_t)tn * DM + 128 * i + boff); }
            first = false;
#pragma unroll
            for (int b = 0; b < 3; ++b) {
                if (jj[8 * b] >= 0) {
                    f32x4 acc = (f32x4){0.f, 0.f, 0.f, 0.f};
#pragma unroll
                    for (int i = 0; i < 8; ++i) { acc = __builtin_amdgcn_mfma_f32_16x16x32_fp8_fp8(lo64(a[b][i]), lo64(hb[i]), acc, 0, 0, 0);
                        acc = __builtin_amdgcn_mfma_f32_16x16x32_fp8_fp8(hi64(a[b][i]), hi64(hb[i]), acc, 0, 0, 0); }
                    float w[4];
#pragma unroll
                    for (int i = 0; i < 4; ++i) { const float tt = acc[i] + __shfl(acc[i], (lane + 40) & 63); w[i] = __shfl(tt, 16 * ((lane >> 2) & 1)); }
                    const int l3 = lane & 3;
                    const float s = l3 == 0 ? w[0] : l3 == 1 ? w[1] : l3 == 2 ? w[2] : w[3];
                    const int jl = jm[b] < 0 ? 0 : (jm[b] & 63);
                    const float gl = __shfl(g_lo, jl), gh = __shfl(g_hi, jl);
                    ps_val[b] = gelu_fast(s * (1.f / (U8_SCALE * H8_SCALE))) * (jm[b] < 64 ? gl : gh); ps_idx[b] = lane < 8 ? jm[b] : -1;
                }
            }
            ps_t = t;
        } while (m0 | m1);
        e_lo = ne_lo; e_hi = ne_hi; g_lo = ng_lo; g_hi = ng_hi;
#pragma unroll
        for (int i = 0; i < 8; ++i) hb[i] = nhb[i];
    }
#pragma unroll
    for (int b = 0; b < 3; ++b) if (ps_idx[b] >= 0) ACT[(size_t)ps_t * 128 + ps_idx[b]] = ps_val[b];
}
DI void ph_peer_v(const unsigned char* V8  , const int* IDS, const float* ACT, const float* Xin, float* Xout, const float* g2, int bx, int G, int wave, int lane) {
    const int x = bx & 7, rank = bx >> 3, nslots = ((G - x + 7) >> 3) * 8;
    const bool b5 = (lane & 32) != 0, b4 = (lane & 16) != 0, b3 = (lane & 8) != 0;
    const int grp = lane >> 3;
    const unsigned char* Vx = V8 + (size_t)x * NEXP * 128;
    const unsigned coff = 16u * (unsigned)(lane & 7);
    const int dim = 128 * x + 16 * (lane & 7) + 2 * grp;
    int t = rank * 8 + wave;
    int e_lo = 0, e_hi = 0; float a_lo = 0.f, a_hi = 0.f; f32x2v xv = (f32x2v){0.f, 0.f};
    if (t < MTOK) { e_lo = IDS[(size_t)t * 128 + lane]; e_hi = IDS[(size_t)t * 128 + 64 + lane]; a_lo = ACT[(size_t)t * 128 + lane]; a_hi = ACT[(size_t)t * 128 + 64 + lane]; xv = *(const f32x2v*)(Xin + (size_t)t * DM + dim); }
#pragma unroll 1
    for (; t < MTOK; t += nslots) {
        u32x4 v[16]; float aw[16];
#pragma unroll
        for (int it = 0; it < 16; ++it) { const int src = 8 * (it & 7) + grp; const int e = __shfl(it < 8 ? e_lo : e_hi, src); aw[it] = __shfl(it < 8 ? a_lo : a_hi, src);
            v[it] = *(const u32x4*)(Vx + ((unsigned)e * 128u + coff)); }
        const int tn = t + nslots;
        int ne_lo = 0, ne_hi = 0; float na_lo = 0.f, na_hi = 0.f; f32x2v nxv = xv;
        if (tn < MTOK) { ne_lo = IDS[(size_t)tn * 128 + lane]; ne_hi = IDS[(size_t)tn * 128 + 64 + lane]; na_lo = ACT[(size_t)tn * 128 + lane]; na_hi = ACT[(size_t)tn * 128 + 64 + lane]; nxv = *(const f32x2v*)(Xin + (size_t)tn * DM + dim); }
        float acc[16];
#pragma unroll
        for (int i = 0; i < 16; ++i) acc[i] = 0.f;
#pragma unroll
        for (int it = 0; it < 16; ++it)
#pragma unroll
            for (int e = 0; e < 4; ++e) { const f32x2v lo = __builtin_amdgcn_cvt_pk_f32_fp8((int)v[it][e], false), hi = __builtin_amdgcn_cvt_pk_f32_fp8((int)v[it][e], true);
                acc[4 * e] += aw[it] * lo.x; acc[4 * e + 1] += aw[it] * lo.y; acc[4 * e + 2] += aw[it] * hi.x; acc[4 * e + 3] += aw[it] * hi.y;
                if (e == 3) __builtin_amdgcn_sched_barrier(0); }
        float v8[8], v4[4], v2[2];
#pragma unroll
        for (int i = 0; i < 8; ++i) { const float keep = b5 ? acc[i + 8] : acc[i], give = b5 ? acc[i] : acc[i + 8]; v8[i] = keep + __shfl_xor(give, 32); }
#pragma unroll
        for (int i = 0; i < 4; ++i) { const float keep = b4 ? v8[i + 4] : v8[i], give = b4 ? v8[i] : v8[i + 4]; v4[i] = keep + __shfl_xor(give, 16); }
#pragma unroll
        for (int i = 0; i < 2; ++i) { const float keep = b3 ? v4[i + 2] : v4[i], give = b3 ? v4[i] : v4[i + 2]; v2[i] = keep + __shfl_xor(give, 8); }
        const f32x2v gg = *(const f32x2v*)(g2 + (size_t)(t >> 12) * 6144 + dim);
        xv.x += gg.x * v2[0] * (1.f / V8_SCALE); xv.y += gg.y * v2[1] * (1.f / V8_SCALE);
        *(f32x2v*)(Xout + (size_t)t * DM + dim) = xv;
        e_lo = ne_lo; e_hi = ne_hi; a_lo = na_lo; a_hi = na_hi; xv = nxv;
    }
}

DI void ph_latnorm(const bf16* LAT, const float* qg, const float* kvg, bf16* QN, bf16* KVN, int gw, int NGW, int lane) {
    for (int t = gw; t < MTOK; t += NGW) {
        const unsigned* lr = (const unsigned*)(LAT + (size_t)t * MLA_IN_PAD);
        unsigned q[3], k[2]; float sq = 0.f, sk = 0.f;
#pragma unroll
        for (int j = 0; j < 3; ++j) { q[j] = lr[lane + 64 * j]; sq += bflo(q[j]) * bflo(q[j]) + bfhi(q[j]) * bfhi(q[j]); }
#pragma unroll
        for (int j = 0; j < 2; ++j) { k[j] = lr[192 + lane + 64 * j]; sk += bflo(k[j]) * bflo(k[j]) + bfhi(k[j]) * bfhi(k[j]); }
        const float rq = rsqrtf(wave_sum(sq) * (1.f / QLORA) + NORM_EPS), rk = rsqrtf(wave_sum(sk) * (1.f / KVLORA) + NORM_EPS);
        unsigned* qo = (unsigned*)(QN + (size_t)t * QLORA); unsigned* ko = (unsigned*)(KVN + (size_t)t * KVLORA);
#pragma unroll
        for (int j = 0; j < 3; ++j) { const int c = 2 * (lane + 64 * j); qo[lane + 64 * j] = pk2(bflo(q[j]) * rq * qg[c], bfhi(q[j]) * rq * qg[c + 1]); }
#pragma unroll
        for (int j = 0; j < 2; ++j) { const int c = 2 * (lane + 64 * j); ko[lane + 64 * j] = pk2(bflo(k[j]) * rk * kvg[c], bfhi(k[j]) * rk * kvg[c + 1]); }
    }
}

DI void ph_qkprep(const bf16* QRAW, const bf16* KVRAW, const bf16* LAT, const int* positions, const float* qg, const float* kg,
                  bf16* Qf, bf16* Kf, bf16* Vt, int gw, int NGW, int lane) {
    const int f = lane & 31;
    const float invf = exp2f(-(float)f * (13.287712379549449f / 32.f));
    const float qg0 = qg[lane], qg1 = qg[64 + lane], qg2 = qg[128 + lane], kg0 = kg[lane], kg1 = kg[64 + lane], kg2 = kg[128 + lane];
    for (int task = gw; task < MTOK / 8; task += NGW) {
        const int t0 = task * 8, b = t0 >> 12, s0 = t0 & (SEQ - 1);
#pragma unroll 1
        for (int tt = 0; tt < 8; ++tt) {
            const int t = t0 + tt, s = s0 + tt;
            const float ang = (float)positions[t] * invf;
            double rev = (double)ang * 0.15915494309189535; rev -= floor(rev);
            const float rv = (float)rev, sn = __builtin_amdgcn_sinf(rv), cs = __builtin_amdgcn_cosf(rv);
            const float kr = bf1(LAT[(size_t)t * MLA_IN_PAD + 640 + lane]);
#pragma unroll 1
            for (int h = 0; h < NH; ++h) {
                { const bf16* qp = QRAW + (size_t)t * 1536 + QKH * h;
                  const float x0 = bf1(qp[lane]), x1 = bf1(qp[64 + lane]), x2 = bf1(qp[128 + lane]);
                  const float rstd = rsqrtf(wave_sum(x0 * x0 + x1 * x1 + x2 * x2) * (1.f / QKH) + NORM_EPS);
                  const float y0 = x0 * rstd * qg0, y1 = x1 * rstd * qg1, y2 = x2 * rstd * qg2, pr = __shfl_xor(y2, 32);
                  const float r2 = lane < 32 ? y2 * cs - pr * sn : pr * sn + y2 * cs;
                  bf16* o = Qf + ((size_t)(b * NH + h) * SEQ + s) * QKH;
                  o[lane] = (bf16)f2bf(y0 * QSCALE); o[64 + lane] = (bf16)f2bf(y1 * QSCALE); o[128 + lane] = (bf16)f2bf(r2 * QSCALE); }
                { const bf16* kp = KVRAW + (size_t)t * 2048 + 256 * h;
                  const float x0 = bf1(kp[lane]), x1 = bf1(kp[64 + lane]), x2 = kr;
                  const float rstd = rsqrtf(wave_sum(x0 * x0 + x1 * x1 + x2 * x2) * (1.f / QKH) + NORM_EPS);
                  const float y0 = x0 * rstd * kg0, y1 = x1 * rstd * kg1, y2 = x2 * rstd * kg2, pr = __shfl_xor(y2, 32);
                  const float r2 = lane < 32 ? y2 * cs - pr * sn : pr * sn + y2 * cs;
                  bf16* o = Kf + ((size_t)(b * NH + h) * SEQ + s) * QKH;
                  o[lane] = (bf16)f2bf(y0); o[64 + lane] = (bf16)f2bf(y1); o[128 + lane] = (bf16)f2bf(r2); }
            }
        }
#pragma unroll 1
        for (int h = 0; h < NH; ++h)
#pragma unroll
            for (int dd = 0; dd < 128; dd += 64) {
                const bf16* vp = KVRAW + (size_t)t0 * 2048 + 256 * h + 128 + dd + lane;
                unsigned w[4];
#pragma unroll
                for (int i = 0; i < 4; ++i) w[i] = (unsigned)vp[(size_t)(2 * i) * 2048] | ((unsigned)vp[(size_t)(2 * i + 1) * 2048] << 16);
                *(u32x4*)(Vt + ((size_t)(b * NH + h) * VH + dd + lane) * SEQ + s0) = (u32x4){w[0], w[1], w[2], w[3]};
            }
    }
}

typedef float f32x2_t __attribute__((ext_vector_type(2))); typedef __bf16 bf16x2_t __attribute__((ext_vector_type(2)));
DI unsigned cvtpk(float lo, float hi) { f32x2_t v = {lo, hi}; bf16x2_t b = __builtin_convertvector(v, bf16x2_t); return __builtin_bit_cast(unsigned, b); }
DI void attn_unit(const bf16* Qf, const bf16* Kf, const bf16* Vt, bf16* O, int bh, int qb, int wave, int lane) {
    const int r32 = lane & 31, hi = lane >> 5;
    const int q0 = qb * 256 + wave * 32;
    s16x8 qf[12];
    { const bf16* Qp = Qf + ((size_t)bh * SEQ + q0 + r32) * QKH + 8 * hi;
#pragma unroll
      for (int ks = 0; ks < 12; ++ks) qf[ks] = *(const s16x8*)(Qp + 16 * ks); }
    f32x16 o[4];
#pragma unroll
    for (int d = 0; d < 4; ++d)
#pragma unroll
        for (int r = 0; r < 16; ++r) o[d][r] = 0.f;
    float m = -1e30f, l = 0.f;
    const bf16* Kp = Kf + ((size_t)bh * SEQ + r32) * QKH + 8 * hi;
    const bf16* Vp = Vt + ((size_t)bh * VH + r32) * SEQ + 4 * hi;
    const int nkt = q0 / 32 + 1;
#pragma unroll 1
    for (int kt = 0; kt < nkt; ++kt) {
        f32x16 sc;
#pragma unroll
        for (int r = 0; r < 16; ++r) sc[r] = 0.f;
        const bf16* kp = Kp + (size_t)kt * 32 * QKH;
#pragma unroll
        for (int ks = 0; ks < 12; ++ks) sc = __builtin_amdgcn_mfma_f32_32x32x16_bf16(*(const s16x8*)(kp + 16 * ks), qf[ks], sc, 0, 0, 0);
        if (kt == nkt - 1) {
#pragma unroll
            for (int r = 0; r < 16; ++r) if (crow(r, hi) > r32) sc[r] = -INFINITY;
        }
        float mt = sc[0];
#pragma unroll
        for (int r = 1; r < 16; ++r) mt = fmaxf(mt, sc[r]);
        mt = fmaxf(mt, __shfl_xor(mt, 32));
        const float mn = fmaxf(m, mt), alpha = __builtin_amdgcn_exp2f(m - mn);
        m = mn; l *= alpha;
#pragma unroll
        for (int d = 0; d < 4; ++d)
#pragma unroll
            for (int r = 0; r < 16; ++r) o[d][r] *= alpha;
        float ps = 0.f;
#pragma unroll
        for (int r = 0; r < 16; ++r) { sc[r] = __builtin_amdgcn_exp2f(sc[r] - mn); ps += sc[r]; }
        l += ps;
#pragma unroll
        for (int s = 0; s < 2; ++s) {
            u32x4 pw; pw.x = cvtpk(sc[8 * s], sc[8 * s + 1]); pw.y = cvtpk(sc[8 * s + 2], sc[8 * s + 3]); pw.z = cvtpk(sc[8 * s + 4], sc[8 * s + 5]); pw.w = cvtpk(sc[8 * s + 6], sc[8 * s + 7]);
            const s16x8 pb = __builtin_bit_cast(s16x8, pw);
#pragma unroll
            for (int d = 0; d < 4; ++d) {
                const bf16* vp = Vp + (size_t)d * 32 * SEQ + kt * 32 + 16 * s;
                const s16x4 lo = *(const s16x4*)vp, hh = *(const s16x4*)(vp + 8);
                const s16x8 va = __builtin_shufflevector(lo, hh, 0, 1, 2, 3, 4, 5, 6, 7);
                o[d] = __builtin_amdgcn_mfma_f32_32x32x16_bf16(va, pb, o[d], 0, 0, 0);
            }
        }
    }
    l += __shfl_xor(l, 32);
    const float inv = 1.f / l;
    bf16* Op = O + ((size_t)((bh >> 3) * SEQ + q0 + r32)) * DM + (bh & 7) * VH + 4 * hi;
#pragma unroll
    for (int d = 0; d < 4; ++d)
#pragma unroll
        for (int g = 0; g < 4; ++g) { u32x2 w; w.x = cvtpk(o[d][4 * g] * inv, o[d][4 * g + 1] * inv); w.y = cvtpk(o[d][4 * g + 2] * inv, o[d][4 * g + 3] * inv);
            *(u32x2*)(Op + 32 * d + 8 * g) = w; }
}
constexpr int AT_KROW = 400, AT_VROW = 136, AT_KBYTES = 64 * AT_KROW, AT_VBYTES = 128 * AT_VROW, AT_STAGE = AT_KBYTES + AT_VBYTES;
DI void attn_unit_lds(const bf16* Qf, const bf16* Kf, const bf16* Vt, bf16* O, LAS unsigned char* lds, int bh, int qb, int wave, int lane) {
    const int r32 = lane & 31, hi = lane >> 5, tid = wave * 64 + lane;
    const int q0 = qb * 256 + wave * 32;
    s16x8 qf[12];
    { const bf16* Qp = Qf + ((size_t)bh * SEQ + q0 + r32) * QKH + 8 * hi;
#pragma unroll
      for (int ks = 0; ks < 12; ++ks) qf[ks] = *(const s16x8*)(Qp + 16 * ks); }
    f32x16 o[4];
#pragma unroll
    for (int d = 0; d < 4; ++d)
#pragma unroll
        for (int r = 0; r < 16; ++r) o[d][r] = 0.f;
    float m = -1e30f, l = 0.f;
    const int NT = 4 * (qb + 1);
    const __amdgpu_buffer_rsrc_t krs = __builtin_amdgcn_make_buffer_rsrc((void*)(Kf + (size_t)bh * SEQ * QKH), 0, SEQ * QKH * 2, 0x00020000);
    const __amdgpu_buffer_rsrc_t vrs = __builtin_amdgcn_make_buffer_rsrc((void*)(Vt + (size_t)bh * VH * SEQ), 0, VH * SEQ * 2, 0x00020000);
    unsigned kgo[3], kl[3], vgo[2], vl[2];
#pragma unroll
    for (int i = 0; i < 3; ++i) { const int c = tid + 512 * i, row = c / 24, col = c - row * 24; kgo[i] = (unsigned)(row * 384 + col * 16); kl[i] = (unsigned)(row * AT_KROW + col * 16); }
#pragma unroll
    for (int i = 0; i < 2; ++i) { const int c = tid + 512 * i, d = c >> 3, part = c & 7; vgo[i] = (unsigned)(d * (SEQ * 2) + part * 16); vl[i] = (unsigned)(AT_KBYTES + d * AT_VROW + part * 16); }
    u32x4 kr[3], vr[2];
#pragma unroll
    for (int i = 0; i < 3; ++i) kr[i] = __builtin_amdgcn_raw_buffer_load_b128(krs, kgo[i], 0, 0);
#pragma unroll
    for (int i = 0; i < 2; ++i) vr[i] = __builtin_amdgcn_raw_buffer_load_b128(vrs, vgo[i], 0, 0);
#pragma unroll
    for (int i = 0; i < 3; ++i) *(LAS u32x4*)(lds + kl[i]) = kr[i];
#pragma unroll
    for (int i = 0; i < 2; ++i) { *(LAS u32x2*)(lds + vl[i]) = (u32x2){vr[i].x, vr[i].y}; *(LAS u32x2*)(lds + vl[i] + 8) = (u32x2){vr[i].z, vr[i].w}; }
    __syncthreads();
    const unsigned kfo = (unsigned)(r32 * AT_KROW + 16 * hi), vfo = (unsigned)(AT_KBYTES + r32 * AT_VROW + 8 * hi);
#pragma unroll 1
    for (int t = 0; t < NT; ++t) {
        const unsigned sb = (unsigned)((t & 1) * AT_STAGE), sn = (unsigned)(((t + 1) & 1) * AT_STAGE);
        const bool more = t + 1 < NT;
        if (more) {
#pragma unroll
            for (int i = 0; i < 3; ++i) kr[i] = __builtin_amdgcn_raw_buffer_load_b128(krs, kgo[i], (t + 1) * (64 * 384), 0);
#pragma unroll
            for (int i = 0; i < 2; ++i) vr[i] = __builtin_amdgcn_raw_buffer_load_b128(vrs, vgo[i], (t + 1) * 128, 0);
        }
        const int k0 = 64 * t;
        if (k0 <= q0 + 31) {
            f32x16 s0, s1;
#pragma unroll
            for (int r = 0; r < 16; ++r) { s0[r] = 0.f; s1[r] = 0.f; }
#pragma unroll
            for (int ks = 0; ks < 12; ++ks) {
                const s16x8 ka = *(const LAS s16x8*)(lds + sb + kfo + 32 * ks), kb = *(const LAS s16x8*)(lds + sb + kfo + 32 * AT_KROW + 32 * ks);
                s0 = __builtin_amdgcn_mfma_f32_32x32x16_bf16(ka, qf[ks], s0, 0, 0, 0);
                s1 = __builtin_amdgcn_mfma_f32_32x32x16_bf16(kb, qf[ks], s1, 0, 0, 0);
                if ((ks & 3) == 3) __builtin_amdgcn_sched_barrier(0);
            }
            if (k0 + 63 > q0) {
                const int qa = q0 + r32 - k0 - 4 * hi;
#pragma unroll
                for (int r = 0; r < 16; ++r) { if (((r & 3) + 8 * (r >> 2)) > qa) s0[r] = -INFINITY; if ((32 + (r & 3) + 8 * (r >> 2)) > qa) s1[r] = -INFINITY; }
            }
            float mt = fmaxf(s0[0], s1[0]);
#pragma unroll
            for (int r = 1; r < 16; ++r) mt = fmaxf(mt, fmaxf(s0[r], s1[r]));
            mt = fmaxf(mt, __shfl_xor(mt, 32));
            const float mn = fmaxf(m, mt), alpha = __builtin_amdgcn_exp2f(m - mn);
            m = mn; l *= alpha;
#pragma unroll
            for (int d = 0; d < 4; ++d)
#pragma unroll
                for (int r = 0; r < 16; ++r) o[d][r] *= alpha;
            float ps = 0.f;
#pragma unroll
            for (int r = 0; r < 16; ++r) { s0[r] = __builtin_amdgcn_exp2f(s0[r] - mn); s1[r] = __builtin_amdgcn_exp2f(s1[r] - mn); ps += s0[r] + s1[r]; }
            l += ps;
#pragma unroll
            for (int s = 0; s < 4; ++s) {
                u32x4 pw;
                if (s < 2) { pw.x = cvtpk(s0[8 * s], s0[8 * s + 1]); pw.y = cvtpk(s0[8 * s + 2], s0[8 * s + 3]); pw.z = cvtpk(s0[8 * s + 4], s0[8 * s + 5]); pw.w = cvtpk(s0[8 * s + 6], s0[8 * s + 7]); }
                else { const int z = s - 2; pw.x = cvtpk(s1[8 * z], s1[8 * z + 1]); pw.y = cvtpk(s1[8 * z + 2], s1[8 * z + 3]); pw.z = cvtpk(s1[8 * z + 4], s1[8 * z + 5]); pw.w = cvtpk(s1[8 * z + 6], s1[8 * z + 7]); }
                const s16x8 pb = __builtin_bit_cast(s16x8, pw);
#pragma unroll
                for (int d = 0; d < 4; ++d) {
                    const unsigned va = sb + vfo + (unsigned)(d * 32 * AT_VROW + 32 * s);
                    const s16x4 lo = *(const LAS s16x4*)(lds + va), hh = *(const LAS s16x4*)(lds + va + 16);
                    const s16x8 vfrag = __builtin_shufflevector(lo, hh, 0, 1, 2, 3, 4, 5, 6, 7);
                    o[d] = __builtin_amdgcn_mfma_f32_32x32x16_bf16(vfrag, pb, o[d], 0, 0, 0);
                }
                __builtin_amdgcn_sched_barrier(0);
            }
        }
        if (more) {
#pragma unroll
            for (int i = 0; i < 3; ++i) *(LAS u32x4*)(lds + sn + kl[i]) = kr[i];
#pragma unroll
            for (int i = 0; i < 2; ++i) { *(LAS u32x2*)(lds + sn + vl[i]) = (u32x2){vr[i].x, vr[i].y}; *(LAS u32x2*)(lds + sn + vl[i] + 8) = (u32x2){vr[i].z, vr[i].w}; }
        }
        __syncthreads();
    }
    l += __shfl_xor(l, 32);
    const float inv = 1.f / l;
    bf16* Op = O + ((size_t)((bh >> 3) * SEQ + q0 + r32)) * DM + (bh & 7) * VH + 4 * hi;
#pragma unroll
    for (int d = 0; d < 4; ++d)
#pragma unroll
        for (int g = 0; g < 4; ++g) { u32x2 w; w.x = cvtpk(o[d][4 * g] * inv, o[d][4 * g + 1] * inv); w.y = cvtpk(o[d][4 * g + 2] * inv, o[d][4 * g + 3] * inv);
            *(u32x2*)(Op + 32 * d + 8 * g) = w; }
}
DI void ph_attn(const bf16* Qf, const bf16* Kf, const bf16* Vt, bf16* O, LAS unsigned char* lds, int vcu, int G, int wave, int lane) {
    for (int p = vcu; p < 256; p += G) {
        const int bh = p >> 3, s8 = p & 7;
#pragma unroll 1
        for (int u = 0; u < 2; ++u) attn_unit_lds(Qf, Kf, Vt, O, lds, bh, u ? s8 : 15 - s8, wave, lane);
    }
}

__global__ void __launch_bounds__(NWAVES * 64, 2) mk_fwd(Args args) {
    extern __shared__ __attribute__((aligned(16))) unsigned char lds_raw[];
    LAS unsigned char* lds = (LAS unsigned char*)lds_raw;
    const int tid = threadIdx.x, lane = tid & 63, wave = __builtin_amdgcn_readfirstlane(tid >> 6);
    const int G = gridDim.x, bx = blockIdx.x, vcu = (G % 8 == 0) ? (bx % 8) * (G / 8) + bx / 8 : bx;
    const int gw = vcu * NWAVES + wave, NGW = G * NWAVES;
    const size_t GT = (size_t)G * 512;
    unsigned char* ws = args.ws;
    for (int u = tid; u < (LDS_BYTES - LDSCTL_OFF) / 4; u += NWAVES * 64) ((LAS unsigned*)(lds + LDSCTL_OFF))[u] = 0u;
    __syncthreads();
    const bool multi = (args.ph_hi - args.ph_lo) > 1;
    XcdBarrier bar; bar.bar = (unsigned*)(ws + WS_CTL) + CW_BAR; bar.x = 0; bar.st = (volatile LAS unsigned*)(lds + MISC_OFF) + 8;
    if (multi) bar = xcd_barrier_post((unsigned*)(ws + WS_CTL) + CW_BAR, (volatile LAS unsigned*)(lds + MISC_OFF) + 8);

    float* X = args.out;
    const float* mod = (const float*)(ws + WS_MOD);
    bf16* XN = (bf16*)(ws + WS_XN);

    const int lo = args.ph_lo, hi = args.ph_hi;
#define IN(k) (EN(k) && lo <= (k) && (k) < hi)
    auto opq = [](int v) { asm volatile("" : "+v"(v)); return v; };
#define LN opq(lane)
#define TD opq(tid)
#define GTID ((size_t)vcu * 512 + (size_t)opq(tid))
#define SEAM(k) do { if (lo <= (k) && (k) + 1 < hi) xcd_barrier(bar); } while (0)
#define GEMM_BF16(Aptr, Bptr, NN, KK, Optr, LDC) do { pg8::Gemm g{(const bf16*)(Aptr), (const bf16*)(Bptr), MTOK, (NN), (KK)}; pg8::StaticOrder S; S.init(MTOK, (NN), G, bx); \
        pg8::EpiBf16<0> E{(bf16*)(Optr), (LDC), nullptr, 0, 0, 1.f}; pg8::gemm_phase<pg8::EpiBf16<0>, pg8::StaticOrder, true, true>(lds, g, S, E); } while (0)
#define GEMM_RES(Aptr, Bptr, BASE, OUT, GATE) do { pg8::Gemm g{(const bf16*)(Aptr), (const bf16*)(Bptr), MTOK, DM, DM}; pg8::StaticOrder S; S.init(MTOK, DM, G, bx); \
        EpiResGate E{(BASE), (OUT), (GATE)}; pg8::gemm_phase<EpiResGate, pg8::StaticOrder, true, true>(lds, g, S, E); } while (0)

    if (IN(0)) for (int r_ = 0; r_ < NREP(0); ++r_) ph_prologue(args, lds, TD, wave, vcu, G);
    SEAM(0);
    if (IN(1)) for (int r_ = 0; r_ < NREP(1); ++r_) ph_modulate((const float*)args.in[0], XN, nullptr, (const float*)args.in[3], mod, 0, 1024, gw, NGW, LN);
    SEAM(1);
    if (IN(2)) for (int r_ = 0; r_ < NREP(2); ++r_) GEMM_BF16(XN, ws + WS_WCIN, 3072, 1024, ws + WS_BCV, 3072);
    SEAM(2);
    if (IN(3)) for (int r_ = 0; r_ < NREP(3); ++r_) ph_conv((const bf16*)(ws + WS_BCV), (const float*)args.in[8], (bf16*)(ws + WS_Z), GTID, GT);
    SEAM(3);
    if (IN(4)) for (int r_ = 0; r_ < NREP(4); ++r_) GEMM_RES(ws + WS_Z, ws + WS_WCOUT, (const float*)args.in[0], X, mod + 2048);
    SEAM(4);
    if (IN(5)) for (int r_ = 0; r_ < NREP(5); ++r_) ph_modulate(X, XN, ws + WS_XN8, (const float*)args.in[4], mod, 3072, 4096, gw, NGW, LN);
    SEAM(5);
    if (IN(6)) for (int r_ = 0; r_ < NREP(6); ++r_) GEMM_BF16(XN, ws + WS_WPQ0, 2048, 1024, ws + WS_PQ, 2048);
    SEAM(6);
    if (IN(7)) for (int r_ = 0; r_ < NREP(7); ++r_) ph_topk((const bf16*)(ws + WS_PQ), (const bf16*)(ws + WS_SUBK), (int*)(ws + WS_IDS), (float*)(ws + WS_GATES), lds, gw, NGW, wave, LN);
    SEAM(7);
    if (IN(8)) { ph_peer_u<0>(ws + WS_PU, (const int*)(ws + WS_IDS), (const float*)(ws + WS_GATES), ws + WS_XN8, (float*)(ws + WS_ACT), bx, G, wave, LN);
        for (int r_ = 1; r_ < NREP(8); ++r_) ph_peer_u<PROBE_VAR>(ws + WS_PU, (const int*)(ws + WS_IDS), (const float*)(ws + WS_GATES), ws + WS_XN8, (float*)(ws + WS_DUMMY), bx, G, wave, LN); }
    SEAM(8);
    if (IN(9)) for (int r_ = 0; r_ < NREP(9); ++r_) ph_peer_v(ws + WS_PV, (const int*)(ws + WS_IDS), (const float*)(ws + WS_ACT), X, (r_ + 1 < NREP(9) ? (float*)(ws + WS_DUMMY) : X), mod + 5120, bx, G, wave, LN);
    SEAM(9);
    if (IN(10)) for (int r_ = 0; r_ < NREP(10); ++r_) ph_modulate(X, XN, nullptr, (const float*)args.in[3] + DM, mod + (size_t)4 * 6144, 0, 1024, gw, NGW, LN);
    SEAM(10);
    if (IN(11)) for (int r_ = 0; r_ < NREP(11); ++r_) GEMM_BF16(XN, ws + WS_WMIN, MLA_IN_PAD, 1024, ws + WS_LAT, MLA_IN_PAD);
    SEAM(11);
    if (IN(12)) for (int r_ = 0; r_ < NREP(12); ++r_) ph_latnorm((const bf16*)(ws + WS_LAT), (const float*)args.in[11], (const float*)args.in[12], (bf16*)(ws + WS_QN), (bf16*)(ws + WS_KVN), gw, NGW, LN);
    SEAM(12);
    if (IN(13)) for (int r_ = 0; r_ < NREP(13); ++r_) { GEMM_BF16(ws + WS_QN, ws + WS_WQB, 1536, QLORA, ws + WS_QRAW, 1536); GEMM_BF16(ws + WS_KVN, ws + WS_WKVB, 2048, KVLORA, ws + WS_KVRAW, 2048); }
    SEAM(13);
    if (IN(14)) for (int r_ = 0; r_ < NREP(14); ++r_) ph_qkprep((const bf16*)(ws + WS_QRAW), (const bf16*)(ws + WS_KVRAW), (const bf16*)(ws + WS_LAT), (const int*)args.in[2], (const float*)args.in[15], (const float*)args.in[16],
                          (bf16*)(ws + WS_QF), (bf16*)(ws + WS_KF), (bf16*)(ws + WS_VT), gw, NGW, LN);
    SEAM(14);
    if (IN(15)) for (int r_ = 0; r_ < NREP(15); ++r_) ph_attn((const bf16*)(ws + WS_QF), (const bf16*)(ws + WS_KF), (const bf16*)(ws + WS_VT), (bf16*)(ws + WS_O), lds, vcu, G, wave, LN);
    SEAM(15);
    if (IN(16)) for (int r_ = 0; r_ < NREP(16); ++r_) GEMM_RES(ws + WS_O, ws + WS_WMOUT, (const float*)X, (r_ + 1 < NREP(16) ? (float*)(ws + WS_DUMMY) : X), mod + (size_t)4 * 6144 + 2048);
    SEAM(16);
    if (IN(17)) for (int r_ = 0; r_ < NREP(17); ++r_) ph_modulate(X, XN, ws + WS_XN8, (const float*)args.in[4] + DM, mod + (size_t)4 * 6144, 3072, 4096, gw, NGW, LN);
    SEAM(17);
    if (IN(18)) for (int r_ = 0; r_ < NREP(18); ++r_) GEMM_BF16(XN, ws + WS_WPQ1, 2048, 1024, ws + WS_PQ, 2048);
    SEAM(18);
    if (IN(19)) for (int r_ = 0; r_ < NREP(19); ++r_) ph_topk((const bf16*)(ws + WS_PQ), (const bf16*)(ws + WS_SUBK) + (size_t)8 * 2 * 128 * 128, (int*)(ws + WS_IDS), (float*)(ws + WS_GATES), lds, gw, NGW, wave, LN);
    SEAM(19);
    if (IN(20)) for (int r_ = 0; r_ < NREP(20); ++r_) ph_peer_u<0>(ws + WS_PU + (size_t)NEXP * 1024, (const int*)(ws + WS_IDS), (const float*)(ws + WS_GATES), ws + WS_XN8, (float*)(ws + WS_ACT), bx, G, wave, LN);
    SEAM(20);
    if (IN(21)) for (int r_ = 0; r_ < NREP(21); ++r_) ph_peer_v(ws + WS_PV + (size_t)8 * NEXP * 128, (const int*)(ws + WS_IDS), (const float*)(ws + WS_ACT), X, (r_ + 1 < NREP(21) ? (float*)(ws + WS_DUMMY) : X), mod + (size_t)4 * 6144 + 5120, bx, G, wave, LN);
}

extern "C" void kernel_launch(void* const* d_in, const int* in_sizes, int n_in, void* d_out, int out_size, void* d_ws, size_t ws_size, hipStream_t stream) {
    static int grid = 0;
    if (grid == 0) {
        if (n_in != 22 || out_size != MTOK * DM || ws_size < WS_END) { fprintf(stderr, "kernel_launch: unexpected shapes: n_in %d out %d ws %zu (need %zu)\n", n_in, out_size, ws_size, (size_t)WS_END); grid = -1; return; }
        int dev = 0, cus = 0;
        if (hipGetDevice(&dev) != hipSuccess || hipDeviceGetAttribute(&cus, hipDeviceAttributeMultiprocessorCount, dev) != hipSuccess) { grid = -1; return; }
        if (hipFuncSetAttribute((const void*)mk_fwd, hipFuncAttributeMaxDynamicSharedMemorySize, LDS_BYTES) != hipSuccess) { fprintf(stderr, "kernel_launch: hipFuncSetAttribute failed\n"); grid = -1; return; }
        int per_cu = 0;
        if (hipOccupancyMaxActiveBlocksPerMultiprocessor(&per_cu, (const void*)mk_fwd, NWAVES * 64, LDS_BYTES) != hipSuccess || per_cu < 1) fprintf(stderr, "kernel_launch: occupancy query says %d\n", per_cu);
        (void)hipGetLastError();
        grid = cus;
    }
    if (grid < 0) return;
    (void)hipMemsetAsync((char*)d_ws + WS_CTL, 0, CTL_ZERO_BYTES, stream);
    Args a{};
    for (int i = 0; i < 22; ++i) a.in[i] = d_in[i];
    a.out = (float*)d_out; a.ws = (unsigned char*)d_ws;
#if MK_N_LAUNCHES == 1
    a.ph_lo = 0; a.ph_hi = NPHASES;
    hipLaunchKernelGGL(mk_fwd, dim3(grid), dim3(NWAVES * 64), LDS_BYTES, stream, a);
#else
    for (int ph = 0; ph < NPHASES; ++ph) { a.ph_lo = ph; a.ph_hi = ph + 1; hipLaunchKernelGGL(mk_fwd, dim3(grid), dim3(NWAVES * 64), LDS_BYTES, stream, a); }
#endif
}
```

```cpp
#include <hip/hip_runtime.h>
#include <cstdio>
#include <cstdint>
#define GAS __attribute__((address_space(1)))
#define LAS __attribute__((address_space(3)))
namespace pg8 {
#define PG8_LAS __attribute__((address_space(3)))
typedef unsigned short bf16_t;
typedef short bf16x8 __attribute__((ext_vector_type(8)));
typedef float f32x4 __attribute__((ext_vector_type(4)));
typedef unsigned u32x4 __attribute__((ext_vector_type(4)));
constexpr int BM = 256, BK = 64, HALF = 128, HTB = HALF * BK * 2  , STAGE_BYTES = 8 * HTB, NXCD = 8, WGM = 8;

__host__ __device__ __forceinline__ int lds_byte(int r, int c) { const int st = (r >> 4) * 2 + (c >> 5), rr = r & 15, cc = c & 31, ob = rr * 64 + cc * 2; return st * 1024 + (ob ^ (((ob >> 9) & 1) << 5)); }
__host__ __device__ __forceinline__ void stage_rc(int b, int& R, int& C) { const int st = b / 1024, sb = b % 1024, swz = sb ^ (((sb >> 9) & 1) << 5); R = (st >> 1) * 16 + swz / 64; C = (st & 1) * 32 + (swz % 64) / 2; }
__host__ __device__ __forceinline__ int perm32(int rho) { const int n = rho >> 4, i = rho & 15; return 8 * (i >> 2) + 4 * n + (i & 3); }

struct Unit { int pm, pn; };
struct Gemm { const bf16_t* A; const bf16_t* Bt; int M, N, K; };

struct StaticOrder {
    int nM, nN, nwg, G, c;
    __host__ __device__ void init(int M, int N, int G_, int c_) { nM = M / BM; nN = N / BM; nwg = nM * nN; G = G_; c = c_; }
    __host__ __device__ bool next(int i, Unit& u) const {
        const long L = (long)i * G + c; if (L >= nwg) return false;
        int wgid = (int)L; { const int q = nwg / NXCD, r = nwg % NXCD, xcd = wgid % NXCD, off = wgid / NXCD; wgid = (xcd < r ? xcd * (q + 1) : r * (q + 1) + (xcd - r) * q) + off; }
        const int nig = WGM * nN, gid = wgid / nig, fm = gid * WGM, gsz = (nM - fm) < WGM ? (nM - fm) : WGM;
        u.pm = fm + ((wgid % nig) % gsz); u.pn = (wgid % nig) / gsz; return true;
    }
    __device__ __forceinline__ void a_ready(const Unit&) const {}
    __device__ __forceinline__ void done(const Unit&) const {}
};

__device__ __forceinline__ unsigned cvt_pk_bf16(float lo, float hi) { unsigned r; asm volatile("v_cvt_pk_bf16_f32 %0, %1, %2" : "=v"(r) : "v"(lo), "v"(hi)); return r; }
typedef float f32x2 __attribute__((ext_vector_type(2)));
__device__ __forceinline__ f32x2 gelu_pk(f32x2 v) {
    const f32x2 av = __builtin_elementwise_abs(v), d = av * 0.2316418882f + 1.0f;
    f32x2 t; t.x = __builtin_amdgcn_rcpf(d.x); t.y = __builtin_amdgcn_rcpf(d.y);
    f32x2 q = t * 0.5307027145f + (-0.7265760135f); q = q * t + 0.7107068705f; q = q * t + (-0.142248368f); q = q * t + 0.127414796f; q = q * t;
    const f32x2 s = (v * v) * (-0.72134752044f);
    f32x2 e; e.x = __builtin_amdgcn_exp2f(s.x); e.y = __builtin_amdgcn_exp2f(s.y);
    const f32x2 m = v * (q * e), r = v - m;
    f32x2 o; o.x = v.x < 0.f ? m.x : r.x; o.y = v.y < 0.f ? m.y : r.y; return o;
}

template <int ACT  > struct EpiBf16 {
    static constexpr bool PERM = true, AFTER_DRAIN = false; static_assert(ACT == 0 || ACT == 1, "EpiBf16: ACT is 0 (none) or 1 (gelu_pk)");
    bf16_t* O; int ldc; const float* bias; int split_cols; size_t split_stride; float scale0;
    __device__ __forceinline__ void operator()(const f32x4 (&acc)[2][2][4][2], const Unit& u, int wr, int wc, int fr, int fq) const {
        const int row0 = u.pm * BM + wr * 64 + fr; int colt = u.pn * BM; bf16_t* base = O;
        float sc = 1.f; if (split_cols) { const int t = colt / split_cols; base += (size_t)t * split_stride; colt -= t * split_cols; if (t == 0) sc = scale0; }
        const int col0 = colt + wc * 32 + 8 * fq, bcol0 = u.pn * BM + wc * 32 + 8 * fq;
        f32x4 bv[2][2];
#pragma unroll
        for (int bj = 0; bj < 2; ++bj)
#pragma unroll
            for (int n = 0; n < 2; ++n) bv[bj][n] = bias ? *(const f32x4*)(bias + bcol0 + bj * HALF + 4 * n) : (f32x4){0.f, 0.f, 0.f, 0.f};
#pragma unroll
        for (int ai = 0; ai < 2; ++ai)
#pragma unroll
            for (int m = 0; m < 4; ++m) { bf16_t* rowp = base + (size_t)(row0 + ai * HALF + m * 16) * ldc + col0;
#pragma unroll
                for (int bj = 0; bj < 2; ++bj) { f32x4 v0 = acc[ai][bj][m][0] + bv[bj][0], v1 = acc[ai][bj][m][1] + bv[bj][1];
                    if (ACT == 1) { f32x2 a = gelu_pk((f32x2){v0[0], v0[1]}), b = gelu_pk((f32x2){v0[2], v0[3]}), c = gelu_pk((f32x2){v1[0], v1[1]}), d = gelu_pk((f32x2){v1[2], v1[3]});
                        v0 = (f32x4){a.x, a.y, b.x, b.y}; v1 = (f32x4){c.x, c.y, d.x, d.y}; }
                    v0 = v0 * sc; v1 = v1 * sc; u32x4 w; w.x = cvt_pk_bf16(v0[0], v0[1]); w.y = cvt_pk_bf16(v0[2], v0[3]); w.z = cvt_pk_bf16(v1[0], v1[1]); w.w = cvt_pk_bf16(v1[2], v1[3]);
                    *(u32x4*)(rowp + bj * HALF) = w; } }
    }
};

template <class Epi, class Sched, bool ALIGN_EPI = false, bool SP2 = false>
__device__ __forceinline__ void gemm_phase(PG8_LAS unsigned char* lds, const Gemm g, const Sched& S, const Epi& E) {
    int tid_raw = threadIdx.x; asm volatile("" : "+v"(tid_raw));
    const int tid = tid_raw, wid = __builtin_amdgcn_readfirstlane(tid >> 6), lane = tid & 63, wr = wid >> 2, wc = wid & 3, fr = lane & 15, fq = lane >> 4;
    const int K = g.K, nt = K / BK;
    unsigned voffA[2], voffB[2];
#pragma unroll
    for (int i = 0; i < 2; ++i) { int R, C; stage_rc(tid * 16 + i * 8192, R, C); const int Rb = Epi::PERM ? ((R & ~31) + perm32(R & 31)) : R;
        voffA[i] = (unsigned)(R * K + C) * 2u; voffB[i] = (unsigned)(Rb * K + C) * 2u; }
    const size_t kstep = (size_t)(BK * 2);
    const size_t hstep = (size_t)HALF * K * 2;
    const size_t tstep = 2 * hstep;
    const unsigned ldsw = (unsigned)wid * 1024u;
    const int aoff = lds_byte(wr * 64 + fr, fq * 8), boff = lds_byte(wc * 32 + fr, fq * 8);
#define PG8_SA(b, h) (((b) * 2 + (h)) * HTB)
#define PG8_SB(b, h) ((4 + (b) * 2 + (h)) * HTB)
#define PG8_STAGE(bufoff, gbase, voff) do { _Pragma("unroll") for (int _i = 0; _i < 2; ++_i) \
        __builtin_amdgcn_global_load_lds((const unsigned*)((const char*)(gbase) + (voff)[_i]), (PG8_LAS unsigned*)(lds + (bufoff) + ldsw + _i * 8192), 16, 0, 0); } while (0)
#define PG8_LDA(dst, b, h) do { _Pragma("unroll") for (int m = 0; m < 4; ++m) _Pragma("unroll") for (int k = 0; k < 2; ++k) dst[m][k] = *(const PG8_LAS bf16x8*)(lds + PG8_SA(b, h) + aoff + m * 2048 + k * 1024); } while (0)
#define PG8_LDB(dst, b, h) do { _Pragma("unroll") for (int n = 0; n < 2; ++n) _Pragma("unroll") for (int k = 0; k < 2; ++k) dst[n][k] = *(const PG8_LAS bf16x8*)(lds + PG8_SB(b, h) + boff + n * 2048 + k * 1024); } while (0)
#define PG8_MMA(ai, bj, At, Bt) do { __builtin_amdgcn_s_setprio(1); _Pragma("unroll") for (int m = 0; m < 4; ++m) _Pragma("unroll") for (int n = 0; n < 2; ++n) _Pragma("unroll") for (int k = 0; k < 2; ++k) \
        acc[ai][bj][m][n] = __builtin_amdgcn_mfma_f32_16x16x32_bf16(Bt[n][k], At[m][k], acc[ai][bj][m][n], 0, 0, 0); __builtin_amdgcn_s_setprio(0); } while (0)
#define PG8_WAIT_V(n) asm volatile("s_waitcnt vmcnt(" #n ")" ::: "memory")
#define PG8_WAIT_L(n) asm volatile("s_waitcnt lgkmcnt(" #n ")" ::: "memory")
#define PG8_BAR __builtin_amdgcn_s_barrier()
#define PG8_SCHED __builtin_amdgcn_sched_barrier(0)
    Unit cur, nxt; int ui = 0;
    if (!S.next(0, cur)) return;
    f32x4 acc[2][2][4][2];
#pragma unroll
    for (int a = 0; a < 2; ++a)
#pragma unroll
        for (int b = 0; b < 2; ++b)
#pragma unroll
            for (int m = 0; m < 4; ++m)
#pragma unroll
                for (int n = 0; n < 2; ++n) acc[a][b][m][n] = (f32x4){0.f, 0.f, 0.f, 0.f};
    bf16x8 At[4][2], B0[2][2], B1[2][2];
    const char* cA = (const char*)g.A + (size_t)cur.pm * tstep; const char* cB = (const char*)g.Bt + (size_t)cur.pn * tstep;
    S.a_ready(cur);
    if constexpr (SP2) {
        PG8_STAGE(PG8_SB(0, 0), cB, voffB); PG8_STAGE(PG8_SB(0, 1), cB + hstep, voffB); PG8_STAGE(PG8_SA(0, 0), cA, voffA); PG8_STAGE(PG8_SA(0, 1), cA + hstep, voffA);
        if (wr == 1) PG8_BAR;
        PG8_WAIT_V(2); PG8_BAR;
        PG8_STAGE(PG8_SB(1, 0), cB + kstep, voffB); PG8_STAGE(PG8_SA(1, 0), cA + kstep, voffA); PG8_STAGE(PG8_SB(1, 1), cB + hstep + kstep, voffB);
        PG8_WAIT_V(6); PG8_BAR;
    } else {
        PG8_STAGE(PG8_SB(0, 0), cB, voffB); PG8_STAGE(PG8_SA(0, 0), cA, voffA); PG8_STAGE(PG8_SB(0, 1), cB + hstep, voffB); PG8_STAGE(PG8_SA(0, 1), cA + hstep, voffA);
        if (wr == 1) PG8_BAR;
        PG8_WAIT_V(4); PG8_BAR;
        PG8_STAGE(PG8_SB(1, 0), cB + kstep, voffB); PG8_STAGE(PG8_SA(1, 0), cA + kstep, voffA); PG8_STAGE(PG8_SB(1, 1), cB + hstep + kstep, voffB);
        PG8_WAIT_V(6); PG8_BAR;
    }
    for (;;) {
        const bool has_next = S.next(ui + 1, nxt);
        const char* nA = has_next ? (const char*)g.A + (size_t)nxt.pm * tstep : cA; const char* nB = has_next ? (const char*)g.Bt + (size_t)nxt.pn * tstep : cB;
        for (int t = 0; t < nt; t += 2) {
            const bool last = (t == nt - 2);
            const char* a1 = cA + (size_t)(t + 1) * kstep;
            const char* a2 = last ? nA : cA + (size_t)(t + 2) * kstep; const char* b2 = last ? nB : cB + (size_t)(t + 2) * kstep;
            const char* a3 = a2 + kstep; const char* b3 = b2 + kstep;
            if (last && has_next) S.a_ready(nxt);
            if constexpr (SP2) {
            PG8_LDB(B0, 0, 0); PG8_LDB(B1, 0, 1); PG8_SCHED; PG8_LDA(At, 0, 0); PG8_STAGE(PG8_SA(1, 1), a1 + hstep, voffA);
            PG8_WAIT_V(8); PG8_WAIT_L(0); PG8_BAR; PG8_MMA(0, 0, At, B0); PG8_MMA(0, 1, At, B1); PG8_BAR; PG8_SCHED;
            PG8_LDA(At, 0, 1); PG8_STAGE(PG8_SB(0, 0), b2, voffB); PG8_STAGE(PG8_SB(0, 1), b2 + hstep, voffB); PG8_STAGE(PG8_SA(0, 0), a2, voffA);
            PG8_WAIT_V(8); PG8_WAIT_L(0); PG8_BAR; PG8_MMA(1, 0, At, B0); PG8_MMA(1, 1, At, B1); PG8_BAR; PG8_SCHED;
            PG8_LDB(B0, 1, 0); PG8_LDB(B1, 1, 1); PG8_SCHED; PG8_LDA(At, 1, 0); PG8_STAGE(PG8_SA(0, 1), a2 + hstep, voffA);
            PG8_WAIT_V(8); PG8_WAIT_L(0); PG8_BAR; PG8_MMA(0, 0, At, B0); PG8_MMA(0, 1, At, B1); PG8_BAR; PG8_SCHED;
            PG8_LDA(At, 1, 1); PG8_STAGE(PG8_SB(1, 0), b3, voffB); PG8_STAGE(PG8_SB(1, 1), b3 + hstep, voffB); PG8_STAGE(PG8_SA(1, 0), a3, voffA);
            PG8_WAIT_V(8); PG8_WAIT_L(0); PG8_BAR; PG8_MMA(1, 0, At, B0); PG8_MMA(1, 1, At, B1); PG8_BAR; PG8_SCHED;
            } else {
            PG8_LDB(B0, 0, 0); PG8_SCHED; PG8_LDA(At, 0, 0); PG8_STAGE(PG8_SA(1, 1), a1 + hstep, voffA);
            PG8_WAIT_L(8); PG8_BAR; PG8_WAIT_L(0); PG8_MMA(0, 0, At, B0); PG8_BAR; PG8_SCHED;
            PG8_LDB(B1, 0, 1); PG8_STAGE(PG8_SB(0, 0), b2, voffB);
            PG8_BAR; PG8_WAIT_L(0); PG8_MMA(0, 1, At, B1); PG8_BAR;
            PG8_LDA(At, 0, 1); PG8_STAGE(PG8_SA(0, 0), a2, voffA);
            PG8_BAR; PG8_WAIT_L(0); PG8_MMA(1, 0, At, B0); PG8_BAR; PG8_SCHED;
            PG8_STAGE(PG8_SB(0, 1), b2 + hstep, voffB);
            PG8_WAIT_V(6); PG8_BAR; PG8_MMA(1, 1, At, B1); PG8_BAR;
            PG8_LDB(B0, 1, 0); PG8_SCHED; PG8_LDA(At, 1, 0); PG8_STAGE(PG8_SA(0, 1), a2 + hstep, voffA);
            PG8_WAIT_L(8); PG8_BAR; PG8_WAIT_L(0); PG8_MMA(0, 0, At, B0); PG8_BAR; PG8_SCHED;
            PG8_LDB(B1, 1, 1); PG8_STAGE(PG8_SB(1, 0), b3, voffB);
            PG8_BAR; PG8_WAIT_L(0); PG8_MMA(0, 1, At, B1); PG8_BAR;
            PG8_LDA(At, 1, 1); PG8_STAGE(PG8_SA(1, 0), a3, voffA);
            PG8_BAR; PG8_WAIT_L(0); PG8_MMA(1, 0, At, B0); PG8_BAR; PG8_SCHED;
            PG8_STAGE(PG8_SB(1, 1), b3 + hstep, voffB);
            PG8_WAIT_V(6); PG8_BAR; PG8_MMA(1, 1, At, B1); PG8_BAR;
            }
        }
        if constexpr (ALIGN_EPI) { if (wr == 0) PG8_BAR; }
        if constexpr (!Epi::AFTER_DRAIN) { E(acc, cur, wr, wc, fr, fq); S.done(cur); }
        if (!has_next) break;
#pragma unroll
        for (int a = 0; a < 2; ++a)
#pragma unroll
            for (int b = 0; b < 2; ++b)
#pragma unroll
                for (int m = 0; m < 4; ++m)
#pragma unroll
                    for (int n = 0; n < 2; ++n) acc[a][b][m][n] = (f32x4){0.f, 0.f, 0.f, 0.f};
        cur = nxt; cA = nA; cB = nB; ++ui;
        if constexpr (ALIGN_EPI) { if (wr == 1) PG8_BAR; }
    }
    PG8_WAIT_V(0);
    if constexpr (!ALIGN_EPI) { if (wr == 0) PG8_BAR; }
    PG8_BAR;
    if constexpr (Epi::AFTER_DRAIN) { E.fused(acc, cur, wr, wc, fr, fq, lds, wid, lane); S.done(cur); }
#undef PG8_SA
#undef PG8_SB
#undef PG8_STAGE
#undef PG8_LDA
#undef PG8_LDB
#undef PG8_MMA
#undef PG8_WAIT_V
#undef PG8_WAIT_L
#undef PG8_BAR
#undef PG8_SCHED
}
}
#define XB_TMO      128
#define XB_XCNT(j)  (256  + 64 * (j))
#define XB_XSUB(j)  (1280 + 64 * (j))
#define XB_XGEN(j)  (2304 + 64 * (j))
#define XB_TOP      3328
#define XB_TOPGEN   3392
#define XCD_BAR_WORDS 3456
#define XB_SPIN_CAP (1u << 18)

__device__ __forceinline__ unsigned xb_ld(unsigned* p)              { return __hip_atomic_load(p, __ATOMIC_RELAXED, __HIP_MEMORY_SCOPE_AGENT); }
__device__ __forceinline__ unsigned xb_add(unsigned* p, unsigned v) { return __hip_atomic_fetch_add(p, v, __ATOMIC_RELAXED, __HIP_MEMORY_SCOPE_AGENT); }
__device__ __forceinline__ unsigned xb_xcc_id() { return (unsigned)__builtin_amdgcn_s_getreg((3 << 11) | 20) & 0xFu; }
#define XB_SPIN(cond, bar) do { unsigned _sp = 0; while (cond) { __builtin_amdgcn_s_sleep(1); \
    if ((++_sp & 255u) == 0u) { if (xb_ld(&(bar)[XB_TMO])) break; if (_sp > XB_SPIN_CAP) { atomicAdd(&(bar)[XB_TMO], 1u); break; } } } } while (0)

struct XcdBarrier {
    unsigned* bar; unsigned x;
    volatile LAS unsigned* st;
};

__device__ __forceinline__ XcdBarrier xcd_barrier_post(unsigned* bar, volatile LAS unsigned* st) {
    XcdBarrier b; b.bar = bar; b.x = xb_xcc_id(); b.st = st;
    if (threadIdx.x == 0) (void)xb_add(&bar[XB_XCNT(b.x)], 1u);
    return b;
}
__device__ __forceinline__ void xcd_barrier_complete(unsigned* bar, unsigned x, unsigned& nloc, unsigned& nx) {
    const unsigned G = gridDim.x * gridDim.y * gridDim.z;
    unsigned sum, cnt, mine, sp = 0u;
    for (;;) {
        sum = 0u; cnt = 0u; mine = 0u;
#pragma unroll
        for (unsigned j = 0; j < 16; ++j) { const unsigned c = xb_ld(&bar[XB_XCNT(j)]); sum += c; cnt += (c > 0u) ? 1u : 0u; mine = (j == x) ? c : mine; }
        if (sum == G) break;
        __builtin_amdgcn_s_sleep(1);
        if ((++sp & 255u) == 0u) { if (xb_ld(&bar[XB_TMO])) break; if (sp > XB_SPIN_CAP) { atomicAdd(&bar[XB_TMO], 1u); break; } }
    }
    nloc = mine > 0u ? mine : 1u; nx = cnt > 0u ? cnt : 1u;
}

__device__ __forceinline__ void xcd_barrier(const XcdBarrier& b) {
    asm volatile("s_waitcnt vmcnt(0)" ::: "memory");
    __syncthreads();
    if (threadIdx.x == 0) {
        unsigned* bar = b.bar;
        __builtin_amdgcn_s_waitcnt(0);
        unsigned nloc = b.st[0], nx = b.st[1];
        if (nloc == 0u) { xcd_barrier_complete(bar, b.x, nloc, nx); b.st[0] = nloc; b.st[1] = nx; }
        const unsigned old = xb_add(&bar[XB_XSUB(b.x)], 1u);
        const unsigned gen = old / nloc;
        if (old + 1u == (gen + 1u) * nloc) {
            __builtin_amdgcn_fence(__ATOMIC_RELEASE, "agent");
            asm volatile("s_waitcnt vmcnt(0)" ::: "memory");
            const unsigned og = xb_add(&bar[XB_TOP], 1u);
            const unsigned tg = og / nx;
            if (og + 1u == (tg + 1u) * nx) xb_add(&bar[XB_TOPGEN], 1u);
            else XB_SPIN(xb_ld(&bar[XB_TOPGEN]) == tg, bar);
            __builtin_amdgcn_fence(__ATOMIC_ACQUIRE, "agent");
            xb_add(&bar[XB_XGEN(b.x)], 1u);
            asm volatile("s_waitcnt vmcnt(0)" ::: "memory");
        } else {
            XB_SPIN(xb_ld(&bar[XB_XGEN(b.x)]) == gen, bar);
            __builtin_amdgcn_fence(__ATOMIC_ACQUIRE, "agent");
            asm volatile("s_waitcnt vmcnt(0)" ::: "memory");
        }
    }
    __syncthreads();
}

constexpr int DM = 1024, NB = 4, SEQ = 4096, MTOK = NB * SEQ;
constexpr int QLORA = 384, KVLORA = 256, ROPE = 64, NOPE = 128, QKH = 192, VH = 128, NH = 8;
constexpr int MLA_IN = 704, MLA_IN_PAD = 768;
constexpr int NEXP = 16384;
constexpr float NORM_EPS = 1e-6f;
constexpr float U8_SCALE = 256.f, V8_SCALE = 16.f, H8_SCALE = 8.f;
constexpr float QSCALE = 0.07216878364870322f * 1.4426950408889634f;

#ifndef MK_N_LAUNCHES
#define MK_N_LAUNCHES 1
#endif
constexpr int NPHASES = 24;
#ifndef PHMASK
#define PHMASK 0xFFFFFFu
#endif
#define EN(k) (((PHMASK) >> (k)) & 1u)
#ifndef PROBE_PHASE
#define PROBE_PHASE -1
#endif
#ifndef PROBE_VAR
#define PROBE_VAR 0
#endif
#ifndef PROBE_REPS
#define PROBE_REPS 2
#endif
#define NREP(k) ((k) == (PROBE_PHASE) ? (PROBE_REPS) : 1)
constexpr int NWAVES = 8;

constexpr size_t MiB = 1u << 20;
constexpr size_t WS_CTL = 0, CTL_ZERO_BYTES = 64 * 1024;
constexpr size_t WS_MOD = 1 * MiB;
constexpr size_t WS_WCIN = 2 * MiB;
constexpr size_t WS_WCOUT = 8 * MiB;
constexpr size_t WS_WPQ0 = 10 * MiB, WS_WPQ1 = 14 * MiB;
constexpr size_t WS_WMIN = 18 * MiB;
constexpr size_t WS_WQB = 20 * MiB;
constexpr size_t WS_WKVB = 22 * MiB;
constexpr size_t WS_WMOUT = 24 * MiB;
constexpr size_t WS_SUBK = 26 * MiB;
constexpr size_t WS_PU = 32 * MiB;
constexpr size_t WS_PV = 96 * MiB;
constexpr size_t WS_XN = 160 * MiB;
constexpr size_t WS_VT = 160 * MiB;
constexpr size_t WS_BCV = 192 * MiB;
constexpr size_t WS_LAT = 192 * MiB;
constexpr size_t WS_O = 192 * MiB;
constexpr size_t WS_QN = 216 * MiB;
constexpr size_t WS_KVN = 228 * MiB;
constexpr size_t WS_QRAW = 236 * MiB;
constexpr size_t WS_Z = 288 * MiB;
constexpr size_t WS_KVRAW = 288 * MiB;
constexpr size_t WS_PQ = 288 * MiB;
constexpr size_t WS_QF = 352 * MiB;
constexpr size_t WS_KF = 400 * MiB;
constexpr size_t WS_IDS = 448 * MiB;
constexpr size_t WS_GATES = 456 * MiB;
constexpr size_t WS_PART = 192 * MiB;
constexpr size_t WS_DUMMY = 288 * MiB;
constexpr size_t WS_ACT = 464 * MiB;
constexpr size_t WS_XN8 = 472 * MiB;
constexpr size_t WS_END = 488 * MiB;
constexpr int CW_BAR = 1024;

constexpr int RING_BYTES = 131072;
constexpr int LDSCTL_OFF = RING_BYTES, MISC_OFF = LDSCTL_OFF + 320;
constexpr int LDS_BYTES = 147456;


typedef unsigned short bf16;
typedef unsigned u32x4 __attribute__((ext_vector_type(4)));
typedef unsigned u32x2 __attribute__((ext_vector_type(2)));
typedef float f32x4 __attribute__((ext_vector_type(4)));
typedef float f32x16 __attribute__((ext_vector_type(16)));
typedef short s16x8 __attribute__((ext_vector_type(8)));
typedef short s16x4 __attribute__((ext_vector_type(4)));
#define LDS_WAIT() asm volatile("s_waitcnt lgkmcnt(0)" ::: "memory")
#define VM_WAIT() asm volatile("s_waitcnt vmcnt(0)" ::: "memory")
#define DI __device__ __forceinline__

DI unsigned f2bf(float f) { unsigned u = __builtin_bit_cast(unsigned, f); return (u + 0x7fffu + ((u >> 16) & 1u)) >> 16; }
DI unsigned pk2(float lo, float hi) { return f2bf(lo) | (f2bf(hi) << 16); }
DI float bflo(unsigned u) { return __uint_as_float(u << 16); }
DI float bfhi(unsigned u) { return __uint_as_float(u & 0xffff0000u); }
DI float bf1(bf16 b) { return __uint_as_float((unsigned)b << 16); }
DI float wave_sum(float v) {
#pragma unroll
    for (int o = 32; o > 0; o >>= 1) v += __shfl_xor(v, o);
    return v;
}
DI int crow(int r, int hi) { return (r & 3) + 8 * (r >> 2) + 4 * hi; }

struct Args { const void* in[22]; float* out; unsigned char* ws; int ph_lo, ph_hi; };

DI void transpose_item(const float* W, int K, int N, bf16* WT, LAS float* scr, int item, int lane) {
    const int nblk = N / 32, kb = item / nblk, nb = item % nblk, k0 = 64 * kb, n0 = 32 * nb;
#pragma unroll 8
    for (int i = 0; i < 32; ++i) { const int kk = 2 * i + (lane >> 5); scr[kk * 33 + (lane & 31)] = W[(size_t)(k0 + kk) * N + n0 + (lane & 31)]; }
    LDS_WAIT(); asm volatile("" ::: "memory");
    const int c = lane & 7;
#pragma unroll
    for (int j = 0; j < 4; ++j) { const int n = (lane >> 3) + 8 * j; const LAS float* s = scr + (8 * c) * 33 + n;
        u32x4 o; o.x = pk2(s[0 * 33], s[1 * 33]); o.y = pk2(s[2 * 33], s[3 * 33]); o.z = pk2(s[4 * 33], s[5 * 33]); o.w = pk2(s[6 * 33], s[7 * 33]);
        *(u32x4*)(WT + (size_t)(n0 + n) * K + k0 + 8 * c) = o; }
    LDS_WAIT(); asm volatile("" ::: "memory");
}
DI void cvt_f32_bf16(const float* src, bf16* dst, size_t n8, size_t gt, size_t GT) {
#pragma unroll 4
    for (size_t i = gt; i < n8; i += GT) {
        const f32x4 a = ((const f32x4*)src)[2 * i], b = ((const f32x4*)src)[2 * i + 1];
        u32x4 o; o.x = pk2(a.x, a.y); o.y = pk2(a.z, a.w); o.z = pk2(b.x, b.y); o.w = pk2(b.z, b.w);
        ((u32x4*)dst)[i] = o; }
}

typedef float f32x2v __attribute__((ext_vector_type(2)));
DI unsigned pack4_fp8(float a, float b, float c, float d, float sc) {
    a = fminf(fmaxf(a * sc, -448.f), 448.f); b = fminf(fmaxf(b * sc, -448.f), 448.f); c = fminf(fmaxf(c * sc, -448.f), 448.f); d = fminf(fmaxf(d * sc, -448.f), 448.f);
    int w = __builtin_amdgcn_cvt_pk_fp8_f32(a, b, 0, false); w = __builtin_amdgcn_cvt_pk_fp8_f32(c, d, w, true); return (unsigned)w;
}
DI void cvt_tables_fp8(const float* u, const float* v, unsigned char* u8, unsigned char* v8, size_t gt, size_t GT) {
    const size_t n16 = (size_t)2 * NEXP * 1024 / 16;
#pragma unroll 2
    for (size_t i = gt; i < n16; i += GT) {
        const f32x4* s = (const f32x4*)(u + i * 16); const f32x4 a = s[0], b = s[1], c = s[2], d = s[3];
        u32x4 o; o.x = pack4_fp8(a.x, a.y, a.z, a.w, U8_SCALE); o.y = pack4_fp8(b.x, b.y, b.z, b.w, U8_SCALE); o.z = pack4_fp8(c.x, c.y, c.z, c.w, U8_SCALE); o.w = pack4_fp8(d.x, d.y, d.z, d.w, U8_SCALE);
        const size_t k = i & 63, row = i >> 6, e = row & (NEXP - 1), layer = row >> 14;
        *(u32x4*)(u8 + (((layer * 8 + (k >> 3)) * NEXP + e) * 128 + (k & 7) * 16)) = o; }
#pragma unroll 2
    for (size_t i = gt; i < n16; i += GT) {
        const f32x4* s = (const f32x4*)(v + i * 16); const f32x4 a = s[0], b = s[1], c = s[2], d = s[3];
        u32x4 o; o.x = pack4_fp8(a.x, a.y, a.z, a.w, V8_SCALE); o.y = pack4_fp8(b.x, b.y, b.z, b.w, V8_SCALE); o.z = pack4_fp8(c.x, c.y, c.z, c.w, V8_SCALE); o.w = pack4_fp8(d.x, d.y, d.z, d.w, V8_SCALE);
        const size_t k = i & 63, row = i >> 6, e = row & (NEXP - 1), layer = row >> 14;
        *(u32x4*)(v8 + (((layer * 8 + (k >> 3)) * NEXP + e) * 128 + (k & 7) * 16)) = o; }
}
DI void ph_prologue(const Args& a, LAS unsigned char* lds, int tid, int wave, int vcu, int G) {
    const int lane = tid & 63;
    {
        const float* c = (const float*)a.in[1]; const float* ada_w = (const float*)a.in[5]; const float* ada_b = (const float*)a.in[6];
        float* mod = (float*)(a.ws + WS_MOD);
        LAS float* cact = (LAS float*)lds; LAS float* red = cact + 4096;
        for (int it = blockIdx.x; it < 192; it += G) {
            const int i = it / 96, n0 = (it % 96) * 64;
            for (int e = tid; e < 4096; e += 512) { const float v = c[e]; cact[e] = v / (1.f + expf(-v)); }
            __syncthreads();
            const float* W = ada_w + (size_t)i * 1024 * 6144 + n0 + lane;
            float a0 = 0.f, a1 = 0.f, a2 = 0.f, a3 = 0.f;
            const int k0 = wave * 128;
#pragma unroll 8
            for (int k = k0; k < k0 + 128; ++k) { const float w = W[(size_t)k * 6144]; a0 += cact[k] * w; a1 += cact[1024 + k] * w; a2 += cact[2048 + k] * w; a3 += cact[3072 + k] * w; }
            red[(wave * 4 + 0) * 64 + lane] = a0; red[(wave * 4 + 1) * 64 + lane] = a1; red[(wave * 4 + 2) * 64 + lane] = a2; red[(wave * 4 + 3) * 64 + lane] = a3;
            __syncthreads();
            if (tid < 256) { const int b = tid >> 6; float s = 0.f;
#pragma unroll
                for (int w = 0; w < 8; ++w) s += red[(w * 4 + b) * 64 + lane];
                mod[(size_t)(i * 4 + b) * 6144 + n0 + lane] = s + ada_b[i * 6144 + n0 + lane]; }
            __syncthreads();
        }
    }
    {
        LAS float* scr = (LAS float*)(lds + 32768 + wave * 8704);
        const int gw = vcu * NWAVES + wave, NGW = G * NWAVES;
        unsigned char* ws = a.ws;
        constexpr int I_CIN = 16 * 96, I_COUT = 16 * 32, I_PQ = 16 * 64, I_MIN = 16 * 22, I_QB = 6 * 48, I_KVB = 4 * 64, I_MOUT = 16 * 32;
        constexpr int NITEMS = I_CIN + I_COUT + 2 * I_PQ + I_MIN + I_QB + I_KVB + I_MOUT;
        for (int it = gw; it < NITEMS; it += NGW) {
            int r = it;
            if (r < I_CIN) { transpose_item((const float*)a.in[7], 1024, 3072, (bf16*)(ws + WS_WCIN), scr, r, lane); continue; } r -= I_CIN;
            if (r < I_COUT) { transpose_item((const float*)a.in[9], 1024, 1024, (bf16*)(ws + WS_WCOUT), scr, r, lane); continue; } r -= I_COUT;
            if (r < I_PQ) { transpose_item((const float*)a.in[18], 1024, 2048, (bf16*)(ws + WS_WPQ0), scr, r, lane); continue; } r -= I_PQ;
            if (r < I_PQ) { transpose_item((const float*)a.in[18] + (size_t)1024 * 2048, 1024, 2048, (bf16*)(ws + WS_WPQ1), scr, r, lane); continue; } r -= I_PQ;
            if (r < I_MIN) { transpose_item((const float*)a.in[10], 1024, MLA_IN, (bf16*)(ws + WS_WMIN), scr, r, lane); continue; } r -= I_MIN;
            if (r < I_QB) { transpose_item((const float*)a.in[13], 384, 1536, (bf16*)(ws + WS_WQB), scr, r, lane); continue; } r -= I_QB;
            if (r < I_KVB) { transpose_item((const float*)a.in[14], 256, 2048, (bf16*)(ws + WS_WKVB), scr, r, lane); continue; } r -= I_KVB;
            transpose_item((const float*)a.in[17], 1024, 1024, (bf16*)(ws + WS_WMOUT), scr, r, lane);
        }
        const size_t gt = (size_t)vcu * 512 + tid, GT = (size_t)G * 512;
        for (size_t i = gt; i < (size_t)(MLA_IN_PAD - MLA_IN) * 1024 / 8; i += GT) ((u32x4*)(ws + WS_WMIN + (size_t)MLA_IN * 1024 * 2))[i] = (u32x4){0u, 0u, 0u, 0u};
        cvt_f32_bf16((const float*)a.in[19], (bf16*)(ws + WS_SUBK), (size_t)2 * 8 * 2 * 128 * 128 / 8, gt, GT);
        cvt_tables_fp8((const float*)a.in[20], (const float*)a.in[21], ws + WS_PU, ws + WS_PV, gt, GT);
    }
}

DI void ph_modulate(const float* x, bf16* xn, unsigned char* xn8  , const float* gain, const float* modl, int sh_off, int sc_off, int gw, int NGW, int lane) {
    for (int m = gw; m < MTOK; m += NGW) {
        const float* mb = modl + (size_t)(m >> 12) * 6144;
        const f32x4* xr = (const f32x4*)(x + (size_t)m * DM) + lane;
        f32x4 v[4]; float s = 0.f;
#pragma unroll
        for (int j = 0; j < 4; ++j) { v[j] = xr[64 * j]; s += (v[j].x * v[j].x + v[j].y * v[j].y) + (v[j].z * v[j].z + v[j].w * v[j].w); }
        const float rstd = rsqrtf(wave_sum(s) * (1.f / DM) + NORM_EPS);
        u32x2* o8 = (u32x2*)(xn + (size_t)m * DM) + lane;
#pragma unroll
        for (int j = 0; j < 4; ++j) {
            const f32x4 g = ((const f32x4*)gain)[lane + 64 * j], sh = ((const f32x4*)(mb + sh_off))[lane + 64 * j], sc = ((const f32x4*)(mb + sc_off))[lane + 64 * j];
            const f32x4 y = v[j] * rstd * g * (sc + 1.f) + sh;
            u32x2 w; w.x = pk2(y.x, y.y); w.y = pk2(y.z, y.w); o8[64 * j] = w;
            if (xn8) ((unsigned*)(xn8 + (size_t)m * DM))[lane + 64 * j] = pack4_fp8(y.x, y.y, y.z, y.w, H8_SCALE); }
    }
}

DI void ph_conv(const bf16* bcv, const float* cw, bf16* z, size_t gt, size_t GT) {
    for (size_t it = gt; it < (size_t)MTOK * 128; it += GT) {
        const int t = (int)(it >> 7), ch = (int)(it & 127) * 8, s = t & (SEQ - 1);
        const bf16* row = bcv + (size_t)t * 3072 + ch;
        const u32x4 zero = (u32x4){0u, 0u, 0u, 0u};
        const u32x4 bq = *(const u32x4*)row;
        const u32x4 c0 = *(const u32x4*)(row + 1024), v0 = *(const u32x4*)(row + 2048);
        const u32x4 c1 = s >= 1 ? *(const u32x4*)(row - 3072 + 1024) : zero, v1 = s >= 1 ? *(const u32x4*)(row - 3072 + 2048) : zero;
        const u32x4 c2 = s >= 2 ? *(const u32x4*)(row - 6144 + 1024) : zero, v2 = s >= 2 ? *(const u32x4*)(row - 6144 + 2048) : zero;
        const f32x4 w0a = *(const f32x4*)(cw + ch), w0b = *(const f32x4*)(cw + ch + 4);
        const f32x4 w1a = *(const f32x4*)(cw + 1024 + ch), w1b = *(const f32x4*)(cw + 1024 + ch + 4);
        const f32x4 w2a = *(const f32x4*)(cw + 2048 + ch), w2b = *(const f32x4*)(cw + 2048 + ch + 4);
        float r[8];
#pragma unroll
        for (int e = 0; e < 4; ++e) {
            const float w0l = e < 2 ? w0a[2 * e] : w0b[2 * e - 4], w0h = e < 2 ? w0a[2 * e + 1] : w0b[2 * e - 3];
            const float w1l = e < 2 ? w1a[2 * e] : w1b[2 * e - 4], w1h = e < 2 ? w1a[2 * e + 1] : w1b[2 * e - 3];
            const float w2l = e < 2 ? w2a[2 * e] : w2b[2 * e - 4], w2h = e < 2 ? w2a[2 * e + 1] : w2b[2 * e - 3];
            const float ut_l = bflo(c0[e]) * bflo(v0[e]), ut_h = bfhi(c0[e]) * bfhi(v0[e]);
            const float u1_l = bflo(c1[e]) * bflo(v1[e]), u1_h = bfhi(c1[e]) * bfhi(v1[e]);
            const float u2_l = bflo(c2[e]) * bflo(v2[e]), u2_h = bfhi(c2[e]) * bfhi(v2[e]);
            r[2 * e] = bflo(bq[e]) * (w0l * u2_l + w1l * u1_l + w2l * ut_l);
            r[2 * e + 1] = bfhi(bq[e]) * (w0h * u2_h + w1h * u1_h + w2h * ut_h);
        }
        u32x4 o; o.x = pk2(r[0], r[1]); o.y = pk2(r[2], r[3]); o.z = pk2(r[4], r[5]); o.w = pk2(r[6], r[7]);
        *(u32x4*)(z + (size_t)t * DM + ch) = o;
    }
}

struct EpiResGate {
    static constexpr bool PERM = false, AFTER_DRAIN = false;
    const float* base; float* out; const float* gate;
    __device__ __forceinline__ void operator()(const pg8::f32x4 (&acc)[2][2][4][2], const pg8::Unit& u, int wr, int wc, int fr, int fq) const {
        const int row0 = u.pm * 256 + wr * 64 + fr, col0 = u.pn * 256 + wc * 32 + 4 * fq;
        const float* gp = gate + (size_t)(u.pm >> 4) * 6144 + col0;
        pg8::f32x4 gv[2][2];
#pragma unroll
        for (int bj = 0; bj < 2; ++bj)
#pragma unroll
            for (int n = 0; n < 2; ++n) gv[bj][n] = *(const pg8::f32x4*)(gp + bj * 128 + n * 16);
#pragma unroll
        for (int ai = 0; ai < 2; ++ai)
#pragma unroll
            for (int m = 0; m < 4; ++m) { const size_t off = (size_t)(row0 + ai * 128 + m * 16) * DM + col0;
#pragma unroll
                for (int bj = 0; bj < 2; ++bj)
#pragma unroll
                    for (int n = 0; n < 2; ++n) { const pg8::f32x4 bs = *(const pg8::f32x4*)(base + off + bj * 128 + n * 16);
                        *(pg8::f32x4*)(out + off + bj * 128 + n * 16) = bs + gv[bj][n] * acc[ai][bj][m][n]; } }
    }
};

DI unsigned f2key(float f) { const unsigned u = __float_as_uint(f); return u ^ ((unsigned)((int)u >> 31) | 0x80000000u); }
DI float key2f(unsigned k) { const unsigned u = (k & 0x80000000u) ? (k ^ 0x80000000u) : ~k; return __uint_as_float(u); }
DI unsigned umax_(unsigned a, unsigned b) { return a > b ? a : b; }
DI unsigned umin_(unsigned a, unsigned b) { return a < b ? a : b; }
template <int N> DI void bitonic_sort_desc(unsigned (&v)[N]) {
#pragma unroll
    for (int k = 2; k <= N; k <<= 1) {
#pragma unroll
        for (int j = k >> 1; j > 0; j >>= 1) {
#pragma unroll
            for (int i = 0; i < N; ++i) { const int l = i ^ j;
                if (l > i) { const bool desc = ((i & k) == 0); const unsigned x = v[i], y = v[l], mx = umax_(x, y), mn = umin_(x, y); v[i] = desc ? mx : mn; v[l] = desc ? mn : mx; } }
        }
    }
}
template <int N> DI void bitonic_merge_desc(unsigned (&v)[N]) {
#pragma unroll
    for (int j = N >> 1; j > 0; j >>= 1) {
#pragma unroll
        for (int i = 0; i < N; ++i) { const int l = i ^ j;
            if (l > i) { const unsigned x = v[i], y = v[l]; v[i] = umax_(x, y); v[l] = umin_(x, y); } }
    }
}
DI void top16_merge(unsigned (&t)[16], unsigned (&n)[16]) {
#pragma unroll
    for (int i = 0; i < 16; ++i) t[i] = umax_(t[i], n[15 - i]);
    bitonic_merge_desc<16>(t);
}

DI void topk_task(const bf16* PQ, const bf16* SK  , unsigned short* IDS, float* GATES, LAS unsigned short* tab  , int tok0, int h, int lane) {
    const int r32 = lane & 31, hi = lane >> 5;
    s16x8 qf[16];
    const bf16* qp = PQ + (size_t)(tok0 + r32) * 2048 + 256 * h + 8 * hi;
#pragma unroll
    for (int ks = 0; ks < 16; ++ks) qf[ks] = *(const s16x8*)(qp + 16 * ks);
    const int p = (r32 >> 2) & 1, keyl = (r32 & 3) + 4 * (r32 >> 3);
    const bf16* kp0 = SK + ((size_t)(h * 2 + p) * 128 + keyl) * 128 + 8 * hi;
    const s16x8 zero8 = (s16x8){0, 0, 0, 0, 0, 0, 0, 0};
    unsigned top[16];
#pragma unroll
    for (int i = 0; i < 16; ++i) top[i] = 0u;
#pragma unroll 1
    for (int rb = 0; rb < 8; ++rb) {
        const bf16* kp = kp0 + (size_t)rb * 16 * 128;
        f32x16 acc;
#pragma unroll
        for (int r = 0; r < 16; ++r) acc[r] = 0.f;
#pragma unroll
        for (int ks = 0; ks < 8; ++ks) {
            const s16x8 kf = *(const s16x8*)(kp + 16 * ks);
            const s16x8 a0 = p == 0 ? kf : zero8, a1 = p == 1 ? kf : zero8;
            acc = __builtin_amdgcn_mfma_f32_32x32x16_bf16(a0, qf[ks], acc, 0, 0, 0);
            acc = __builtin_amdgcn_mfma_f32_32x32x16_bf16(a1, qf[ks + 8], acc, 0, 0, 0);
        }
        unsigned nw[16];
#pragma unroll
        for (int r = 0; r < 16; ++r) nw[r] = (f2key(acc[r]) & ~127u) | (unsigned)(127 - (16 * rb + r));
        bitonic_sort_desc<16>(nw);
        top16_merge(top, nw);
    }
    unsigned LA[16], LB[16];
#pragma unroll
    for (int i = 0; i < 16; ++i) { const unsigned other = (unsigned)__shfl_xor((int)top[i], 32); LA[i] = hi ? other : top[i]; LB[i] = hi ? top[i] : other; }
#pragma unroll
    for (int i = 0; i < 16; ++i) { tab[i * 64 + lane] = (unsigned short)(127u - (LA[i] & 127u)); tab[(16 + i) * 64 + lane] = (unsigned short)(127u - (LB[i] & 127u)); }
    float av[16], bv[16];
#pragma unroll
    for (int i = 0; i < 16; ++i) { av[i] = key2f(LA[i] & ~127u); bv[i] = key2f(LB[i] & ~127u); }
    unsigned cg[4][16];
#pragma unroll
    for (int g = 0; g < 4; ++g)
#pragma unroll
        for (int e = 0; e < 16; ++e) cg[g][e] = 0u;
    {
        int cnt = 0;
#pragma unroll
        for (int i = 0; i < 16; ++i)
#pragma unroll
            for (int j = 0; j < 16; ++j)
                if ((i + 1) * (j + 1) <= 16) { cg[cnt >> 4][cnt & 15] = (f2key(av[i] + bv[j]) & ~255u) | (unsigned)(255 - (16 * i + j)); ++cnt; }
    }
    bitonic_sort_desc<16>(cg[0]); bitonic_sort_desc<16>(cg[1]); bitonic_sort_desc<16>(cg[2]); bitonic_sort_desc<16>(cg[3]);
    top16_merge(cg[0], cg[1]); top16_merge(cg[0], cg[2]); top16_merge(cg[0], cg[3]);
    LDS_WAIT(); asm volatile("" ::: "memory");
    float sv[16]; int ex[16];
#pragma unroll
    for (int k = 0; k < 16; ++k) { const unsigned key = cg[0][k]; const int pos = 255 - (int)(key & 255u); sv[k] = key2f(key & ~255u);
        const int ia = tab[(pos >> 4) * 64 + lane], ib = tab[(16 + (pos & 15)) * 64 + lane]; ex[k] = ia * 128 + ib; }
    LDS_WAIT(); asm volatile("" ::: "memory");
    const float mx = sv[0]; float sum = 0.f;
#pragma unroll
    for (int k = 0; k < 16; ++k) { sv[k] = expf(sv[k] - mx); sum += sv[k]; }
    const float inv = 1.f / sum;
    if (hi == 0) {
        unsigned short* ip = IDS + (size_t)(tok0 + r32) * 128 + h * 16; float* gp = GATES + (size_t)(tok0 + r32) * 128 + h * 16;
#pragma unroll
        for (int k = 0; k < 16; k += 8) *(u32x4*)(ip + k) = (u32x4){(unsigned)ex[k] | ((unsigned)ex[k + 1] << 16), (unsigned)ex[k + 2] | ((unsigned)ex[k + 3] << 16), (unsigned)ex[k + 4] | ((unsigned)ex[k + 5] << 16), (unsigned)ex[k + 6] | ((unsigned)ex[k + 7] << 16)};
#pragma unroll
        for (int k = 0; k < 16; k += 4) *(f32x4*)(gp + k) = (f32x4){sv[k] * inv, sv[k + 1] * inv, sv[k + 2] * inv, sv[k + 3] * inv};
    }
}
DI void ph_topk(const bf16* PQ, const bf16* SK, unsigned short* IDS, float* GATES, LAS unsigned char* lds, int gw, int NGW, int wave, int lane) {
    LAS unsigned short* tab = (LAS unsigned short*)(lds + wave * 4096);
    for (int task = gw; task < (MTOK / 32) * 8; task += NGW) topk_task(PQ, SK, IDS, GATES, tab, (task >> 3) * 32, task & 7, lane);
}

DI float gelu_erf(float x) { return 0.5f * x * (1.f + erff(x * 0.70710678118654752f)); }
DI float dot16_fp8(const u32x4& w, const float (&h)[16]) {
    float d0 = 0.f, d1 = 0.f;
#pragma unroll
    for (int e = 0; e < 4; ++e) { const f32x2v lo = __builtin_amdgcn_cvt_pk_f32_fp8((int)w[e], false), hi = __builtin_amdgcn_cvt_pk_f32_fp8((int)w[e], true);
        d0 += lo.x * h[4 * e] + lo.y * h[4 * e + 1]; d1 += hi.x * h[4 * e + 2] + hi.y * h[4 * e + 3]; }
    return d0 + d1;
}
DI float gelu_fast(float v) {
    const float av = fabsf(v), d = av * 0.2316418882f + 1.0f, t = __builtin_amdgcn_rcpf(d);
    float q = t * 0.5307027145f + (-0.7265760135f); q = q * t + 0.7107068705f; q = q * t + (-0.142248368f); q = q * t + 0.127414796f; q = q * t;
    const float e = __builtin_amdgcn_exp2f((v * v) * (-0.72134752044f)), mm = v * (q * e);
    return v < 0.f ? mm : v - mm;
}
DI long lo64(const u32x4& w) { return (long)(((unsigned long long)w.y << 32) | w.x); }
DI long hi64(const u32x4& w) { return (long)(((unsigned long long)w.w << 32) | w.z); }
typedef __amdgpu_buffer_rsrc_t brsrc_t;
DI brsrc_t mkrsrc(const void* p, unsigned bytes) { return __builtin_amdgcn_make_buffer_rsrc((void*)p, 0, (int)bytes, 0x00020000); }
DI u32x4 bl128(brsrc_t r, unsigned voff, unsigned soff) { return __builtin_amdgcn_raw_buffer_load_b128(r, (int)voff, (int)soff, 0); }
DI u32x2 bl64(brsrc_t r, unsigned voff, unsigned soff) { return __builtin_amdgcn_raw_buffer_load_b64(r, (int)voff, (int)soff, 0); }
DI void bs64(brsrc_t r, u32x2 v, unsigned voff, unsigned soff) { __builtin_amdgcn_raw_buffer_store_b64(v, r, (int)voff, (int)soff, 0); }
DI f32x4 asf4(u32x4 v) { return __builtin_bit_cast(f32x4, v); }
template <int VAR> DI void ph_peer_u(const unsigned char* U8s, const unsigned short* IDS, const bf16* XN, float* PART, int bx, int G, int wave, int lane) {
    const int x = bx & 7, rank = bx >> 3, nslots = ((G - x + 7) >> 3) * 8;
    const int grp = lane >> 3, c = lane & 7;
    const bool b2 = (lane & 4) != 0, b1 = (lane & 2) != 0, b0 = (lane & 1) != 0;
    const unsigned char* Ux = U8s + (size_t)x * NEXP * 128;
    const unsigned coff = 16u * (unsigned)c;
    const unsigned hoff = (unsigned)(128 * x + 16 * c) * 2u, ioff = 32u * (unsigned)grp;
    const brsrc_t ids_r = mkrsrc(IDS, MTOK * 128 * 2), xn_r = mkrsrc(XN, MTOK * DM * 2), part_r = mkrsrc(PART + (size_t)x * MTOK * 128, MTOK * 128 * 4); const unsigned poff = (unsigned)(16 * grp + 8 * (int)b2 + 4 * (int)b1 + 2 * (int)b0) * 4u;
    int t = rank * 8 + wave;
    u32x4 ev0[2], ev1[2]; u32x4 ha0, hb0;
    { const int ta = t < MTOK ? t : MTOK - 1, tb = t + nslots < MTOK ? t + nslots : MTOK - 1;
#pragma unroll
      for (int q = 0; q < 2; ++q) { ev0[q] = bl128(ids_r, ioff + 16 * q, ta * 256); ev1[q] = bl128(ids_r, ioff + 16 * q, tb * 256); }
      ha0 = bl128(xn_r, hoff, ta * 2048); hb0 = bl128(xn_r, hoff + 16, ta * 2048); }
#pragma unroll 1
    for (; t < MTOK; t += nslots) {
        u32x4 a[16];
#pragma unroll
        for (int it = 0; it < 16; ++it) { const unsigned ew = ev0[it >> 3][(it >> 1) & 3], e = (it & 1) ? (ew >> 16) : (ew & 0xffffu);
            if (VAR == 1) a[it] = (u32x4){e, coff, 0x38383838u, 0x40404040u}; else a[it] = *(const u32x4*)(Ux + (e * 128u + coff)); }
        u32x4 ev2[2]; u32x4 ha1, hb1;
        { const int t2 = t + 2 * nslots, tc = t2 < MTOK ? t2 : t, t1 = t + nslots, td = t1 < MTOK ? t1 : t;
#pragma unroll
          for (int q = 0; q < 2; ++q) ev2[q] = bl128(ids_r, ioff + 16 * q, tc * 256);
          ha1 = bl128(xn_r, hoff, td * 2048); hb1 = bl128(xn_r, hoff + 16, td * 2048); }
        __builtin_amdgcn_sched_barrier(0);
        float h[16];
#pragma unroll
        for (int e = 0; e < 4; ++e) { h[2 * e] = bflo(ha0[e]); h[2 * e + 1] = bfhi(ha0[e]); h[8 + 2 * e] = bflo(hb0[e]); h[8 + 2 * e + 1] = bfhi(hb0[e]); }
        float p[16];
#pragma unroll
        for (int it = 0; it < 16; ++it) {
            float d0 = 0.f, d1 = 0.f;
#pragma unroll
            for (int e = 0; e < 4; ++e) { const f32x2v lo = __builtin_amdgcn_cvt_pk_f32_fp8((int)a[it][e], false), hi = __builtin_amdgcn_cvt_pk_f32_fp8((int)a[it][e], true);
                d0 = fmaf(lo.x, h[4 * e], d0); d1 = fmaf(lo.y, h[4 * e + 1], d1); d0 = fmaf(hi.x, h[4 * e + 2], d0); d1 = fmaf(hi.y, h[4 * e + 3], d1); }
            p[it] = d0 + d1;
            __builtin_amdgcn_sched_barrier(0);
        }
        float v8[8], v4[4], v2[2];
#pragma unroll
        for (int i = 0; i < 8; ++i) { const float keep = b2 ? p[i + 8] : p[i], give = b2 ? p[i] : p[i + 8]; v8[i] = keep + __shfl_xor(give, 4); }
#pragma unroll
        for (int i = 0; i < 4; ++i) { const float keep = b1 ? v8[i + 4] : v8[i], give = b1 ? v8[i] : v8[i + 4]; v4[i] = keep + __shfl_xor(give, 2); }
#pragma unroll
        for (int i = 0; i < 2; ++i) { const float keep = b0 ? v4[i + 2] : v4[i], give = b0 ? v4[i] : v4[i + 2]; v2[i] = keep + __shfl_xor(give, 1); }
        bs64(part_r, (u32x2){__float_as_uint(v2[0]), __float_as_uint(v2[1])}, poff, t * 512);
#pragma unroll
        for (int q = 0; q < 2; ++q) { ev0[q] = ev1[q]; ev1[q] = ev2[q]; }
        ha0 = ha1; hb0 = hb1;
    }
}
DI void ph_peer_c(const float* PART, const float* GATES, float* ACT, int gw, int NGW, int lane) {
    const float inv = 1.f / U8_SCALE;
    for (int t = gw; t < MTOK; t += NGW) {
        float s0 = 0.f, s1 = 0.f;
#pragma unroll
        for (int xx = 0; xx < 8; ++xx) { const float* p = PART + ((size_t)xx * MTOK + t) * 128; s0 += p[lane]; s1 += p[64 + lane]; }
        const float g0 = GATES[(size_t)t * 128 + lane], g1 = GATES[(size_t)t * 128 + 64 + lane];
        ACT[(size_t)t * 128 + lane] = gelu_fast(s0 * inv) * g0; ACT[(size_t)t * 128 + 64 + lane] = gelu_fast(s1 * inv) * g1;
    }
}
DI void ph_peer_v(const unsigned char* V8  , const unsigned short* IDS, const float* ACT, const float* Xin, float* Xout, const float* g2, int bx, int G, int wave, int lane) {
    const int x = bx & 7, rank = bx >> 3, nslots = ((G - x + 7) >> 3) * 8;
    const bool b5 = (lane & 32) != 0, b4 = (lane & 16) != 0, b3 = (lane & 8) != 0;
    const int grp = lane >> 3;
    const unsigned char* Vx = V8 + (size_t)x * NEXP * 128;
    const unsigned coff = 16u * (unsigned)(lane & 7);
    const int dim = 128 * x + 16 * (lane & 7) + 2 * grp;
    const unsigned ioff = 32u * (unsigned)grp, aoffb = 64u * (unsigned)grp, xoff = 4u * (unsigned)dim;
    const brsrc_t ids_r = mkrsrc(IDS, MTOK * 128 * 2), act_r = mkrsrc(ACT, MTOK * 128 * 4), xin_r = mkrsrc(Xin, MTOK * DM * 4), xout_r = mkrsrc(Xout, MTOK * DM * 4), g2_r = mkrsrc(g2, 4 * 6144 * 4);
    int t = rank * 8 + wave;
    u32x4 ev0[2], ev1[2]; u32x4 av0[4]; u32x2 xv0;
    { const int ta = t < MTOK ? t : MTOK - 1, tb = t + nslots < MTOK ? t + nslots : MTOK - 1;
#pragma unroll
      for (int q = 0; q < 2; ++q) { ev0[q] = bl128(ids_r, ioff + 16 * q, ta * 256); ev1[q] = bl128(ids_r, ioff + 16 * q, tb * 256); }
#pragma unroll
      for (int q = 0; q < 4; ++q) av0[q] = bl128(act_r, aoffb + 16 * q, ta * 512);
      xv0 = bl64(xin_r, xoff, ta * 4096); }
#pragma unroll 1
    for (; t < MTOK; t += nslots) {
        u32x4 v[16];
#pragma unroll
        for (int it = 0; it < 16; ++it) { const unsigned ew = ev0[it >> 3][(it >> 1) & 3], e = (it & 1) ? (ew >> 16) : (ew & 0xffffu);
            v[it] = *(const u32x4*)(Vx + (e * 128u + coff)); }
        u32x4 ev2[2]; u32x4 av1[4]; u32x2 xv1;
        { const int t2 = t + 2 * nslots, tc = t2 < MTOK ? t2 : t, t1 = t + nslots, td = t1 < MTOK ? t1 : t;
#pragma unroll
          for (int q = 0; q < 2; ++q) ev2[q] = bl128(ids_r, ioff + 16 * q, tc * 256);
#pragma unroll
          for (int q = 0; q < 4; ++q) av1[q] = bl128(act_r, aoffb + 16 * q, td * 512);
          xv1 = bl64(xin_r, xoff, td * 4096); }
        __builtin_amdgcn_sched_barrier(0);
        float acc[16];
#pragma unroll
        for (int i = 0; i < 16; ++i) acc[i] = 0.f;
#pragma unroll
        for (int it = 0; it < 16; ++it) {
            const float aw = __uint_as_float(av0[it >> 2][it & 3]);
#pragma unroll
            for (int e = 0; e < 4; ++e) { const f32x2v lo = __builtin_amdgcn_cvt_pk_f32_fp8((int)v[it][e], false), hi = __builtin_amdgcn_cvt_pk_f32_fp8((int)v[it][e], true);
                acc[4 * e] = fmaf(aw, lo.x, acc[4 * e]); acc[4 * e + 1] = fmaf(aw, lo.y, acc[4 * e + 1]); acc[4 * e + 2] = fmaf(aw, hi.x, acc[4 * e + 2]); acc[4 * e + 3] = fmaf(aw, hi.y, acc[4 * e + 3]); }
            __builtin_amdgcn_sched_barrier(0);
        }
        float v8[8], v4[4], v2[2];
#pragma unroll
        for (int i = 0; i < 8; ++i) { const float keep = b5 ? acc[i + 8] : acc[i], give = b5 ? acc[i] : acc[i + 8]; v8[i] = keep + __shfl_xor(give, 32); }
#pragma unroll
        for (int i = 0; i < 4; ++i) { const float keep = b4 ? v8[i + 4] : v8[i], give = b4 ? v8[i] : v8[i + 4]; v4[i] = keep + __shfl_xor(give, 16); }
#pragma unroll
        for (int i = 0; i < 2; ++i) { const float keep = b3 ? v4[i + 2] : v4[i], give = b3 ? v4[i] : v4[i + 2]; v2[i] = keep + __shfl_xor(give, 8); }
        const u32x2 gg = bl64(g2_r, xoff, (t >> 12) * (6144 * 4));
        u32x2 xo; xo.x = __float_as_uint(__uint_as_float(xv0.x) + __uint_as_float(gg.x) * v2[0] * (1.f / V8_SCALE)); xo.y = __float_as_uint(__uint_as_float(xv0.y) + __uint_as_float(gg.y) * v2[1] * (1.f / V8_SCALE));
        bs64(xout_r, xo, xoff, t * 4096);
#pragma unroll
        for (int q = 0; q < 2; ++q) { ev0[q] = ev1[q]; ev1[q] = ev2[q]; }
#pragma unroll
        for (int q = 0; q < 4; ++q) av0[q] = av1[q];
        xv0 = xv1;
    }
}

DI void ph_latnorm(const bf16* LAT, const float* qg, const float* kvg, bf16* QN, bf16* KVN, int gw, int NGW, int lane) {
    for (int t = gw; t < MTOK; t += NGW) {
        const unsigned* lr = (const unsigned*)(LAT + (size_t)t * MLA_IN_PAD);
        unsigned q[3], k[2]; float sq = 0.f, sk = 0.f;
#pragma unroll
        for (int j = 0; j < 3; ++j) { q[j] = lr[lane + 64 * j]; sq += bflo(q[j]) * bflo(q[j]) + bfhi(q[j]) * bfhi(q[j]); }
#pragma unroll
        for (int j = 0; j < 2; ++j) { k[j] = lr[192 + lane + 64 * j]; sk += bflo(k[j]) * bflo(k[j]) + bfhi(k[j]) * bfhi(k[j]); }
        const float rq = rsqrtf(wave_sum(sq) * (1.f / QLORA) + NORM_EPS), rk = rsqrtf(wave_sum(sk) * (1.f / KVLORA) + NORM_EPS);
        unsigned* qo = (unsigned*)(QN + (size_t)t * QLORA); unsigned* ko = (unsigned*)(KVN + (size_t)t * KVLORA);
#pragma unroll
        for (int j = 0; j < 3; ++j) { const int c = 2 * (lane + 64 * j); qo[lane + 64 * j] = pk2(bflo(q[j]) * rq * qg[c], bfhi(q[j]) * rq * qg[c + 1]); }
#pragma unroll
        for (int j = 0; j < 2; ++j) { const int c = 2 * (lane + 64 * j); ko[lane + 64 * j] = pk2(bflo(k[j]) * rk * kvg[c], bfhi(k[j]) * rk * kvg[c + 1]); }
    }
}

DI void ph_qkprep(const bf16* QRAW, const bf16* KVRAW, const bf16* LAT, const int* positions, const float* qg, const float* kg,
                  bf16* Qf, bf16* Kf, bf16* Vt, int gw, int NGW, int lane) {
    const int f = lane & 31;
    const float invf = exp2f(-(float)f * (13.287712379549449f / 32.f));
    const float qg0 = qg[lane], qg1 = qg[64 + lane], qg2 = qg[128 + lane], kg0 = kg[lane], kg1 = kg[64 + lane], kg2 = kg[128 + lane];
    for (int task = gw; task < MTOK / 8; task += NGW) {
        const int t0 = task * 8, b = t0 >> 12, s0 = t0 & (SEQ - 1);
#pragma unroll 1
        for (int tt = 0; tt < 8; ++tt) {
            const int t = t0 + tt, s = s0 + tt;
            const float ang = (float)positions[t] * invf;
            double rev = (double)ang * 0.15915494309189535; rev -= floor(rev);
            const float rv = (float)rev, sn = __builtin_amdgcn_sinf(rv), cs = __builtin_amdgcn_cosf(rv);
            const float kr = bf1(LAT[(size_t)t * MLA_IN_PAD + 640 + lane]);
#pragma unroll 1
            for (int h = 0; h < NH; ++h) {
                { const bf16* qp = QRAW + (size_t)t * 1536 + QKH * h;
                  const float x0 = bf1(qp[lane]), x1 = bf1(qp[64 + lane]), x2 = bf1(qp[128 + lane]);
                  const float rstd = rsqrtf(wave_sum(x0 * x0 + x1 * x1 + x2 * x2) * (1.f / QKH) + NORM_EPS);
                  const float y0 = x0 * rstd * qg0, y1 = x1 * rstd * qg1, y2 = x2 * rstd * qg2, pr = __shfl_xor(y2, 32);
                  const float r2 = lane < 32 ? y2 * cs - pr * sn : pr * sn + y2 * cs;
                  bf16* o = Qf + ((size_t)(b * NH + h) * SEQ + s) * QKH;
                  o[lane] = (bf16)f2bf(y0 * QSCALE); o[64 + lane] = (bf16)f2bf(y1 * QSCALE); o[128 + lane] = (bf16)f2bf(r2 * QSCALE); }
                { const bf16* kp = KVRAW + (size_t)t * 2048 + 256 * h;
                  const float x0 = bf1(kp[lane]), x1 = bf1(kp[64 + lane]), x2 = kr;
                  const float rstd = rsqrtf(wave_sum(x0 * x0 + x1 * x1 + x2 * x2) * (1.f / QKH) + NORM_EPS);
                  const float y0 = x0 * rstd * kg0, y1 = x1 * rstd * kg1, y2 = x2 * rstd * kg2, pr = __shfl_xor(y2, 32);
                  const float r2 = lane < 32 ? y2 * cs - pr * sn : pr * sn + y2 * cs;
                  bf16* o = Kf + ((size_t)(b * NH + h) * SEQ + s) * QKH;
                  o[lane] = (bf16)f2bf(y0); o[64 + lane] = (bf16)f2bf(y1); o[128 + lane] = (bf16)f2bf(r2); }
            }
        }
#pragma unroll 1
        for (int h = 0; h < NH; ++h)
#pragma unroll
            for (int dd = 0; dd < 128; dd += 64) {
                const bf16* vp = KVRAW + (size_t)t0 * 2048 + 256 * h + 128 + dd + lane;
                unsigned w[4];
#pragma unroll
                for (int i = 0; i < 4; ++i) w[i] = (unsigned)vp[(size_t)(2 * i) * 2048] | ((unsigned)vp[(size_t)(2 * i + 1) * 2048] << 16);
                *(u32x4*)(Vt + ((size_t)(b * NH + h) * VH + dd + lane) * SEQ + s0) = (u32x4){w[0], w[1], w[2], w[3]};
            }
    }
}

typedef float f32x2_t __attribute__((ext_vector_type(2))); typedef __bf16 bf16x2_t __attribute__((ext_vector_type(2)));
DI unsigned cvtpk(float lo, float hi) { f32x2_t v = {lo, hi}; bf16x2_t b = __builtin_convertvector(v, bf16x2_t); return __builtin_bit_cast(unsigned, b); }
DI void attn_unit(const bf16* Qf, const bf16* Kf, const bf16* Vt, bf16* O, int bh, int qb, int wave, int lane) {
    const int r32 = lane & 31, hi = lane >> 5;
    const int q0 = qb * 256 + wave * 32;
    s16x8 qf[12];
    { const bf16* Qp = Qf + ((size_t)bh * SEQ + q0 + r32) * QKH + 8 * hi;
#pragma unroll
      for (int ks = 0; ks < 12; ++ks) qf[ks] = *(const s16x8*)(Qp + 16 * ks); }
    f32x16 o[4];
#pragma unroll
    for (int d = 0; d < 4; ++d)
#pragma unroll
        for (int r = 0; r < 16; ++r) o[d][r] = 0.f;
    float m = -1e30f, l = 0.f;
    const bf16* Kp = Kf + ((size_t)bh * SEQ + r32) * QKH + 8 * hi;
    const bf16* Vp = Vt + ((size_t)bh * VH + r32) * SEQ + 4 * hi;
    const int nkt = q0 / 32 + 1;
#pragma unroll 1
    for (int kt = 0; kt < nkt; ++kt) {
        f32x16 sc;
#pragma unroll
        for (int r = 0; r < 16; ++r) sc[r] = 0.f;
        const bf16* kp = Kp + (size_t)kt * 32 * QKH;
#pragma unroll
        for (int ks = 0; ks < 12; ++ks) sc = __builtin_amdgcn_mfma_f32_32x32x16_bf16(*(const s16x8*)(kp + 16 * ks), qf[ks], sc, 0, 0, 0);
        if (kt == nkt - 1) {
#pragma unroll
            for (int r = 0; r < 16; ++r) if (crow(r, hi) > r32) sc[r] = -INFINITY;
        }
        float mt = sc[0];
#pragma unroll
        for (int r = 1; r < 16; ++r) mt = fmaxf(mt, sc[r]);
        mt = fmaxf(mt, __shfl_xor(mt, 32));
        const float mn = fmaxf(m, mt), alpha = __builtin_amdgcn_exp2f(m - mn);
        m = mn; l *= alpha;
#pragma unroll
        for (int d = 0; d < 4; ++d)
#pragma unroll
            for (int r = 0; r < 16; ++r) o[d][r] *= alpha;
        float ps = 0.f;
#pragma unroll
        for (int r = 0; r < 16; ++r) { sc[r] = __builtin_amdgcn_exp2f(sc[r] - mn); ps += sc[r]; }
        l += ps;
#pragma unroll
        for (int s = 0; s < 2; ++s) {
            u32x4 pw; pw.x = cvtpk(sc[8 * s], sc[8 * s + 1]); pw.y = cvtpk(sc[8 * s + 2], sc[8 * s + 3]); pw.z = cvtpk(sc[8 * s + 4], sc[8 * s + 5]); pw.w = cvtpk(sc[8 * s + 6], sc[8 * s + 7]);
            const s16x8 pb = __builtin_bit_cast(s16x8, pw);
#pragma unroll
            for (int d = 0; d < 4; ++d) {
                const bf16* vp = Vp + (size_t)d * 32 * SEQ + kt * 32 + 16 * s;
                const s16x4 lo = *(const s16x4*)vp, hh = *(const s16x4*)(vp + 8);
                const s16x8 va = __builtin_shufflevector(lo, hh, 0, 1, 2, 3, 4, 5, 6, 7);
                o[d] = __builtin_amdgcn_mfma_f32_32x32x16_bf16(va, pb, o[d], 0, 0, 0);
            }
        }
    }
    l += __shfl_xor(l, 32);
    const float inv = 1.f / l;
    bf16* Op = O + ((size_t)((bh >> 3) * SEQ + q0 + r32)) * DM + (bh & 7) * VH + 4 * hi;
#pragma unroll
    for (int d = 0; d < 4; ++d)
#pragma unroll
        for (int g = 0; g < 4; ++g) { u32x2 w; w.x = cvtpk(o[d][4 * g] * inv, o[d][4 * g + 1] * inv); w.y = cvtpk(o[d][4 * g + 2] * inv, o[d][4 * g + 3] * inv);
            *(u32x2*)(Op + 32 * d + 8 * g) = w; }
}
constexpr int AT_KROW = 400, AT_VROW = 136, AT_KBYTES = 64 * AT_KROW, AT_VBYTES = 128 * AT_VROW, AT_STAGE = AT_KBYTES + AT_VBYTES;
DI void attn_unit_lds(const bf16* Qf, const bf16* Kf, const bf16* Vt, bf16* O, LAS unsigned char* lds, int bh, int qb, int wave, int lane) {
    const int r32 = lane & 31, hi = lane >> 5, tid = wave * 64 + lane;
    const int q0 = qb * 256 + wave * 32;
    s16x8 qf[12];
    { const bf16* Qp = Qf + ((size_t)bh * SEQ + q0 + r32) * QKH + 8 * hi;
#pragma unroll
      for (int ks = 0; ks < 12; ++ks) qf[ks] = *(const s16x8*)(Qp + 16 * ks); }
    f32x16 o[4];
#pragma unroll
    for (int d = 0; d < 4; ++d)
#pragma unroll
        for (int r = 0; r < 16; ++r) o[d][r] = 0.f;
    float m = -1e30f, l = 0.f;
    const int NT = 4 * (qb + 1);
    const __amdgpu_buffer_rsrc_t krs = __builtin_amdgcn_make_buffer_rsrc((void*)(Kf + (size_t)bh * SEQ * QKH), 0, SEQ * QKH * 2, 0x00020000);
    const __amdgpu_buffer_rsrc_t vrs = __builtin_amdgcn_make_buffer_rsrc((void*)(Vt + (size_t)bh * VH * SEQ), 0, VH * SEQ * 2, 0x00020000);
    unsigned kgo[3], kl[3], vgo[2], vl[2];
#pragma unroll
    for (int i = 0; i < 3; ++i) { const int c = tid + 512 * i, row = c / 24, col = c - row * 24; kgo[i] = (unsigned)(row * 384 + col * 16); kl[i] = (unsigned)(row * AT_KROW + col * 16); }
#pragma unroll
    for (int i = 0; i < 2; ++i) { const int c = tid + 512 * i, d = c >> 3, part = c & 7; vgo[i] = (unsigned)(d * (SEQ * 2) + part * 16); vl[i] = (unsigned)(AT_KBYTES + d * AT_VROW + part * 16); }
    u32x4 kr[3], vr[2];
#pragma unroll
    for (int i = 0; i < 3; ++i) kr[i] = __builtin_amdgcn_raw_buffer_load_b128(krs, kgo[i], 0, 0);
#pragma unroll
    for (int i = 0; i < 2; ++i) vr[i] = __builtin_amdgcn_raw_buffer_load_b128(vrs, vgo[i], 0, 0);
#pragma unroll
    for (int i = 0; i < 3; ++i) *(LAS u32x4*)(lds + kl[i]) = kr[i];
#pragma unroll
    for (int i = 0; i < 2; ++i) { *(LAS u32x2*)(lds + vl[i]) = (u32x2){vr[i].x, vr[i].y}; *(LAS u32x2*)(lds + vl[i] + 8) = (u32x2){vr[i].z, vr[i].w}; }
    __syncthreads();
    const unsigned kfo = (unsigned)(r32 * AT_KROW + 16 * hi), vfo = (unsigned)(AT_KBYTES + r32 * AT_VROW + 8 * hi);
#pragma unroll 1
    for (int t = 0; t < NT; ++t) {
        const unsigned sb = (unsigned)((t & 1) * AT_STAGE), sn = (unsigned)(((t + 1) & 1) * AT_STAGE);
        const bool more = t + 1 < NT;
        if (more) {
#pragma unroll
            for (int i = 0; i < 3; ++i) kr[i] = __builtin_amdgcn_raw_buffer_load_b128(krs, kgo[i], (t + 1) * (64 * 384), 0);
#pragma unroll
            for (int i = 0; i < 2; ++i) vr[i] = __builtin_amdgcn_raw_buffer_load_b128(vrs, vgo[i], (t + 1) * 128, 0);
        }
        const int k0 = 64 * t;
        if (k0 <= q0 + 31) {
            f32x16 s0, s1;
#pragma unroll
            for (int r = 0; r < 16; ++r) { s0[r] = 0.f; s1[r] = 0.f; }
#pragma unroll
            for (int ks = 0; ks < 12; ++ks) {
                const s16x8 ka = *(const LAS s16x8*)(lds + sb + kfo + 32 * ks), kb = *(const LAS s16x8*)(lds + sb + kfo + 32 * AT_KROW + 32 * ks);
                s0 = __builtin_amdgcn_mfma_f32_32x32x16_bf16(ka, qf[ks], s0, 0, 0, 0);
                s1 = __builtin_amdgcn_mfma_f32_32x32x16_bf16(kb, qf[ks], s1, 0, 0, 0);
                if ((ks & 3) == 3) __builtin_amdgcn_sched_barrier(0);
            }
            if (k0 + 63 > q0) {
                const int qa = q0 + r32 - k0 - 4 * hi;
#pragma unroll
                for (int r = 0; r < 16; ++r) { if (((r & 3) + 8 * (r >> 2)) > qa) s0[r] = -INFINITY; if ((32 + (r & 3) + 8 * (r >> 2)) > qa) s1[r] = -INFINITY; }
            }
            float mt = fmaxf(s0[0], s1[0]);
#pragma unroll
            for (int r = 1; r < 16; ++r) mt = fmaxf(mt, fmaxf(s0[r], s1[r]));
            mt = fmaxf(mt, __shfl_xor(mt, 32));
            const float mn = fmaxf(m, mt), alpha = __builtin_amdgcn_exp2f(m - mn);
            m = mn; l *= alpha;
#pragma unroll
            for (int d = 0; d < 4; ++d)
#pragma unroll
                for (int r = 0; r < 16; ++r) o[d][r] *= alpha;
            float ps = 0.f;
#pragma unroll
            for (int r = 0; r < 16; ++r) { s0[r] = __builtin_amdgcn_exp2f(s0[r] - mn); s1[r] = __builtin_amdgcn_exp2f(s1[r] - mn); ps += s0[r] + s1[r]; }
            l += ps;
#pragma unroll
            for (int s = 0; s < 4; ++s) {
                u32x4 pw;
                if (s < 2) { pw.x = cvtpk(s0[8 * s], s0[8 * s + 1]); pw.y = cvtpk(s0[8 * s + 2], s0[8 * s + 3]); pw.z = cvtpk(s0[8 * s + 4], s0[8 * s + 5]); pw.w = cvtpk(s0[8 * s + 6], s0[8 * s + 7]); }
                else { const int z = s - 2; pw.x = cvtpk(s1[8 * z], s1[8 * z + 1]); pw.y = cvtpk(s1[8 * z + 2], s1[8 * z + 3]); pw.z = cvtpk(s1[8 * z + 4], s1[8 * z + 5]); pw.w = cvtpk(s1[8 * z + 6], s1[8 * z + 7]); }
                const s16x8 pb = __builtin_bit_cast(s16x8, pw);
#pragma unroll
                for (int d = 0; d < 4; ++d) {
                    const unsigned va = sb + vfo + (unsigned)(d * 32 * AT_VROW + 32 * s);
                    const s16x4 lo = *(const LAS s16x4*)(lds + va), hh = *(const LAS s16x4*)(lds + va + 16);
                    const s16x8 vfrag = __builtin_shufflevector(lo, hh, 0, 1, 2, 3, 4, 5, 6, 7);
                    o[d] = __builtin_amdgcn_mfma_f32_32x32x16_bf16(vfrag, pb, o[d], 0, 0, 0);
                }
                __builtin_amdgcn_sched_barrier(0);
            }
        }
        if (more) {
#pragma unroll
            for (int i = 0; i < 3; ++i) *(LAS u32x4*)(lds + sn + kl[i]) = kr[i];
#pragma unroll
            for (int i = 0; i < 2; ++i) { *(LAS u32x2*)(lds + sn + vl[i]) = (u32x2){vr[i].x, vr[i].y}; *(LAS u32x2*)(lds + sn + vl[i] + 8) = (u32x2){vr[i].z, vr[i].w}; }
        }
        __syncthreads();
    }
    l += __shfl_xor(l, 32);
    const float inv = 1.f / l;
    bf16* Op = O + ((size_t)((bh >> 3) * SEQ + q0 + r32)) * DM + (bh & 7) * VH + 4 * hi;
#pragma unroll
    for (int d = 0; d < 4; ++d)
#pragma unroll
        for (int g = 0; g < 4; ++g) { u32x2 w; w.x = cvtpk(o[d][4 * g] * inv, o[d][4 * g + 1] * inv); w.y = cvtpk(o[d][4 * g + 2] * inv, o[d][4 * g + 3] * inv);
            *(u32x2*)(Op + 32 * d + 8 * g) = w; }
}
DI void ph_attn(const bf16* Qf, const bf16* Kf, const bf16* Vt, bf16* O, LAS unsigned char* lds, int vcu, int G, int wave, int lane) {
    for (int p = vcu; p < 256; p += G) {
        const int bh = p >> 3, s8 = p & 7;
#pragma unroll 1
        for (int u = 0; u < 2; ++u) attn_unit_lds(Qf, Kf, Vt, O, lds, bh, u ? s8 : 15 - s8, wave, lane);
    }
}

__global__ void __launch_bounds__(NWAVES * 64, 2) mk_fwd(Args args) {
    extern __shared__ __attribute__((aligned(16))) unsigned char lds_raw[];
    LAS unsigned char* lds = (LAS unsigned char*)lds_raw;
    const int tid = threadIdx.x, lane = tid & 63, wave = __builtin_amdgcn_readfirstlane(tid >> 6);
    const int G = gridDim.x, bx = blockIdx.x, vcu = (G % 8 == 0) ? (bx % 8) * (G / 8) + bx / 8 : bx;
    const int gw = vcu * NWAVES + wave, NGW = G * NWAVES;
    const size_t GT = (size_t)G * 512;
    unsigned char* ws = args.ws;
    for (int u = tid; u < (LDS_BYTES - LDSCTL_OFF) / 4; u += NWAVES * 64) ((LAS unsigned*)(lds + LDSCTL_OFF))[u] = 0u;
    __syncthreads();
    const bool multi = (args.ph_hi - args.ph_lo) > 1;
    XcdBarrier bar; bar.bar = (unsigned*)(ws + WS_CTL) + CW_BAR; bar.x = 0; bar.st = (volatile LAS unsigned*)(lds + MISC_OFF) + 8;
    if (multi) bar = xcd_barrier_post((unsigned*)(ws + WS_CTL) + CW_BAR, (volatile LAS unsigned*)(lds + MISC_OFF) + 8);

    float* X = args.out;
    const float* mod = (const float*)(ws + WS_MOD);
    bf16* XN = (bf16*)(ws + WS_XN);

    const int lo = args.ph_lo, hi = args.ph_hi;
#define IN(k) (EN(k) && lo <= (k) && (k) < hi)
    auto opq = [](int v) { asm volatile("" : "+v"(v)); return v; };
#define LN opq(lane)
#define TD opq(tid)
#define GTID ((size_t)vcu * 512 + (size_t)opq(tid))
#define SEAM(k) do { if (lo <= (k) && (k) + 1 < hi) xcd_barrier(bar); } while (0)
#define GEMM_BF16(Aptr, Bptr, NN, KK, Optr, LDC) do { pg8::Gemm g{(const bf16*)(Aptr), (const bf16*)(Bptr), MTOK, (NN), (KK)}; pg8::StaticOrder S; S.init(MTOK, (NN), G, bx); \
        pg8::EpiBf16<0> E{(bf16*)(Optr), (LDC), nullptr, 0, 0, 1.f}; pg8::gemm_phase<pg8::EpiBf16<0>, pg8::StaticOrder, true, true>(lds, g, S, E); } while (0)
#define GEMM_RES(Aptr, Bptr, BASE, OUT, GATE) do { pg8::Gemm g{(const bf16*)(Aptr), (const bf16*)(Bptr), MTOK, DM, DM}; pg8::StaticOrder S; S.init(MTOK, DM, G, bx); \
        EpiResGate E{(BASE), (OUT), (GATE)}; pg8::gemm_phase<EpiResGate, pg8::StaticOrder, true, true>(lds, g, S, E); } while (0)

    if (IN(0)) for (int r_ = 0; r_ < NREP(0); ++r_) ph_prologue(args, lds, TD, wave, vcu, G);
    SEAM(0);
    if (IN(1)) for (int r_ = 0; r_ < NREP(1); ++r_) ph_modulate((const float*)args.in[0], XN, nullptr, (const float*)args.in[3], mod, 0, 1024, gw, NGW, LN);
    SEAM(1);
    if (IN(2)) for (int r_ = 0; r_ < NREP(2); ++r_) GEMM_BF16(XN, ws + WS_WCIN, 3072, 1024, ws + WS_BCV, 3072);
    SEAM(2);
    if (IN(3)) for (int r_ = 0; r_ < NREP(3); ++r_) ph_conv((const bf16*)(ws + WS_BCV), (const float*)args.in[8], (bf16*)(ws + WS_Z), GTID, GT);
    SEAM(3);
    if (IN(4)) for (int r_ = 0; r_ < NREP(4); ++r_) GEMM_RES(ws + WS_Z, ws + WS_WCOUT, (const float*)args.in[0], X, mod + 2048);
    SEAM(4);
    if (IN(5)) for (int r_ = 0; r_ < NREP(5); ++r_) ph_modulate(X, XN, nullptr, (const float*)args.in[4], mod, 3072, 4096, gw, NGW, LN);
    SEAM(5);
    if (IN(6)) for (int r_ = 0; r_ < NREP(6); ++r_) GEMM_BF16(XN, ws + WS_WPQ0, 2048, 1024, ws + WS_PQ, 2048);
    SEAM(6);
    if (IN(7)) for (int r_ = 0; r_ < NREP(7); ++r_) ph_topk((const bf16*)(ws + WS_PQ), (const bf16*)(ws + WS_SUBK), (unsigned short*)(ws + WS_IDS), (float*)(ws + WS_GATES), lds, gw, NGW, wave, LN);
    SEAM(7);
    if (IN(8)) { ph_peer_u<0>(ws + WS_PU, (const unsigned short*)(ws + WS_IDS), XN, (float*)(ws + WS_PART), bx, G, wave, LN);
        for (int r_ = 1; r_ < NREP(8); ++r_) ph_peer_u<PROBE_VAR>(ws + WS_PU, (const unsigned short*)(ws + WS_IDS), XN, (float*)(ws + WS_DUMMY), bx, G, wave, LN); }
    SEAM(8);
    if (IN(9)) for (int r_ = 0; r_ < NREP(9); ++r_) ph_peer_c((const float*)(ws + WS_PART), (const float*)(ws + WS_GATES), (float*)(ws + WS_ACT), gw, NGW, LN);
    SEAM(9);
    if (IN(10)) for (int r_ = 0; r_ < NREP(10); ++r_) ph_peer_v(ws + WS_PV, (const unsigned short*)(ws + WS_IDS), (const float*)(ws + WS_ACT), X, (r_ + 1 < NREP(10) ? (float*)(ws + WS_DUMMY) : X), mod + 5120, bx, G, wave, LN);
    SEAM(10);
    if (IN(11)) for (int r_ = 0; r_ < NREP(11); ++r_) ph_modulate(X, XN, nullptr, (const float*)args.in[3] + DM, mod + (size_t)4 * 6144, 0, 1024, gw, NGW, LN);
    SEAM(11);
    if (IN(12)) for (int r_ = 0; r_ < NREP(12); ++r_) GEMM_BF16(XN, ws + WS_WMIN, MLA_IN_PAD, 1024, ws + WS_LAT, MLA_IN_PAD);
    SEAM(12);
    if (IN(13)) for (int r_ = 0; r_ < NREP(13); ++r_) ph_latnorm((const bf16*)(ws + WS_LAT), (const float*)args.in[11], (const float*)args.in[12], (bf16*)(ws + WS_QN), (bf16*)(ws + WS_KVN), gw, NGW, LN);
    SEAM(13);
    if (IN(14)) for (int r_ = 0; r_ < NREP(14); ++r_) { GEMM_BF16(ws + WS_QN, ws + WS_WQB, 1536, QLORA, ws + WS_QRAW, 1536); GEMM_BF16(ws + WS_KVN, ws + WS_WKVB, 2048, KVLORA, ws + WS_KVRAW, 2048); }
    SEAM(14);
    if (IN(15)) for (int r_ = 0; r_ < NREP(15); ++r_) ph_qkprep((const bf16*)(ws + WS_QRAW), (const bf16*)(ws + WS_KVRAW), (const bf16*)(ws + WS_LAT), (const int*)args.in[2], (const float*)args.in[15], (const float*)args.in[16],
                          (bf16*)(ws + WS_QF), (bf16*)(ws + WS_KF), (bf16*)(ws + WS_VT), gw, NGW, LN);
    SEAM(15);
    if (IN(16)) for (int r_ = 0; r_ < NREP(16); ++r_) ph_attn((const bf16*)(ws + WS_QF), (const bf16*)(ws + WS_KF), (const bf16*)(ws + WS_VT), (bf16*)(ws + WS_O), lds, vcu, G, wave, LN);
    SEAM(16);
    if (IN(17)) for (int r_ = 0; r_ < NREP(17); ++r_) GEMM_RES(ws + WS_O, ws + WS_WMOUT, (const float*)X, (r_ + 1 < NREP(17) ? (float*)(ws + WS_DUMMY) : X), mod + (size_t)4 * 6144 + 2048);
    SEAM(17);
    if (IN(18)) for (int r_ = 0; r_ < NREP(18); ++r_) ph_modulate(X, XN, nullptr, (const float*)args.in[4] + DM, mod + (size_t)4 * 6144, 3072, 4096, gw, NGW, LN);
    SEAM(18);
    if (IN(19)) for (int r_ = 0; r_ < NREP(19); ++r_) GEMM_BF16(XN, ws + WS_WPQ1, 2048, 1024, ws + WS_PQ, 2048);
    SEAM(19);
    if (IN(20)) for (int r_ = 0; r_ < NREP(20); ++r_) ph_topk((const bf16*)(ws + WS_PQ), (const bf16*)(ws + WS_SUBK) + (size_t)8 * 2 * 128 * 128, (unsigned short*)(ws + WS_IDS), (float*)(ws + WS_GATES), lds, gw, NGW, wave, LN);
    SEAM(20);
    if (IN(21)) for (int r_ = 0; r_ < NREP(21); ++r_) ph_peer_u<0>(ws + WS_PU + (size_t)8 * NEXP * 128, (const unsigned short*)(ws + WS_IDS), XN, (float*)(ws + WS_PART), bx, G, wave, LN);
    SEAM(21);
    if (IN(22)) for (int r_ = 0; r_ < NREP(22); ++r_) ph_peer_c((const float*)(ws + WS_PART), (const float*)(ws + WS_GATES), (float*)(ws + WS_ACT), gw, NGW, LN);
    SEAM(22);
    if (IN(23)) for (int r_ = 0; r_ < NREP(23); ++r_) ph_peer_v(ws + WS_PV + (size_t)8 * NEXP * 128, (const unsigned short*)(ws + WS_IDS), (const float*)(ws + WS_ACT), X, (r_ + 1 < NREP(23) ? (float*)(ws + WS_DUMMY) : X), mod + (size_t)4 * 6144 + 5120, bx, G, wave, LN);
}

extern "C" void kernel_launch(void* const* d_in, const int* in_sizes, int n_in, void* d_out, int out_size, void* d_ws, size_t ws_size, hipStream_t stream) {
    static int grid = 0;
    if (grid == 0) {
        if (n_in != 22 || out_size != MTOK * DM || ws_size < WS_END) { fprintf(stderr, "kernel_launch: unexpected shapes: n_in %d out %d ws %zu (need %zu)\n", n_in, out_size, ws_size, (size_t)WS_END); grid = -1; return; }
        int dev = 0, cus = 0;
        if (hipGetDevice(&dev) != hipSuccess || hipDeviceGetAttribute(&cus, hipDeviceAttributeMultiprocessorCount, dev) != hipSuccess) { grid = -1; return; }
        if (hipFuncSetAttribute((const void*)mk_fwd, hipFuncAttributeMaxDynamicSharedMemorySize, LDS_BYTES) != hipSuccess) { fprintf(stderr, "kernel_launch: hipFuncSetAttribute failed\n"); grid = -1; return; }
        int per_cu = 0;
        if (hipOccupancyMaxActiveBlocksPerMultiprocessor(&per_cu, (const void*)mk_fwd, NWAVES * 64, LDS_BYTES) != hipSuccess || per_cu < 1) fprintf(stderr, "kernel_launch: occupancy query says %d\n", per_cu);
        (void)hipGetLastError();
        grid = cus;
    }
    if (grid < 0) return;
    (void)hipMemsetAsync((char*)d_ws + WS_CTL, 0, CTL_ZERO_BYTES, stream);
    Args a{};
    for (int i = 0; i < 22; ++i) a.in[i] = d_in[i];
    a.out = (float*)d_out; a.ws = (unsigned char*)d_ws;
#if MK_N_LAUNCHES == 1
    a.ph_lo = 0; a.ph_hi = NPHASES;
    hipLaunchKernelGGL(mk_fwd, dim3(grid), dim3(NWAVES * 64), LDS_BYTES, stream, a);
#else
    for (int ph = 0; ph < NPHASES; ++ph) { a.ph_lo = ph; a.ph_hi = ph + 1; hipLaunchKernelGGL(mk_fwd, dim3(grid), dim3(NWAVES * 64), LDS_BYTES, stream, a); }
#endif
}
```

```cpp
#include <hip/hip_runtime.h>
#include <cstdio>
#include <cstdint>
#define GAS __attribute__((address_space(1)))
#define LAS __attribute__((address_space(3)))
namespace pg8 {
#define PG8_LAS __attribute__((address_space(3)))
typedef unsigned short bf16_t;
typedef short bf16x8 __attribute__((ext_vector_type(8)));
typedef float f32x4 __attribute__((ext_vector_type(4)));
typedef unsigned u32x4 __attribute__((ext_vector_type(4)));
constexpr int BM = 256, BK = 64, HALF = 128, HTB = HALF * BK * 2  , STAGE_BYTES = 8 * HTB, NXCD = 8, WGM = 8;

__host__ __device__ __forceinline__ int lds_byte(int r, int c) { const int st = (r >> 4) * 2 + (c >> 5), rr = r & 15, cc = c & 31, ob = rr * 64 + cc * 2; return st * 1024 + (ob ^ (((ob >> 9) & 1) << 5)); }
__host__ __device__ __forceinline__ void stage_rc(int b, int& R, int& C) { const int st = b / 1024, sb = b % 1024, swz = sb ^ (((sb >> 9) & 1) << 5); R = (st >> 1) * 16 + swz / 64; C = (st & 1) * 32 + (swz % 64) / 2; }
__host__ __device__ __forceinline__ int perm32(int rho) { const int n = rho >> 4, i = rho & 15; return 8 * (i >> 2) + 4 * n + (i & 3); }

struct Unit { int pm, pn; };
struct Gemm { const bf16_t* A; const bf16_t* Bt; int M, N, K; };

struct StaticOrder {
    int nM, nN, nwg, G, c;
    __host__ __device__ void init(int M, int N, int G_, int c_) { nM = M / BM; nN = N / BM; nwg = nM * nN; G = G_; c = c_; }
    __host__ __device__ bool next(int i, Unit& u) const {
        const long L = (long)i * G + c; if (L >= nwg) return false;
        int wgid = (int)L; { const int q = nwg / NXCD, r = nwg % NXCD, xcd = wgid % NXCD, off = wgid / NXCD; wgid = (xcd < r ? xcd * (q + 1) : r * (q + 1) + (xcd - r) * q) + off; }
        const int nig = WGM * nN, gid = wgid / nig, fm = gid * WGM, gsz = (nM - fm) < WGM ? (nM - fm) : WGM;
        u.pm = fm + ((wgid % nig) % gsz); u.pn = (wgid % nig) / gsz; return true;
    }
    __device__ __forceinline__ void a_ready(const Unit&) const {}
    __device__ __forceinline__ void done(const Unit&) const {}
};

__device__ __forceinline__ unsigned cvt_pk_bf16(float lo, float hi) { unsigned r; asm volatile("v_cvt_pk_bf16_f32 %0, %1, %2" : "=v"(r) : "v"(lo), "v"(hi)); return r; }
typedef float f32x2 __attribute__((ext_vector_type(2)));
__device__ __forceinline__ f32x2 gelu_pk(f32x2 v) {
    const f32x2 av = __builtin_elementwise_abs(v), d = av * 0.2316418882f + 1.0f;
    f32x2 t; t.x = __builtin_amdgcn_rcpf(d.x); t.y = __builtin_amdgcn_rcpf(d.y);
    f32x2 q = t * 0.5307027145f + (-0.7265760135f); q = q * t + 0.7107068705f; q = q * t + (-0.142248368f); q = q * t + 0.127414796f; q = q * t;
    const f32x2 s = (v * v) * (-0.72134752044f);
    f32x2 e; e.x = __builtin_amdgcn_exp2f(s.x); e.y = __builtin_amdgcn_exp2f(s.y);
    const f32x2 m = v * (q * e), r = v - m;
    f32x2 o; o.x = v.x < 0.f ? m.x : r.x; o.y = v.y < 0.f ? m.y : r.y; return o;
}

template <int ACT  > struct EpiBf16 {
    static constexpr bool PERM = true, AFTER_DRAIN = false; static_assert(ACT == 0 || ACT == 1, "EpiBf16: ACT is 0 (none) or 1 (gelu_pk)");
    bf16_t* O; int ldc; const float* bias; int split_cols; size_t split_stride; float scale0;
    __device__ __forceinline__ void operator()(const f32x4 (&acc)[2][2][4][2], const Unit& u, int wr, int wc, int fr, int fq) const {
        const int row0 = u.pm * BM + wr * 64 + fr; int colt = u.pn * BM; bf16_t* base = O;
        float sc = 1.f; if (split_cols) { const int t = colt / split_cols; base += (size_t)t * split_stride; colt -= t * split_cols; if (t == 0) sc = scale0; }
        const int col0 = colt + wc * 32 + 8 * fq, bcol0 = u.pn * BM + wc * 32 + 8 * fq;
        f32x4 bv[2][2];
#pragma unroll
        for (int bj = 0; bj < 2; ++bj)
#pragma unroll
            for (int n = 0; n < 2; ++n) bv[bj][n] = bias ? *(const f32x4*)(bias + bcol0 + bj * HALF + 4 * n) : (f32x4){0.f, 0.f, 0.f, 0.f};
#pragma unroll
        for (int ai = 0; ai < 2; ++ai)
#pragma unroll
            for (int m = 0; m < 4; ++m) { bf16_t* rowp = base + (size_t)(row0 + ai * HALF + m * 16) * ldc + col0;
#pragma unroll
                for (int bj = 0; bj < 2; ++bj) { f32x4 v0 = acc[ai][bj][m][0] + bv[bj][0], v1 = acc[ai][bj][m][1] + bv[bj][1];
                    if (ACT == 1) { f32x2 a = gelu_pk((f32x2){v0[0], v0[1]}), b = gelu_pk((f32x2){v0[2], v0[3]}), c = gelu_pk((f32x2){v1[0], v1[1]}), d = gelu_pk((f32x2){v1[2], v1[3]});
                        v0 = (f32x4){a.x, a.y, b.x, b.y}; v1 = (f32x4){c.x, c.y, d.x, d.y}; }
                    v0 = v0 * sc; v1 = v1 * sc; u32x4 w; w.x = cvt_pk_bf16(v0[0], v0[1]); w.y = cvt_pk_bf16(v0[2], v0[3]); w.z = cvt_pk_bf16(v1[0], v1[1]); w.w = cvt_pk_bf16(v1[2], v1[3]);
                    *(u32x4*)(rowp + bj * HALF) = w; } }
    }
};

template <class Epi, class Sched, bool ALIGN_EPI = false, bool SP2 = false>
__device__ __forceinline__ void gemm_phase(PG8_LAS unsigned char* lds, const Gemm g, const Sched& S, const Epi& E) {
    int tid_raw = threadIdx.x; asm volatile("" : "+v"(tid_raw));
    const int tid = tid_raw, wid = __builtin_amdgcn_readfirstlane(tid >> 6), lane = tid & 63, wr = wid >> 2, wc = wid & 3, fr = lane & 15, fq = lane >> 4;
    const int K = g.K, nt = K / BK;
    unsigned voffA[2], voffB[2];
#pragma unroll
    for (int i = 0; i < 2; ++i) { int R, C; stage_rc(tid * 16 + i * 8192, R, C); const int Rb = Epi::PERM ? ((R & ~31) + perm32(R & 31)) : R;
        voffA[i] = (unsigned)(R * K + C) * 2u; voffB[i] = (unsigned)(Rb * K + C) * 2u; }
    const size_t kstep = (size_t)(BK * 2);
    const size_t hstep = (size_t)HALF * K * 2;
    const size_t tstep = 2 * hstep;
    const unsigned ldsw = (unsigned)wid * 1024u;
    const int aoff = lds_byte(wr * 64 + fr, fq * 8), boff = lds_byte(wc * 32 + fr, fq * 8);
#define PG8_SA(b, h) (((b) * 2 + (h)) * HTB)
#define PG8_SB(b, h) ((4 + (b) * 2 + (h)) * HTB)
#define PG8_STAGE(bufoff, gbase, voff) do { _Pragma("unroll") for (int _i = 0; _i < 2; ++_i) \
        __builtin_amdgcn_global_load_lds((const unsigned*)((const char*)(gbase) + (voff)[_i]), (PG8_LAS unsigned*)(lds + (bufoff) + ldsw + _i * 8192), 16, 0, 0); } while (0)
#define PG8_LDA(dst, b, h) do { _Pragma("unroll") for (int m = 0; m < 4; ++m) _Pragma("unroll") for (int k = 0; k < 2; ++k) dst[m][k] = *(const PG8_LAS bf16x8*)(lds + PG8_SA(b, h) + aoff + m * 2048 + k * 1024); } while (0)
#define PG8_LDB(dst, b, h) do { _Pragma("unroll") for (int n = 0; n < 2; ++n) _Pragma("unroll") for (int k = 0; k < 2; ++k) dst[n][k] = *(const PG8_LAS bf16x8*)(lds + PG8_SB(b, h) + boff + n * 2048 + k * 1024); } while (0)
#define PG8_MMA(ai, bj, At, Bt) do { __builtin_amdgcn_s_setprio(1); _Pragma("unroll") for (int m = 0; m < 4; ++m) _Pragma("unroll") for (int n = 0; n < 2; ++n) _Pragma("unroll") for (int k = 0; k < 2; ++k) \
        acc[ai][bj][m][n] = __builtin_amdgcn_mfma_f32_16x16x32_bf16(Bt[n][k], At[m][k], acc[ai][bj][m][n], 0, 0, 0); __builtin_amdgcn_s_setprio(0); } while (0)
#define PG8_WAIT_V(n) asm volatile("s_waitcnt vmcnt(" #n ")" ::: "memory")
#define PG8_WAIT_L(n) asm volatile("s_waitcnt lgkmcnt(" #n ")" ::: "memory")
#define PG8_BAR __builtin_amdgcn_s_barrier()
#define PG8_SCHED __builtin_amdgcn_sched_barrier(0)
    Unit cur, nxt; int ui = 0;
    if (!S.next(0, cur)) return;
    f32x4 acc[2][2][4][2];
#pragma unroll
    for (int a = 0; a < 2; ++a)
#pragma unroll
        for (int b = 0; b < 2; ++b)
#pragma unroll
            for (int m = 0; m < 4; ++m)
#pragma unroll
                for (int n = 0; n < 2; ++n) acc[a][b][m][n] = (f32x4){0.f, 0.f, 0.f, 0.f};
    bf16x8 At[4][2], B0[2][2], B1[2][2];
    const char* cA = (const char*)g.A + (size_t)cur.pm * tstep; const char* cB = (const char*)g.Bt + (size_t)cur.pn * tstep;
    S.a_ready(cur);
    if constexpr (SP2) {
        PG8_STAGE(PG8_SB(0, 0), cB, voffB); PG8_STAGE(PG8_SB(0, 1), cB + hstep, voffB); PG8_STAGE(PG8_SA(0, 0), cA, voffA); PG8_STAGE(PG8_SA(0, 1), cA + hstep, voffA);
        if (wr == 1) PG8_BAR;
        PG8_WAIT_V(2); PG8_BAR;
        PG8_STAGE(PG8_SB(1, 0), cB + kstep, voffB); PG8_STAGE(PG8_SA(1, 0), cA + kstep, voffA); PG8_STAGE(PG8_SB(1, 1), cB + hstep + kstep, voffB);
        PG8_WAIT_V(6); PG8_BAR;
    } else {
        PG8_STAGE(PG8_SB(0, 0), cB, voffB); PG8_STAGE(PG8_SA(0, 0), cA, voffA); PG8_STAGE(PG8_SB(0, 1), cB + hstep, voffB); PG8_STAGE(PG8_SA(0, 1), cA + hstep, voffA);
        if (wr == 1) PG8_BAR;
        PG8_WAIT_V(4); PG8_BAR;
        PG8_STAGE(PG8_SB(1, 0), cB + kstep, voffB); PG8_STAGE(PG8_SA(1, 0), cA + kstep, voffA); PG8_STAGE(PG8_SB(1, 1), cB + hstep + kstep, voffB);
        PG8_WAIT_V(6); PG8_BAR;
    }
    for (;;) {
        const bool has_next = S.next(ui + 1, nxt);
        const char* nA = has_next ? (const char*)g.A + (size_t)nxt.pm * tstep : cA; const char* nB = has_next ? (const char*)g.Bt + (size_t)nxt.pn * tstep : cB;
        for (int t = 0; t < nt; t += 2) {
            const bool last = (t == nt - 2);
            const char* a1 = cA + (size_t)(t + 1) * kstep;
            const char* a2 = last ? nA : cA + (size_t)(t + 2) * kstep; const char* b2 = last ? nB : cB + (size_t)(t + 2) * kstep;
            const char* a3 = a2 + kstep; const char* b3 = b2 + kstep;
            if (last && has_next) S.a_ready(nxt);
            if constexpr (SP2) {
            PG8_LDB(B0, 0, 0); PG8_LDB(B1, 0, 1); PG8_SCHED; PG8_LDA(At, 0, 0); PG8_STAGE(PG8_SA(1, 1), a1 + hstep, voffA);
            PG8_WAIT_V(8); PG8_WAIT_L(0); PG8_BAR; PG8_MMA(0, 0, At, B0); PG8_MMA(0, 1, At, B1); PG8_BAR; PG8_SCHED;
            PG8_LDA(At, 0, 1); PG8_STAGE(PG8_SB(0, 0), b2, voffB); PG8_STAGE(PG8_SB(0, 1), b2 + hstep, voffB); PG8_STAGE(PG8_SA(0, 0), a2, voffA);
            PG8_WAIT_V(8); PG8_WAIT_L(0); PG8_BAR; PG8_MMA(1, 0, At, B0); PG8_MMA(1, 1, At, B1); PG8_BAR; PG8_SCHED;
            PG8_LDB(B0, 1, 0); PG8_LDB(B1, 1, 1); PG8_SCHED; PG8_LDA(At, 1, 0); PG8_STAGE(PG8_SA(0, 1), a2 + hstep, voffA);
            PG8_WAIT_V(8); PG8_WAIT_L(0); PG8_BAR; PG8_MMA(0, 0, At, B0); PG8_MMA(0, 1, At, B1); PG8_BAR; PG8_SCHED;
            PG8_LDA(At, 1, 1); PG8_STAGE(PG8_SB(1, 0), b3, voffB); PG8_STAGE(PG8_SB(1, 1), b3 + hstep, voffB); PG8_STAGE(PG8_SA(1, 0), a3, voffA);
            PG8_WAIT_V(8); PG8_WAIT_L(0); PG8_BAR; PG8_MMA(1, 0, At, B0); PG8_MMA(1, 1, At, B1); PG8_BAR; PG8_SCHED;
            } else {
            PG8_LDB(B0, 0, 0); PG8_SCHED; PG8_LDA(At, 0, 0); PG8_STAGE(PG8_SA(1, 1), a1 + hstep, voffA);
            PG8_WAIT_L(8); PG8_BAR; PG8_WAIT_L(0); PG8_MMA(0, 0, At, B0); PG8_BAR; PG8_SCHED;
            PG8_LDB(B1, 0, 1); PG8_STAGE(PG8_SB(0, 0), b2, voffB);
            PG8_BAR; PG8_WAIT_L(0); PG8_MMA(0, 1, At, B1); PG8_BAR;
            PG8_LDA(At, 0, 1); PG8_STAGE(PG8_SA(0, 0), a2, voffA);
            PG8_BAR; PG8_WAIT_L(0); PG8_MMA(1, 0, At, B0); PG8_BAR; PG8_SCHED;
            PG8_STAGE(PG8_SB(0, 1), b2 + hstep, voffB);
            PG8_WAIT_V(6); PG8_BAR; PG8_MMA(1, 1, At, B1); PG8_BAR;
            PG8_LDB(B0, 1, 0); PG8_SCHED; PG8_LDA(At, 1, 0); PG8_STAGE(PG8_SA(0, 1), a2 + hstep, voffA);
            PG8_WAIT_L(8); PG8_BAR; PG8_WAIT_L(0); PG8_MMA(0, 0, At, B0); PG8_BAR; PG8_SCHED;
            PG8_LDB(B1, 1, 1); PG8_STAGE(PG8_SB(1, 0), b3, voffB);
            PG8_BAR; PG8_WAIT_L(0); PG8_MMA(0, 1, At, B1); PG8_BAR;
            PG8_LDA(At, 1, 1); PG8_STAGE(PG8_SA(1, 0), a3, voffA);
            PG8_BAR; PG8_WAIT_L(0); PG8_MMA(1, 0, At, B0); PG8_BAR; PG8_SCHED;
            PG8_STAGE(PG8_SB(1, 1), b3 + hstep, voffB);
            PG8_WAIT_V(6); PG8_BAR; PG8_MMA(1, 1, At, B1); PG8_BAR;
            }
        }
        if constexpr (ALIGN_EPI) { if (wr == 0) PG8_BAR; }
        if constexpr (!Epi::AFTER_DRAIN) { E(acc, cur, wr, wc, fr, fq); S.done(cur); }
        if (!has_next) break;
#pragma unroll
        for (int a = 0; a < 2; ++a)
#pragma unroll
            for (int b = 0; b < 2; ++b)
#pragma unroll
                for (int m = 0; m < 4; ++m)
#pragma unroll
                    for (int n = 0; n < 2; ++n) acc[a][b][m][n] = (f32x4){0.f, 0.f, 0.f, 0.f};
        cur = nxt; cA = nA; cB = nB; ++ui;
        if constexpr (ALIGN_EPI) { if (wr == 1) PG8_BAR; }
    }
    PG8_WAIT_V(0);
    if constexpr (!ALIGN_EPI) { if (wr == 0) PG8_BAR; }
    PG8_BAR;
    if constexpr (Epi::AFTER_DRAIN) { E.fused(acc, cur, wr, wc, fr, fq, lds, wid, lane); S.done(cur); }
#undef PG8_SA
#undef PG8_SB
#undef PG8_STAGE
#undef PG8_LDA
#undef PG8_LDB
#undef PG8_MMA
#undef PG8_WAIT_V
#undef PG8_WAIT_L
#undef PG8_BAR
#undef PG8_SCHED
}
}
#define XB_TMO      128
#define XB_XCNT(j)  (256  + 64 * (j))
#define XB_XSUB(j)  (1280 + 64 * (j))
#define XB_XGEN(j)  (2304 + 64 * (j))
#define XB_TOP      3328
#define XB_TOPGEN   3392
#define XCD_BAR_WORDS 3456
#define XB_SPIN_CAP (1u << 18)

__device__ __forceinline__ unsigned xb_ld(unsigned* p)              { return __hip_atomic_load(p, __ATOMIC_RELAXED, __HIP_MEMORY_SCOPE_AGENT); }
__device__ __forceinline__ unsigned xb_add(unsigned* p, unsigned v) { return __hip_atomic_fetch_add(p, v, __ATOMIC_RELAXED, __HIP_MEMORY_SCOPE_AGENT); }
__device__ __forceinline__ unsigned xb_xcc_id() { return (unsigned)__builtin_amdgcn_s_getreg((3 << 11) | 20) & 0xFu; }
#define XB_SPIN(cond, bar) do { unsigned _sp = 0; while (cond) { __builtin_amdgcn_s_sleep(1); \
    if ((++_sp & 255u) == 0u) { if (xb_ld(&(bar)[XB_TMO])) break; if (_sp > XB_SPIN_CAP) { atomicAdd(&(bar)[XB_TMO], 1u); break; } } } } while (0)

struct XcdBarrier {
    unsigned* bar; unsigned x;
    volatile LAS unsigned* st;
};

__device__ __forceinline__ XcdBarrier xcd_barrier_post(unsigned* bar, volatile LAS unsigned* st) {
    XcdBarrier b; b.bar = bar; b.x = xb_xcc_id(); b.st = st;
    if (threadIdx.x == 0) (void)xb_add(&bar[XB_XCNT(b.x)], 1u);
    return b;
}
__device__ __forceinline__ void xcd_barrier_complete(unsigned* bar, unsigned x, unsigned& nloc, unsigned& nx) {
    const unsigned G = gridDim.x * gridDim.y * gridDim.z;
    unsigned sum, cnt, mine, sp = 0u;
    for (;;) {
        sum = 0u; cnt = 0u; mine = 0u;
#pragma unroll
        for (unsigned j = 0; j < 16; ++j) { const unsigned c = xb_ld(&bar[XB_XCNT(j)]); sum += c; cnt += (c > 0u) ? 1u : 0u; mine = (j == x) ? c : mine; }
        if (sum == G) break;
        __builtin_amdgcn_s_sleep(1);
        if ((++sp & 255u) == 0u) { if (xb_ld(&bar[XB_TMO])) break; if (sp > XB_SPIN_CAP) { atomicAdd(&bar[XB_TMO], 1u); break; } }
    }
    nloc = mine > 0u ? mine : 1u; nx = cnt > 0u ? cnt : 1u;
}

__device__ __forceinline__ void xcd_barrier(const XcdBarrier& b) {
    asm volatile("s_waitcnt vmcnt(0)" ::: "memory");
    __syncthreads();
    if (threadIdx.x == 0) {
        unsigned* bar = b.bar;
        __builtin_amdgcn_s_waitcnt(0);
        unsigned nloc = b.st[0], nx = b.st[1];
        if (nloc == 0u) { xcd_barrier_complete(bar, b.x, nloc, nx); b.st[0] = nloc; b.st[1] = nx; }
        const unsigned old = xb_add(&bar[XB_XSUB(b.x)], 1u);
        const unsigned gen = old / nloc;
        if (old + 1u == (gen + 1u) * nloc) {
            __builtin_amdgcn_fence(__ATOMIC_RELEASE, "agent");
            asm volatile("s_waitcnt vmcnt(0)" ::: "memory");
            const unsigned og = xb_add(&bar[XB_TOP], 1u);
            const unsigned tg = og / nx;
            if (og + 1u == (tg + 1u) * nx) xb_add(&bar[XB_TOPGEN], 1u);
            else XB_SPIN(xb_ld(&bar[XB_TOPGEN]) == tg, bar);
            __builtin_amdgcn_fence(__ATOMIC_ACQUIRE, "agent");
            xb_add(&bar[XB_XGEN(b.x)], 1u);
            asm volatile("s_waitcnt vmcnt(0)" ::: "memory");
        } else {
            XB_SPIN(xb_ld(&bar[XB_XGEN(b.x)]) == gen, bar);
            __builtin_amdgcn_fence(__ATOMIC_ACQUIRE, "agent");
            asm volatile("s_waitcnt vmcnt(0)" ::: "memory");
        }
    }
    __syncthreads();
}

constexpr int DM = 1024, NB = 4, SEQ = 4096, MTOK = NB * SEQ;
constexpr int QLORA = 384, KVLORA = 256, ROPE = 64, NOPE = 128, QKH = 192, VH = 128, NH = 8;
constexpr int MLA_IN = 704, MLA_IN_PAD = 768;
constexpr int NEXP = 16384;
constexpr float NORM_EPS = 1e-6f;
constexpr float U8_SCALE = 256.f, V8_SCALE = 16.f, H8_SCALE = 8.f;
constexpr float QSCALE = 0.07216878364870322f * 1.4426950408889634f;

#ifndef MK_N_LAUNCHES
#define MK_N_LAUNCHES 1
#endif
constexpr int NPHASES = 24;
#ifndef PHMASK
#define PHMASK 0xFFFFFFu
#endif
#define EN(k) (((PHMASK) >> (k)) & 1u)
#ifndef PROBE_PHASE
#define PROBE_PHASE -1
#endif
#ifndef PROBE_VAR
#define PROBE_VAR 0
#endif
#ifndef PROBE_REPS
#define PROBE_REPS 2
#endif
#define NREP(k) ((k) == (PROBE_PHASE) ? (PROBE_REPS) : 1)
constexpr int NWAVES = 8;

constexpr size_t MiB = 1u << 20;
constexpr size_t WS_CTL = 0, CTL_ZERO_BYTES = 64 * 1024;
constexpr size_t WS_MOD = 1 * MiB;
constexpr size_t WS_WCIN = 2 * MiB;
constexpr size_t WS_WCOUT = 8 * MiB;
constexpr size_t WS_WPQ0 = 10 * MiB, WS_WPQ1 = 14 * MiB;
constexpr size_t WS_WMIN = 18 * MiB;
constexpr size_t WS_WQB = 20 * MiB;
constexpr size_t WS_WKVB = 22 * MiB;
constexpr size_t WS_WMOUT = 24 * MiB;
constexpr size_t WS_SUBK = 26 * MiB;
constexpr size_t WS_PU = 32 * MiB;
constexpr size_t WS_PV = 96 * MiB;
constexpr size_t WS_XN = 160 * MiB;
constexpr size_t WS_VT = 160 * MiB;
constexpr size_t WS_BCV = 192 * MiB;
constexpr size_t WS_LAT = 192 * MiB;
constexpr size_t WS_O = 192 * MiB;
constexpr size_t WS_QN = 216 * MiB;
constexpr size_t WS_KVN = 228 * MiB;
constexpr size_t WS_QRAW = 236 * MiB;
constexpr size_t WS_Z = 288 * MiB;
constexpr size_t WS_KVRAW = 288 * MiB;
constexpr size_t WS_PQ = 288 * MiB;
constexpr size_t WS_QF = 352 * MiB;
constexpr size_t WS_KF = 400 * MiB;
constexpr size_t WS_IDS = 448 * MiB;
constexpr size_t WS_GATES = 456 * MiB;
constexpr size_t WS_PART = 192 * MiB;
constexpr size_t WS_DUMMY = 288 * MiB;
constexpr size_t WS_ACT = 464 * MiB;
constexpr size_t WS_XN8 = 472 * MiB;
constexpr size_t WS_END = 488 * MiB;
constexpr int CW_BAR = 1024;

constexpr int RING_BYTES = 131072;
constexpr int LDSCTL_OFF = RING_BYTES, MISC_OFF = LDSCTL_OFF + 320;
constexpr int LDS_BYTES = 147456;


typedef unsigned short bf16;
typedef unsigned u32x4 __attribute__((ext_vector_type(4)));
typedef unsigned u32x2 __attribute__((ext_vector_type(2)));
typedef float f32x4 __attribute__((ext_vector_type(4)));
typedef float f32x16 __attribute__((ext_vector_type(16)));
typedef short s16x8 __attribute__((ext_vector_type(8)));
typedef short s16x4 __attribute__((ext_vector_type(4)));
#define LDS_WAIT() asm volatile("s_waitcnt lgkmcnt(0)" ::: "memory")
#define VM_WAIT() asm volatile("s_waitcnt vmcnt(0)" ::: "memory")
#define DI __device__ __forceinline__

DI unsigned f2bf(float f) { unsigned u = __builtin_bit_cast(unsigned, f); return (u + 0x7fffu + ((u >> 16) & 1u)) >> 16; }
DI unsigned pk2(float lo, float hi) { return f2bf(lo) | (f2bf(hi) << 16); }
DI float bflo(unsigned u) { return __uint_as_float(u << 16); }
DI float bfhi(unsigned u) { return __uint_as_float(u & 0xffff0000u); }
DI float bf1(bf16 b) { return __uint_as_float((unsigned)b << 16); }
DI float wave_sum(float v) {
#pragma unroll
    for (int o = 32; o > 0; o >>= 1) v += __shfl_xor(v, o);
    return v;
}
DI int crow(int r, int hi) { return (r & 3) + 8 * (r >> 2) + 4 * hi; }

struct Args { const void* in[22]; float* out; unsigned char* ws; int ph_lo, ph_hi; };

DI void transpose_item(const float* W, int K, int N, bf16* WT, LAS float* scr, int item, int lane) {
    const int nblk = N / 32, kb = item / nblk, nb = item % nblk, k0 = 64 * kb, n0 = 32 * nb;
#pragma unroll 8
    for (int i = 0; i < 32; ++i) { const int kk = 2 * i + (lane >> 5); scr[kk * 33 + (lane & 31)] = W[(size_t)(k0 + kk) * N + n0 + (lane & 31)]; }
    LDS_WAIT(); asm volatile("" ::: "memory");
    const int c = lane & 7;
#pragma unroll
    for (int j = 0; j < 4; ++j) { const int n = (lane >> 3) + 8 * j; const LAS float* s = scr + (8 * c) * 33 + n;
        u32x4 o; o.x = pk2(s[0 * 33], s[1 * 33]); o.y = pk2(s[2 * 33], s[3 * 33]); o.z = pk2(s[4 * 33], s[5 * 33]); o.w = pk2(s[6 * 33], s[7 * 33]);
        *(u32x4*)(WT + (size_t)(n0 + n) * K + k0 + 8 * c) = o; }
    LDS_WAIT(); asm volatile("" ::: "memory");
}
DI void cvt_f32_bf16(const float* src, bf16* dst, size_t n8, size_t gt, size_t GT) {
#pragma unroll 4
    for (size_t i = gt; i < n8; i += GT) {
        const f32x4 a = ((const f32x4*)src)[2 * i], b = ((const f32x4*)src)[2 * i + 1];
        u32x4 o; o.x = pk2(a.x, a.y); o.y = pk2(a.z, a.w); o.z = pk2(b.x, b.y); o.w = pk2(b.z, b.w);
        ((u32x4*)dst)[i] = o; }
}

typedef float f32x2v __attribute__((ext_vector_type(2)));
DI unsigned pack4_fp8(float a, float b, float c, float d, float sc) {
    a = fminf(fmaxf(a * sc, -448.f), 448.f); b = fminf(fmaxf(b * sc, -448.f), 448.f); c = fminf(fmaxf(c * sc, -448.f), 448.f); d = fminf(fmaxf(d * sc, -448.f), 448.f);
    int w = __builtin_amdgcn_cvt_pk_fp8_f32(a, b, 0, false); w = __builtin_amdgcn_cvt_pk_fp8_f32(c, d, w, true); return (unsigned)w;
}
DI void cvt_tables_fp8(const float* u, const float* v, unsigned char* u8, unsigned char* v8, size_t gt, size_t GT) {
    const size_t n16 = (size_t)2 * NEXP * 1024 / 16;
#pragma unroll 2
    for (size_t i = gt; i < n16; i += GT) {
        const f32x4* s = (const f32x4*)(u + i * 16); const f32x4 a = s[0], b = s[1], c = s[2], d = s[3];
        u32x4 o; o.x = pack4_fp8(a.x, a.y, a.z, a.w, U8_SCALE); o.y = pack4_fp8(b.x, b.y, b.z, b.w, U8_SCALE); o.z = pack4_fp8(c.x, c.y, c.z, c.w, U8_SCALE); o.w = pack4_fp8(d.x, d.y, d.z, d.w, U8_SCALE);
        const size_t k = i & 63, row = i >> 6, e = row & (NEXP - 1), layer = row >> 14;
        *(u32x4*)(u8 + (((layer * 8 + (k >> 3)) * NEXP + e) * 128 + (k & 7) * 16)) = o; }
#pragma unroll 2
    for (size_t i = gt; i < n16; i += GT) {
        const f32x4* s = (const f32x4*)(v + i * 16); const f32x4 a = s[0], b = s[1], c = s[2], d = s[3];
        u32x4 o; o.x = pack4_fp8(a.x, a.y, a.z, a.w, V8_SCALE); o.y = pack4_fp8(b.x, b.y, b.z, b.w, V8_SCALE); o.z = pack4_fp8(c.x, c.y, c.z, c.w, V8_SCALE); o.w = pack4_fp8(d.x, d.y, d.z, d.w, V8_SCALE);
        const size_t k = i & 63, row = i >> 6, e = row & (NEXP - 1), layer = row >> 14;
        *(u32x4*)(v8 + (((layer * 8 + (k >> 3)) * NEXP + e) * 128 + (k & 7) * 16)) = o; }
}
DI void ph_prologue(const Args& a, LAS unsigned char* lds, int tid, int wave, int vcu, int G) {
    const int lane = tid & 63;
    {
        const float* c = (const float*)a.in[1]; const float* ada_w = (const float*)a.in[5]; const float* ada_b = (const float*)a.in[6];
        float* mod = (float*)(a.ws + WS_MOD);
        LAS float* cact = (LAS float*)lds; LAS float* red = cact + 4096;
        for (int it = blockIdx.x; it < 192; it += G) {
            const int i = it / 96, n0 = (it % 96) * 64;
            for (int e = tid; e < 4096; e += 512) { const float v = c[e]; cact[e] = v / (1.f + expf(-v)); }
            __syncthreads();
            const float* W = ada_w + (size_t)i * 1024 * 6144 + n0 + lane;
            float a0 = 0.f, a1 = 0.f, a2 = 0.f, a3 = 0.f;
            const int k0 = wave * 128;
#pragma unroll 8
            for (int k = k0; k < k0 + 128; ++k) { const float w = W[(size_t)k * 6144]; a0 += cact[k] * w; a1 += cact[1024 + k] * w; a2 += cact[2048 + k] * w; a3 += cact[3072 + k] * w; }
            red[(wave * 4 + 0) * 64 + lane] = a0; red[(wave * 4 + 1) * 64 + lane] = a1; red[(wave * 4 + 2) * 64 + lane] = a2; red[(wave * 4 + 3) * 64 + lane] = a3;
            __syncthreads();
            if (tid < 256) { const int b = tid >> 6; float s = 0.f;
#pragma unroll
                for (int w = 0; w < 8; ++w) s += red[(w * 4 + b) * 64 + lane];
                mod[(size_t)(i * 4 + b) * 6144 + n0 + lane] = s + ada_b[i * 6144 + n0 + lane]; }
            __syncthreads();
        }
    }
    {
        LAS float* scr = (LAS float*)(lds + 32768 + wave * 8704);
        const int gw = vcu * NWAVES + wave, NGW = G * NWAVES;
        unsigned char* ws = a.ws;
        constexpr int I_CIN = 16 * 96, I_COUT = 16 * 32, I_PQ = 16 * 64, I_MIN = 16 * 22, I_QB = 6 * 48, I_KVB = 4 * 64, I_MOUT = 16 * 32;
        constexpr int NITEMS = I_CIN + I_COUT + 2 * I_PQ + I_MIN + I_QB + I_KVB + I_MOUT;
        for (int it = gw; it < NITEMS; it += NGW) {
            int r = it;
            if (r < I_CIN) { transpose_item((const float*)a.in[7], 1024, 3072, (bf16*)(ws + WS_WCIN), scr, r, lane); continue; } r -= I_CIN;
            if (r < I_COUT) { transpose_item((const float*)a.in[9], 1024, 1024, (bf16*)(ws + WS_WCOUT), scr, r, lane); continue; } r -= I_COUT;
            if (r < I_PQ) { transpose_item((const float*)a.in[18], 1024, 2048, (bf16*)(ws + WS_WPQ0), scr, r, lane); continue; } r -= I_PQ;
            if (r < I_PQ) { transpose_item((const float*)a.in[18] + (size_t)1024 * 2048, 1024, 2048, (bf16*)(ws + WS_WPQ1), scr, r, lane); continue; } r -= I_PQ;
            if (r < I_MIN) { transpose_item((const float*)a.in[10], 1024, MLA_IN, (bf16*)(ws + WS_WMIN), scr, r, lane); continue; } r -= I_MIN;
            if (r < I_QB) { transpose_item((const float*)a.in[13], 384, 1536, (bf16*)(ws + WS_WQB), scr, r, lane); continue; } r -= I_QB;
            if (r < I_KVB) { transpose_item((const float*)a.in[14], 256, 2048, (bf16*)(ws + WS_WKVB), scr, r, lane); continue; } r -= I_KVB;
            transpose_item((const float*)a.in[17], 1024, 1024, (bf16*)(ws + WS_WMOUT), scr, r, lane);
        }
        const size_t gt = (size_t)vcu * 512 + tid, GT = (size_t)G * 512;
        for (size_t i = gt; i < (size_t)(MLA_IN_PAD - MLA_IN) * 1024 / 8; i += GT) ((u32x4*)(ws + WS_WMIN + (size_t)MLA_IN * 1024 * 2))[i] = (u32x4){0u, 0u, 0u, 0u};
        cvt_f32_bf16((const float*)a.in[19], (bf16*)(ws + WS_SUBK), (size_t)2 * 8 * 2 * 128 * 128 / 8, gt, GT);
        cvt_tables_fp8((const float*)a.in[20], (const float*)a.in[21], ws + WS_PU, ws + WS_PV, gt, GT);
    }
}

DI void ph_modulate(const float* x, bf16* xn, unsigned char* xn8  , const float* gain, const float* modl, int sh_off, int sc_off, int gw, int NGW, int lane) {
    for (int m = gw; m < MTOK; m += NGW) {
        const float* mb = modl + (size_t)(m >> 12) * 6144;
        const f32x4* xr = (const f32x4*)(x + (size_t)m * DM) + lane;
        f32x4 v[4]; float s = 0.f;
#pragma unroll
        for (int j = 0; j < 4; ++j) { v[j] = xr[64 * j]; s += (v[j].x * v[j].x + v[j].y * v[j].y) + (v[j].z * v[j].z + v[j].w * v[j].w); }
        const float rstd = rsqrtf(wave_sum(s) * (1.f / DM) + NORM_EPS);
        u32x2* o8 = (u32x2*)(xn + (size_t)m * DM) + lane;
#pragma unroll
        for (int j = 0; j < 4; ++j) {
            const f32x4 g = ((const f32x4*)gain)[lane + 64 * j], sh = ((const f32x4*)(mb + sh_off))[lane + 64 * j], sc = ((const f32x4*)(mb + sc_off))[lane + 64 * j];
            const f32x4 y = v[j] * rstd * g * (sc + 1.f) + sh;
            u32x2 w; w.x = pk2(y.x, y.y); w.y = pk2(y.z, y.w); o8[64 * j] = w;
            if (xn8) ((unsigned*)(xn8 + (size_t)m * DM))[lane + 64 * j] = pack4_fp8(y.x, y.y, y.z, y.w, H8_SCALE); }
    }
}

DI void ph_conv(const bf16* bcv, const float* cw, bf16* z, size_t gt, size_t GT) {
    for (size_t it = gt; it < (size_t)MTOK * 128; it += GT) {
        const int t = (int)(it >> 7), ch = (int)(it & 127) * 8, s = t & (SEQ - 1);
        const bf16* row = bcv + (size_t)t * 3072 + ch;
        const u32x4 zero = (u32x4){0u, 0u, 0u, 0u};
        const u32x4 bq = *(const u32x4*)row;
        const u32x4 c0 = *(const u32x4*)(row + 1024), v0 = *(const u32x4*)(row + 2048);
        const u32x4 c1 = s >= 1 ? *(const u32x4*)(row - 3072 + 1024) : zero, v1 = s >= 1 ? *(const u32x4*)(row - 3072 + 2048) : zero;
        const u32x4 c2 = s >= 2 ? *(const u32x4*)(row - 6144 + 1024) : zero, v2 = s >= 2 ? *(const u32x4*)(row - 6144 + 2048) : zero;
        const f32x4 w0a = *(const f32x4*)(cw + ch), w0b = *(const f32x4*)(cw + ch + 4);
        const f32x4 w1a = *(const f32x4*)(cw + 1024 + ch), w1b = *(const f32x4*)(cw + 1024 + ch + 4);
        const f32x4 w2a = *(const f32x4*)(cw + 2048 + ch), w2b = *(const f32x4*)(cw + 2048 + ch + 4);
        float r[8];
#pragma unroll
        for (int e = 0; e < 4; ++e) {
            const float w0l = e < 2 ? w0a[2 * e] : w0b[2 * e - 4], w0h = e < 2 ? w0a[2 * e + 1] : w0b[2 * e - 3];
            const float w1l = e < 2 ? w1a[2 * e] : w1b[2 * e - 4], w1h = e < 2 ? w1a[2 * e + 1] : w1b[2 * e - 3];
            const float w2l = e < 2 ? w2a[2 * e] : w2b[2 * e - 4], w2h = e < 2 ? w2a[2 * e + 1] : w2b[2 * e - 3];
            const float ut_l = bflo(c0[e]) * bflo(v0[e]), ut_h = bfhi(c0[e]) * bfhi(v0[e]);
            const float u1_l = bflo(c1[e]) * bflo(v1[e]), u1_h = bfhi(c1[e]) * bfhi(v1[e]);
            const float u2_l = bflo(c2[e]) * bflo(v2[e]), u2_h = bfhi(c2[e]) * bfhi(v2[e]);
            r[2 * e] = bflo(bq[e]) * (w0l * u2_l + w1l * u1_l + w2l * ut_l);
            r[2 * e + 1] = bfhi(bq[e]) * (w0h * u2_h + w1h * u1_h + w2h * ut_h);
        }
        u32x4 o; o.x = pk2(r[0], r[1]); o.y = pk2(r[2], r[3]); o.z = pk2(r[4], r[5]); o.w = pk2(r[6], r[7]);
        *(u32x4*)(z + (size_t)t * DM + ch) = o;
    }
}

struct EpiResGate {
    static constexpr bool PERM = false, AFTER_DRAIN = false;
    const float* base; float* out; const float* gate;
    __device__ __forceinline__ void operator()(const pg8::f32x4 (&acc)[2][2][4][2], const pg8::Unit& u, int wr, int wc, int fr, int fq) const {
        const int row0 = u.pm * 256 + wr * 64 + fr, col0 = u.pn * 256 + wc * 32 + 4 * fq;
        const float* gp = gate + (size_t)(u.pm >> 4) * 6144 + col0;
        pg8::f32x4 gv[2][2];
#pragma unroll
        for (int bj = 0; bj < 2; ++bj)
#pragma unroll
            for (int n = 0; n < 2; ++n) gv[bj][n] = *(const pg8::f32x4*)(gp + bj * 128 + n * 16);
#pragma unroll
        for (int ai = 0; ai < 2; ++ai)
#pragma unroll
            for (int m = 0; m < 4; ++m) { const size_t off = (size_t)(row0 + ai * 128 + m * 16) * DM + col0;
#pragma unroll
                for (int bj = 0; bj < 2; ++bj)
#pragma unroll
                    for (int n = 0; n < 2; ++n) { const pg8::f32x4 bs = *(const pg8::f32x4*)(base + off + bj * 128 + n * 16);
                        *(pg8::f32x4*)(out + off + bj * 128 + n * 16) = bs + gv[bj][n] * acc[ai][bj][m][n]; } }
    }
};

typedef float f32x2_t __attribute__((ext_vector_type(2))); typedef __bf16 bf16x2_t __attribute__((ext_vector_type(2)));
DI unsigned cvtpk(float lo, float hi) { f32x2_t v = {lo, hi}; bf16x2_t b = __builtin_convertvector(v, bf16x2_t); return __builtin_bit_cast(unsigned, b); }
DI unsigned f2key(float f) { const unsigned u = __float_as_uint(f); return u ^ ((unsigned)((int)u >> 31) | 0x80000000u); }
DI float key2f(unsigned k) { const unsigned u = (k & 0x80000000u) ? (k ^ 0x80000000u) : ~k; return __uint_as_float(u); }
DI unsigned umax_(unsigned a, unsigned b) { return a > b ? a : b; }
DI unsigned umin_(unsigned a, unsigned b) { return a < b ? a : b; }
template <int N> DI void bitonic_sort_desc(unsigned (&v)[N]) {
#pragma unroll
    for (int k = 2; k <= N; k <<= 1) {
#pragma unroll
        for (int j = k >> 1; j > 0; j >>= 1) {
#pragma unroll
            for (int i = 0; i < N; ++i) { const int l = i ^ j;
                if (l > i) { const bool desc = ((i & k) == 0); const unsigned x = v[i], y = v[l], mx = umax_(x, y), mn = umin_(x, y); v[i] = desc ? mx : mn; v[l] = desc ? mn : mx; } }
        }
    }
}
template <int N> DI void bitonic_merge_desc(unsigned (&v)[N]) {
#pragma unroll
    for (int j = N >> 1; j > 0; j >>= 1) {
#pragma unroll
        for (int i = 0; i < N; ++i) { const int l = i ^ j;
            if (l > i) { const unsigned x = v[i], y = v[l]; v[i] = umax_(x, y); v[l] = umin_(x, y); } }
    }
}
DI void top16_merge(unsigned (&t)[16], unsigned (&n)[16]) {
#pragma unroll
    for (int i = 0; i < 16; ++i) t[i] = umax_(t[i], n[15 - i]);
    bitonic_merge_desc<16>(t);
}

constexpr int TK_ROWB = 272, TK_TAB_OFF = 32768;
DI void topk_task(const bf16* PQ, LAS unsigned char* skl  , unsigned short* IDS, float* GATES, LAS unsigned short* tab  , int tok0, int h, int lane) {
    const int r32 = lane & 31, hi = lane >> 5;
    s16x8 qf[16];
    const bf16* qp = PQ + (size_t)(tok0 + r32) * 2048 + 256 * h + 8 * hi;
#pragma unroll
    for (int ks = 0; ks < 16; ++ks) qf[ks] = *(const s16x8*)(qp + 16 * ks);
    const int p = (r32 >> 2) & 1, keyl = (r32 & 3) + 4 * (r32 >> 3);
    const unsigned kl0 = (unsigned)((p * 128 + keyl) * TK_ROWB + 16 * hi);
    const s16x8 zero8 = (s16x8){0, 0, 0, 0, 0, 0, 0, 0};
    unsigned top[16];
#pragma unroll
    for (int i = 0; i < 16; ++i) top[i] = 0u;
#pragma unroll 1
    for (int rb = 0; rb < 8; ++rb) {
        f32x16 acc;
#pragma unroll
        for (int r = 0; r < 16; ++r) acc[r] = 0.f;
#pragma unroll
        for (int ks = 0; ks < 8; ++ks) {
            const s16x8 kf = *(const LAS s16x8*)(skl + kl0 + (unsigned)(rb * 16 * TK_ROWB + 32 * ks));
            const s16x8 a0 = p == 0 ? kf : zero8, a1 = p == 1 ? kf : zero8;
            acc = __builtin_amdgcn_mfma_f32_32x32x16_bf16(a0, qf[ks], acc, 0, 0, 0);
            acc = __builtin_amdgcn_mfma_f32_32x32x16_bf16(a1, qf[ks + 8], acc, 0, 0, 0);
        }
        unsigned nw[16];
#pragma unroll
        for (int r = 0; r < 16; ++r) nw[r] = (f2key(acc[r]) & ~127u) | (unsigned)(127 - (16 * rb + r));
        bitonic_sort_desc<16>(nw);
        top16_merge(top, nw);
    }
    unsigned LA[16], LB[16];
#pragma unroll
    for (int i = 0; i < 16; ++i) { const unsigned other = (unsigned)__shfl_xor((int)top[i], 32); LA[i] = hi ? other : top[i]; LB[i] = hi ? top[i] : other; }
#pragma unroll
    for (int i = 0; i < 16; ++i) { tab[i * 64 + lane] = (unsigned short)(127u - (LA[i] & 127u)); tab[(16 + i) * 64 + lane] = (unsigned short)(127u - (LB[i] & 127u)); }
    float av[16], bv[16];
#pragma unroll
    for (int i = 0; i < 16; ++i) { av[i] = key2f(LA[i] & ~127u); bv[i] = key2f(LB[i] & ~127u); }
    unsigned cg[4][16];
#pragma unroll
    for (int g = 0; g < 4; ++g)
#pragma unroll
        for (int e = 0; e < 16; ++e) cg[g][e] = 0u;
    {
        int cnt = 0;
#pragma unroll
        for (int i = 0; i < 16; ++i)
#pragma unroll
            for (int j = 0; j < 16; ++j)
                if ((i + 1) * (j + 1) <= 16) { cg[cnt >> 4][cnt & 15] = (f2key(av[i] + bv[j]) & ~255u) | (unsigned)(255 - (16 * i + j)); ++cnt; }
    }
    bitonic_sort_desc<16>(cg[0]); bitonic_sort_desc<16>(cg[1]); bitonic_sort_desc<16>(cg[2]); bitonic_sort_desc<16>(cg[3]);
    top16_merge(cg[0], cg[1]); top16_merge(cg[0], cg[2]); top16_merge(cg[0], cg[3]);
    LDS_WAIT(); asm volatile("" ::: "memory");
    float sv[16]; int ex[16];
#pragma unroll
    for (int k = 0; k < 16; ++k) { const unsigned key = cg[0][k]; const int pos = 255 - (int)(key & 255u); sv[k] = key2f(key & ~255u);
        const int ia = tab[(pos >> 4) * 64 + lane], ib = tab[(16 + (pos & 15)) * 64 + lane]; ex[k] = ia * 128 + ib; }
    LDS_WAIT(); asm volatile("" ::: "memory");
    const float mx = sv[0]; float sum = 0.f;
#pragma unroll
    for (int k = 0; k < 16; ++k) { sv[k] = expf(sv[k] - mx); sum += sv[k]; }
    const float inv = 1.f / sum;
    if (hi == 0) {
        unsigned short* ip = IDS + (size_t)(tok0 + r32) * 128 + h * 16; float* gp = GATES + (size_t)(tok0 + r32) * 128 + h * 16;
#pragma unroll
        for (int k = 0; k < 16; k += 8) *(u32x4*)(ip + k) = (u32x4){(unsigned)ex[k] | ((unsigned)ex[k + 1] << 16), (unsigned)ex[k + 2] | ((unsigned)ex[k + 3] << 16), (unsigned)ex[k + 4] | ((unsigned)ex[k + 5] << 16), (unsigned)ex[k + 6] | ((unsigned)ex[k + 7] << 16)};
#pragma unroll
        for (int k = 0; k < 16; k += 4) *(f32x4*)(gp + k) = (f32x4){sv[k] * inv, sv[k + 1] * inv, sv[k + 2] * inv, sv[k + 3] * inv};
    }
}
DI void ph_topk(const bf16* PQ, const bf16* SK, unsigned short* IDS, float* GATES, LAS unsigned char* lds, int bx, int G, int wave, int lane) {
    LAS unsigned short* tab = (LAS unsigned short*)(lds + wave * 4096);
    const int h = bx & 7, rank = bx >> 3, nb = (G - h + 7) >> 3, tid = wave * 64 + lane;
    LAS unsigned char* skl = lds + TK_TAB_OFF;
#pragma unroll
    for (int i = 0; i < 8; ++i) { const int c = tid + 512 * i, row = c >> 4, col = c & 15;
        *(LAS u32x4*)(skl + row * TK_ROWB + col * 16) = *(const u32x4*)(SK + ((size_t)h * 256 + row) * 128 + col * 8); }
    __syncthreads();
    for (int g = rank * 8 + wave; g < MTOK / 32; g += nb * 8) topk_task(PQ, skl, IDS, GATES, tab, g * 32, h, lane);
    __syncthreads();
}

DI float gelu_erf(float x) { return 0.5f * x * (1.f + erff(x * 0.70710678118654752f)); }
DI float dot16_fp8(const u32x4& w, const float (&h)[16]) {
    float d0 = 0.f, d1 = 0.f;
#pragma unroll
    for (int e = 0; e < 4; ++e) { const f32x2v lo = __builtin_amdgcn_cvt_pk_f32_fp8((int)w[e], false), hi = __builtin_amdgcn_cvt_pk_f32_fp8((int)w[e], true);
        d0 += lo.x * h[4 * e] + lo.y * h[4 * e + 1]; d1 += hi.x * h[4 * e + 2] + hi.y * h[4 * e + 3]; }
    return d0 + d1;
}
DI float gelu_fast(float v) {
    const float av = fabsf(v), d = av * 0.2316418882f + 1.0f, t = __builtin_amdgcn_rcpf(d);
    float q = t * 0.5307027145f + (-0.7265760135f); q = q * t + 0.7107068705f; q = q * t + (-0.142248368f); q = q * t + 0.127414796f; q = q * t;
    const float e = __builtin_amdgcn_exp2f((v * v) * (-0.72134752044f)), mm = v * (q * e);
    return v < 0.f ? mm : v - mm;
}
DI long lo64(const u32x4& w) { return (long)(((unsigned long long)w.y << 32) | w.x); }
DI long hi64(const u32x4& w) { return (long)(((unsigned long long)w.w << 32) | w.z); }
typedef __amdgpu_buffer_rsrc_t brsrc_t;
DI brsrc_t mkrsrc(const void* p, unsigned bytes) { return __builtin_amdgcn_make_buffer_rsrc((void*)p, 0, (int)bytes, 0x00020000); }
DI u32x4 bl128(brsrc_t r, unsigned voff, unsigned soff) { return __builtin_amdgcn_raw_buffer_load_b128(r, (int)voff, (int)soff, 0); }
DI u32x2 bl64(brsrc_t r, unsigned voff, unsigned soff) { return __builtin_amdgcn_raw_buffer_load_b64(r, (int)voff, (int)soff, 0); }
DI void bs64(brsrc_t r, u32x2 v, unsigned voff, unsigned soff) { __builtin_amdgcn_raw_buffer_store_b64(v, r, (int)voff, (int)soff, 0); }
DI f32x4 asf4(u32x4 v) { return __builtin_bit_cast(f32x4, v); }
template <int VAR> DI void u_issue8(u32x4 (&r)[8], const u32x4& ev, const unsigned char* Ux, unsigned coff) {
#pragma unroll
    for (int i = 0; i < 8; ++i) { const unsigned ew = ev[i >> 1], e = (i & 1) ? (ew >> 16) : (ew & 0xffffu);
        if (VAR == 1) r[i] = (u32x4){e, coff, 0x38383838u, 0x40404040u}; else r[i] = *(const u32x4*)(Ux + (e * 128u + coff)); }
}
DI void u_dot8(const u32x4 (&r)[8], const u32x4& ha, const u32x4& hb, float* p) {
    float h[16];
#pragma unroll
    for (int e = 0; e < 4; ++e) { h[2 * e] = bflo(ha[e]); h[2 * e + 1] = bfhi(ha[e]); h[8 + 2 * e] = bflo(hb[e]); h[8 + 2 * e + 1] = bfhi(hb[e]); }
#pragma unroll
    for (int i = 0; i < 8; ++i) {
        float d0 = 0.f, d1 = 0.f;
        u32x4 row = r[i]; asm volatile("" : "+v"(row));
#pragma unroll
        for (int e = 0; e < 4; ++e) { const f32x2v lo = __builtin_amdgcn_cvt_pk_f32_fp8((int)row[e], false), hi = __builtin_amdgcn_cvt_pk_f32_fp8((int)row[e], true);
            d0 = fmaf(lo.x, h[4 * e], d0); d1 = fmaf(lo.y, h[4 * e + 1], d1); d0 = fmaf(hi.x, h[4 * e + 2], d0); d1 = fmaf(hi.y, h[4 * e + 3], d1); }
        float pi = d0 + d1; asm volatile("" : "+v"(pi)); p[i] = pi;
    }
}
DI void u_reduce_store(const float* p, brsrc_t part_r, unsigned poff, int tok, bool do_store, bool b2, bool b1, bool b0) {
    float v8[8], v4[4], v2[2];
#pragma unroll
    for (int i = 0; i < 8; ++i) { const float keep = b2 ? p[i + 8] : p[i], give = b2 ? p[i] : p[i + 8]; v8[i] = keep + __shfl_xor(give, 4); }
#pragma unroll
    for (int i = 0; i < 4; ++i) { const float keep = b1 ? v8[i + 4] : v8[i], give = b1 ? v8[i] : v8[i + 4]; v4[i] = keep + __shfl_xor(give, 2); }
#pragma unroll
    for (int i = 0; i < 2; ++i) { const float keep = b0 ? v4[i + 2] : v4[i], give = b0 ? v4[i] : v4[i + 2]; v2[i] = keep + __shfl_xor(give, 1); }
    if (do_store) bs64(part_r, (u32x2){__float_as_uint(v2[0]), __float_as_uint(v2[1])}, poff, tok * 512);
}
template <int VAR> DI void ph_peer_u(const unsigned char* U8s, const unsigned short* IDS, const bf16* XN, float* PART, int bx, int G, int wave, int lane) {
    const int x = bx & 7, rank = bx >> 3, nslots = ((G - x + 7) >> 3) * 8;
    const int grp = lane >> 3, c = lane & 7;
    const bool b2 = (lane & 4) != 0, b1 = (lane & 2) != 0, b0 = (lane & 1) != 0;
    const unsigned char* Ux = U8s + (size_t)x * NEXP * 128;
    const unsigned coff = 16u * (unsigned)c;
    const unsigned hoff = (unsigned)(128 * x + 16 * c) * 2u, ioff = 32u * (unsigned)grp;
    const brsrc_t ids_r = mkrsrc(IDS, MTOK * 128 * 2), xn_r = mkrsrc(XN, MTOK * DM * 2), part_r = mkrsrc(PART + (size_t)x * MTOK * 128, MTOK * 128 * 4);
    const unsigned poff = (unsigned)(16 * grp + 8 * (int)b2 + 4 * (int)b1 + 2 * (int)b0) * 4u;
    const int t0 = rank * 8 + wave;
#define UTOK(k) ((t0 + (k) * nslots) < MTOK ? (t0 + (k) * nslots) : (MTOK - 1))
#define UVALID(k) ((t0 + (k) * nslots) < MTOK)
#define U_LOAD_IDS(E, tok) do { E[0] = bl128(ids_r, ioff, (tok) * 256); E[1] = bl128(ids_r, ioff + 16, (tok) * 256); } while (0)
#define U_LOAD_H(Ha, Hb, tok) do { Ha = bl128(xn_r, hoff, (tok) * 2048); Hb = bl128(xn_r, hoff + 16, (tok) * 2048); } while (0)
#define SB() __builtin_amdgcn_sched_barrier(0)
    u32x4 RA[8], RB[8], E0[2], E1[2], H0a, H0b, H1a, H1b; float p[16];
    U_LOAD_IDS(E0, UTOK(0)); U_LOAD_H(H0a, H0b, UTOK(0)); U_LOAD_IDS(E1, UTOK(1)); U_LOAD_H(H1a, H1b, UTOK(1));
    u_issue8<VAR>(RA, E0[0], Ux, coff);
#pragma unroll 1
    for (int k = 0; UVALID(k); k += 2) {
        u_issue8<VAR>(RB, E0[1], Ux, coff); SB();
        u_dot8(RA, H0a, H0b, p); SB();
        u_issue8<VAR>(RA, E1[0], Ux, coff); U_LOAD_IDS(E0, UTOK(k + 2)); SB();
        u_dot8(RB, H0a, H0b, p + 8); u_reduce_store(p, part_r, poff, UTOK(k), true, b2, b1, b0); U_LOAD_H(H0a, H0b, UTOK(k + 2)); SB();
        u_issue8<VAR>(RB, E1[1], Ux, coff); SB();
        u_dot8(RA, H1a, H1b, p); SB();
        u_issue8<VAR>(RA, E0[0], Ux, coff); U_LOAD_IDS(E1, UTOK(k + 3)); SB();
        u_dot8(RB, H1a, H1b, p + 8); u_reduce_store(p, part_r, poff, UTOK(k + 1), UVALID(k + 1), b2, b1, b0); U_LOAD_H(H1a, H1b, UTOK(k + 3)); SB();
    }
#undef UTOK
#undef UVALID
#undef U_LOAD_IDS
#undef U_LOAD_H
}
DI void ph_peer_c(const float* PART, const float* GATES, bf16* ACT, int gw, int NGW, int lane) {
    const float inv = 1.f / U8_SCALE;
    for (int t = gw; t < MTOK; t += NGW) {
        f32x2v s = (f32x2v){0.f, 0.f};
#pragma unroll
        for (int xx = 0; xx < 8; ++xx) { const f32x2v p = *(const f32x2v*)(PART + ((size_t)xx * MTOK + t) * 128 + 2 * lane); s.x += p.x; s.y += p.y; }
        const f32x2v g = *(const f32x2v*)(GATES + (size_t)t * 128 + 2 * lane);
        ((unsigned*)(ACT + (size_t)t * 128))[lane] = cvtpk(gelu_fast(s.x * inv) * g.x, gelu_fast(s.y * inv) * g.y);
    }
}
DI void v_issue8(u32x4 (&r)[8], const u32x4& ev, const unsigned char* Vx, unsigned coff) {
#pragma unroll
    for (int i = 0; i < 8; ++i) { const unsigned ew = ev[i >> 1], e = (i & 1) ? (ew >> 16) : (ew & 0xffffu); r[i] = *(const u32x4*)(Vx + (e * 128u + coff)); }
}
DI void v_acc8(const u32x4 (&r)[8], const u32x4& av, float* acc) {
#pragma unroll
    for (int i = 0; i < 8; ++i) {
        const unsigned aw2 = av[i >> 1]; const float aw = (i & 1) ? bfhi(aw2) : bflo(aw2);
        u32x4 row = r[i]; asm volatile("" : "+v"(row));
#pragma unroll
        for (int e = 0; e < 4; ++e) { const f32x2v lo = __builtin_amdgcn_cvt_pk_f32_fp8((int)row[e], false), hi = __builtin_amdgcn_cvt_pk_f32_fp8((int)row[e], true);
            acc[4 * e] = fmaf(aw, lo.x, acc[4 * e]); acc[4 * e + 1] = fmaf(aw, lo.y, acc[4 * e + 1]); acc[4 * e + 2] = fmaf(aw, hi.x, acc[4 * e + 2]); acc[4 * e + 3] = fmaf(aw, hi.y, acc[4 * e + 3]); }
        asm volatile("" : "+v"(acc[0]), "+v"(acc[1]), "+v"(acc[2]), "+v"(acc[3]), "+v"(acc[4]), "+v"(acc[5]), "+v"(acc[6]), "+v"(acc[7]),
                          "+v"(acc[8]), "+v"(acc[9]), "+v"(acc[10]), "+v"(acc[11]), "+v"(acc[12]), "+v"(acc[13]), "+v"(acc[14]), "+v"(acc[15]));
    }
}
DI void v_reduce_store(float* acc, const u32x2& xv, brsrc_t xout_r, brsrc_t g2_r, unsigned xoff, int tok, bool do_store, bool b5, bool b4, bool b3) {
    float v8[8], v4[4], v2[2];
#pragma unroll
    for (int i = 0; i < 8; ++i) { const float keep = b5 ? acc[i + 8] : acc[i], give = b5 ? acc[i] : acc[i + 8]; v8[i] = keep + __shfl_xor(give, 32); }
#pragma unroll
    for (int i = 0; i < 4; ++i) { const float keep = b4 ? v8[i + 4] : v8[i], give = b4 ? v8[i] : v8[i + 4]; v4[i] = keep + __shfl_xor(give, 16); }
#pragma unroll
    for (int i = 0; i < 2; ++i) { const float keep = b3 ? v4[i + 2] : v4[i], give = b3 ? v4[i] : v4[i + 2]; v2[i] = keep + __shfl_xor(give, 8); }
    const u32x2 gg = bl64(g2_r, xoff, (tok >> 12) * (6144 * 4));
    u32x2 xo; xo.x = __float_as_uint(__uint_as_float(xv.x) + __uint_as_float(gg.x) * v2[0] * (1.f / V8_SCALE)); xo.y = __float_as_uint(__uint_as_float(xv.y) + __uint_as_float(gg.y) * v2[1] * (1.f / V8_SCALE));
    if (do_store) bs64(xout_r, xo, xoff, tok * 4096);
#pragma unroll
    for (int i = 0; i < 16; ++i) acc[i] = 0.f;
}
DI void ph_peer_v(const unsigned char* V8  , const unsigned short* IDS, const bf16* ACT, const float* Xin, float* Xout, const float* g2, int bx, int G, int wave, int lane) {
    const int x = bx & 7, rank = bx >> 3, nslots = ((G - x + 7) >> 3) * 8;
    const bool b5 = (lane & 32) != 0, b4 = (lane & 16) != 0, b3 = (lane & 8) != 0;
    const int grp = lane >> 3;
    const unsigned char* Vx = V8 + (size_t)x * NEXP * 128;
    const unsigned coff = 16u * (unsigned)(lane & 7);
    const int dim = 128 * x + 16 * (lane & 7) + 2 * grp;
    const unsigned ioff = 32u * (unsigned)grp, xoff = 4u * (unsigned)dim;
    const brsrc_t ids_r = mkrsrc(IDS, MTOK * 128 * 2), act_r = mkrsrc(ACT, MTOK * 128 * 2), xin_r = mkrsrc(Xin, MTOK * DM * 4), xout_r = mkrsrc(Xout, MTOK * DM * 4), g2_r = mkrsrc(g2, 4 * 6144 * 4);
    const int t0 = rank * 8 + wave;
#define VTOK(k) ((t0 + (k) * nslots) < MTOK ? (t0 + (k) * nslots) : (MTOK - 1))
#define VVALID(k) ((t0 + (k) * nslots) < MTOK)
#define V_LOAD_IDS(E, tok) do { E[0] = bl128(ids_r, ioff, (tok) * 256); E[1] = bl128(ids_r, ioff + 16, (tok) * 256); } while (0)
#define V_LOAD_AX(AV, XV, tok) do { AV[0] = bl128(act_r, ioff, (tok) * 256); AV[1] = bl128(act_r, ioff + 16, (tok) * 256); XV = bl64(xin_r, xoff, (tok) * 4096); } while (0)
    u32x4 RA[8], RB[8], E0[2], E1[2], A0[2], A1[2]; u32x2 X0, X1; float acc[16];
#pragma unroll
    for (int i = 0; i < 16; ++i) acc[i] = 0.f;
    V_LOAD_IDS(E0, VTOK(0)); V_LOAD_AX(A0, X0, VTOK(0)); V_LOAD_IDS(E1, VTOK(1)); V_LOAD_AX(A1, X1, VTOK(1));
    v_issue8(RA, E0[0], Vx, coff);
#pragma unroll 1
    for (int k = 0; VVALID(k); k += 2) {
        v_issue8(RB, E0[1], Vx, coff); SB();
        v_acc8(RA, A0[0], acc); SB();
        v_issue8(RA, E1[0], Vx, coff); V_LOAD_IDS(E0, VTOK(k + 2)); SB();
        v_acc8(RB, A0[1], acc); v_reduce_store(acc, X0, xout_r, g2_r, xoff, VTOK(k), true, b5, b4, b3); V_LOAD_AX(A0, X0, VTOK(k + 2)); SB();
        v_issue8(RB, E1[1], Vx, coff); SB();
        v_acc8(RA, A1[0], acc); SB();
        v_issue8(RA, E0[0], Vx, coff); V_LOAD_IDS(E1, VTOK(k + 3)); SB();
        v_acc8(RB, A1[1], acc); v_reduce_store(acc, X1, xout_r, g2_r, xoff, VTOK(k + 1), VVALID(k + 1), b5, b4, b3); V_LOAD_AX(A1, X1, VTOK(k + 3)); SB();
    }
#undef VTOK
#undef VVALID
#undef V_LOAD_IDS
#undef V_LOAD_AX
#undef SB
}

DI void ph_latnorm(const bf16* LAT, const float* qg, const float* kvg, bf16* QN, bf16* KVN, int gw, int NGW, int lane) {
    for (int t = gw; t < MTOK; t += NGW) {
        const unsigned* lr = (const unsigned*)(LAT + (size_t)t * MLA_IN_PAD);
        unsigned q[3], k[2]; float sq = 0.f, sk = 0.f;
#pragma unroll
        for (int j = 0; j < 3; ++j) { q[j] = lr[lane + 64 * j]; sq += bflo(q[j]) * bflo(q[j]) + bfhi(q[j]) * bfhi(q[j]); }
#pragma unroll
        for (int j = 0; j < 2; ++j) { k[j] = lr[192 + lane + 64 * j]; sk += bflo(k[j]) * bflo(k[j]) + bfhi(k[j]) * bfhi(k[j]); }
        const float rq = rsqrtf(wave_sum(sq) * (1.f / QLORA) + NORM_EPS), rk = rsqrtf(wave_sum(sk) * (1.f / KVLORA) + NORM_EPS);
        unsigned* qo = (unsigned*)(QN + (size_t)t * QLORA); unsigned* ko = (unsigned*)(KVN + (size_t)t * KVLORA);
#pragma unroll
        for (int j = 0; j < 3; ++j) { const int c = 2 * (lane + 64 * j); qo[lane + 64 * j] = pk2(bflo(q[j]) * rq * qg[c], bfhi(q[j]) * rq * qg[c + 1]); }
#pragma unroll
        for (int j = 0; j < 2; ++j) { const int c = 2 * (lane + 64 * j); ko[lane + 64 * j] = pk2(bflo(k[j]) * rk * kvg[c], bfhi(k[j]) * rk * kvg[c + 1]); }
    }
}

DI void ph_qkprep(const bf16* QRAW, const bf16* KVRAW, const bf16* LAT, const int* positions, const float* qg, const float* kg,
                  bf16* Qf, bf16* Kf, bf16* Vt, int gw, int NGW, int lane) {
    const int hh = lane >> 3, p = lane & 7;
    float qgn[16], qgr[8], kgn[16], kgr[8], invf[8];
#pragma unroll
    for (int i = 0; i < 16; ++i) { qgn[i] = qg[16 * p + i] * QSCALE; kgn[i] = kg[16 * p + i]; }
#pragma unroll
    for (int i = 0; i < 8; ++i) { qgr[i] = qg[128 + 8 * p + i] * QSCALE; kgr[i] = kg[128 + 8 * p + i]; invf[i] = exp2f(-(float)((8 * p + i) & 31) * (13.287712379549449f / 32.f)); }
    for (int task = gw; task < MTOK / 8; task += NGW) {
        const int t0 = task * 8, b = t0 >> 12, s0 = t0 & (SEQ - 1);
#pragma unroll 1
        for (int tt = 0; tt < 8; ++tt) {
            const int t = t0 + tt, s = s0 + tt;
            const float posf = (float)positions[t];
            float cs[8], sn[8];
#pragma unroll
            for (int i = 0; i < 8; ++i) { const float ang = posf * invf[i]; double rev = (double)ang * 0.15915494309189535; rev -= floor(rev); const float rv = (float)rev; sn[i] = __builtin_amdgcn_sinf(rv); cs[i] = __builtin_amdgcn_cosf(rv); }
            const u32x4 kr4 = *(const u32x4*)(LAT + (size_t)t * MLA_IN_PAD + 640 + 8 * p);
#pragma unroll
            for (int which = 0; which < 2; ++which) {
                const bf16* src = which == 0 ? QRAW + (size_t)t * 1536 + QKH * hh : KVRAW + (size_t)t * 2048 + 256 * hh;
                const u32x4 n0 = *(const u32x4*)(src + 16 * p), n1 = *(const u32x4*)(src + 16 * p + 8);
                const u32x4 r0 = which == 0 ? *(const u32x4*)(src + 128 + 8 * p) : kr4;
                float xn[16], xr[8];
#pragma unroll
                for (int e = 0; e < 4; ++e) { xn[2 * e] = bflo(n0[e]); xn[2 * e + 1] = bfhi(n0[e]); xn[8 + 2 * e] = bflo(n1[e]); xn[8 + 2 * e + 1] = bfhi(n1[e]); xr[2 * e] = bflo(r0[e]); xr[2 * e + 1] = bfhi(r0[e]); }
                float ss = 0.f;
#pragma unroll
                for (int i = 0; i < 16; ++i) ss = fmaf(xn[i], xn[i], ss);
#pragma unroll
                for (int i = 0; i < 8; ++i) ss = fmaf(xr[i], xr[i], ss);
                ss += __shfl_xor(ss, 1); ss += __shfl_xor(ss, 2); ss += __shfl_xor(ss, 4);
                const float rstd = rsqrtf(ss * (1.f / QKH) + NORM_EPS);
                float yr[8], ro[8];
#pragma unroll
                for (int i = 0; i < 16; ++i) xn[i] = xn[i] * rstd * (which == 0 ? qgn[i] : kgn[i]);
#pragma unroll
                for (int i = 0; i < 8; ++i) yr[i] = xr[i] * rstd * (which == 0 ? qgr[i] : kgr[i]);
#pragma unroll
                for (int i = 0; i < 8; ++i) { const float pr = __shfl_xor(yr[i], 4); ro[i] = p < 4 ? yr[i] * cs[i] - pr * sn[i] : pr * sn[i] + yr[i] * cs[i]; }
                bf16* dst = (which == 0 ? Qf : Kf) + ((size_t)(b * NH + hh) * SEQ + s) * QKH;
                u32x4 o0, o1, o2;
                o0.x = cvtpk(xn[0], xn[1]); o0.y = cvtpk(xn[2], xn[3]); o0.z = cvtpk(xn[4], xn[5]); o0.w = cvtpk(xn[6], xn[7]);
                o1.x = cvtpk(xn[8], xn[9]); o1.y = cvtpk(xn[10], xn[11]); o1.z = cvtpk(xn[12], xn[13]); o1.w = cvtpk(xn[14], xn[15]);
                o2.x = cvtpk(ro[0], ro[1]); o2.y = cvtpk(ro[2], ro[3]); o2.z = cvtpk(ro[4], ro[5]); o2.w = cvtpk(ro[6], ro[7]);
                *(u32x4*)(dst + 16 * p) = o0; *(u32x4*)(dst + 16 * p + 8) = o1; *(u32x4*)(dst + 128 + 8 * p) = o2;
            }
        }
#pragma unroll 1
        for (int h = 0; h < NH; ++h)
#pragma unroll
            for (int dd = 0; dd < 128; dd += 64) {
                const bf16* vp = KVRAW + (size_t)t0 * 2048 + 256 * h + 128 + dd + lane;
                unsigned w[4];
#pragma unroll
                for (int i = 0; i < 4; ++i) w[i] = (unsigned)vp[(size_t)(2 * i) * 2048] | ((unsigned)vp[(size_t)(2 * i + 1) * 2048] << 16);
                *(u32x4*)(Vt + ((size_t)(b * NH + h) * VH + dd + lane) * SEQ + s0) = (u32x4){w[0], w[1], w[2], w[3]};
            }
    }
}

DI void attn_unit(const bf16* Qf, const bf16* Kf, const bf16* Vt, bf16* O, int bh, int qb, int wave, int lane) {
    const int r32 = lane & 31, hi = lane >> 5;
    const int q0 = qb * 256 + wave * 32;
    s16x8 qf[12];
    { const bf16* Qp = Qf + ((size_t)bh * SEQ + q0 + r32) * QKH + 8 * hi;
#pragma unroll
      for (int ks = 0; ks < 12; ++ks) qf[ks] = *(const s16x8*)(Qp + 16 * ks); }
    f32x16 o[4];
#pragma unroll
    for (int d = 0; d < 4; ++d)
#pragma unroll
        for (int r = 0; r < 16; ++r) o[d][r] = 0.f;
    float m = -1e30f, l = 0.f;
    const bf16* Kp = Kf + ((size_t)bh * SEQ + r32) * QKH + 8 * hi;
    const bf16* Vp = Vt + ((size_t)bh * VH + r32) * SEQ + 4 * hi;
    const int nkt = q0 / 32 + 1;
#pragma unroll 1
    for (int kt = 0; kt < nkt; ++kt) {
        f32x16 sc;
#pragma unroll
        for (int r = 0; r < 16; ++r) sc[r] = 0.f;
        const bf16* kp = Kp + (size_t)kt * 32 * QKH;
#pragma unroll
        for (int ks = 0; ks < 12; ++ks) sc = __builtin_amdgcn_mfma_f32_32x32x16_bf16(*(const s16x8*)(kp + 16 * ks), qf[ks], sc, 0, 0, 0);
        if (kt == nkt - 1) {
#pragma unroll
            for (int r = 0; r < 16; ++r) if (crow(r, hi) > r32) sc[r] = -INFINITY;
        }
        float mt = sc[0];
#pragma unroll
        for (int r = 1; r < 16; ++r) mt = fmaxf(mt, sc[r]);
        mt = fmaxf(mt, __shfl_xor(mt, 32));
        const float mn = fmaxf(m, mt), alpha = __builtin_amdgcn_exp2f(m - mn);
        m = mn; l *= alpha;
#pragma unroll
        for (int d = 0; d < 4; ++d)
#pragma unroll
            for (int r = 0; r < 16; ++r) o[d][r] *= alpha;
        float ps = 0.f;
#pragma unroll
        for (int r = 0; r < 16; ++r) { sc[r] = __builtin_amdgcn_exp2f(sc[r] - mn); ps += sc[r]; }
        l += ps;
#pragma unroll
        for (int s = 0; s < 2; ++s) {
            u32x4 pw; pw.x = cvtpk(sc[8 * s], sc[8 * s + 1]); pw.y = cvtpk(sc[8 * s + 2], sc[8 * s + 3]); pw.z = cvtpk(sc[8 * s + 4], sc[8 * s + 5]); pw.w = cvtpk(sc[8 * s + 6], sc[8 * s + 7]);
            const s16x8 pb = __builtin_bit_cast(s16x8, pw);
#pragma unroll
            for (int d = 0; d < 4; ++d) {
                const bf16* vp = Vp + (size_t)d * 32 * SEQ + kt * 32 + 16 * s;
                const s16x4 lo = *(const s16x4*)vp, hh = *(const s16x4*)(vp + 8);
                const s16x8 va = __builtin_shufflevector(lo, hh, 0, 1, 2, 3, 4, 5, 6, 7);
                o[d] = __builtin_amdgcn_mfma_f32_32x32x16_bf16(va, pb, o[d], 0, 0, 0);
            }
        }
    }
    l += __shfl_xor(l, 32);
    const float inv = 1.f / l;
    bf16* Op = O + ((size_t)((bh >> 3) * SEQ + q0 + r32)) * DM + (bh & 7) * VH + 4 * hi;
#pragma unroll
    for (int d = 0; d < 4; ++d)
#pragma unroll
        for (int g = 0; g < 4; ++g) { u32x2 w; w.x = cvtpk(o[d][4 * g] * inv, o[d][4 * g + 1] * inv); w.y = cvtpk(o[d][4 * g + 2] * inv, o[d][4 * g + 3] * inv);
            *(u32x2*)(Op + 32 * d + 8 * g) = w; }
}
constexpr int AT_KROW = 400, AT_VROW = 136, AT_KBYTES = 64 * AT_KROW, AT_VBYTES = 128 * AT_VROW, AT_STAGE = AT_KBYTES + AT_VBYTES;
DI void attn_unit_lds(const bf16* Qf, const bf16* Kf, const bf16* Vt, bf16* O, LAS unsigned char* lds, int bh, int qb, int wave, int lane) {
    const int r32 = lane & 31, hi = lane >> 5, tid = wave * 64 + lane;
    const int q0 = qb * 256 + wave * 32;
    s16x8 qf[12];
    { const bf16* Qp = Qf + ((size_t)bh * SEQ + q0 + r32) * QKH + 8 * hi;
#pragma unroll
      for (int ks = 0; ks < 12; ++ks) qf[ks] = *(const s16x8*)(Qp + 16 * ks); }
    f32x16 o[4];
#pragma unroll
    for (int d = 0; d < 4; ++d)
#pragma unroll
        for (int r = 0; r < 16; ++r) o[d][r] = 0.f;
    float m = -1e30f, l = 0.f;
    const int NT = 4 * (qb + 1);
    const __amdgpu_buffer_rsrc_t krs = __builtin_amdgcn_make_buffer_rsrc((void*)(Kf + (size_t)bh * SEQ * QKH), 0, SEQ * QKH * 2, 0x00020000);
    const __amdgpu_buffer_rsrc_t vrs = __builtin_amdgcn_make_buffer_rsrc((void*)(Vt + (size_t)bh * VH * SEQ), 0, VH * SEQ * 2, 0x00020000);
    unsigned kgo[3], kl[3], vgo[2], vl[2];
#pragma unroll
    for (int i = 0; i < 3; ++i) { const int c = tid + 512 * i, row = c / 24, col = c - row * 24; kgo[i] = (unsigned)(row * 384 + col * 16); kl[i] = (unsigned)(row * AT_KROW + col * 16); }
#pragma unroll
    for (int i = 0; i < 2; ++i) { const int c = tid + 512 * i, d = c >> 3, part = c & 7; vgo[i] = (unsigned)(d * (SEQ * 2) + part * 16); vl[i] = (unsigned)(AT_KBYTES + d * AT_VROW + part * 16); }
    u32x4 kr[3], vr[2];
#pragma unroll
    for (int i = 0; i < 3; ++i) kr[i] = __builtin_amdgcn_raw_buffer_load_b128(krs, kgo[i], 0, 0);
#pragma unroll
    for (int i = 0; i < 2; ++i) vr[i] = __builtin_amdgcn_raw_buffer_load_b128(vrs, vgo[i], 0, 0);
#pragma unroll
    for (int i = 0; i < 3; ++i) *(LAS u32x4*)(lds + kl[i]) = kr[i];
#pragma unroll
    for (int i = 0; i < 2; ++i) { *(LAS u32x2*)(lds + vl[i]) = (u32x2){vr[i].x, vr[i].y}; *(LAS u32x2*)(lds + vl[i] + 8) = (u32x2){vr[i].z, vr[i].w}; }
    __syncthreads();
    const unsigned kfo = (unsigned)(r32 * AT_KROW + 16 * hi), vfo = (unsigned)(AT_KBYTES + r32 * AT_VROW + 8 * hi);
#pragma unroll 1
    for (int t = 0; t < NT; ++t) {
        const unsigned sb = (unsigned)((t & 1) * AT_STAGE), sn = (unsigned)(((t + 1) & 1) * AT_STAGE);
        const bool more = t + 1 < NT;
        if (more) {
#pragma unroll
            for (int i = 0; i < 3; ++i) kr[i] = __builtin_amdgcn_raw_buffer_load_b128(krs, kgo[i], (t + 1) * (64 * 384), 0);
#pragma unroll
            for (int i = 0; i < 2; ++i) vr[i] = __builtin_amdgcn_raw_buffer_load_b128(vrs, vgo[i], (t + 1) * 128, 0);
        }
        const int k0 = 64 * t;
        if (k0 <= q0 + 31) {
            f32x16 s0, s1;
#pragma unroll
            for (int r = 0; r < 16; ++r) { s0[r] = 0.f; s1[r] = 0.f; }
#pragma unroll
            for (int ks = 0; ks < 12; ++ks) {
                const s16x8 ka = *(const LAS s16x8*)(lds + sb + kfo + 32 * ks), kb = *(const LAS s16x8*)(lds + sb + kfo + 32 * AT_KROW + 32 * ks);
                s0 = __builtin_amdgcn_mfma_f32_32x32x16_bf16(ka, qf[ks], s0, 0, 0, 0);
                s1 = __builtin_amdgcn_mfma_f32_32x32x16_bf16(kb, qf[ks], s1, 0, 0, 0);
                if ((ks & 3) == 3) __builtin_amdgcn_sched_barrier(0);
            }
            if (k0 + 63 > q0) {
                const int qa = q0 + r32 - k0 - 4 * hi;
#pragma unroll
                for (int r = 0; r < 16; ++r) { if (((r & 3) + 8 * (r >> 2)) > qa) s0[r] = -INFINITY; if ((32 + (r & 3) + 8 * (r >> 2)) > qa) s1[r] = -INFINITY; }
            }
            float mt = fmaxf(s0[0], s1[0]);
#pragma unroll
            for (int r = 1; r < 16; ++r) mt = fmaxf(mt, fmaxf(s0[r], s1[r]));
            mt = fmaxf(mt, __shfl_xor(mt, 32));
            const float mn = fmaxf(m, mt), alpha = __builtin_amdgcn_exp2f(m - mn);
            m = mn; l *= alpha;
#pragma unroll
            for (int d = 0; d < 4; ++d)
#pragma unroll
                for (int r = 0; r < 16; ++r) o[d][r] *= alpha;
            float ps = 0.f;
#pragma unroll
            for (int r = 0; r < 16; ++r) { s0[r] = __builtin_amdgcn_exp2f(s0[r] - mn); s1[r] = __builtin_amdgcn_exp2f(s1[r] - mn); ps += s0[r] + s1[r]; }
            l += ps;
#pragma unroll
            for (int s = 0; s < 4; ++s) {
                u32x4 pw;
                if (s < 2) { pw.x = cvtpk(s0[8 * s], s0[8 * s + 1]); pw.y = cvtpk(s0[8 * s + 2], s0[8 * s + 3]); pw.z = cvtpk(s0[8 * s + 4], s0[8 * s + 5]); pw.w = cvtpk(s0[8 * s + 6], s0[8 * s + 7]); }
                else { const int z = s - 2; pw.x = cvtpk(s1[8 * z], s1[8 * z + 1]); pw.y = cvtpk(s1[8 * z + 2], s1[8 * z + 3]); pw.z = cvtpk(s1[8 * z + 4], s1[8 * z + 5]); pw.w = cvtpk(s1[8 * z + 6], s1[8 * z + 7]); }
                const s16x8 pb = __builtin_bit_cast(s16x8, pw);
#pragma unroll
                for (int d = 0; d < 4; ++d) {
                    const unsigned va = sb + vfo + (unsigned)(d * 32 * AT_VROW + 32 * s);
                    const s16x4 lo = *(const LAS s16x4*)(lds + va), hh = *(const LAS s16x4*)(lds + va + 16);
                    const s16x8 vfrag = __builtin_shufflevector(lo, hh, 0, 1, 2, 3, 4, 5, 6, 7);
                    o[d] = __builtin_amdgcn_mfma_f32_32x32x16_bf16(vfrag, pb, o[d], 0, 0, 0);
                }
                __builtin_amdgcn_sched_barrier(0);
            }
        }
        if (more) {
#pragma unroll
            for (int i = 0; i < 3; ++i) *(LAS u32x4*)(lds + sn + kl[i]) = kr[i];
#pragma unroll
            for (int i = 0; i < 2; ++i) { *(LAS u32x2*)(lds + sn + vl[i]) = (u32x2){vr[i].x, vr[i].y}; *(LAS u32x2*)(lds + sn + vl[i] + 8) = (u32x2){vr[i].z, vr[i].w}; }
        }
        __syncthreads();
    }
    l += __shfl_xor(l, 32);
    const float inv = 1.f / l;
    bf16* Op = O + ((size_t)((bh >> 3) * SEQ + q0 + r32)) * DM + (bh & 7) * VH + 4 * hi;
#pragma unroll
    for (int d = 0; d < 4; ++d)
#pragma unroll
        for (int g = 0; g < 4; ++g) { u32x2 w; w.x = cvtpk(o[d][4 * g] * inv, o[d][4 * g + 1] * inv); w.y = cvtpk(o[d][4 * g + 2] * inv, o[d][4 * g + 3] * inv);
            *(u32x2*)(Op + 32 * d + 8 * g) = w; }
}
DI void ph_attn(const bf16* Qf, const bf16* Kf, const bf16* Vt, bf16* O, LAS unsigned char* lds, int vcu, int G, int wave, int lane) {
    for (int p = vcu; p < 256; p += G) {
        const int bh = p >> 3, s8 = p & 7;
#pragma unroll 1
        for (int u = 0; u < 2; ++u) attn_unit_lds(Qf, Kf, Vt, O, lds, bh, u ? s8 : 15 - s8, wave, lane);
    }
}

__global__ void __launch_bounds__(NWAVES * 64, 2) mk_fwd(Args args) {
    extern __shared__ __attribute__((aligned(16))) unsigned char lds_raw[];
    LAS unsigned char* lds = (LAS unsigned char*)lds_raw;
    const int tid = threadIdx.x, lane = tid & 63, wave = __builtin_amdgcn_readfirstlane(tid >> 6);
    const int G = gridDim.x, bx = blockIdx.x, vcu = (G % 8 == 0) ? (bx % 8) * (G / 8) + bx / 8 : bx;
    const int gw = vcu * NWAVES + wave, NGW = G * NWAVES;
    const size_t GT = (size_t)G * 512;
    unsigned char* ws = args.ws;
    for (int u = tid; u < (LDS_BYTES - LDSCTL_OFF) / 4; u += NWAVES * 64) ((LAS unsigned*)(lds + LDSCTL_OFF))[u] = 0u;
    __syncthreads();
    const bool multi = (args.ph_hi - args.ph_lo) > 1;
    XcdBarrier bar; bar.bar = (unsigned*)(ws + WS_CTL) + CW_BAR; bar.x = 0; bar.st = (volatile LAS unsigned*)(lds + MISC_OFF) + 8;
    if (multi) bar = xcd_barrier_post((unsigned*)(ws + WS_CTL) + CW_BAR, (volatile LAS unsigned*)(lds + MISC_OFF) + 8);

    float* X = args.out;
    const float* mod = (const float*)(ws + WS_MOD);
    bf16* XN = (bf16*)(ws + WS_XN);

    const int lo = args.ph_lo, hi = args.ph_hi;
#define IN(k) (EN(k) && lo <= (k) && (k) < hi)
    auto opq = [](int v) { asm volatile("" : "+v"(v)); return v; };
#define LN opq(lane)
#define TD opq(tid)
#define GTID ((size_t)vcu * 512 + (size_t)opq(tid))
#define SEAM(k) do { if (lo <= (k) && (k) + 1 < hi) xcd_barrier(bar); } while (0)
#define GEMM_BF16(Aptr, Bptr, NN, KK, Optr, LDC) do { pg8::Gemm g{(const bf16*)(Aptr), (const bf16*)(Bptr), MTOK, (NN), (KK)}; pg8::StaticOrder S; S.init(MTOK, (NN), G, bx); \
        pg8::EpiBf16<0> E{(bf16*)(Optr), (LDC), nullptr, 0, 0, 1.f}; pg8::gemm_phase<pg8::EpiBf16<0>, pg8::StaticOrder, true, true>(lds, g, S, E); } while (0)
#define GEMM_RES(Aptr, Bptr, BASE, OUT, GATE) do { pg8::Gemm g{(const bf16*)(Aptr), (const bf16*)(Bptr), MTOK, DM, DM}; pg8::StaticOrder S; S.init(MTOK, DM, G, bx); \
        EpiResGate E{(BASE), (OUT), (GATE)}; pg8::gemm_phase<EpiResGate, pg8::StaticOrder, true, true>(lds, g, S, E); } while (0)

    if (IN(0)) for (int r_ = 0; r_ < NREP(0); ++r_) ph_prologue(args, lds, TD, wave, vcu, G);
    SEAM(0);
    if (IN(1)) for (int r_ = 0; r_ < NREP(1); ++r_) ph_modulate((const float*)args.in[0], XN, nullptr, (const float*)args.in[3], mod, 0, 1024, gw, NGW, LN);
    SEAM(1);
    if (IN(2)) for (int r_ = 0; r_ < NREP(2); ++r_) GEMM_BF16(XN, ws + WS_WCIN, 3072, 1024, ws + WS_BCV, 3072);
    SEAM(2);
    if (IN(3)) for (int r_ = 0; r_ < NREP(3); ++r_) ph_conv((const bf16*)(ws + WS_BCV), (const float*)args.in[8], (bf16*)(ws + WS_Z), GTID, GT);
    SEAM(3);
    if (IN(4)) for (int r_ = 0; r_ < NREP(4); ++r_) GEMM_RES(ws + WS_Z, ws + WS_WCOUT, (const float*)args.in[0], X, mod + 2048);
    SEAM(4);
    if (IN(5)) for (int r_ = 0; r_ < NREP(5); ++r_) ph_modulate(X, XN, nullptr, (const float*)args.in[4], mod, 3072, 4096, gw, NGW, LN);
    SEAM(5);
    if (IN(6)) for (int r_ = 0; r_ < NREP(6); ++r_) GEMM_BF16(XN, ws + WS_WPQ0, 2048, 1024, ws + WS_PQ, 2048);
    SEAM(6);
    if (IN(7)) for (int r_ = 0; r_ < NREP(7); ++r_) ph_topk((const bf16*)(ws + WS_PQ), (const bf16*)(ws + WS_SUBK), (unsigned short*)(ws + WS_IDS), (float*)(ws + WS_GATES), lds, bx, G, wave, LN);
    SEAM(7);
    if (IN(8)) { ph_peer_u<0>(ws + WS_PU, (const unsigned short*)(ws + WS_IDS), XN, (float*)(ws + WS_PART), bx, G, wave, LN);
        for (int r_ = 1; r_ < NREP(8); ++r_) ph_peer_u<PROBE_VAR>(ws + WS_PU, (const unsigned short*)(ws + WS_IDS), XN, (float*)(ws + WS_DUMMY), bx, G, wave, LN); }
    SEAM(8);
    if (IN(9)) for (int r_ = 0; r_ < NREP(9); ++r_) ph_peer_c((const float*)(ws + WS_PART), (const float*)(ws + WS_GATES), (bf16*)(ws + WS_ACT), gw, NGW, LN);
    SEAM(9);
    if (IN(10)) for (int r_ = 0; r_ < NREP(10); ++r_) ph_peer_v(ws + WS_PV, (const unsigned short*)(ws + WS_IDS), (const bf16*)(ws + WS_ACT), X, (r_ + 1 < NREP(10) ? (float*)(ws + WS_DUMMY) : X), mod + 5120, bx, G, wave, LN);
    SEAM(10);
    if (IN(11)) for (int r_ = 0; r_ < NREP(11); ++r_) ph_modulate(X, XN, nullptr, (const float*)args.in[3] + DM, mod + (size_t)4 * 6144, 0, 1024, gw, NGW, LN);
    SEAM(11);
    if (IN(12)) for (int r_ = 0; r_ < NREP(12); ++r_) GEMM_BF16(XN, ws + WS_WMIN, MLA_IN_PAD, 1024, ws + WS_LAT, MLA_IN_PAD);
    SEAM(12);
    if (IN(13)) for (int r_ = 0; r_ < NREP(13); ++r_) ph_latnorm((const bf16*)(ws + WS_LAT), (const float*)args.in[11], (const float*)args.in[12], (bf16*)(ws + WS_QN), (bf16*)(ws + WS_KVN), gw, NGW, LN);
    SEAM(13);
    if (IN(14)) for (int r_ = 0; r_ < NREP(14); ++r_) { GEMM_BF16(ws + WS_QN, ws + WS_WQB, 1536, QLORA, ws + WS_QRAW, 1536); GEMM_BF16(ws + WS_KVN, ws + WS_WKVB, 2048, KVLORA, ws + WS_KVRAW, 2048); }
    SEAM(14);
    if (IN(15)) for (int r_ = 0; r_ < NREP(15); ++r_) ph_qkprep((const bf16*)(ws + WS_QRAW), (const bf16*)(ws + WS_KVRAW), (const bf16*)(ws + WS_LAT), (const int*)args.in[2], (const float*)args.in[15], (const float*)args.in[16],
                          (bf16*)(ws + WS_QF), (bf16*)(ws + WS_KF), (bf16*)(ws + WS_VT), gw, NGW, LN);
    SEAM(15);
    if (IN(16)) for (int r_ = 0; r_ < NREP(16); ++r_) ph_attn((const bf16*)(ws + WS_QF), (const bf16*)(ws + WS_KF), (const bf16*)(ws + WS_VT), (bf16*)(ws + WS_O), lds, vcu, G, wave, LN);
    SEAM(16);
    if (IN(17)) for (int r_ = 0; r_ < NREP(17); ++r_) GEMM_RES(ws + WS_O, ws + WS_WMOUT, (const float*)X, (r_ + 1 < NREP(17) ? (float*)(ws + WS_DUMMY) : X), mod + (size_t)4 * 6144 + 2048);
    SEAM(17);
    if (IN(18)) for (int r_ = 0; r_ < NREP(18); ++r_) ph_modulate(X, XN, nullptr, (const float*)args.in[4] + DM, mod + (size_t)4 * 6144, 3072, 4096, gw, NGW, LN);
    SEAM(18);
    if (IN(19)) for (int r_ = 0; r_ < NREP(19); ++r_) GEMM_BF16(XN, ws + WS_WPQ1, 2048, 1024, ws + WS_PQ, 2048);
    SEAM(19);
    if (IN(20)) for (int r_ = 0; r_ < NREP(20); ++r_) ph_topk((const bf16*)(ws + WS_PQ), (const bf16*)(ws + WS_SUBK) + (size_t)8 * 2 * 128 * 128, (unsigned short*)(ws + WS_IDS), (float*)(ws + WS_GATES), lds, bx, G, wave, LN);
    SEAM(20);
    if (IN(21)) for (int r_ = 0; r_ < NREP(21); ++r_) ph_peer_u<0>(ws + WS_PU + (size_t)8 * NEXP * 128, (const unsigned short*)(ws + WS_IDS), XN, (float*)(ws + WS_PART), bx, G, wave, LN);
    SEAM(21);
    if (IN(22)) for (int r_ = 0; r_ < NREP(22); ++r_) ph_peer_c((const float*)(ws + WS_PART), (const float*)(ws + WS_GATES), (bf16*)(ws + WS_ACT), gw, NGW, LN);
    SEAM(22);
    if (IN(23)) for (int r_ = 0; r_ < NREP(23); ++r_) ph_peer_v(ws + WS_PV + (size_t)8 * NEXP * 128, (const unsigned short*)(ws + WS_IDS), (const bf16*)(ws + WS_ACT), X, (r_ + 1 < NREP(23) ? (float*)(ws + WS_DUMMY) : X), mod + (size_t)4 * 6144 + 5120, bx, G, wave, LN);
}

extern "C" void kernel_launch(void* const* d_in, const int* in_sizes, int n_in, void* d_out, int out_size, void* d_ws, size_t ws_size, hipStream_t stream) {
    static int grid = 0;
    if (grid == 0) {
        if (n_in != 22 || out_size != MTOK * DM || ws_size < WS_END) { fprintf(stderr, "kernel_launch: unexpected shapes: n_in %d out %d ws %zu (need %zu)\n", n_in, out_size, ws_size, (size_t)WS_END); grid = -1; return; }
        int dev = 0, cus = 0;
        if (hipGetDevice(&dev) != hipSuccess || hipDeviceGetAttribute(&cus, hipDeviceAttributeMultiprocessorCount, dev) != hipSuccess) { grid = -1; return; }
        if (hipFuncSetAttribute((const void*)mk_fwd, hipFuncAttributeMaxDynamicSharedMemorySize, LDS_BYTES) != hipSuccess) { fprintf(stderr, "kernel_launch: hipFuncSetAttribute failed\n"); grid = -1; return; }
        int per_cu = 0;
        if (hipOccupancyMaxActiveBlocksPerMultiprocessor(&per_cu, (const void*)mk_fwd, NWAVES * 64, LDS_BYTES) != hipSuccess || per_cu < 1) fprintf(stderr, "kernel_launch: occupancy query says %d\n", per_cu);
        (void)hipGetLastError();
        grid = cus;
    }
    if (grid < 0) return;
    (void)hipMemsetAsync((char*)d_ws + WS_CTL, 0, CTL_ZERO_BYTES, stream);
    Args a{};
    for (int i = 0; i < 22; ++i) a.in[i] = d_in[i];
    a.out = (float*)d_out; a.ws = (unsigned char*)d_ws;
#if MK_N_LAUNCHES == 1
    a.ph_lo = 0; a.ph_hi = NPHASES;
    hipLaunchKernelGGL(mk_fwd, dim3(grid), dim3(NWAVES * 64), LDS_BYTES, stream, a);
#else
    for (int ph = 0; ph < NPHASES; ++ph) { a.ph_lo = ph; a.ph_hi = ph + 1; hipLaunchKernelGGL(mk_fwd, dim3(grid), dim3(NWAVES * 64), LDS_BYTES, stream, a); }
#endif
}
```

```cpp
#include <hip/hip_runtime.h>
#include <cstdio>
#include <cstdint>
#define GAS __attribute__((address_space(1)))
#define LAS __attribute__((address_space(3)))
namespace pg8 {
#define PG8_LAS __attribute__((address_space(3)))
typedef unsigned short bf16_t;
typedef short bf16x8 __attribute__((ext_vector_type(8)));
typedef float f32x4 __attribute__((ext_vector_type(4)));
typedef unsigned u32x4 __attribute__((ext_vector_type(4)));
constexpr int BM = 256, BK = 64, HALF = 128, HTB = HALF * BK * 2  , STAGE_BYTES = 8 * HTB, NXCD = 8, WGM = 8;

__host__ __device__ __forceinline__ int lds_byte(int r, int c) { const int st = (r >> 4) * 2 + (c >> 5), rr = r & 15, cc = c & 31, ob = rr * 64 + cc * 2; return st * 1024 + (ob ^ (((ob >> 9) & 1) << 5)); }
__host__ __device__ __forceinline__ void stage_rc(int b, int& R, int& C) { const int st = b / 1024, sb = b % 1024, swz = sb ^ (((sb >> 9) & 1) << 5); R = (st >> 1) * 16 + swz / 64; C = (st & 1) * 32 + (swz % 64) / 2; }
__host__ __device__ __forceinline__ int perm32(int rho) { const int n = rho >> 4, i = rho & 15; return 8 * (i >> 2) + 4 * n + (i & 3); }

struct Unit { int pm, pn; };
struct Gemm { const bf16_t* A; const bf16_t* Bt; int M, N, K; };

struct StaticOrder {
    int nM, nN, nwg, G, c;
    __host__ __device__ void init(int M, int N, int G_, int c_) { nM = M / BM; nN = N / BM; nwg = nM * nN; G = G_; c = c_; }
    __host__ __device__ bool next(int i, Unit& u) const {
        const long L = (long)i * G + c; if (L >= nwg) return false;
        int wgid = (int)L; { const int q = nwg / NXCD, r = nwg % NXCD, xcd = wgid % NXCD, off = wgid / NXCD; wgid = (xcd < r ? xcd * (q + 1) : r * (q + 1) + (xcd - r) * q) + off; }
        const int nig = WGM * nN, gid = wgid / nig, fm = gid * WGM, gsz = (nM - fm) < WGM ? (nM - fm) : WGM;
        u.pm = fm + ((wgid % nig) % gsz); u.pn = (wgid % nig) / gsz; return true;
    }
    __device__ __forceinline__ void a_ready(const Unit&) const {}
    __device__ __forceinline__ void done(const Unit&) const {}
};

__device__ __forceinline__ unsigned cvt_pk_bf16(float lo, float hi) { unsigned r; asm volatile("v_cvt_pk_bf16_f32 %0, %1, %2" : "=v"(r) : "v"(lo), "v"(hi)); return r; }
typedef float f32x2 __attribute__((ext_vector_type(2)));
__device__ __forceinline__ f32x2 gelu_pk(f32x2 v) {
    const f32x2 av = __builtin_elementwise_abs(v), d = av * 0.2316418882f + 1.0f;
    f32x2 t; t.x = __builtin_amdgcn_rcpf(d.x); t.y = __builtin_amdgcn_rcpf(d.y);
    f32x2 q = t * 0.5307027145f + (-0.7265760135f); q = q * t + 0.7107068705f; q = q * t + (-0.142248368f); q = q * t + 0.127414796f; q = q * t;
    const f32x2 s = (v * v) * (-0.72134752044f);
    f32x2 e; e.x = __builtin_amdgcn_exp2f(s.x); e.y = __builtin_amdgcn_exp2f(s.y);
    const f32x2 m = v * (q * e), r = v - m;
    f32x2 o; o.x = v.x < 0.f ? m.x : r.x; o.y = v.y < 0.f ? m.y : r.y; return o;
}

template <int ACT  > struct EpiBf16 {
    static constexpr bool PERM = true, AFTER_DRAIN = false; static_assert(ACT == 0 || ACT == 1, "EpiBf16: ACT is 0 (none) or 1 (gelu_pk)");
    bf16_t* O; int ldc; const float* bias; int split_cols; size_t split_stride; float scale0;
    __device__ __forceinline__ void operator()(const f32x4 (&acc)[2][2][4][2], const Unit& u, int wr, int wc, int fr, int fq) const {
        const int row0 = u.pm * BM + wr * 64 + fr; int colt = u.pn * BM; bf16_t* base = O;
        float sc = 1.f; if (split_cols) { const int t = colt / split_cols; base += (size_t)t * split_stride; colt -= t * split_cols; if (t == 0) sc = scale0; }
        const int col0 = colt + wc * 32 + 8 * fq, bcol0 = u.pn * BM + wc * 32 + 8 * fq;
        f32x4 bv[2][2];
#pragma unroll
        for (int bj = 0; bj < 2; ++bj)
#pragma unroll
            for (int n = 0; n < 2; ++n) bv[bj][n] = bias ? *(const f32x4*)(bias + bcol0 + bj * HALF + 4 * n) : (f32x4){0.f, 0.f, 0.f, 0.f};
#pragma unroll
        for (int ai = 0; ai < 2; ++ai)
#pragma unroll
            for (int m = 0; m < 4; ++m) { bf16_t* rowp = base + (size_t)(row0 + ai * HALF + m * 16) * ldc + col0;
#pragma unroll
                for (int bj = 0; bj < 2; ++bj) { f32x4 v0 = acc[ai][bj][m][0] + bv[bj][0], v1 = acc[ai][bj][m][1] + bv[bj][1];
                    if (ACT == 1) { f32x2 a = gelu_pk((f32x2){v0[0], v0[1]}), b = gelu_pk((f32x2){v0[2], v0[3]}), c = gelu_pk((f32x2){v1[0], v1[1]}), d = gelu_pk((f32x2){v1[2], v1[3]});
                        v0 = (f32x4){a.x, a.y, b.x, b.y}; v1 = (f32x4){c.x, c.y, d.x, d.y}; }
                    v0 = v0 * sc; v1 = v1 * sc; u32x4 w; w.x = cvt_pk_bf16(v0[0], v0[1]); w.y = cvt_pk_bf16(v0[2], v0[3]); w.z = cvt_pk_bf16(v1[0], v1[1]); w.w = cvt_pk_bf16(v1[2], v1[3]);
                    *(u32x4*)(rowp + bj * HALF) = w; } }
    }
};

template <class Epi, class Sched, bool ALIGN_EPI = false, bool SP2 = false>
__device__ __forceinline__ void gemm_phase(PG8_LAS unsigned char* lds, const Gemm g, const Sched& S, const Epi& E) {
    int tid_raw = threadIdx.x; asm volatile("" : "+v"(tid_raw));
    const int tid = tid_raw, wid = __builtin_amdgcn_readfirstlane(tid >> 6), lane = tid & 63, wr = wid >> 2, wc = wid & 3, fr = lane & 15, fq = lane >> 4;
    const int K = g.K, nt = K / BK;
    unsigned voffA[2], voffB[2];
#pragma unroll
    for (int i = 0; i < 2; ++i) { int R, C; stage_rc(tid * 16 + i * 8192, R, C); const int Rb = Epi::PERM ? ((R & ~31) + perm32(R & 31)) : R;
        voffA[i] = (unsigned)(R * K + C) * 2u; voffB[i] = (unsigned)(Rb * K + C) * 2u; }
    const size_t kstep = (size_t)(BK * 2);
    const size_t hstep = (size_t)HALF * K * 2;
    const size_t tstep = 2 * hstep;
    const unsigned ldsw = (unsigned)wid * 1024u;
    const int aoff = lds_byte(wr * 64 + fr, fq * 8), boff = lds_byte(wc * 32 + fr, fq * 8);
#define PG8_SA(b, h) (((b) * 2 + (h)) * HTB)
#define PG8_SB(b, h) ((4 + (b) * 2 + (h)) * HTB)
#define PG8_STAGE(bufoff, gbase, voff) do { _Pragma("unroll") for (int _i = 0; _i < 2; ++_i) \
        __builtin_amdgcn_global_load_lds((const unsigned*)((const char*)(gbase) + (voff)[_i]), (PG8_LAS unsigned*)(lds + (bufoff) + ldsw + _i * 8192), 16, 0, 0); } while (0)
#define PG8_LDA(dst, b, h) do { _Pragma("unroll") for (int m = 0; m < 4; ++m) _Pragma("unroll") for (int k = 0; k < 2; ++k) dst[m][k] = *(const PG8_LAS bf16x8*)(lds + PG8_SA(b, h) + aoff + m * 2048 + k * 1024); } while (0)
#define PG8_LDB(dst, b, h) do { _Pragma("unroll") for (int n = 0; n < 2; ++n) _Pragma("unroll") for (int k = 0; k < 2; ++k) dst[n][k] = *(const PG8_LAS bf16x8*)(lds + PG8_SB(b, h) + boff + n * 2048 + k * 1024); } while (0)
#define PG8_MMA(ai, bj, At, Bt) do { __builtin_amdgcn_s_setprio(1); _Pragma("unroll") for (int m = 0; m < 4; ++m) _Pragma("unroll") for (int n = 0; n < 2; ++n) _Pragma("unroll") for (int k = 0; k < 2; ++k) \
        acc[ai][bj][m][n] = __builtin_amdgcn_mfma_f32_16x16x32_bf16(Bt[n][k], At[m][k], acc[ai][bj][m][n], 0, 0, 0); __builtin_amdgcn_s_setprio(0); } while (0)
#define PG8_WAIT_V(n) asm volatile("s_waitcnt vmcnt(" #n ")" ::: "memory")
#define PG8_WAIT_L(n) asm volatile("s_waitcnt lgkmcnt(" #n ")" ::: "memory")
#define PG8_BAR __builtin_amdgcn_s_barrier()
#define PG8_SCHED __builtin_amdgcn_sched_barrier(0)
    Unit cur, nxt; int ui = 0;
    if (!S.next(0, cur)) return;
    f32x4 acc[2][2][4][2];
#pragma unroll
    for (int a = 0; a < 2; ++a)
#pragma unroll
        for (int b = 0; b < 2; ++b)
#pragma unroll
            for (int m = 0; m < 4; ++m)
#pragma unroll
                for (int n = 0; n < 2; ++n) acc[a][b][m][n] = (f32x4){0.f, 0.f, 0.f, 0.f};
    bf16x8 At[4][2], B0[2][2], B1[2][2];
    const char* cA = (const char*)g.A + (size_t)cur.pm * tstep; const char* cB = (const char*)g.Bt + (size_t)cur.pn * tstep;
    S.a_ready(cur);
    if constexpr (SP2) {
        PG8_STAGE(PG8_SB(0, 0), cB, voffB); PG8_STAGE(PG8_SB(0, 1), cB + hstep, voffB); PG8_STAGE(PG8_SA(0, 0), cA, voffA); PG8_STAGE(PG8_SA(0, 1), cA + hstep, voffA);
        if (wr == 1) PG8_BAR;
        PG8_WAIT_V(2); PG8_BAR;
        PG8_STAGE(PG8_SB(1, 0), cB + kstep, voffB); PG8_STAGE(PG8_SA(1, 0), cA + kstep, voffA); PG8_STAGE(PG8_SB(1, 1), cB + hstep + kstep, voffB);
        PG8_WAIT_V(6); PG8_BAR;
    } else {
        PG8_STAGE(PG8_SB(0, 0), cB, voffB); PG8_STAGE(PG8_SA(0, 0), cA, voffA); PG8_STAGE(PG8_SB(0, 1), cB + hstep, voffB); PG8_STAGE(PG8_SA(0, 1), cA + hstep, voffA);
        if (wr == 1) PG8_BAR;
        PG8_WAIT_V(4); PG8_BAR;
        PG8_STAGE(PG8_SB(1, 0), cB + kstep, voffB); PG8_STAGE(PG8_SA(1, 0), cA + kstep, voffA); PG8_STAGE(PG8_SB(1, 1), cB + hstep + kstep, voffB);
        PG8_WAIT_V(6); PG8_BAR;
    }
    for (;;) {
        const bool has_next = S.next(ui + 1, nxt);
        const char* nA = has_next ? (const char*)g.A + (size_t)nxt.pm * tstep : cA; const char* nB = has_next ? (const char*)g.Bt + (size_t)nxt.pn * tstep : cB;
        for (int t = 0; t < nt; t += 2) {
            const bool last = (t == nt - 2);
            const char* a1 = cA + (size_t)(t + 1) * kstep;
            const char* a2 = last ? nA : cA + (size_t)(t + 2) * kstep; const char* b2 = last ? nB : cB + (size_t)(t + 2) * kstep;
            const char* a3 = a2 + kstep; const char* b3 = b2 + kstep;
            if (last && has_next) S.a_ready(nxt);
            if constexpr (SP2) {
            PG8_LDB(B0, 0, 0); PG8_LDB(B1, 0, 1); PG8_SCHED; PG8_LDA(At, 0, 0); PG8_STAGE(PG8_SA(1, 1), a1 + hstep, voffA);
            PG8_WAIT_V(8); PG8_WAIT_L(0); PG8_BAR; PG8_MMA(0, 0, At, B0); PG8_MMA(0, 1, At, B1); PG8_BAR; PG8_SCHED;
            PG8_LDA(At, 0, 1); PG8_STAGE(PG8_SB(0, 0), b2, voffB); PG8_STAGE(PG8_SB(0, 1), b2 + hstep, voffB); PG8_STAGE(PG8_SA(0, 0), a2, voffA);
            PG8_WAIT_V(8); PG8_WAIT_L(0); PG8_BAR; PG8_MMA(1, 0, At, B0); PG8_MMA(1, 1, At, B1); PG8_BAR; PG8_SCHED;
            PG8_LDB(B0, 1, 0); PG8_LDB(B1, 1, 1); PG8_SCHED; PG8_LDA(At, 1, 0); PG8_STAGE(PG8_SA(0, 1), a2 + hstep, voffA);
            PG8_WAIT_V(8); PG8_WAIT_L(0); PG8_BAR; PG8_MMA(0, 0, At, B0); PG8_MMA(0, 1, At, B1); PG8_BAR; PG8_SCHED;
            PG8_LDA(At, 1, 1); PG8_STAGE(PG8_SB(1, 0), b3, voffB); PG8_STAGE(PG8_SB(1, 1), b3 + hstep, voffB); PG8_STAGE(PG8_SA(1, 0), a3, voffA);
            PG8_WAIT_V(8); PG8_WAIT_L(0); PG8_BAR; PG8_MMA(1, 0, At, B0); PG8_MMA(1, 1, At, B1); PG8_BAR; PG8_SCHED;
            } else {
            PG8_LDB(B0, 0, 0); PG8_SCHED; PG8_LDA(At, 0, 0); PG8_STAGE(PG8_SA(1, 1), a1 + hstep, voffA);
            PG8_WAIT_L(8); PG8_BAR; PG8_WAIT_L(0); PG8_MMA(0, 0, At, B0); PG8_BAR; PG8_SCHED;
            PG8_LDB(B1, 0, 1); PG8_STAGE(PG8_SB(0, 0), b2, voffB);
            PG8_BAR; PG8_WAIT_L(0); PG8_MMA(0, 1, At, B1); PG8_BAR;
            PG8_LDA(At, 0, 1); PG8_STAGE(PG8_SA(0, 0), a2, voffA);
            PG8_BAR; PG8_WAIT_L(0); PG8_MMA(1, 0, At, B0); PG8_BAR; PG8_SCHED;
            PG8_STAGE(PG8_SB(0, 1), b2 + hstep, voffB);
            PG8_WAIT_V(6); PG8_BAR; PG8_MMA(1, 1, At, B1); PG8_BAR;
            PG8_LDB(B0, 1, 0); PG8_SCHED; PG8_LDA(At, 1, 0); PG8_STAGE(PG8_SA(0, 1), a2 + hstep, voffA);
            PG8_WAIT_L(8); PG8_BAR; PG8_WAIT_L(0); PG8_MMA(0, 0, At, B0); PG8_BAR; PG8_SCHED;
            PG8_LDB(B1, 1, 1); PG8_STAGE(PG8_SB(1, 0), b3, voffB);
            PG8_BAR; PG8_WAIT_L(0); PG8_MMA(0, 1, At, B1); PG8_BAR;
            PG8_LDA(At, 1, 1); PG8_STAGE(PG8_SA(1, 0), a3, voffA);
            PG8_BAR; PG8_WAIT_L(0); PG8_MMA(1, 0, At, B0); PG8_BAR; PG8_SCHED;
            PG8_STAGE(PG8_SB(1, 1), b3 + hstep, voffB);
            PG8_WAIT_V(6); PG8_BAR; PG8_MMA(1, 1, At, B1); PG8_BAR;
            }
        }
        if constexpr (ALIGN_EPI) { if (wr == 0) PG8_BAR; }
        if constexpr (!Epi::AFTER_DRAIN) { E(acc, cur, wr, wc, fr, fq); S.done(cur); }
        if (!has_next) break;
#pragma unroll
        for (int a = 0; a < 2; ++a)
#pragma unroll
            for (int b = 0; b < 2; ++b)
#pragma unroll
                for (int m = 0; m < 4; ++m)
#pragma unroll
                    for (int n = 0; n < 2; ++n) acc[a][b][m][n] = (f32x4){0.f, 0.f, 0.f, 0.f};
        cur = nxt; cA = nA; cB = nB; ++ui;
        if constexpr (ALIGN_EPI) { if (wr == 1) PG8_BAR; }
    }
    PG8_WAIT_V(0);
    if constexpr (!ALIGN_EPI) { if (wr == 0) PG8_BAR; }
    PG8_BAR;
    if constexpr (Epi::AFTER_DRAIN) { E.fused(acc, cur, wr, wc, fr, fq, lds, wid, lane); S.done(cur); }
#undef PG8_SA
#undef PG8_SB
#undef PG8_STAGE
#undef PG8_LDA
#undef PG8_LDB
#undef PG8_MMA
#undef PG8_WAIT_V
#undef PG8_WAIT_L
#undef PG8_BAR
#undef PG8_SCHED
}
}
#define XB_TMO      128
#define XB_XCNT(j)  (256  + 64 * (j))
#define XB_XSUB(j)  (1280 + 64 * (j))
#define XB_XGEN(j)  (2304 + 64 * (j))
#define XB_TOP      3328
#define XB_TOPGEN   3392
#define XCD_BAR_WORDS 3456
#define XB_SPIN_CAP (1u << 18)

__device__ __forceinline__ unsigned xb_ld(unsigned* p)              { return __hip_atomic_load(p, __ATOMIC_RELAXED, __HIP_MEMORY_SCOPE_AGENT); }
__device__ __forceinline__ unsigned xb_add(unsigned* p, unsigned v) { return __hip_atomic_fetch_add(p, v, __ATOMIC_RELAXED, __HIP_MEMORY_SCOPE_AGENT); }
__device__ __forceinline__ unsigned xb_xcc_id() { return (unsigned)__builtin_amdgcn_s_getreg((3 << 11) | 20) & 0xFu; }
#define XB_SPIN(cond, bar) do { unsigned _sp = 0; while (cond) { __builtin_amdgcn_s_sleep(1); \
    if ((++_sp & 255u) == 0u) { if (xb_ld(&(bar)[XB_TMO])) break; if (_sp > XB_SPIN_CAP) { atomicAdd(&(bar)[XB_TMO], 1u); break; } } } } while (0)

struct XcdBarrier {
    unsigned* bar; unsigned x;
    volatile LAS unsigned* st;
};

__device__ __forceinline__ XcdBarrier xcd_barrier_post(unsigned* bar, volatile LAS unsigned* st) {
    XcdBarrier b; b.bar = bar; b.x = xb_xcc_id(); b.st = st;
    if (threadIdx.x == 0) (void)xb_add(&bar[XB_XCNT(b.x)], 1u);
    return b;
}
__device__ __forceinline__ void xcd_barrier_complete(unsigned* bar, unsigned x, unsigned& nloc, unsigned& nx) {
    const unsigned G = gridDim.x * gridDim.y * gridDim.z;
    unsigned sum, cnt, mine, sp = 0u;
    for (;;) {
        sum = 0u; cnt = 0u; mine = 0u;
#pragma unroll
        for (unsigned j = 0; j < 16; ++j) { const unsigned c = xb_ld(&bar[XB_XCNT(j)]); sum += c; cnt += (c > 0u) ? 1u : 0u; mine = (j == x) ? c : mine; }
        if (sum == G) break;
        __builtin_amdgcn_s_sleep(1);
        if ((++sp & 255u) == 0u) { if (xb_ld(&bar[XB_TMO])) break; if (sp > XB_SPIN_CAP) { atomicAdd(&bar[XB_TMO], 1u); break; } }
    }
    nloc = mine > 0u ? mine : 1u; nx = cnt > 0u ? cnt : 1u;
}

__device__ __forceinline__ void xcd_barrier(const XcdBarrier& b) {
    asm volatile("s_waitcnt vmcnt(0)" ::: "memory");
    __syncthreads();
    if (threadIdx.x == 0) {
        unsigned* bar = b.bar;
        __builtin_amdgcn_s_waitcnt(0);
        unsigned nloc = b.st[0], nx = b.st[1];
        if (nloc == 0u) { xcd_barrier_complete(bar, b.x, nloc, nx); b.st[0] = nloc; b.st[1] = nx; }
        const unsigned old = xb_add(&bar[XB_XSUB(b.x)], 1u);
        const unsigned gen = old / nloc;
        if (old + 1u == (gen + 1u) * nloc) {
            __builtin_amdgcn_fence(__ATOMIC_RELEASE, "agent");
            asm volatile("s_waitcnt vmcnt(0)" ::: "memory");
            const unsigned og = xb_add(&bar[XB_TOP], 1u);
            const unsigned tg = og / nx;
            if (og + 1u == (tg + 1u) * nx) xb_add(&bar[XB_TOPGEN], 1u);
            else XB_SPIN(xb_ld(&bar[XB_TOPGEN]) == tg, bar);
            __builtin_amdgcn_fence(__ATOMIC_ACQUIRE, "agent");
            xb_add(&bar[XB_XGEN(b.x)], 1u);
            asm volatile("s_waitcnt vmcnt(0)" ::: "memory");
        } else {
            XB_SPIN(xb_ld(&bar[XB_XGEN(b.x)]) == gen, bar);
            __builtin_amdgcn_fence(__ATOMIC_ACQUIRE, "agent");
            asm volatile("s_waitcnt vmcnt(0)" ::: "memory");
        }
    }
    __syncthreads();
}

constexpr int DM = 1024, NB = 4, SEQ = 4096, MTOK = NB * SEQ;
constexpr int QLORA = 384, KVLORA = 256, ROPE = 64, NOPE = 128, QKH = 192, VH = 128, NH = 8;
constexpr int MLA_IN = 704, MLA_IN_PAD = 768;
constexpr int NEXP = 16384;
constexpr float NORM_EPS = 1e-6f;
constexpr float U8_SCALE = 256.f, V8_SCALE = 16.f, H8_SCALE = 8.f;
constexpr float QSCALE = 0.07216878364870322f * 1.4426950408889634f;

#ifndef MK_N_LAUNCHES
#define MK_N_LAUNCHES 1
#endif
constexpr int NPHASES = 24;
#ifndef PHMASK
#define PHMASK 0xFFFFFFu
#endif
#define EN(k) (((PHMASK) >> (k)) & 1u)
#ifndef PROBE_PHASE
#define PROBE_PHASE -1
#endif
#ifndef PROBE_VAR
#define PROBE_VAR 0
#endif
#ifndef PROBE_REPS
#define PROBE_REPS 2
#endif
#define NREP(k) ((k) == (PROBE_PHASE) ? (PROBE_REPS) : 1)
constexpr int NWAVES = 8;

constexpr size_t MiB = 1u << 20;
constexpr size_t WS_CTL = 0, CTL_ZERO_BYTES = 64 * 1024;
constexpr size_t WS_MOD = 1 * MiB;
constexpr size_t WS_WCIN = 2 * MiB;
constexpr size_t WS_WCOUT = 8 * MiB;
constexpr size_t WS_WPQ0 = 10 * MiB, WS_WPQ1 = 14 * MiB;
constexpr size_t WS_WMIN = 18 * MiB;
constexpr size_t WS_WQB = 20 * MiB;
constexpr size_t WS_WKVB = 22 * MiB;
constexpr size_t WS_WMOUT = 24 * MiB;
constexpr size_t WS_SUBK = 26 * MiB;
constexpr size_t WS_PU = 32 * MiB;
constexpr size_t WS_PV = 96 * MiB;
constexpr size_t WS_XN = 160 * MiB;
constexpr size_t WS_VT = 160 * MiB;
constexpr size_t WS_BCV = 192 * MiB;
constexpr size_t WS_LAT = 192 * MiB;
constexpr size_t WS_O = 192 * MiB;
constexpr size_t WS_QN = 216 * MiB;
constexpr size_t WS_KVN = 228 * MiB;
constexpr size_t WS_QRAW = 236 * MiB;
constexpr size_t WS_Z = 288 * MiB;
constexpr size_t WS_KVRAW = 288 * MiB;
constexpr size_t WS_PQ = 288 * MiB;
constexpr size_t WS_QF = 352 * MiB;
constexpr size_t WS_KF = 400 * MiB;
constexpr size_t WS_IDS = 448 * MiB;
constexpr size_t WS_GATES = 456 * MiB;
constexpr size_t WS_PART = 192 * MiB;
constexpr size_t WS_DUMMY = 288 * MiB;
constexpr size_t WS_ACT = 464 * MiB;
constexpr size_t WS_XN8 = 472 * MiB;
constexpr size_t WS_END = 488 * MiB;
constexpr int CW_BAR = 1024;

constexpr int RING_BYTES = 131072;
constexpr int LDSCTL_OFF = RING_BYTES, MISC_OFF = LDSCTL_OFF + 320;
constexpr int LDS_BYTES = 147456;


typedef unsigned short bf16;
typedef unsigned u32x4 __attribute__((ext_vector_type(4)));
typedef unsigned u32x2 __attribute__((ext_vector_type(2)));
typedef float f32x4 __attribute__((ext_vector_type(4)));
typedef float f32x16 __attribute__((ext_vector_type(16)));
typedef short s16x8 __attribute__((ext_vector_type(8)));
typedef short s16x4 __attribute__((ext_vector_type(4)));
#define LDS_WAIT() asm volatile("s_waitcnt lgkmcnt(0)" ::: "memory")
#define VM_WAIT() asm volatile("s_waitcnt vmcnt(0)" ::: "memory")
#define DI __device__ __forceinline__

DI unsigned f2bf(float f) { unsigned u = __builtin_bit_cast(unsigned, f); return (u + 0x7fffu + ((u >> 16) & 1u)) >> 16; }
DI unsigned pk2(float lo, float hi) { return f2bf(lo) | (f2bf(hi) << 16); }
DI float bflo(unsigned u) { return __uint_as_float(u << 16); }
DI float bfhi(unsigned u) { return __uint_as_float(u & 0xffff0000u); }
DI float bf1(bf16 b) { return __uint_as_float((unsigned)b << 16); }
DI float wave_sum(float v) {
#pragma unroll
    for (int o = 32; o > 0; o >>= 1) v += __shfl_xor(v, o);
    return v;
}
DI int crow(int r, int hi) { return (r & 3) + 8 * (r >> 2) + 4 * hi; }

struct Args { const void* in[22]; float* out; unsigned char* ws; int ph_lo, ph_hi; };

DI void transpose_item(const float* W, int K, int N, bf16* WT, LAS float* scr, int item, int lane) {
    const int nblk = N / 32, kb = item / nblk, nb = item % nblk, k0 = 64 * kb, n0 = 32 * nb;
#pragma unroll 8
    for (int i = 0; i < 32; ++i) { const int kk = 2 * i + (lane >> 5); scr[kk * 33 + (lane & 31)] = W[(size_t)(k0 + kk) * N + n0 + (lane & 31)]; }
    LDS_WAIT(); asm volatile("" ::: "memory");
    const int c = lane & 7;
#pragma unroll
    for (int j = 0; j < 4; ++j) { const int n = (lane >> 3) + 8 * j; const LAS float* s = scr + (8 * c) * 33 + n;
        u32x4 o; o.x = pk2(s[0 * 33], s[1 * 33]); o.y = pk2(s[2 * 33], s[3 * 33]); o.z = pk2(s[4 * 33], s[5 * 33]); o.w = pk2(s[6 * 33], s[7 * 33]);
        *(u32x4*)(WT + (size_t)(n0 + n) * K + k0 + 8 * c) = o; }
    LDS_WAIT(); asm volatile("" ::: "memory");
}
DI void cvt_f32_bf16(const float* src, bf16* dst, size_t n8, size_t gt, size_t GT) {
#pragma unroll 4
    for (size_t i = gt; i < n8; i += GT) {
        const f32x4 a = ((const f32x4*)src)[2 * i], b = ((const f32x4*)src)[2 * i + 1];
        u32x4 o; o.x = pk2(a.x, a.y); o.y = pk2(a.z, a.w); o.z = pk2(b.x, b.y); o.w = pk2(b.z, b.w);
        ((u32x4*)dst)[i] = o; }
}

typedef float f32x2v __attribute__((ext_vector_type(2)));
DI unsigned pack4_fp8(float a, float b, float c, float d, float sc) {
    a = fminf(fmaxf(a * sc, -448.f), 448.f); b = fminf(fmaxf(b * sc, -448.f), 448.f); c = fminf(fmaxf(c * sc, -448.f), 448.f); d = fminf(fmaxf(d * sc, -448.f), 448.f);
    int w = __builtin_amdgcn_cvt_pk_fp8_f32(a, b, 0, false); w = __builtin_amdgcn_cvt_pk_fp8_f32(c, d, w, true); return (unsigned)w;
}
DI void cvt_tables_fp8(const float* u, const float* v, unsigned char* u8, unsigned char* v8, size_t gt, size_t GT) {
    const size_t n16 = (size_t)2 * NEXP * 1024 / 16;
#pragma unroll 2
    for (size_t i = gt; i < n16; i += GT) {
        const f32x4* s = (const f32x4*)(u + i * 16); const f32x4 a = s[0], b = s[1], c = s[2], d = s[3];
        u32x4 o; o.x = pack4_fp8(a.x, a.y, a.z, a.w, U8_SCALE); o.y = pack4_fp8(b.x, b.y, b.z, b.w, U8_SCALE); o.z = pack4_fp8(c.x, c.y, c.z, c.w, U8_SCALE); o.w = pack4_fp8(d.x, d.y, d.z, d.w, U8_SCALE);
        const size_t k = i & 63, row = i >> 6, e = row & (NEXP - 1), layer = row >> 14;
        *(u32x4*)(u8 + (((layer * 8 + (k >> 3)) * NEXP + e) * 128 + (k & 7) * 16)) = o; }
#pragma unroll 2
    for (size_t i = gt; i < n16; i += GT) {
        const f32x4* s = (const f32x4*)(v + i * 16); const f32x4 a = s[0], b = s[1], c = s[2], d = s[3];
        u32x4 o; o.x = pack4_fp8(a.x, a.y, a.z, a.w, V8_SCALE); o.y = pack4_fp8(b.x, b.y, b.z, b.w, V8_SCALE); o.z = pack4_fp8(c.x, c.y, c.z, c.w, V8_SCALE); o.w = pack4_fp8(d.x, d.y, d.z, d.w, V8_SCALE);
        const size_t k = i & 63, row = i >> 6, e = row & (NEXP - 1), layer = row >> 14;
        *(u32x4*)(v8 + (((layer * 8 + (k >> 3)) * NEXP + e) * 128 + (k & 7) * 16)) = o; }
}
DI void ph_prologue(const Args& a, LAS unsigned char* lds, int tid, int wave, int vcu, int G) {
    const int lane = tid & 63;
    {
        const float* c = (const float*)a.in[1]; const float* ada_w = (const float*)a.in[5]; const float* ada_b = (const float*)a.in[6];
        float* mod = (float*)(a.ws + WS_MOD);
        LAS float* cact = (LAS float*)lds; LAS float* red = cact + 4096;
        for (int it = blockIdx.x; it < 192; it += G) {
            const int i = it / 96, n0 = (it % 96) * 64;
            for (int e = tid; e < 4096; e += 512) { const float v = c[e]; cact[e] = v / (1.f + expf(-v)); }
            __syncthreads();
            const float* W = ada_w + (size_t)i * 1024 * 6144 + n0 + lane;
            float a0 = 0.f, a1 = 0.f, a2 = 0.f, a3 = 0.f;
            const int k0 = wave * 128;
#pragma unroll 8
            for (int k = k0; k < k0 + 128; ++k) { const float w = W[(size_t)k * 6144]; a0 += cact[k] * w; a1 += cact[1024 + k] * w; a2 += cact[2048 + k] * w; a3 += cact[3072 + k] * w; }
            red[(wave * 4 + 0) * 64 + lane] = a0; red[(wave * 4 + 1) * 64 + lane] = a1; red[(wave * 4 + 2) * 64 + lane] = a2; red[(wave * 4 + 3) * 64 + lane] = a3;
            __syncthreads();
            if (tid < 256) { const int b = tid >> 6; float s = 0.f;
#pragma unroll
                for (int w = 0; w < 8; ++w) s += red[(w * 4 + b) * 64 + lane];
                mod[(size_t)(i * 4 + b) * 6144 + n0 + lane] = s + ada_b[i * 6144 + n0 + lane]; }
            __syncthreads();
        }
    }
    {
        LAS float* scr = (LAS float*)(lds + 32768 + wave * 8704);
        const int gw = vcu * NWAVES + wave, NGW = G * NWAVES;
        unsigned char* ws = a.ws;
        constexpr int I_CIN = 16 * 96, I_COUT = 16 * 32, I_PQ = 16 * 64, I_MIN = 16 * 22, I_QB = 6 * 48, I_KVB = 4 * 64, I_MOUT = 16 * 32;
        constexpr int NITEMS = I_CIN + I_COUT + 2 * I_PQ + I_MIN + I_QB + I_KVB + I_MOUT;
        for (int it = gw; it < NITEMS; it += NGW) {
            int r = it;
            if (r < I_CIN) { transpose_item((const float*)a.in[7], 1024, 3072, (bf16*)(ws + WS_WCIN), scr, r, lane); continue; } r -= I_CIN;
            if (r < I_COUT) { transpose_item((const float*)a.in[9], 1024, 1024, (bf16*)(ws + WS_WCOUT), scr, r, lane); continue; } r -= I_COUT;
            if (r < I_PQ) { transpose_item((const float*)a.in[18], 1024, 2048, (bf16*)(ws + WS_WPQ0), scr, r, lane); continue; } r -= I_PQ;
            if (r < I_PQ) { transpose_item((const float*)a.in[18] + (size_t)1024 * 2048, 1024, 2048, (bf16*)(ws + WS_WPQ1), scr, r, lane); continue; } r -= I_PQ;
            if (r < I_MIN) { transpose_item((const float*)a.in[10], 1024, MLA_IN, (bf16*)(ws + WS_WMIN), scr, r, lane); continue; } r -= I_MIN;
            if (r < I_QB) { transpose_item((const float*)a.in[13], 384, 1536, (bf16*)(ws + WS_WQB), scr, r, lane); continue; } r -= I_QB;
            if (r < I_KVB) { transpose_item((const float*)a.in[14], 256, 2048, (bf16*)(ws + WS_WKVB), scr, r, lane); continue; } r -= I_KVB;
            transpose_item((const float*)a.in[17], 1024, 1024, (bf16*)(ws + WS_WMOUT), scr, r, lane);
        }
        const size_t gt = (size_t)vcu * 512 + tid, GT = (size_t)G * 512;
        for (size_t i = gt; i < (size_t)(MLA_IN_PAD - MLA_IN) * 1024 / 8; i += GT) ((u32x4*)(ws + WS_WMIN + (size_t)MLA_IN * 1024 * 2))[i] = (u32x4){0u, 0u, 0u, 0u};
        cvt_f32_bf16((const float*)a.in[19], (bf16*)(ws + WS_SUBK), (size_t)2 * 8 * 2 * 128 * 128 / 8, gt, GT);
        cvt_tables_fp8((const float*)a.in[20], (const float*)a.in[21], ws + WS_PU, ws + WS_PV, gt, GT);
    }
}

DI void ph_modulate(const float* x, bf16* xn, unsigned char* xn8  , const float* gain, const float* modl, int sh_off, int sc_off, int gw, int NGW, int lane) {
    for (int m = gw; m < MTOK; m += NGW) {
        const float* mb = modl + (size_t)(m >> 12) * 6144;
        const f32x4* xr = (const f32x4*)(x + (size_t)m * DM) + lane;
        f32x4 v[4]; float s = 0.f;
#pragma unroll
        for (int j = 0; j < 4; ++j) { v[j] = xr[64 * j]; s += (v[j].x * v[j].x + v[j].y * v[j].y) + (v[j].z * v[j].z + v[j].w * v[j].w); }
        const float rstd = rsqrtf(wave_sum(s) * (1.f / DM) + NORM_EPS);
        u32x2* o8 = (u32x2*)(xn + (size_t)m * DM) + lane;
#pragma unroll
        for (int j = 0; j < 4; ++j) {
            const f32x4 g = ((const f32x4*)gain)[lane + 64 * j], sh = ((const f32x4*)(mb + sh_off))[lane + 64 * j], sc = ((const f32x4*)(mb + sc_off))[lane + 64 * j];
            const f32x4 y = v[j] * rstd * g * (sc + 1.f) + sh;
            u32x2 w; w.x = pk2(y.x, y.y); w.y = pk2(y.z, y.w); o8[64 * j] = w;
            if (xn8) ((unsigned*)(xn8 + (size_t)m * DM))[lane + 64 * j] = pack4_fp8(y.x, y.y, y.z, y.w, H8_SCALE); }
    }
}

DI void ph_conv(const bf16* bcv, const float* cw, bf16* z, size_t gt, size_t GT) {
    for (size_t it = gt; it < (size_t)MTOK * 128; it += GT) {
        const int t = (int)(it >> 7), ch = (int)(it & 127) * 8, s = t & (SEQ - 1);
        const bf16* row = bcv + (size_t)t * 3072 + ch;
        const u32x4 zero = (u32x4){0u, 0u, 0u, 0u};
        const u32x4 bq = *(const u32x4*)row;
        const u32x4 c0 = *(const u32x4*)(row + 1024), v0 = *(const u32x4*)(row + 2048);
        const u32x4 c1 = s >= 1 ? *(const u32x4*)(row - 3072 + 1024) : zero, v1 = s >= 1 ? *(const u32x4*)(row - 3072 + 2048) : zero;
        const u32x4 c2 = s >= 2 ? *(const u32x4*)(row - 6144 + 1024) : zero, v2 = s >= 2 ? *(const u32x4*)(row - 6144 + 2048) : zero;
        const f32x4 w0a = *(const f32x4*)(cw + ch), w0b = *(const f32x4*)(cw + ch + 4);
        const f32x4 w1a = *(const f32x4*)(cw + 1024 + ch), w1b = *(const f32x4*)(cw + 1024 + ch + 4);
        const f32x4 w2a = *(const f32x4*)(cw + 2048 + ch), w2b = *(const f32x4*)(cw + 2048 + ch + 4);
        float r[8];
#pragma unroll
        for (int e = 0; e < 4; ++e) {
            const float w0l = e < 2 ? w0a[2 * e] : w0b[2 * e - 4], w0h = e < 2 ? w0a[2 * e + 1] : w0b[2 * e - 3];
            const float w1l = e < 2 ? w1a[2 * e] : w1b[2 * e - 4], w1h = e < 2 ? w1a[2 * e + 1] : w1b[2 * e - 3];
            const float w2l = e < 2 ? w2a[2 * e] : w2b[2 * e - 4], w2h = e < 2 ? w2a[2 * e + 1] : w2b[2 * e - 3];
            const float ut_l = bflo(c0[e]) * bflo(v0[e]), ut_h = bfhi(c0[e]) * bfhi(v0[e]);
            const float u1_l = bflo(c1[e]) * bflo(v1[e]), u1_h = bfhi(c1[e]) * bfhi(v1[e]);
            const float u2_l = bflo(c2[e]) * bflo(v2[e]), u2_h = bfhi(c2[e]) * bfhi(v2[e]);
            r[2 * e] = bflo(bq[e]) * (w0l * u2_l + w1l * u1_l + w2l * ut_l);
            r[2 * e + 1] = bfhi(bq[e]) * (w0h * u2_h + w1h * u1_h + w2h * ut_h);
        }
        u32x4 o; o.x = pk2(r[0], r[1]); o.y = pk2(r[2], r[3]); o.z = pk2(r[4], r[5]); o.w = pk2(r[6], r[7]);
        *(u32x4*)(z + (size_t)t * DM + ch) = o;
    }
}

struct EpiResGate {
    static constexpr bool PERM = false, AFTER_DRAIN = false;
    const float* base; float* out; const float* gate;
    __device__ __forceinline__ void operator()(const pg8::f32x4 (&acc)[2][2][4][2], const pg8::Unit& u, int wr, int wc, int fr, int fq) const {
        const int row0 = u.pm * 256 + wr * 64 + fr, col0 = u.pn * 256 + wc * 32 + 4 * fq;
        const float* gp = gate + (size_t)(u.pm >> 4) * 6144 + col0;
        pg8::f32x4 gv[2][2];
#pragma unroll
        for (int bj = 0; bj < 2; ++bj)
#pragma unroll
            for (int n = 0; n < 2; ++n) gv[bj][n] = *(const pg8::f32x4*)(gp + bj * 128 + n * 16);
#pragma unroll
        for (int ai = 0; ai < 2; ++ai)
#pragma unroll
            for (int m = 0; m < 4; ++m) { const size_t off = (size_t)(row0 + ai * 128 + m * 16) * DM + col0;
#pragma unroll
                for (int bj = 0; bj < 2; ++bj)
#pragma unroll
                    for (int n = 0; n < 2; ++n) { const pg8::f32x4 bs = *(const pg8::f32x4*)(base + off + bj * 128 + n * 16);
                        *(pg8::f32x4*)(out + off + bj * 128 + n * 16) = bs + gv[bj][n] * acc[ai][bj][m][n]; } }
    }
};

typedef float f32x2_t __attribute__((ext_vector_type(2))); typedef __bf16 bf16x2_t __attribute__((ext_vector_type(2)));
DI unsigned cvtpk(float lo, float hi) { f32x2_t v = {lo, hi}; bf16x2_t b = __builtin_convertvector(v, bf16x2_t); return __builtin_bit_cast(unsigned, b); }
DI unsigned f2key(float f) { const unsigned u = __float_as_uint(f); return u ^ ((unsigned)((int)u >> 31) | 0x80000000u); }
DI float key2f(unsigned k) { const unsigned u = (k & 0x80000000u) ? (k ^ 0x80000000u) : ~k; return __uint_as_float(u); }
DI unsigned umax_(unsigned a, unsigned b) { return a > b ? a : b; }
DI unsigned umin_(unsigned a, unsigned b) { return a < b ? a : b; }
template <int N> DI void bitonic_sort_desc(unsigned (&v)[N]) {
#pragma unroll
    for (int k = 2; k <= N; k <<= 1) {
#pragma unroll
        for (int j = k >> 1; j > 0; j >>= 1) {
#pragma unroll
            for (int i = 0; i < N; ++i) { const int l = i ^ j;
                if (l > i) { const bool desc = ((i & k) == 0); const unsigned x = v[i], y = v[l], mx = umax_(x, y), mn = umin_(x, y); v[i] = desc ? mx : mn; v[l] = desc ? mn : mx; } }
        }
    }
}
template <int N> DI void bitonic_merge_desc(unsigned (&v)[N]) {
#pragma unroll
    for (int j = N >> 1; j > 0; j >>= 1) {
#pragma unroll
        for (int i = 0; i < N; ++i) { const int l = i ^ j;
            if (l > i) { const unsigned x = v[i], y = v[l]; v[i] = umax_(x, y); v[l] = umin_(x, y); } }
    }
}
DI void top16_merge(unsigned (&t)[16], unsigned (&n)[16]) {
#pragma unroll
    for (int i = 0; i < 16; ++i) t[i] = umax_(t[i], n[15 - i]);
    bitonic_merge_desc<16>(t);
}

constexpr int TK_ROWB = 272, TK_TAB_OFF = 32768;
DI void topk_task(const bf16* PQ, LAS unsigned char* skl  , unsigned short* IDS, float* GATES, LAS unsigned short* tab  , int tok0, int h, int lane) {
    const int r32 = lane & 31, hi = lane >> 5;
    s16x8 qf[16];
    const bf16* qp = PQ + (size_t)(tok0 + r32) * 2048 + 256 * h + 8 * hi;
#pragma unroll
    for (int ks = 0; ks < 16; ++ks) qf[ks] = *(const s16x8*)(qp + 16 * ks);
    const int p = (r32 >> 2) & 1, keyl = (r32 & 3) + 4 * (r32 >> 3);
    const unsigned kl0 = (unsigned)((p * 128 + keyl) * TK_ROWB + 16 * hi);
    const s16x8 zero8 = (s16x8){0, 0, 0, 0, 0, 0, 0, 0};
    unsigned top[16];
#pragma unroll
    for (int i = 0; i < 16; ++i) top[i] = 0u;
#pragma unroll 1
    for (int rb = 0; rb < 8; ++rb) {
        f32x16 acc;
#pragma unroll
        for (int r = 0; r < 16; ++r) acc[r] = 0.f;
#pragma unroll
        for (int ks = 0; ks < 8; ++ks) {
            const s16x8 kf = *(const LAS s16x8*)(skl + kl0 + (unsigned)(rb * 16 * TK_ROWB + 32 * ks));
            const s16x8 a0 = p == 0 ? kf : zero8, a1 = p == 1 ? kf : zero8;
            acc = __builtin_amdgcn_mfma_f32_32x32x16_bf16(a0, qf[ks], acc, 0, 0, 0);
            acc = __builtin_amdgcn_mfma_f32_32x32x16_bf16(a1, qf[ks + 8], acc, 0, 0, 0);
        }
        unsigned nw[16];
#pragma unroll
        for (int r = 0; r < 16; ++r) nw[r] = (f2key(acc[r]) & ~127u) | (unsigned)(127 - (16 * rb + r));
        bitonic_sort_desc<16>(nw);
        top16_merge(top, nw);
    }
    unsigned LA[16], LB[16];
#pragma unroll
    for (int i = 0; i < 16; ++i) { const unsigned other = (unsigned)__shfl_xor((int)top[i], 32); LA[i] = hi ? other : top[i]; LB[i] = hi ? top[i] : other; }
#pragma unroll
    for (int i = 0; i < 16; ++i) { tab[i * 64 + lane] = (unsigned short)(127u - (LA[i] & 127u)); tab[(16 + i) * 64 + lane] = (unsigned short)(127u - (LB[i] & 127u)); }
    float av[16], bv[16];
#pragma unroll
    for (int i = 0; i < 16; ++i) { av[i] = key2f(LA[i] & ~127u); bv[i] = key2f(LB[i] & ~127u); }
    unsigned cg[4][16];
#pragma unroll
    for (int g = 0; g < 4; ++g)
#pragma unroll
        for (int e = 0; e < 16; ++e) cg[g][e] = 0u;
    {
        int cnt = 0;
#pragma unroll
        for (int i = 0; i < 16; ++i)
#pragma unroll
            for (int j = 0; j < 16; ++j)
                if ((i + 1) * (j + 1) <= 16) { cg[cnt >> 4][cnt & 15] = (f2key(av[i] + bv[j]) & ~255u) | (unsigned)(255 - (16 * i + j)); ++cnt; }
    }
    bitonic_sort_desc<16>(cg[0]); bitonic_sort_desc<16>(cg[1]); bitonic_sort_desc<16>(cg[2]); bitonic_sort_desc<16>(cg[3]);
    top16_merge(cg[0], cg[1]); top16_merge(cg[0], cg[2]); top16_merge(cg[0], cg[3]);
    LDS_WAIT(); asm volatile("" ::: "memory");
    float sv[16]; int ex[16];
#pragma unroll
    for (int k = 0; k < 16; ++k) { const unsigned key = cg[0][k]; const int pos = 255 - (int)(key & 255u); sv[k] = key2f(key & ~255u);
        const int ia = tab[(pos >> 4) * 64 + lane], ib = tab[(16 + (pos & 15)) * 64 + lane]; ex[k] = ia * 128 + ib; }
    LDS_WAIT(); asm volatile("" ::: "memory");
    const float mx = sv[0]; float sum = 0.f;
#pragma unroll
    for (int k = 0; k < 16; ++k) { sv[k] = expf(sv[k] - mx); sum += sv[k]; }
    const float inv = 1.f / sum;
    if (hi == 0) {
        unsigned short* ip = IDS + (size_t)(tok0 + r32) * 128 + h * 16; float* gp = GATES + (size_t)(tok0 + r32) * 128 + h * 16;
#pragma unroll
        for (int k = 0; k < 16; k += 8) *(u32x4*)(ip + k) = (u32x4){(unsigned)ex[k] | ((unsigned)ex[k + 1] << 16), (unsigned)ex[k + 2] | ((unsigned)ex[k + 3] << 16), (unsigned)ex[k + 4] | ((unsigned)ex[k + 5] << 16), (unsigned)ex[k + 6] | ((unsigned)ex[k + 7] << 16)};
#pragma unroll
        for (int k = 0; k < 16; k += 4) *(f32x4*)(gp + k) = (f32x4){sv[k] * inv, sv[k + 1] * inv, sv[k + 2] * inv, sv[k + 3] * inv};
    }
}
DI void ph_topk(const bf16* PQ, const bf16* SK, unsigned short* IDS, float* GATES, LAS unsigned char* lds, int bx, int G, int wave, int lane) {
    LAS unsigned short* tab = (LAS unsigned short*)(lds + wave * 4096);
    const int h = bx & 7, rank = bx >> 3, nb = (G - h + 7) >> 3, tid = wave * 64 + lane;
    LAS unsigned char* skl = lds + TK_TAB_OFF;
#pragma unroll
    for (int i = 0; i < 8; ++i) { const int c = tid + 512 * i, row = c >> 4, col = c & 15;
        *(LAS u32x4*)(skl + row * TK_ROWB + col * 16) = *(const u32x4*)(SK + ((size_t)h * 256 + row) * 128 + col * 8); }
    __syncthreads();
    for (int g = rank * 8 + wave; g < MTOK / 32; g += nb * 8) topk_task(PQ, skl, IDS, GATES, tab, g * 32, h, lane);
    __syncthreads();
}

DI float gelu_erf(float x) { return 0.5f * x * (1.f + erff(x * 0.70710678118654752f)); }
DI float dot16_fp8(const u32x4& w, const float (&h)[16]) {
    float d0 = 0.f, d1 = 0.f;
#pragma unroll
    for (int e = 0; e < 4; ++e) { const f32x2v lo = __builtin_amdgcn_cvt_pk_f32_fp8((int)w[e], false), hi = __builtin_amdgcn_cvt_pk_f32_fp8((int)w[e], true);
        d0 += lo.x * h[4 * e] + lo.y * h[4 * e + 1]; d1 += hi.x * h[4 * e + 2] + hi.y * h[4 * e + 3]; }
    return d0 + d1;
}
DI float gelu_fast(float v) {
    const float av = fabsf(v), d = av * 0.2316418882f + 1.0f, t = __builtin_amdgcn_rcpf(d);
    float q = t * 0.5307027145f + (-0.7265760135f); q = q * t + 0.7107068705f; q = q * t + (-0.142248368f); q = q * t + 0.127414796f; q = q * t;
    const float e = __builtin_amdgcn_exp2f((v * v) * (-0.72134752044f)), mm = v * (q * e);
    return v < 0.f ? mm : v - mm;
}
DI long lo64(const u32x4& w) { return (long)(((unsigned long long)w.y << 32) | w.x); }
DI long hi64(const u32x4& w) { return (long)(((unsigned long long)w.w << 32) | w.z); }
typedef __amdgpu_buffer_rsrc_t brsrc_t;
DI brsrc_t mkrsrc(const void* p, unsigned bytes) { return __builtin_amdgcn_make_buffer_rsrc((void*)p, 0, (int)bytes, 0x00020000); }
DI u32x4 bl128(brsrc_t r, unsigned voff, unsigned soff) { return __builtin_amdgcn_raw_buffer_load_b128(r, (int)voff, (int)soff, 0); }
DI u32x2 bl64(brsrc_t r, unsigned voff, unsigned soff) { return __builtin_amdgcn_raw_buffer_load_b64(r, (int)voff, (int)soff, 0); }
DI void bs64(brsrc_t r, u32x2 v, unsigned voff, unsigned soff) { __builtin_amdgcn_raw_buffer_store_b64(v, r, (int)voff, (int)soff, 0); }
DI f32x4 asf4(u32x4 v) { return __builtin_bit_cast(f32x4, v); }
template <int VAR> DI void u_issue8(u32x4 (&r)[8], const u32x4& ev, const unsigned char* Ux, unsigned coff) {
#pragma unroll
    for (int i = 0; i < 8; ++i) { const unsigned ew = ev[i >> 1], e = (i & 1) ? (ew >> 16) : (ew & 0xffffu);
        if (VAR == 1) r[i] = (u32x4){e, coff, 0x38383838u, 0x40404040u}; else r[i] = *(const u32x4*)(Ux + (e * 128u + coff)); }
}
DI void u_dot8(const u32x4 (&r)[8], const u32x4& ha, const u32x4& hb, float* p) {
    float h[16];
#pragma unroll
    for (int e = 0; e < 4; ++e) { h[2 * e] = bflo(ha[e]); h[2 * e + 1] = bfhi(ha[e]); h[8 + 2 * e] = bflo(hb[e]); h[8 + 2 * e + 1] = bfhi(hb[e]); }
#pragma unroll
    for (int i = 0; i < 8; ++i) {
        float d0 = 0.f, d1 = 0.f;
        u32x4 row = r[i]; asm volatile("" : "+v"(row));
#pragma unroll
        for (int e = 0; e < 4; ++e) { const f32x2v lo = __builtin_amdgcn_cvt_pk_f32_fp8((int)row[e], false), hi = __builtin_amdgcn_cvt_pk_f32_fp8((int)row[e], true);
            d0 = fmaf(lo.x, h[4 * e], d0); d1 = fmaf(lo.y, h[4 * e + 1], d1); d0 = fmaf(hi.x, h[4 * e + 2], d0); d1 = fmaf(hi.y, h[4 * e + 3], d1); }
        float pi = d0 + d1; asm volatile("" : "+v"(pi)); p[i] = pi;
    }
}
DI void u_reduce_store(const float* p, brsrc_t part_r, unsigned poff, int tok, bool do_store, bool b2, bool b1, bool b0) {
    float v8[8], v4[4], v2[2];
#pragma unroll
    for (int i = 0; i < 8; ++i) { const float keep = b2 ? p[i + 8] : p[i], give = b2 ? p[i] : p[i + 8]; v8[i] = keep + __shfl_xor(give, 4); }
#pragma unroll
    for (int i = 0; i < 4; ++i) { const float keep = b1 ? v8[i + 4] : v8[i], give = b1 ? v8[i] : v8[i + 4]; v4[i] = keep + __shfl_xor(give, 2); }
#pragma unroll
    for (int i = 0; i < 2; ++i) { const float keep = b0 ? v4[i + 2] : v4[i], give = b0 ? v4[i] : v4[i + 2]; v2[i] = keep + __shfl_xor(give, 1); }
    if (do_store) bs64(part_r, (u32x2){__float_as_uint(v2[0]), __float_as_uint(v2[1])}, poff, tok * 512);
}
template <int VAR> DI void ph_peer_u(const unsigned char* U8s, const unsigned short* IDS, const bf16* XN, float* PART, int bx, int G, int wave, int lane) {
    const int x = bx & 7, rank = bx >> 3, nslots = ((G - x + 7) >> 3) * 8;
    const int grp = lane >> 3, c = lane & 7;
    const bool b2 = (lane & 4) != 0, b1 = (lane & 2) != 0, b0 = (lane & 1) != 0;
    const unsigned char* Ux = U8s + (size_t)x * NEXP * 128;
    const unsigned coff = 16u * (unsigned)c;
    const unsigned hoff = (unsigned)(128 * x + 16 * c) * 2u, ioff = 32u * (unsigned)grp;
    const brsrc_t ids_r = mkrsrc(IDS, MTOK * 128 * 2), xn_r = mkrsrc(XN, MTOK * DM * 2), part_r = mkrsrc(PART + (size_t)x * MTOK * 128, MTOK * 128 * 4);
    const unsigned poff = (unsigned)(16 * grp + 8 * (int)b2 + 4 * (int)b1 + 2 * (int)b0) * 4u;
    const int t0 = rank * 8 + wave;
#define UTOK(k) ((t0 + (k) * nslots) < MTOK ? (t0 + (k) * nslots) : (MTOK - 1))
#define UVALID(k) ((t0 + (k) * nslots) < MTOK)
#define U_LOAD_IDS(E, tok) do { E[0] = bl128(ids_r, ioff, (tok) * 256); E[1] = bl128(ids_r, ioff + 16, (tok) * 256); } while (0)
#define U_LOAD_H(Ha, Hb, tok) do { Ha = bl128(xn_r, hoff, (tok) * 2048); Hb = bl128(xn_r, hoff + 16, (tok) * 2048); } while (0)
#define SB() __builtin_amdgcn_sched_barrier(0)
    u32x4 RA[8], RB[8], E0[2], E1[2], H0a, H0b, H1a, H1b; float p[16];
    U_LOAD_IDS(E0, UTOK(0)); U_LOAD_H(H0a, H0b, UTOK(0)); U_LOAD_IDS(E1, UTOK(1)); U_LOAD_H(H1a, H1b, UTOK(1));
    u_issue8<VAR>(RA, E0[0], Ux, coff);
#pragma unroll 1
    for (int k = 0; UVALID(k); k += 2) {
        u_issue8<VAR>(RB, E0[1], Ux, coff); SB();
        u_dot8(RA, H0a, H0b, p); SB();
        u_issue8<VAR>(RA, E1[0], Ux, coff); U_LOAD_IDS(E0, UTOK(k + 2)); SB();
        u_dot8(RB, H0a, H0b, p + 8); u_reduce_store(p, part_r, poff, UTOK(k), true, b2, b1, b0); U_LOAD_H(H0a, H0b, UTOK(k + 2)); SB();
        u_issue8<VAR>(RB, E1[1], Ux, coff); SB();
        u_dot8(RA, H1a, H1b, p); SB();
        u_issue8<VAR>(RA, E0[0], Ux, coff); U_LOAD_IDS(E1, UTOK(k + 3)); SB();
        u_dot8(RB, H1a, H1b, p + 8); u_reduce_store(p, part_r, poff, UTOK(k + 1), UVALID(k + 1), b2, b1, b0); U_LOAD_H(H1a, H1b, UTOK(k + 3)); SB();
    }
#undef UTOK
#undef UVALID
#undef U_LOAD_IDS
#undef U_LOAD_H
}
DI void ph_peer_c(const float* PART, const float* GATES, bf16* ACT, int gw, int NGW, int lane) {
    const float inv = 1.f / U8_SCALE;
    for (int t = gw; t < MTOK; t += NGW) {
        f32x2v s = (f32x2v){0.f, 0.f};
#pragma unroll
        for (int xx = 0; xx < 8; ++xx) { const f32x2v p = *(const f32x2v*)(PART + ((size_t)xx * MTOK + t) * 128 + 2 * lane); s.x += p.x; s.y += p.y; }
        const f32x2v g = *(const f32x2v*)(GATES + (size_t)t * 128 + 2 * lane);
        ((unsigned*)(ACT + (size_t)t * 128))[lane] = cvtpk(gelu_fast(s.x * inv) * g.x, gelu_fast(s.y * inv) * g.y);
    }
}
template <int VAR> DI void v_issue8(u32x4 (&r)[8], const u32x4& ev, const unsigned char* Vx, unsigned coff) {
#pragma unroll
    for (int i = 0; i < 8; ++i) { const unsigned ew = ev[i >> 1], e = (i & 1) ? (ew >> 16) : (ew & 0xffffu);
        if (VAR == 1) r[i] = (u32x4){e, coff, 0x38383838u, 0x40404040u}; else r[i] = *(const u32x4*)(Vx + (e * 128u + coff)); }
}
template <int VAR> DI void v_acc8(const u32x4 (&r)[8], const u32x4& av, float* acc) {
#pragma unroll
    for (int i = 0; i < 8; ++i) {
        const unsigned aw2 = av[i >> 1]; const float aw = (i & 1) ? bfhi(aw2) : bflo(aw2);
        u32x4 row = r[i]; asm volatile("" : "+v"(row));
        if (VAR == 2) { acc[i] += aw * __uint_as_float((row.x ^ row.y ^ row.z ^ row.w) & 0x3fffffffu); continue; }
#pragma unroll
        for (int e = 0; e < 4; ++e) { const f32x2v lo = __builtin_amdgcn_cvt_pk_f32_fp8((int)row[e], false), hi = __builtin_amdgcn_cvt_pk_f32_fp8((int)row[e], true);
            acc[4 * e] = fmaf(aw, lo.x, acc[4 * e]); acc[4 * e + 1] = fmaf(aw, lo.y, acc[4 * e + 1]); acc[4 * e + 2] = fmaf(aw, hi.x, acc[4 * e + 2]); acc[4 * e + 3] = fmaf(aw, hi.y, acc[4 * e + 3]); }
        asm volatile("" : "+v"(acc[0]), "+v"(acc[1]), "+v"(acc[2]), "+v"(acc[3]), "+v"(acc[4]), "+v"(acc[5]), "+v"(acc[6]), "+v"(acc[7]),
                          "+v"(acc[8]), "+v"(acc[9]), "+v"(acc[10]), "+v"(acc[11]), "+v"(acc[12]), "+v"(acc[13]), "+v"(acc[14]), "+v"(acc[15]));
    }
}
DI void v_reduce_store(float* acc, const u32x2& xv, const u32x2& gg, brsrc_t xout_r, unsigned xoff, int tok, bool do_store, bool b5, bool b4, bool b3) {
    float v8[8], v4[4], v2[2];
#pragma unroll
    for (int i = 0; i < 8; ++i) { const float keep = b5 ? acc[i + 8] : acc[i], give = b5 ? acc[i] : acc[i + 8]; v8[i] = keep + __shfl_xor(give, 32); }
#pragma unroll
    for (int i = 0; i < 4; ++i) { const float keep = b4 ? v8[i + 4] : v8[i], give = b4 ? v8[i] : v8[i + 4]; v4[i] = keep + __shfl_xor(give, 16); }
#pragma unroll
    for (int i = 0; i < 2; ++i) { const float keep = b3 ? v4[i + 2] : v4[i], give = b3 ? v4[i] : v4[i + 2]; v2[i] = keep + __shfl_xor(give, 8); }
    u32x2 xo; xo.x = __float_as_uint(__uint_as_float(xv.x) + __uint_as_float(gg.x) * v2[0] * (1.f / V8_SCALE)); xo.y = __float_as_uint(__uint_as_float(xv.y) + __uint_as_float(gg.y) * v2[1] * (1.f / V8_SCALE));
    if (do_store) bs64(xout_r, xo, xoff, tok * 4096);
#pragma unroll
    for (int i = 0; i < 16; ++i) acc[i] = 0.f;
}
template <int VAR> DI void ph_peer_v(const unsigned char* V8  , const unsigned short* IDS, const bf16* ACT, const float* Xin, float* Xout, const float* g2, int bx, int G, int wave, int lane) {
    const int x = bx & 7, rank = bx >> 3, nslots = ((G - x + 7) >> 3) * 8;
    const bool b5 = (lane & 32) != 0, b4 = (lane & 16) != 0, b3 = (lane & 8) != 0;
    const int grp = lane >> 3;
    const unsigned char* Vx = V8 + (size_t)x * NEXP * 128;
    const unsigned coff = 16u * (unsigned)(lane & 7);
    const int dim = 128 * x + 16 * (lane & 7) + 2 * grp;
    const unsigned ioff = 32u * (unsigned)grp, xoff = 4u * (unsigned)dim;
    const brsrc_t ids_r = mkrsrc(IDS, MTOK * 128 * 2), act_r = mkrsrc(ACT, MTOK * 128 * 2), xin_r = mkrsrc(Xin, MTOK * DM * 4), xout_r = mkrsrc(Xout, MTOK * DM * 4), g2_r = mkrsrc(g2, 4 * 6144 * 4);
    const int t0 = rank * 8 + wave;
#define VTOK(k) ((t0 + (k) * nslots) < MTOK ? (t0 + (k) * nslots) : (MTOK - 1))
#define VVALID(k) ((t0 + (k) * nslots) < MTOK)
#define V_LOAD_IDS(E, tok) do { E[0] = bl128(ids_r, ioff, (tok) * 256); E[1] = bl128(ids_r, ioff + 16, (tok) * 256); } while (0)
#define V_LOAD_AX(AV, XV, GV, tok) do { AV[0] = bl128(act_r, ioff, (tok) * 256); AV[1] = bl128(act_r, ioff + 16, (tok) * 256); XV = bl64(xin_r, xoff, (tok) * 4096); GV = bl64(g2_r, xoff, ((tok) >> 12) * (6144 * 4)); } while (0)
    u32x4 RA[8], RB[8], E0[2], E1[2], A0[2], A1[2]; u32x2 X0, X1, G0, G1; float acc[16];
#pragma unroll
    for (int i = 0; i < 16; ++i) acc[i] = 0.f;
    V_LOAD_IDS(E0, VTOK(0)); V_LOAD_AX(A0, X0, G0, VTOK(0)); V_LOAD_IDS(E1, VTOK(1)); V_LOAD_AX(A1, X1, G1, VTOK(1));
    v_issue8<VAR>(RA, E0[0], Vx, coff);
#pragma unroll 1
    for (int k = 0; VVALID(k); k += 2) {
        v_issue8<VAR>(RB, E0[1], Vx, coff); SB();
        v_acc8<VAR>(RA, A0[0], acc); SB();
        v_issue8<VAR>(RA, E1[0], Vx, coff); V_LOAD_IDS(E0, VTOK(k + 2)); SB();
        v_acc8<VAR>(RB, A0[1], acc); v_reduce_store(acc, X0, G0, xout_r, xoff, VTOK(k), true, b5, b4, b3); V_LOAD_AX(A0, X0, G0, VTOK(k + 2)); SB();
        v_issue8<VAR>(RB, E1[1], Vx, coff); SB();
        v_acc8<VAR>(RA, A1[0], acc); SB();
        v_issue8<VAR>(RA, E0[0], Vx, coff); V_LOAD_IDS(E1, VTOK(k + 3)); SB();
        v_acc8<VAR>(RB, A1[1], acc); v_reduce_store(acc, X1, G1, xout_r, xoff, VTOK(k + 1), VVALID(k + 1), b5, b4, b3); V_LOAD_AX(A1, X1, G1, VTOK(k + 3)); SB();
    }
#undef VTOK
#undef VVALID
#undef V_LOAD_IDS
#undef V_LOAD_AX
#undef SB
}

DI void ph_latnorm(const bf16* LAT, const float* qg, const float* kvg, bf16* QN, bf16* KVN, int gw, int NGW, int lane) {
    for (int t = gw; t < MTOK; t += NGW) {
        const unsigned* lr = (const unsigned*)(LAT + (size_t)t * MLA_IN_PAD);
        unsigned q[3], k[2]; float sq = 0.f, sk = 0.f;
#pragma unroll
        for (int j = 0; j < 3; ++j) { q[j] = lr[lane + 64 * j]; sq += bflo(q[j]) * bflo(q[j]) + bfhi(q[j]) * bfhi(q[j]); }
#pragma unroll
        for (int j = 0; j < 2; ++j) { k[j] = lr[192 + lane + 64 * j]; sk += bflo(k[j]) * bflo(k[j]) + bfhi(k[j]) * bfhi(k[j]); }
        const float rq = rsqrtf(wave_sum(sq) * (1.f / QLORA) + NORM_EPS), rk = rsqrtf(wave_sum(sk) * (1.f / KVLORA) + NORM_EPS);
        unsigned* qo = (unsigned*)(QN + (size_t)t * QLORA); unsigned* ko = (unsigned*)(KVN + (size_t)t * KVLORA);
#pragma unroll
        for (int j = 0; j < 3; ++j) { const int c = 2 * (lane + 64 * j); qo[lane + 64 * j] = pk2(bflo(q[j]) * rq * qg[c], bfhi(q[j]) * rq * qg[c + 1]); }
#pragma unroll
        for (int j = 0; j < 2; ++j) { const int c = 2 * (lane + 64 * j); ko[lane + 64 * j] = pk2(bflo(k[j]) * rk * kvg[c], bfhi(k[j]) * rk * kvg[c + 1]); }
    }
}

DI void ph_qkprep(const bf16* QRAW, const bf16* KVRAW, const bf16* LAT, const int* positions, const float* qg, const float* kg,
                  bf16* Qf, bf16* Kf, bf16* Vt, int gw, int NGW, int lane) {
    const int hh = lane >> 3, p = lane & 7;
    float qgn[16], qgr[8], kgn[16], kgr[8], invf[8];
#pragma unroll
    for (int i = 0; i < 16; ++i) { qgn[i] = qg[16 * p + i] * QSCALE; kgn[i] = kg[16 * p + i]; }
#pragma unroll
    for (int i = 0; i < 8; ++i) { qgr[i] = qg[128 + 8 * p + i] * QSCALE; kgr[i] = kg[128 + 8 * p + i]; invf[i] = exp2f(-(float)((8 * p + i) & 31) * (13.287712379549449f / 32.f)); }
    for (int task = gw; task < MTOK / 8; task += NGW) {
        const int t0 = task * 8, b = t0 >> 12, s0 = t0 & (SEQ - 1);
#pragma unroll 1
        for (int tt = 0; tt < 8; ++tt) {
            const int t = t0 + tt, s = s0 + tt;
            const float posf = (float)positions[t];
            float cs[8], sn[8];
#pragma unroll
            for (int i = 0; i < 8; ++i) { const float ang = posf * invf[i]; double rev = (double)ang * 0.15915494309189535; rev -= floor(rev); const float rv = (float)rev; sn[i] = __builtin_amdgcn_sinf(rv); cs[i] = __builtin_amdgcn_cosf(rv); }
            const u32x4 kr4 = *(const u32x4*)(LAT + (size_t)t * MLA_IN_PAD + 640 + 8 * p);
#pragma unroll
            for (int which = 0; which < 2; ++which) {
                const bf16* src = which == 0 ? QRAW + (size_t)t * 1536 + QKH * hh : KVRAW + (size_t)t * 2048 + 256 * hh;
                const u32x4 n0 = *(const u32x4*)(src + 16 * p), n1 = *(const u32x4*)(src + 16 * p + 8);
                const u32x4 r0 = which == 0 ? *(const u32x4*)(src + 128 + 8 * p) : kr4;
                float xn[16], xr[8];
#pragma unroll
                for (int e = 0; e < 4; ++e) { xn[2 * e] = bflo(n0[e]); xn[2 * e + 1] = bfhi(n0[e]); xn[8 + 2 * e] = bflo(n1[e]); xn[8 + 2 * e + 1] = bfhi(n1[e]); xr[2 * e] = bflo(r0[e]); xr[2 * e + 1] = bfhi(r0[e]); }
                float ss = 0.f;
#pragma unroll
                for (int i = 0; i < 16; ++i) ss = fmaf(xn[i], xn[i], ss);
#pragma unroll
                for (int i = 0; i < 8; ++i) ss = fmaf(xr[i], xr[i], ss);
                ss += __shfl_xor(ss, 1); ss += __shfl_xor(ss, 2); ss += __shfl_xor(ss, 4);
                const float rstd = rsqrtf(ss * (1.f / QKH) + NORM_EPS);
                float yr[8], ro[8];
#pragma unroll
                for (int i = 0; i < 16; ++i) xn[i] = xn[i] * rstd * (which == 0 ? qgn[i] : kgn[i]);
#pragma unroll
                for (int i = 0; i < 8; ++i) yr[i] = xr[i] * rstd * (which == 0 ? qgr[i] : kgr[i]);
#pragma unroll
                for (int i = 0; i < 8; ++i) { const float pr = __shfl_xor(yr[i], 4); ro[i] = p < 4 ? yr[i] * cs[i] - pr * sn[i] : pr * sn[i] + yr[i] * cs[i]; }
                bf16* dst = (which == 0 ? Qf : Kf) + ((size_t)(b * NH + hh) * SEQ + s) * QKH;
                u32x4 o0, o1, o2;
                o0.x = cvtpk(xn[0], xn[1]); o0.y = cvtpk(xn[2], xn[3]); o0.z = cvtpk(xn[4], xn[5]); o0.w = cvtpk(xn[6], xn[7]);
                o1.x = cvtpk(xn[8], xn[9]); o1.y = cvtpk(xn[10], xn[11]); o1.z = cvtpk(xn[12], xn[13]); o1.w = cvtpk(xn[14], xn[15]);
                o2.x = cvtpk(ro[0], ro[1]); o2.y = cvtpk(ro[2], ro[3]); o2.z = cvtpk(ro[4], ro[5]); o2.w = cvtpk(ro[6], ro[7]);
                *(u32x4*)(dst + 16 * p) = o0; *(u32x4*)(dst + 16 * p + 8) = o1; *(u32x4*)(dst + 128 + 8 * p) = o2;
            }
        }
#pragma unroll 1
        for (int h = 0; h < NH; ++h)
#pragma unroll
            for (int dd = 0; dd < 128; dd += 64) {
                const bf16* vp = KVRAW + (size_t)t0 * 2048 + 256 * h + 128 + dd + lane;
                unsigned w[4];
#pragma unroll
                for (int i = 0; i < 4; ++i) w[i] = (unsigned)vp[(size_t)(2 * i) * 2048] | ((unsigned)vp[(size_t)(2 * i + 1) * 2048] << 16);
                *(u32x4*)(Vt + ((size_t)(b * NH + h) * VH + dd + lane) * SEQ + s0) = (u32x4){w[0], w[1], w[2], w[3]};
            }
    }
}

DI void attn_unit(const bf16* Qf, const bf16* Kf, const bf16* Vt, bf16* O, int bh, int qb, int wave, int lane) {
    const int r32 = lane & 31, hi = lane >> 5;
    const int q0 = qb * 256 + wave * 32;
    s16x8 qf[12];
    { const bf16* Qp = Qf + ((size_t)bh * SEQ + q0 + r32) * QKH + 8 * hi;
#pragma unroll
      for (int ks = 0; ks < 12; ++ks) qf[ks] = *(const s16x8*)(Qp + 16 * ks); }
    f32x16 o[4];
#pragma unroll
    for (int d = 0; d < 4; ++d)
#pragma unroll
        for (int r = 0; r < 16; ++r) o[d][r] = 0.f;
    float m = -1e30f, l = 0.f;
    const bf16* Kp = Kf + ((size_t)bh * SEQ + r32) * QKH + 8 * hi;
    const bf16* Vp = Vt + ((size_t)bh * VH + r32) * SEQ + 4 * hi;
    const int nkt = q0 / 32 + 1;
#pragma unroll 1
    for (int kt = 0; kt < nkt; ++kt) {
        f32x16 sc;
#pragma unroll
        for (int r = 0; r < 16; ++r) sc[r] = 0.f;
        const bf16* kp = Kp + (size_t)kt * 32 * QKH;
#pragma unroll
        for (int ks = 0; ks < 12; ++ks) sc = __builtin_amdgcn_mfma_f32_32x32x16_bf16(*(const s16x8*)(kp + 16 * ks), qf[ks], sc, 0, 0, 0);
        if (kt == nkt - 1) {
#pragma unroll
            for (int r = 0; r < 16; ++r) if (crow(r, hi) > r32) sc[r] = -INFINITY;
        }
        float mt = sc[0];
#pragma unroll
        for (int r = 1; r < 16; ++r) mt = fmaxf(mt, sc[r]);
        mt = fmaxf(mt, __shfl_xor(mt, 32));
        const float mn = fmaxf(m, mt), alpha = __builtin_amdgcn_exp2f(m - mn);
        m = mn; l *= alpha;
#pragma unroll
        for (int d = 0; d < 4; ++d)
#pragma unroll
            for (int r = 0; r < 16; ++r) o[d][r] *= alpha;
        float ps = 0.f;
#pragma unroll
        for (int r = 0; r < 16; ++r) { sc[r] = __builtin_amdgcn_exp2f(sc[r] - mn); ps += sc[r]; }
        l += ps;
#pragma unroll
        for (int s = 0; s < 2; ++s) {
            u32x4 pw; pw.x = cvtpk(sc[8 * s], sc[8 * s + 1]); pw.y = cvtpk(sc[8 * s + 2], sc[8 * s + 3]); pw.z = cvtpk(sc[8 * s + 4], sc[8 * s + 5]); pw.w = cvtpk(sc[8 * s + 6], sc[8 * s + 7]);
            const s16x8 pb = __builtin_bit_cast(s16x8, pw);
#pragma unroll
            for (int d = 0; d < 4; ++d) {
                const bf16* vp = Vp + (size_t)d * 32 * SEQ + kt * 32 + 16 * s;
                const s16x4 lo = *(const s16x4*)vp, hh = *(const s16x4*)(vp + 8);
                const s16x8 va = __builtin_shufflevector(lo, hh, 0, 1, 2, 3, 4, 5, 6, 7);
                o[d] = __builtin_amdgcn_mfma_f32_32x32x16_bf16(va, pb, o[d], 0, 0, 0);
            }
        }
    }
    l += __shfl_xor(l, 32);
    const float inv = 1.f / l;
    bf16* Op = O + ((size_t)((bh >> 3) * SEQ + q0 + r32)) * DM + (bh & 7) * VH + 4 * hi;
#pragma unroll
    for (int d = 0; d < 4; ++d)
#pragma unroll
        for (int g = 0; g < 4; ++g) { u32x2 w; w.x = cvtpk(o[d][4 * g] * inv, o[d][4 * g + 1] * inv); w.y = cvtpk(o[d][4 * g + 2] * inv, o[d][4 * g + 3] * inv);
            *(u32x2*)(Op + 32 * d + 8 * g) = w; }
}
constexpr int AT_KROW = 400, AT_VROW = 136, AT_KBYTES = 64 * AT_KROW, AT_VBYTES = 128 * AT_VROW, AT_STAGE = AT_KBYTES + AT_VBYTES;
DI void attn_unit_lds(const bf16* Qf, const bf16* Kf, const bf16* Vt, bf16* O, LAS unsigned char* lds, int bh, int qb, int wave, int lane) {
    const int r32 = lane & 31, hi = lane >> 5, tid = wave * 64 + lane;
    const int q0 = qb * 256 + wave * 32;
    s16x8 qf[12];
    { const bf16* Qp = Qf + ((size_t)bh * SEQ + q0 + r32) * QKH + 8 * hi;
#pragma unroll
      for (int ks = 0; ks < 12; ++ks) qf[ks] = *(const s16x8*)(Qp + 16 * ks); }
    f32x16 o[4];
#pragma unroll
    for (int d = 0; d < 4; ++d)
#pragma unroll
        for (int r = 0; r < 16; ++r) o[d][r] = 0.f;
    float m = -1e30f, l = 0.f;
    const int NT = 4 * (qb + 1);
    const __amdgpu_buffer_rsrc_t krs = __builtin_amdgcn_make_buffer_rsrc((void*)(Kf + (size_t)bh * SEQ * QKH), 0, SEQ * QKH * 2, 0x00020000);
    const __amdgpu_buffer_rsrc_t vrs = __builtin_amdgcn_make_buffer_rsrc((void*)(Vt + (size_t)bh * VH * SEQ), 0, VH * SEQ * 2, 0x00020000);
    unsigned kgo[3], kl[3], vgo[2], vl[2];
#pragma unroll
    for (int i = 0; i < 3; ++i) { const int c = tid + 512 * i, row = c / 24, col = c - row * 24; kgo[i] = (unsigned)(row * 384 + col * 16); kl[i] = (unsigned)(row * AT_KROW + col * 16); }
#pragma unroll
    for (int i = 0; i < 2; ++i) { const int c = tid + 512 * i, d = c >> 3, part = c & 7; vgo[i] = (unsigned)(d * (SEQ * 2) + part * 16); vl[i] = (unsigned)(AT_KBYTES + d * AT_VROW + part * 16); }
    u32x4 kr[3], vr[2];
#pragma unroll
    for (int i = 0; i < 3; ++i) kr[i] = __builtin_amdgcn_raw_buffer_load_b128(krs, kgo[i], 0, 0);
#pragma unroll
    for (int i = 0; i < 2; ++i) vr[i] = __builtin_amdgcn_raw_buffer_load_b128(vrs, vgo[i], 0, 0);
#pragma unroll
    for (int i = 0; i < 3; ++i) *(LAS u32x4*)(lds + kl[i]) = kr[i];
#pragma unroll
    for (int i = 0; i < 2; ++i) { *(LAS u32x2*)(lds + vl[i]) = (u32x2){vr[i].x, vr[i].y}; *(LAS u32x2*)(lds + vl[i] + 8) = (u32x2){vr[i].z, vr[i].w}; }
    __syncthreads();
    const unsigned kfo = (unsigned)(r32 * AT_KROW + 16 * hi), vfo = (unsigned)(AT_KBYTES + r32 * AT_VROW + 8 * hi);
#pragma unroll 1
    for (int t = 0; t < NT; ++t) {
        const unsigned sb = (unsigned)((t & 1) * AT_STAGE), sn = (unsigned)(((t + 1) & 1) * AT_STAGE);
        const bool more = t + 1 < NT;
        if (more) {
#pragma unroll
            for (int i = 0; i < 3; ++i) kr[i] = __builtin_amdgcn_raw_buffer_load_b128(krs, kgo[i], (t + 1) * (64 * 384), 0);
#pragma unroll
            for (int i = 0; i < 2; ++i) vr[i] = __builtin_amdgcn_raw_buffer_load_b128(vrs, vgo[i], (t + 1) * 128, 0);
        }
        const int k0 = 64 * t;
        if (k0 <= q0 + 31) {
            f32x16 s0, s1;
#pragma unroll
            for (int r = 0; r < 16; ++r) { s0[r] = 0.f; s1[r] = 0.f; }
#pragma unroll
            for (int ks = 0; ks < 12; ++ks) {
                const s16x8 ka = *(const LAS s16x8*)(lds + sb + kfo + 32 * ks), kb = *(const LAS s16x8*)(lds + sb + kfo + 32 * AT_KROW + 32 * ks);
                s0 = __builtin_amdgcn_mfma_f32_32x32x16_bf16(ka, qf[ks], s0, 0, 0, 0);
                s1 = __builtin_amdgcn_mfma_f32_32x32x16_bf16(kb, qf[ks], s1, 0, 0, 0);
                if ((ks & 3) == 3) __builtin_amdgcn_sched_barrier(0);
            }
            if (k0 + 63 > q0) {
                const int qa = q0 + r32 - k0 - 4 * hi;
#pragma unroll
                for (int r = 0; r < 16; ++r) { if (((r & 3) + 8 * (r >> 2)) > qa) s0[r] = -INFINITY; if ((32 + (r & 3) + 8 * (r >> 2)) > qa) s1[r] = -INFINITY; }
            }
            float mt = fmaxf(s0[0], s1[0]);
#pragma unroll
            for (int r = 1; r < 16; ++r) mt = fmaxf(mt, fmaxf(s0[r], s1[r]));
            mt = fmaxf(mt, __shfl_xor(mt, 32));
            const float mn = fmaxf(m, mt), alpha = __builtin_amdgcn_exp2f(m - mn);
            m = mn; l *= alpha;
#pragma unroll
            for (int d = 0; d < 4; ++d)
#pragma unroll
                for (int r = 0; r < 16; ++r) o[d][r] *= alpha;
            float ps = 0.f;
#pragma unroll
            for (int r = 0; r < 16; ++r) { s0[r] = __builtin_amdgcn_exp2f(s0[r] - mn); s1[r] = __builtin_amdgcn_exp2f(s1[r] - mn); ps += s0[r] + s1[r]; }
            l += ps;
#pragma unroll
            for (int s = 0; s < 4; ++s) {
                u32x4 pw;
                if (s < 2) { pw.x = cvtpk(s0[8 * s], s0[8 * s + 1]); pw.y = cvtpk(s0[8 * s + 2], s0[8 * s + 3]); pw.z = cvtpk(s0[8 * s + 4], s0[8 * s + 5]); pw.w = cvtpk(s0[8 * s + 6], s0[8 * s + 7]); }
                else { const int z = s - 2; pw.x = cvtpk(s1[8 * z], s1[8 * z + 1]); pw.y = cvtpk(s1[8 * z + 2], s1[8 * z + 3]); pw.z = cvtpk(s1[8 * z + 4], s1[8 * z + 5]); pw.w = cvtpk(s1[8 * z + 6], s1[8 * z + 7]); }
                const s16x8 pb = __builtin_bit_cast(s16x8, pw);
#pragma unroll
                for (int d = 0; d < 4; ++d) {
                    const unsigned va = sb + vfo + (unsigned)(d * 32 * AT_VROW + 32 * s);
                    const s16x4 lo = *(const LAS s16x4*)(lds + va), hh = *(const LAS s16x4*)(lds + va + 16);
                    const s16x8 vfrag = __builtin_shufflevector(lo, hh, 0, 1, 2, 3, 4, 5, 6, 7);
                    o[d] = __builtin_amdgcn_mfma_f32_32x32x16_bf16(vfrag, pb, o[d], 0, 0, 0);
                }
                __builtin_amdgcn_sched_barrier(0);
            }
        }
        if (more) {
#pragma unroll
            for (int i = 0; i < 3; ++i) *(LAS u32x4*)(lds + sn + kl[i]) = kr[i];
#pragma unroll
            for (int i = 0; i < 2; ++i) { *(LAS u32x2*)(lds + sn + vl[i]) = (u32x2){vr[i].x, vr[i].y}; *(LAS u32x2*)(lds + sn + vl[i] + 8) = (u32x2){vr[i].z, vr[i].w}; }
        }
        __syncthreads();
    }
    l += __shfl_xor(l, 32);
    const float inv = 1.f / l;
    bf16* Op = O + ((size_t)((bh >> 3) * SEQ + q0 + r32)) * DM + (bh & 7) * VH + 4 * hi;
#pragma unroll
    for (int d = 0; d < 4; ++d)
#pragma unroll
        for (int g = 0; g < 4; ++g) { u32x2 w; w.x = cvtpk(o[d][4 * g] * inv, o[d][4 * g + 1] * inv); w.y = cvtpk(o[d][4 * g + 2] * inv, o[d][4 * g + 3] * inv);
            *(u32x2*)(Op + 32 * d + 8 * g) = w; }
}
DI void ph_attn(const bf16* Qf, const bf16* Kf, const bf16* Vt, bf16* O, LAS unsigned char* lds, int vcu, int G, int wave, int lane) {
    for (int p = vcu; p < 256; p += G) {
        const int bh = p >> 3, s8 = p & 7;
#pragma unroll 1
        for (int u = 0; u < 2; ++u) attn_unit_lds(Qf, Kf, Vt, O, lds, bh, u ? s8 : 15 - s8, wave, lane);
    }
}

__global__ void __launch_bounds__(NWAVES * 64, 2) mk_fwd(Args args) {
    extern __shared__ __attribute__((aligned(16))) unsigned char lds_raw[];
    LAS unsigned char* lds = (LAS unsigned char*)lds_raw;
    const int tid = threadIdx.x, lane = tid & 63, wave = __builtin_amdgcn_readfirstlane(tid >> 6);
    const int G = gridDim.x, bx = blockIdx.x, vcu = (G % 8 == 0) ? (bx % 8) * (G / 8) + bx / 8 : bx;
    const int gw = vcu * NWAVES + wave, NGW = G * NWAVES;
    const size_t GT = (size_t)G * 512;
    unsigned char* ws = args.ws;
    for (int u = tid; u < (LDS_BYTES - LDSCTL_OFF) / 4; u += NWAVES * 64) ((LAS unsigned*)(lds + LDSCTL_OFF))[u] = 0u;
    __syncthreads();
    const bool multi = (args.ph_hi - args.ph_lo) > 1;
    XcdBarrier bar; bar.bar = (unsigned*)(ws + WS_CTL) + CW_BAR; bar.x = 0; bar.st = (volatile LAS unsigned*)(lds + MISC_OFF) + 8;
    if (multi) bar = xcd_barrier_post((unsigned*)(ws + WS_CTL) + CW_BAR, (volatile LAS unsigned*)(lds + MISC_OFF) + 8);

    float* X = args.out;
    const float* mod = (const float*)(ws + WS_MOD);
    bf16* XN = (bf16*)(ws + WS_XN);

    const int lo = args.ph_lo, hi = args.ph_hi;
#define IN(k) (EN(k) && lo <= (k) && (k) < hi)
    auto opq = [](int v) { asm volatile("" : "+v"(v)); return v; };
#define LN opq(lane)
#define TD opq(tid)
#define GTID ((size_t)vcu * 512 + (size_t)opq(tid))
#define SEAM(k) do { if (lo <= (k) && (k) + 1 < hi) xcd_barrier(bar); } while (0)
#define GEMM_BF16(Aptr, Bptr, NN, KK, Optr, LDC) do { pg8::Gemm g{(const bf16*)(Aptr), (const bf16*)(Bptr), MTOK, (NN), (KK)}; pg8::StaticOrder S; S.init(MTOK, (NN), G, bx); \
        pg8::EpiBf16<0> E{(bf16*)(Optr), (LDC), nullptr, 0, 0, 1.f}; pg8::gemm_phase<pg8::EpiBf16<0>, pg8::StaticOrder, true, true>(lds, g, S, E); } while (0)
#define GEMM_RES(Aptr, Bptr, BASE, OUT, GATE) do { pg8::Gemm g{(const bf16*)(Aptr), (const bf16*)(Bptr), MTOK, DM, DM}; pg8::StaticOrder S; S.init(MTOK, DM, G, bx); \
        EpiResGate E{(BASE), (OUT), (GATE)}; pg8::gemm_phase<EpiResGate, pg8::StaticOrder, true, true>(lds, g, S, E); } while (0)

    if (IN(0)) for (int r_ = 0; r_ < NREP(0); ++r_) ph_prologue(args, lds, TD, wave, vcu, G);
    SEAM(0);
    if (IN(1)) for (int r_ = 0; r_ < NREP(1); ++r_) ph_modulate((const float*)args.in[0], XN, nullptr, (const float*)args.in[3], mod, 0, 1024, gw, NGW, LN);
    SEAM(1);
    if (IN(2)) for (int r_ = 0; r_ < NREP(2); ++r_) GEMM_BF16(XN, ws + WS_WCIN, 3072, 1024, ws + WS_BCV, 3072);
    SEAM(2);
    if (IN(3)) for (int r_ = 0; r_ < NREP(3); ++r_) ph_conv((const bf16*)(ws + WS_BCV), (const float*)args.in[8], (bf16*)(ws + WS_Z), GTID, GT);
    SEAM(3);
    if (IN(4)) for (int r_ = 0; r_ < NREP(4); ++r_) GEMM_RES(ws + WS_Z, ws + WS_WCOUT, (const float*)args.in[0], X, mod + 2048);
    SEAM(4);
    if (IN(5)) for (int r_ = 0; r_ < NREP(5); ++r_) ph_modulate(X, XN, nullptr, (const float*)args.in[4], mod, 3072, 4096, gw, NGW, LN);
    SEAM(5);
    if (IN(6)) for (int r_ = 0; r_ < NREP(6); ++r_) GEMM_BF16(XN, ws + WS_WPQ0, 2048, 1024, ws + WS_PQ, 2048);
    SEAM(6);
    if (IN(7)) for (int r_ = 0; r_ < NREP(7); ++r_) ph_topk((const bf16*)(ws + WS_PQ), (const bf16*)(ws + WS_SUBK), (unsigned short*)(ws + WS_IDS), (float*)(ws + WS_GATES), lds, bx, G, wave, LN);
    SEAM(7);
    if (IN(8)) { ph_peer_u<0>(ws + WS_PU, (const unsigned short*)(ws + WS_IDS), XN, (float*)(ws + WS_PART), bx, G, wave, LN);
        for (int r_ = 1; r_ < NREP(8); ++r_) ph_peer_u<PROBE_VAR>(ws + WS_PU, (const unsigned short*)(ws + WS_IDS), XN, (float*)(ws + WS_DUMMY), bx, G, wave, LN); }
    SEAM(8);
    if (IN(9)) for (int r_ = 0; r_ < NREP(9); ++r_) ph_peer_c((const float*)(ws + WS_PART), (const float*)(ws + WS_GATES), (bf16*)(ws + WS_ACT), gw, NGW, LN);
    SEAM(9);
    if (IN(10)) { for (int r_ = 1; r_ < NREP(10); ++r_) ph_peer_v<PROBE_VAR>(ws + WS_PV, (const unsigned short*)(ws + WS_IDS), (const bf16*)(ws + WS_ACT), X, (float*)(ws + WS_DUMMY), mod + 5120, bx, G, wave, LN);
        ph_peer_v<0>(ws + WS_PV, (const unsigned short*)(ws + WS_IDS), (const bf16*)(ws + WS_ACT), X, X, mod + 5120, bx, G, wave, LN); }
    SEAM(10);
    if (IN(11)) for (int r_ = 0; r_ < NREP(11); ++r_) ph_modulate(X, XN, nullptr, (const float*)args.in[3] + DM, mod + (size_t)4 * 6144, 0, 1024, gw, NGW, LN);
    SEAM(11);
    if (IN(12)) for (int r_ = 0; r_ < NREP(12); ++r_) GEMM_BF16(XN, ws + WS_WMIN, MLA_IN_PAD, 1024, ws + WS_LAT, MLA_IN_PAD);
    SEAM(12);
    if (IN(13)) for (int r_ = 0; r_ < NREP(13); ++r_) ph_latnorm((const bf16*)(ws + WS_LAT), (const float*)args.in[11], (const float*)args.in[12], (bf16*)(ws + WS_QN), (bf16*)(ws + WS_KVN), gw, NGW, LN);
    SEAM(13);
    if (IN(14)) for (int r_ = 0; r_ < NREP(14); ++r_) { GEMM_BF16(ws + WS_QN, ws + WS_WQB, 1536, QLORA, ws + WS_QRAW, 1536); GEMM_BF16(ws + WS_KVN, ws + WS_WKVB, 2048, KVLORA, ws + WS_KVRAW, 2048); }
    SEAM(14);
    if (IN(15)) for (int r_ = 0; r_ < NREP(15); ++r_) ph_qkprep((const bf16*)(ws + WS_QRAW), (const bf16*)(ws + WS_KVRAW), (const bf16*)(ws + WS_LAT), (const int*)args.in[2], (const float*)args.in[15], (const float*)args.in[16],
                          (bf16*)(ws + WS_QF), (bf16*)(ws + WS_KF), (bf16*)(ws + WS_VT), gw, NGW, LN);
    SEAM(15);
    if (IN(16)) for (int r_ = 0; r_ < NREP(16); ++r_) ph_attn((const bf16*)(ws + WS_QF), (const bf16*)(ws + WS_KF), (const bf16*)(ws + WS_VT), (bf16*)(ws + WS_O), lds, vcu, G, wave, LN);
    SEAM(16);
    if (IN(17)) for (int r_ = 0; r_ < NREP(17); ++r_) GEMM_RES(ws + WS_O, ws + WS_WMOUT, (const float*)X, (r_ + 1 < NREP(17) ? (float*)(ws + WS_DUMMY) : X), mod + (size_t)4 * 6144 + 2048);
    SEAM(17);
    if (IN(18)) for (int r_ = 0; r_ < NREP(18); ++r_) ph_modulate(X, XN, nullptr, (const float*)args.in[4] + DM, mod + (size_t)4 * 6144, 3072, 4096, gw, NGW, LN);
    SEAM(18);
    if (IN(19)) for (int r_ = 0; r_ < NREP(19); ++r_) GEMM_BF16(XN, ws + WS_WPQ1, 2048, 1024, ws + WS_PQ, 2048);
    SEAM(19);
    if (IN(20)) for (int r_ = 0; r_ < NREP(20); ++r_) ph_topk((const bf16*)(ws + WS_PQ), (const bf16*)(ws + WS_SUBK) + (size_t)8 * 2 * 128 * 128, (unsigned short*)(ws + WS_IDS), (float*)(ws + WS_GATES), lds, bx, G, wave, LN);
    SEAM(20);
    if (IN(21)) for (int r_ = 0; r_ < NREP(21); ++r_) ph_peer_u<0>(ws + WS_PU + (size_t)8 * NEXP * 128, (const unsigned short*)(ws + WS_IDS), XN, (float*)(ws + WS_PART), bx, G, wave, LN);
    SEAM(21);
    if (IN(22)) for (int r_ = 0; r_ < NREP(22); ++r_) ph_peer_c((const float*)(ws + WS_PART), (const float*)(ws + WS_GATES), (bf16*)(ws + WS_ACT), gw, NGW, LN);
    SEAM(22);
    if (IN(23)) for (int r_ = 0; r_ < NREP(23); ++r_) ph_peer_v<0>(ws + WS_PV + (size_t)8 * NEXP * 128, (const unsigned short*)(ws + WS_IDS), (const bf16*)(ws + WS_ACT), X, (r_ + 1 < NREP(23) ? (float*)(ws + WS_DUMMY) : X), mod + (size_t)4 * 6144 + 5120, bx, G, wave, LN);
}

extern "C" void kernel_launch(void* const* d_in, const int* in_sizes, int n_in, void* d_out, int out_size, void* d_ws, size_t ws_size, hipStream_t stream) {
    static int grid = 0;
    if (grid == 0) {
        if (n_in != 22 || out_size != MTOK * DM || ws_size < WS_END) { fprintf(stderr, "kernel_launch: unexpected shapes: n_in %d out %d ws %zu (need %zu)\n", n_in, out_size, ws_size, (size_t)WS_END); grid = -1; return; }
        int dev = 0, cus = 0;
        if (hipGetDevice(&dev) != hipSuccess || hipDeviceGetAttribute(&cus, hipDeviceAttributeMultiprocessorCount, dev) != hipSuccess) { grid = -1; return; }
        if (hipFuncSetAttribute((const void*)mk_fwd, hipFuncAttributeMaxDynamicSharedMemorySize, LDS_BYTES) != hipSuccess) { fprintf(stderr, "kernel_launch: hipFuncSetAttribute failed\n"); grid = -1; return; }
        int per_cu = 0;
        if (hipOccupancyMaxActiveBlocksPerMultiprocessor(&per_cu, (const void*)mk_fwd, NWAVES * 64, LDS_BYTES) != hipSuccess || per_cu < 1) fprintf(stderr, "kernel_launch: occupancy query says %d\n", per_cu);
        (void)hipGetLastError();
        grid = cus;
    }
    if (grid < 0) return;
    (void)hipMemsetAsync((char*)d_ws + WS_CTL, 0, CTL_ZERO_BYTES, stream);
    Args a{};
    for (int i = 0; i < 22; ++i) a.in[i] = d_in[i];
    a.out = (float*)d_out; a.ws = (unsigned char*)d_ws;
#if MK_N_LAUNCHES == 1
    a.ph_lo = 0; a.ph_hi = NPHASES;
    hipLaunchKernelGGL(mk_fwd, dim3(grid), dim3(NWAVES * 64), LDS_BYTES, stream, a);
#else
    for (int ph = 0; ph < NPHASES; ++ph) { a.ph_lo = ph; a.ph_hi = ph + 1; hipLaunchKernelGGL(mk_fwd, dim3(grid), dim3(NWAVES * 64), LDS_BYTES, stream, a); }
#endif
}
```

```cpp
#include <hip/hip_runtime.h>
#include <cstdio>
#include <cstdint>
#define GAS __attribute__((address_space(1)))
#define LAS __attribute__((address_space(3)))
namespace pg8 {
#define PG8_LAS __attribute__((address_space(3)))
typedef unsigned short bf16_t;
typedef short bf16x8 __attribute__((ext_vector_type(8)));
typedef float f32x4 __attribute__((ext_vector_type(4)));
typedef unsigned u32x4 __attribute__((ext_vector_type(4)));
constexpr int BM = 256, BK = 64, HALF = 128, HTB = HALF * BK * 2  , STAGE_BYTES = 8 * HTB, NXCD = 8, WGM = 8;

__host__ __device__ __forceinline__ int lds_byte(int r, int c) { const int st = (r >> 4) * 2 + (c >> 5), rr = r & 15, cc = c & 31, ob = rr * 64 + cc * 2; return st * 1024 + (ob ^ (((ob >> 9) & 1) << 5)); }
__host__ __device__ __forceinline__ void stage_rc(int b, int& R, int& C) { const int st = b / 1024, sb = b % 1024, swz = sb ^ (((sb >> 9) & 1) << 5); R = (st >> 1) * 16 + swz / 64; C = (st & 1) * 32 + (swz % 64) / 2; }
__host__ __device__ __forceinline__ int perm32(int rho) { const int n = rho >> 4, i = rho & 15; return 8 * (i >> 2) + 4 * n + (i & 3); }

struct Unit { int pm, pn; };
struct Gemm { const bf16_t* A; const bf16_t* Bt; int M, N, K; };

struct StaticOrder {
    int nM, nN, nwg, G, c;
    __host__ __device__ void init(int M, int N, int G_, int c_) { nM = M / BM; nN = N / BM; nwg = nM * nN; G = G_; c = c_; }
    __host__ __device__ bool next(int i, Unit& u) const {
        const long L = (long)i * G + c; if (L >= nwg) return false;
        int wgid = (int)L; { const int q = nwg / NXCD, r = nwg % NXCD, xcd = wgid % NXCD, off = wgid / NXCD; wgid = (xcd < r ? xcd * (q + 1) : r * (q + 1) + (xcd - r) * q) + off; }
        const int nig = WGM * nN, gid = wgid / nig, fm = gid * WGM, gsz = (nM - fm) < WGM ? (nM - fm) : WGM;
        u.pm = fm + ((wgid % nig) % gsz); u.pn = (wgid % nig) / gsz; return true;
    }
    __device__ __forceinline__ void a_ready(const Unit&) const {}
    __device__ __forceinline__ void done(const Unit&) const {}
};

__device__ __forceinline__ unsigned cvt_pk_bf16(float lo, float hi) { unsigned r; asm volatile("v_cvt_pk_bf16_f32 %0, %1, %2" : "=v"(r) : "v"(lo), "v"(hi)); return r; }
typedef float f32x2 __attribute__((ext_vector_type(2)));
__device__ __forceinline__ f32x2 gelu_pk(f32x2 v) {
    const f32x2 av = __builtin_elementwise_abs(v), d = av * 0.2316418882f + 1.0f;
    f32x2 t; t.x = __builtin_amdgcn_rcpf(d.x); t.y = __builtin_amdgcn_rcpf(d.y);
    f32x2 q = t * 0.5307027145f + (-0.7265760135f); q = q * t + 0.7107068705f; q = q * t + (-0.142248368f); q = q * t + 0.127414796f; q = q * t;
    const f32x2 s = (v * v) * (-0.72134752044f);
    f32x2 e; e.x = __builtin_amdgcn_exp2f(s.x); e.y = __builtin_amdgcn_exp2f(s.y);
    const f32x2 m = v * (q * e), r = v - m;
    f32x2 o; o.x = v.x < 0.f ? m.x : r.x; o.y = v.y < 0.f ? m.y : r.y; return o;
}

template <int ACT  > struct EpiBf16 {
    static constexpr bool PERM = true, AFTER_DRAIN = false; static_assert(ACT == 0 || ACT == 1, "EpiBf16: ACT is 0 (none) or 1 (gelu_pk)");
    bf16_t* O; int ldc; const float* bias; int split_cols; size_t split_stride; float scale0;
    __device__ __forceinline__ void operator()(const f32x4 (&acc)[2][2][4][2], const Unit& u, int wr, int wc, int fr, int fq) const {
        const int row0 = u.pm * BM + wr * 64 + fr; int colt = u.pn * BM; bf16_t* base = O;
        float sc = 1.f; if (split_cols) { const int t = colt / split_cols; base += (size_t)t * split_stride; colt -= t * split_cols; if (t == 0) sc = scale0; }
        const int col0 = colt + wc * 32 + 8 * fq, bcol0 = u.pn * BM + wc * 32 + 8 * fq;
        f32x4 bv[2][2];
#pragma unroll
        for (int bj = 0; bj < 2; ++bj)
#pragma unroll
            for (int n = 0; n < 2; ++n) bv[bj][n] = bias ? *(const f32x4*)(bias + bcol0 + bj * HALF + 4 * n) : (f32x4){0.f, 0.f, 0.f, 0.f};
#pragma unroll
        for (int ai = 0; ai < 2; ++ai)
#pragma unroll
            for (int m = 0; m < 4; ++m) { bf16_t* rowp = base + (size_t)(row0 + ai * HALF + m * 16) * ldc + col0;
#pragma unroll
                for (int bj = 0; bj < 2; ++bj) { f32x4 v0 = acc[ai][bj][m][0] + bv[bj][0], v1 = acc[ai][bj][m][1] + bv[bj][1];
                    if (ACT == 1) { f32x2 a = gelu_pk((f32x2){v0[0], v0[1]}), b = gelu_pk((f32x2){v0[2], v0[3]}), c = gelu_pk((f32x2){v1[0], v1[1]}), d = gelu_pk((f32x2){v1[2], v1[3]});
                        v0 = (f32x4){a.x, a.y, b.x, b.y}; v1 = (f32x4){c.x, c.y, d.x, d.y}; }
                    v0 = v0 * sc; v1 = v1 * sc; u32x4 w; w.x = cvt_pk_bf16(v0[0], v0[1]); w.y = cvt_pk_bf16(v0[2], v0[3]); w.z = cvt_pk_bf16(v1[0], v1[1]); w.w = cvt_pk_bf16(v1[2], v1[3]);
                    *(u32x4*)(rowp + bj * HALF) = w; } }
    }
};

template <class Epi, class Sched, bool ALIGN_EPI = false, bool SP2 = false>
__device__ __forceinline__ void gemm_phase(PG8_LAS unsigned char* lds, const Gemm g, const Sched& S, const Epi& E) {
    int tid_raw = threadIdx.x; asm volatile("" : "+v"(tid_raw));
    const int tid = tid_raw, wid = __builtin_amdgcn_readfirstlane(tid >> 6), lane = tid & 63, wr = wid >> 2, wc = wid & 3, fr = lane & 15, fq = lane >> 4;
    const int K = g.K, nt = K / BK;
    unsigned voffA[2], voffB[2];
#pragma unroll
    for (int i = 0; i < 2; ++i) { int R, C; stage_rc(tid * 16 + i * 8192, R, C); const int Rb = Epi::PERM ? ((R & ~31) + perm32(R & 31)) : R;
        voffA[i] = (unsigned)(R * K + C) * 2u; voffB[i] = (unsigned)(Rb * K + C) * 2u; }
    const size_t kstep = (size_t)(BK * 2);
    const size_t hstep = (size_t)HALF * K * 2;
    const size_t tstep = 2 * hstep;
    const unsigned ldsw = (unsigned)wid * 1024u;
    const int aoff = lds_byte(wr * 64 + fr, fq * 8), boff = lds_byte(wc * 32 + fr, fq * 8);
#define PG8_SA(b, h) (((b) * 2 + (h)) * HTB)
#define PG8_SB(b, h) ((4 + (b) * 2 + (h)) * HTB)
#define PG8_STAGE(bufoff, gbase, voff) do { _Pragma("unroll") for (int _i = 0; _i < 2; ++_i) \
        __builtin_amdgcn_global_load_lds((const unsigned*)((const char*)(gbase) + (voff)[_i]), (PG8_LAS unsigned*)(lds + (bufoff) + ldsw + _i * 8192), 16, 0, 0); } while (0)
#define PG8_LDA(dst, b, h) do { _Pragma("unroll") for (int m = 0; m < 4; ++m) _Pragma("unroll") for (int k = 0; k < 2; ++k) dst[m][k] = *(const PG8_LAS bf16x8*)(lds + PG8_SA(b, h) + aoff + m * 2048 + k * 1024); } while (0)
#define PG8_LDB(dst, b, h) do { _Pragma("unroll") for (int n = 0; n < 2; ++n) _Pragma("unroll") for (int k = 0; k < 2; ++k) dst[n][k] = *(const PG8_LAS bf16x8*)(lds + PG8_SB(b, h) + boff + n * 2048 + k * 1024); } while (0)
#define PG8_MMA(ai, bj, At, Bt) do { __builtin_amdgcn_s_setprio(1); _Pragma("unroll") for (int m = 0; m < 4; ++m) _Pragma("unroll") for (int n = 0; n < 2; ++n) _Pragma("unroll") for (int k = 0; k < 2; ++k) \
        acc[ai][bj][m][n] = __builtin_amdgcn_mfma_f32_16x16x32_bf16(Bt[n][k], At[m][k], acc[ai][bj][m][n], 0, 0, 0); __builtin_amdgcn_s_setprio(0); } while (0)
#define PG8_WAIT_V(n) asm volatile("s_waitcnt vmcnt(" #n ")" ::: "memory")
#define PG8_WAIT_L(n) asm volatile("s_waitcnt lgkmcnt(" #n ")" ::: "memory")
#define PG8_BAR __builtin_amdgcn_s_barrier()
#define PG8_SCHED __builtin_amdgcn_sched_barrier(0)
    Unit cur, nxt; int ui = 0;
    if (!S.next(0, cur)) return;
    f32x4 acc[2][2][4][2];
#pragma unroll
    for (int a = 0; a < 2; ++a)
#pragma unroll
        for (int b = 0; b < 2; ++b)
#pragma unroll
            for (int m = 0; m < 4; ++m)
#pragma unroll
                for (int n = 0; n < 2; ++n) acc[a][b][m][n] = (f32x4){0.f, 0.f, 0.f, 0.f};
    bf16x8 At[4][2], B0[2][2], B1[2][2];
    const char* cA = (const char*)g.A + (size_t)cur.pm * tstep; const char* cB = (const char*)g.Bt + (size_t)cur.pn * tstep;
    S.a_ready(cur);
    if constexpr (SP2) {
        PG8_STAGE(PG8_SB(0, 0), cB, voffB); PG8_STAGE(PG8_SB(0, 1), cB + hstep, voffB); PG8_STAGE(PG8_SA(0, 0), cA, voffA); PG8_STAGE(PG8_SA(0, 1), cA + hstep, voffA);
        if (wr == 1) PG8_BAR;
        PG8_WAIT_V(2); PG8_BAR;
        PG8_STAGE(PG8_SB(1, 0), cB + kstep, voffB); PG8_STAGE(PG8_SA(1, 0), cA + kstep, voffA); PG8_STAGE(PG8_SB(1, 1), cB + hstep + kstep, voffB);
        PG8_WAIT_V(6); PG8_BAR;
    } else {
        PG8_STAGE(PG8_SB(0, 0), cB, voffB); PG8_STAGE(PG8_SA(0, 0), cA, voffA); PG8_STAGE(PG8_SB(0, 1), cB + hstep, voffB); PG8_STAGE(PG8_SA(0, 1), cA + hstep, voffA);
        if (wr == 1) PG8_BAR;
        PG8_WAIT_V(4); PG8_BAR;
        PG8_STAGE(PG8_SB(1, 0), cB + kstep, voffB); PG8_STAGE(PG8_SA(1, 0), cA + kstep, voffA); PG8_STAGE(PG8_SB(1, 1), cB + hstep + kstep, voffB);
        PG8_WAIT_V(6); PG8_BAR;
    }
    for (;;) {
        const bool has_next = S.next(ui + 1, nxt);
        const char* nA = has_next ? (const char*)g.A + (size_t)nxt.pm * tstep : cA; const char* nB = has_next ? (const char*)g.Bt + (size_t)nxt.pn * tstep : cB;
        for (int t = 0; t < nt; t += 2) {
            const bool last = (t == nt - 2);
            const char* a1 = cA + (size_t)(t + 1) * kstep;
            const char* a2 = last ? nA : cA + (size_t)(t + 2) * kstep; const char* b2 = last ? nB : cB + (size_t)(t + 2) * kstep;
            const char* a3 = a2 + kstep; const char* b3 = b2 + kstep;
            if (last && has_next) S.a_ready(nxt);
            if constexpr (SP2) {
            PG8_LDB(B0, 0, 0); PG8_LDB(B1, 0, 1); PG8_SCHED; PG8_LDA(At, 0, 0); PG8_STAGE(PG8_SA(1, 1), a1 + hstep, voffA);
            PG8_WAIT_V(8); PG8_WAIT_L(0); PG8_BAR; PG8_MMA(0, 0, At, B0); PG8_MMA(0, 1, At, B1); PG8_BAR; PG8_SCHED;
            PG8_LDA(At, 0, 1); PG8_STAGE(PG8_SB(0, 0), b2, voffB); PG8_STAGE(PG8_SB(0, 1), b2 + hstep, voffB); PG8_STAGE(PG8_SA(0, 0), a2, voffA);
            PG8_WAIT_V(8); PG8_WAIT_L(0); PG8_BAR; PG8_MMA(1, 0, At, B0); PG8_MMA(1, 1, At, B1); PG8_BAR; PG8_SCHED;
            PG8_LDB(B0, 1, 0); PG8_LDB(B1, 1, 1); PG8_SCHED; PG8_LDA(At, 1, 0); PG8_STAGE(PG8_SA(0, 1), a2 + hstep, voffA);
            PG8_WAIT_V(8); PG8_WAIT_L(0); PG8_BAR; PG8_MMA(0, 0, At, B0); PG8_MMA(0, 1, At, B1); PG8_BAR; PG8_SCHED;
            PG8_LDA(At, 1, 1); PG8_STAGE(PG8_SB(1, 0), b3, voffB); PG8_STAGE(PG8_SB(1, 1), b3 + hstep, voffB); PG8_STAGE(PG8_SA(1, 0), a3, voffA);
            PG8_WAIT_V(8); PG8_WAIT_L(0); PG8_BAR; PG8_MMA(1, 0, At, B0); PG8_MMA(1, 1, At, B1); PG8_BAR; PG8_SCHED;
            } else {
            PG8_LDB(B0, 0, 0); PG8_SCHED; PG8_LDA(At, 0, 0); PG8_STAGE(PG8_SA(1, 1), a1 + hstep, voffA);
            PG8_WAIT_L(8); PG8_BAR; PG8_WAIT_L(0); PG8_MMA(0, 0, At, B0); PG8_BAR; PG8_SCHED;
            PG8_LDB(B1, 0, 1); PG8_STAGE(PG8_SB(0, 0), b2, voffB);
            PG8_BAR; PG8_WAIT_L(0); PG8_MMA(0, 1, At, B1); PG8_BAR;
            PG8_LDA(At, 0, 1); PG8_STAGE(PG8_SA(0, 0), a2, voffA);
            PG8_BAR; PG8_WAIT_L(0); PG8_MMA(1, 0, At, B0); PG8_BAR; PG8_SCHED;
            PG8_STAGE(PG8_SB(0, 1), b2 + hstep, voffB);
            PG8_WAIT_V(6); PG8_BAR; PG8_MMA(1, 1, At, B1); PG8_BAR;
            PG8_LDB(B0, 1, 0); PG8_SCHED; PG8_LDA(At, 1, 0); PG8_STAGE(PG8_SA(0, 1), a2 + hstep, voffA);
            PG8_WAIT_L(8); PG8_BAR; PG8_WAIT_L(0); PG8_MMA(0, 0, At, B0); PG8_BAR; PG8_SCHED;
            PG8_LDB(B1, 1, 1); PG8_STAGE(PG8_SB(1, 0), b3, voffB);
            PG8_BAR; PG8_WAIT_L(0); PG8_MMA(0, 1, At, B1); PG8_BAR;
            PG8_LDA(At, 1, 1); PG8_STAGE(PG8_SA(1, 0), a3, voffA);
            PG8_BAR; PG8_WAIT_L(0); PG8_MMA(1, 0, At, B0); PG8_BAR; PG8_SCHED;
            PG8_STAGE(PG8_SB(1, 1), b3 + hstep, voffB);
            PG8_WAIT_V(6); PG8_BAR; PG8_MMA(1, 1, At, B1); PG8_BAR;
            }
        }
        if constexpr (ALIGN_EPI) { if (wr == 0) PG8_BAR; }
        if constexpr (!Epi::AFTER_DRAIN) { E(acc, cur, wr, wc, fr, fq); S.done(cur); }
        if (!has_next) break;
#pragma unroll
        for (int a = 0; a < 2; ++a)
#pragma unroll
            for (int b = 0; b < 2; ++b)
#pragma unroll
                for (int m = 0; m < 4; ++m)
#pragma unroll
                    for (int n = 0; n < 2; ++n) acc[a][b][m][n] = (f32x4){0.f, 0.f, 0.f, 0.f};
        cur = nxt; cA = nA; cB = nB; ++ui;
        if constexpr (ALIGN_EPI) { if (wr == 1) PG8_BAR; }
    }
    PG8_WAIT_V(0);
    if constexpr (!ALIGN_EPI) { if (wr == 0) PG8_BAR; }
    PG8_BAR;
    if constexpr (Epi::AFTER_DRAIN) { E.fused(acc, cur, wr, wc, fr, fq, lds, wid, lane); S.done(cur); }
#undef PG8_SA
#undef PG8_SB
#undef PG8_STAGE
#undef PG8_LDA
#undef PG8_LDB
#undef PG8_MMA
#undef PG8_WAIT_V
#undef PG8_WAIT_L
#undef PG8_BAR
#undef PG8_SCHED
}
}
#define XB_TMO      128
#define XB_XCNT(j)  (256  + 64 * (j))
#define XB_XSUB(j)  (1280 + 64 * (j))
#define XB_XGEN(j)  (2304 + 64 * (j))
#define XB_TOP      3328
#define XB_TOPGEN   3392
#define XCD_BAR_WORDS 3456
#define XB_SPIN_CAP (1u << 18)

__device__ __forceinline__ unsigned xb_ld(unsigned* p)              { return __hip_atomic_load(p, __ATOMIC_RELAXED, __HIP_MEMORY_SCOPE_AGENT); }
__device__ __forceinline__ unsigned xb_add(unsigned* p, unsigned v) { return __hip_atomic_fetch_add(p, v, __ATOMIC_RELAXED, __HIP_MEMORY_SCOPE_AGENT); }
__device__ __forceinline__ unsigned xb_xcc_id() { return (unsigned)__builtin_amdgcn_s_getreg((3 << 11) | 20) & 0xFu; }
#define XB_SPIN(cond, bar) do { unsigned _sp = 0; while (cond) { __builtin_amdgcn_s_sleep(1); \
    if ((++_sp & 255u) == 0u) { if (xb_ld(&(bar)[XB_TMO])) break; if (_sp > XB_SPIN_CAP) { atomicAdd(&(bar)[XB_TMO], 1u); break; } } } } while (0)

struct XcdBarrier {
    unsigned* bar; unsigned x;
    volatile LAS unsigned* st;
};

__device__ __forceinline__ XcdBarrier xcd_barrier_post(unsigned* bar, volatile LAS unsigned* st) {
    XcdBarrier b; b.bar = bar; b.x = xb_xcc_id(); b.st = st;
    if (threadIdx.x == 0) (void)xb_add(&bar[XB_XCNT(b.x)], 1u);
    return b;
}
__device__ __forceinline__ void xcd_barrier_complete(unsigned* bar, unsigned x, unsigned& nloc, unsigned& nx) {
    const unsigned G = gridDim.x * gridDim.y * gridDim.z;
    unsigned sum, cnt, mine, sp = 0u;
    for (;;) {
        sum = 0u; cnt = 0u; mine = 0u;
#pragma unroll
        for (unsigned j = 0; j < 16; ++j) { const unsigned c = xb_ld(&bar[XB_XCNT(j)]); sum += c; cnt += (c > 0u) ? 1u : 0u; mine = (j == x) ? c : mine; }
        if (sum == G) break;
        __builtin_amdgcn_s_sleep(1);
        if ((++sp & 255u) == 0u) { if (xb_ld(&bar[XB_TMO])) break; if (sp > XB_SPIN_CAP) { atomicAdd(&bar[XB_TMO], 1u); break; } }
    }
    nloc = mine > 0u ? mine : 1u; nx = cnt > 0u ? cnt : 1u;
}

__device__ __forceinline__ void xcd_barrier(const XcdBarrier& b) {
    asm volatile("s_waitcnt vmcnt(0)" ::: "memory");
    __syncthreads();
    if (threadIdx.x == 0) {
        unsigned* bar = b.bar;
        __builtin_amdgcn_s_waitcnt(0);
        unsigned nloc = b.st[0], nx = b.st[1];
        if (nloc == 0u) { xcd_barrier_complete(bar, b.x, nloc, nx); b.st[0] = nloc; b.st[1] = nx; }
        const unsigned old = xb_add(&bar[XB_XSUB(b.x)], 1u);
        const unsigned gen = old / nloc;
        if (old + 1u == (gen + 1u) * nloc) {
            __builtin_amdgcn_fence(__ATOMIC_RELEASE, "agent");
            asm volatile("s_waitcnt vmcnt(0)" ::: "memory");
            const unsigned og = xb_add(&bar[XB_TOP], 1u);
            const unsigned tg = og / nx;
            if (og + 1u == (tg + 1u) * nx) xb_add(&bar[XB_TOPGEN], 1u);
            else XB_SPIN(xb_ld(&bar[XB_TOPGEN]) == tg, bar);
            __builtin_amdgcn_fence(__ATOMIC_ACQUIRE, "agent");
            xb_add(&bar[XB_XGEN(b.x)], 1u);
            asm volatile("s_waitcnt vmcnt(0)" ::: "memory");
        } else {
            XB_SPIN(xb_ld(&bar[XB_XGEN(b.x)]) == gen, bar);
            __builtin_amdgcn_fence(__ATOMIC_ACQUIRE, "agent");
            asm volatile("s_waitcnt vmcnt(0)" ::: "memory");
        }
    }
    __syncthreads();
}

constexpr int DM = 1024, NB = 4, SEQ = 4096, MTOK = NB * SEQ;
constexpr int QLORA = 384, KVLORA = 256, ROPE = 64, NOPE = 128, QKH = 192, VH = 128, NH = 8;
constexpr int MLA_IN = 704, MLA_IN_PAD = 768;
constexpr int NEXP = 16384;
constexpr float NORM_EPS = 1e-6f;
constexpr float U8_SCALE = 256.f, V8_SCALE = 16.f, H8_SCALE = 8.f;
constexpr float QSCALE = 0.07216878364870322f * 1.4426950408889634f;

#ifndef MK_N_LAUNCHES
#define MK_N_LAUNCHES 1
#endif
constexpr int NPHASES = 24;
#ifndef PHMASK
#define PHMASK 0xFFFFFFu
#endif
#define EN(k) (((PHMASK) >> (k)) & 1u)
#ifndef PROBE_PHASE
#define PROBE_PHASE -1
#endif
#ifndef PROBE_VAR
#define PROBE_VAR 0
#endif
#ifndef PROBE_REPS
#define PROBE_REPS 2
#endif
#define NREP(k) ((k) == (PROBE_PHASE) ? (PROBE_REPS) : 1)
constexpr int NWAVES = 8;

constexpr size_t MiB = 1u << 20;
constexpr size_t WS_CTL = 0, CTL_ZERO_BYTES = 64 * 1024;
constexpr size_t WS_MOD = 1 * MiB;
constexpr size_t WS_WCIN = 2 * MiB;
constexpr size_t WS_WCOUT = 8 * MiB;
constexpr size_t WS_WPQ0 = 10 * MiB, WS_WPQ1 = 14 * MiB;
constexpr size_t WS_WMIN = 18 * MiB;
constexpr size_t WS_WQB = 20 * MiB;
constexpr size_t WS_WKVB = 22 * MiB;
constexpr size_t WS_WMOUT = 24 * MiB;
constexpr size_t WS_SUBK = 26 * MiB;
constexpr size_t WS_PU = 32 * MiB;
constexpr size_t WS_PV = 96 * MiB;
constexpr size_t WS_XN = 160 * MiB;
constexpr size_t WS_VT = 160 * MiB;
constexpr size_t WS_BCV = 192 * MiB;
constexpr size_t WS_LAT = 192 * MiB;
constexpr size_t WS_O = 192 * MiB;
constexpr size_t WS_QN = 216 * MiB;
constexpr size_t WS_KVN = 228 * MiB;
constexpr size_t WS_QRAW = 236 * MiB;
constexpr size_t WS_Z = 288 * MiB;
constexpr size_t WS_KVRAW = 288 * MiB;
constexpr size_t WS_PQ = 288 * MiB;
constexpr size_t WS_QF = 352 * MiB;
constexpr size_t WS_KF = 400 * MiB;
constexpr size_t WS_IDS = 448 * MiB;
constexpr size_t WS_GATES = 456 * MiB;
constexpr size_t WS_PART = 192 * MiB;
constexpr size_t WS_DUMMY = 288 * MiB;
constexpr size_t WS_ACT = 464 * MiB;
constexpr size_t WS_XN8 = 472 * MiB;
constexpr size_t WS_END = 488 * MiB;
constexpr int CW_BAR = 1024;

constexpr int RING_BYTES = 131072;
constexpr int LDSCTL_OFF = RING_BYTES, MISC_OFF = LDSCTL_OFF + 320;
constexpr int LDS_BYTES = 147456;


typedef unsigned short bf16;
typedef unsigned u32x4 __attribute__((ext_vector_type(4)));
typedef unsigned u32x2 __attribute__((ext_vector_type(2)));
typedef float f32x4 __attribute__((ext_vector_type(4)));
typedef float f32x16 __attribute__((ext_vector_type(16)));
typedef short s16x8 __attribute__((ext_vector_type(8)));
typedef short s16x4 __attribute__((ext_vector_type(4)));
#define LDS_WAIT() asm volatile("s_waitcnt lgkmcnt(0)" ::: "memory")
#define VM_WAIT() asm volatile("s_waitcnt vmcnt(0)" ::: "memory")
#define DI __device__ __forceinline__

DI unsigned f2bf(float f) { unsigned u = __builtin_bit_cast(unsigned, f); return (u + 0x7fffu + ((u >> 16) & 1u)) >> 16; }
DI unsigned pk2(float lo, float hi) { return f2bf(lo) | (f2bf(hi) << 16); }
DI float bflo(unsigned u) { return __uint_as_float(u << 16); }
DI float bfhi(unsigned u) { return __uint_as_float(u & 0xffff0000u); }
DI float bf1(bf16 b) { return __uint_as_float((unsigned)b << 16); }
DI float wave_sum(float v) {
#pragma unroll
    for (int o = 32; o > 0; o >>= 1) v += __shfl_xor(v, o);
    return v;
}
DI int crow(int r, int hi) { return (r & 3) + 8 * (r >> 2) + 4 * hi; }

struct Args { const void* in[22]; float* out; unsigned char* ws; int ph_lo, ph_hi; };

DI void transpose_item(const float* W, int K, int N, bf16* WT, LAS float* scr, int item, int lane) {
    const int nblk = N / 32, kb = item / nblk, nb = item % nblk, k0 = 64 * kb, n0 = 32 * nb;
#pragma unroll 8
    for (int i = 0; i < 32; ++i) { const int kk = 2 * i + (lane >> 5); scr[kk * 33 + (lane & 31)] = W[(size_t)(k0 + kk) * N + n0 + (lane & 31)]; }
    LDS_WAIT(); asm volatile("" ::: "memory");
    const int c = lane & 7;
#pragma unroll
    for (int j = 0; j < 4; ++j) { const int n = (lane >> 3) + 8 * j; const LAS float* s = scr + (8 * c) * 33 + n;
        u32x4 o; o.x = pk2(s[0 * 33], s[1 * 33]); o.y = pk2(s[2 * 33], s[3 * 33]); o.z = pk2(s[4 * 33], s[5 * 33]); o.w = pk2(s[6 * 33], s[7 * 33]);
        *(u32x4*)(WT + (size_t)(n0 + n) * K + k0 + 8 * c) = o; }
    LDS_WAIT(); asm volatile("" ::: "memory");
}
DI void cvt_f32_bf16(const float* src, bf16* dst, size_t n8, size_t gt, size_t GT) {
#pragma unroll 4
    for (size_t i = gt; i < n8; i += GT) {
        const f32x4 a = ((const f32x4*)src)[2 * i], b = ((const f32x4*)src)[2 * i + 1];
        u32x4 o; o.x = pk2(a.x, a.y); o.y = pk2(a.z, a.w); o.z = pk2(b.x, b.y); o.w = pk2(b.z, b.w);
        ((u32x4*)dst)[i] = o; }
}

typedef float f32x2v __attribute__((ext_vector_type(2)));
DI unsigned pack4_fp8(float a, float b, float c, float d, float sc) {
    a = fminf(fmaxf(a * sc, -448.f), 448.f); b = fminf(fmaxf(b * sc, -448.f), 448.f); c = fminf(fmaxf(c * sc, -448.f), 448.f); d = fminf(fmaxf(d * sc, -448.f), 448.f);
    int w = __builtin_amdgcn_cvt_pk_fp8_f32(a, b, 0, false); w = __builtin_amdgcn_cvt_pk_fp8_f32(c, d, w, true); return (unsigned)w;
}
DI void cvt_utable_fp8(const float* u, unsigned char* u8, size_t gt, size_t GT) {
    const size_t n16 = (size_t)2 * NEXP * 1024 / 16;
#pragma unroll 2
    for (size_t i = gt; i < n16; i += GT) {
        const f32x4* s = (const f32x4*)(u + i * 16); const f32x4 a = s[0], b = s[1], c = s[2], d = s[3];
        u32x4 o; o.x = pack4_fp8(a.x, a.y, a.z, a.w, U8_SCALE); o.y = pack4_fp8(b.x, b.y, b.z, b.w, U8_SCALE); o.z = pack4_fp8(c.x, c.y, c.z, c.w, U8_SCALE); o.w = pack4_fp8(d.x, d.y, d.z, d.w, U8_SCALE);
        const size_t k = i & 63, row = i >> 6, e = row & (NEXP - 1), layer = row >> 14;
        *(u32x4*)(u8 + (((layer * 8 + (k >> 3)) * NEXP + e) * 128 + (k & 7) * 16)) = o; }
}
constexpr int VT_ROWB = 1032;
DI void cvt_vtable_lds(const float* v, unsigned char* v8l, LAS unsigned char* tile, int bx, int G, int tid) {
    for (int item = bx; item < 2 * (NEXP / 64); item += G) {
        const int layer = item / (NEXP / 64), e0 = (item % (NEXP / 64)) * 64;
        const float* src = v + ((size_t)layer * NEXP + e0) * 1024;
#pragma unroll 2
        for (int i = 0; i < 8; ++i) { const int c = tid + 512 * i, row = c >> 6, k = c & 63;
            const f32x4* s = (const f32x4*)(src + (size_t)row * 1024 + 16 * k); const f32x4 a = s[0], b = s[1], cc = s[2], d = s[3];
            const u32x2 lo = (u32x2){pack4_fp8(a.x, a.y, a.z, a.w, V8_SCALE), pack4_fp8(b.x, b.y, b.z, b.w, V8_SCALE)}, hi = (u32x2){pack4_fp8(cc.x, cc.y, cc.z, cc.w, V8_SCALE), pack4_fp8(d.x, d.y, d.z, d.w, V8_SCALE)};
            *(LAS u32x2*)(tile + row * VT_ROWB + 16 * k) = lo; *(LAS u32x2*)(tile + row * VT_ROWB + 16 * k + 8) = hi; }
        __syncthreads();
#pragma unroll 4
        for (int i = 0; i < 16; ++i) { const int q = tid + 512 * i, sl = q >> 6, e = q & 63;
            const u32x2 w = *(const LAS u32x2*)(tile + e * VT_ROWB + 8 * sl);
            *(u32x2*)(v8l + (((size_t)layer * 128 + sl) * NEXP + e0 + e) * 8) = w; }
        __syncthreads();
    }
}
DI void ph_prologue(const Args& a, LAS unsigned char* lds, int tid, int wave, int vcu, int G) {
    const int lane = tid & 63;
    {
        const float* c = (const float*)a.in[1]; const float* ada_w = (const float*)a.in[5]; const float* ada_b = (const float*)a.in[6];
        float* mod = (float*)(a.ws + WS_MOD);
        LAS float* cact = (LAS float*)lds; LAS float* red = cact + 4096;
        for (int it = blockIdx.x; it < 192; it += G) {
            const int i = it / 96, n0 = (it % 96) * 64;
            for (int e = tid; e < 4096; e += 512) { const float v = c[e]; cact[e] = v / (1.f + expf(-v)); }
            __syncthreads();
            const float* W = ada_w + (size_t)i * 1024 * 6144 + n0 + lane;
            float a0 = 0.f, a1 = 0.f, a2 = 0.f, a3 = 0.f;
            const int k0 = wave * 128;
#pragma unroll 8
            for (int k = k0; k < k0 + 128; ++k) { const float w = W[(size_t)k * 6144]; a0 += cact[k] * w; a1 += cact[1024 + k] * w; a2 += cact[2048 + k] * w; a3 += cact[3072 + k] * w; }
            red[(wave * 4 + 0) * 64 + lane] = a0; red[(wave * 4 + 1) * 64 + lane] = a1; red[(wave * 4 + 2) * 64 + lane] = a2; red[(wave * 4 + 3) * 64 + lane] = a3;
            __syncthreads();
            if (tid < 256) { const int b = tid >> 6; float s = 0.f;
#pragma unroll
                for (int w = 0; w < 8; ++w) s += red[(w * 4 + b) * 64 + lane];
                mod[(size_t)(i * 4 + b) * 6144 + n0 + lane] = s + ada_b[i * 6144 + n0 + lane]; }
            __syncthreads();
        }
    }
    {
        LAS float* scr = (LAS float*)(lds + 32768 + wave * 8704);
        const int gw = vcu * NWAVES + wave, NGW = G * NWAVES;
        unsigned char* ws = a.ws;
        constexpr int I_CIN = 16 * 96, I_COUT = 16 * 32, I_PQ = 16 * 64, I_MIN = 16 * 22, I_QB = 6 * 48, I_KVB = 4 * 64, I_MOUT = 16 * 32;
        constexpr int NITEMS = I_CIN + I_COUT + 2 * I_PQ + I_MIN + I_QB + I_KVB + I_MOUT;
        for (int it = gw; it < NITEMS; it += NGW) {
            int r = it;
            if (r < I_CIN) { transpose_item((const float*)a.in[7], 1024, 3072, (bf16*)(ws + WS_WCIN), scr, r, lane); continue; } r -= I_CIN;
            if (r < I_COUT) { transpose_item((const float*)a.in[9], 1024, 1024, (bf16*)(ws + WS_WCOUT), scr, r, lane); continue; } r -= I_COUT;
            if (r < I_PQ) { transpose_item((const float*)a.in[18], 1024, 2048, (bf16*)(ws + WS_WPQ0), scr, r, lane); continue; } r -= I_PQ;
            if (r < I_PQ) { transpose_item((const float*)a.in[18] + (size_t)1024 * 2048, 1024, 2048, (bf16*)(ws + WS_WPQ1), scr, r, lane); continue; } r -= I_PQ;
            if (r < I_MIN) { transpose_item((const float*)a.in[10], 1024, MLA_IN, (bf16*)(ws + WS_WMIN), scr, r, lane); continue; } r -= I_MIN;
            if (r < I_QB) { transpose_item((const float*)a.in[13], 384, 1536, (bf16*)(ws + WS_WQB), scr, r, lane); continue; } r -= I_QB;
            if (r < I_KVB) { transpose_item((const float*)a.in[14], 256, 2048, (bf16*)(ws + WS_WKVB), scr, r, lane); continue; } r -= I_KVB;
            transpose_item((const float*)a.in[17], 1024, 1024, (bf16*)(ws + WS_WMOUT), scr, r, lane);
        }
        const size_t gt = (size_t)vcu * 512 + tid, GT = (size_t)G * 512;
        for (size_t i = gt; i < (size_t)(MLA_IN_PAD - MLA_IN) * 1024 / 8; i += GT) ((u32x4*)(ws + WS_WMIN + (size_t)MLA_IN * 1024 * 2))[i] = (u32x4){0u, 0u, 0u, 0u};
        cvt_f32_bf16((const float*)a.in[19], (bf16*)(ws + WS_SUBK), (size_t)2 * 8 * 2 * 128 * 128 / 8, gt, GT);
        cvt_utable_fp8((const float*)a.in[20], ws + WS_PU, gt, GT);
        __syncthreads();
        cvt_vtable_lds((const float*)a.in[21], ws + WS_PV, lds, blockIdx.x, G, tid);
    }
}

DI void ph_modulate(const float* x, bf16* xn, unsigned char* xn8  , const float* gain, const float* modl, int sh_off, int sc_off, int gw, int NGW, int lane) {
    for (int m = gw; m < MTOK; m += NGW) {
        const float* mb = modl + (size_t)(m >> 12) * 6144;
        const f32x4* xr = (const f32x4*)(x + (size_t)m * DM) + lane;
        f32x4 v[4]; float s = 0.f;
#pragma unroll
        for (int j = 0; j < 4; ++j) { v[j] = xr[64 * j]; s += (v[j].x * v[j].x + v[j].y * v[j].y) + (v[j].z * v[j].z + v[j].w * v[j].w); }
        const float rstd = rsqrtf(wave_sum(s) * (1.f / DM) + NORM_EPS);
        u32x2* o8 = (u32x2*)(xn + (size_t)m * DM) + lane;
#pragma unroll
        for (int j = 0; j < 4; ++j) {
            const f32x4 g = ((const f32x4*)gain)[lane + 64 * j], sh = ((const f32x4*)(mb + sh_off))[lane + 64 * j], sc = ((const f32x4*)(mb + sc_off))[lane + 64 * j];
            const f32x4 y = v[j] * rstd * g * (sc + 1.f) + sh;
            u32x2 w; w.x = pk2(y.x, y.y); w.y = pk2(y.z, y.w); o8[64 * j] = w;
            if (xn8) ((unsigned*)(xn8 + (size_t)m * DM))[lane + 64 * j] = pack4_fp8(y.x, y.y, y.z, y.w, H8_SCALE); }
    }
}

DI void ph_conv(const bf16* bcv, const float* cw, bf16* z, size_t gt, size_t GT) {
    for (size_t it = gt; it < (size_t)MTOK * 128; it += GT) {
        const int t = (int)(it >> 7), ch = (int)(it & 127) * 8, s = t & (SEQ - 1);
        const bf16* row = bcv + (size_t)t * 3072 + ch;
        const u32x4 zero = (u32x4){0u, 0u, 0u, 0u};
        const u32x4 bq = *(const u32x4*)row;
        const u32x4 c0 = *(const u32x4*)(row + 1024), v0 = *(const u32x4*)(row + 2048);
        const u32x4 c1 = s >= 1 ? *(const u32x4*)(row - 3072 + 1024) : zero, v1 = s >= 1 ? *(const u32x4*)(row - 3072 + 2048) : zero;
        const u32x4 c2 = s >= 2 ? *(const u32x4*)(row - 6144 + 1024) : zero, v2 = s >= 2 ? *(const u32x4*)(row - 6144 + 2048) : zero;
        const f32x4 w0a = *(const f32x4*)(cw + ch), w0b = *(const f32x4*)(cw + ch + 4);
        const f32x4 w1a = *(const f32x4*)(cw + 1024 + ch), w1b = *(const f32x4*)(cw + 1024 + ch + 4);
        const f32x4 w2a = *(const f32x4*)(cw + 2048 + ch), w2b = *(const f32x4*)(cw + 2048 + ch + 4);
        float r[8];
#pragma unroll
        for (int e = 0; e < 4; ++e) {
            const float w0l = e < 2 ? w0a[2 * e] : w0b[2 * e - 4], w0h = e < 2 ? w0a[2 * e + 1] : w0b[2 * e - 3];
            const float w1l = e < 2 ? w1a[2 * e] : w1b[2 * e - 4], w1h = e < 2 ? w1a[2 * e + 1] : w1b[2 * e - 3];
            const float w2l = e < 2 ? w2a[2 * e] : w2b[2 * e - 4], w2h = e < 2 ? w2a[2 * e + 1] : w2b[2 * e - 3];
            const float ut_l = bflo(c0[e]) * bflo(v0[e]), ut_h = bfhi(c0[e]) * bfhi(v0[e]);
            const float u1_l = bflo(c1[e]) * bflo(v1[e]), u1_h = bfhi(c1[e]) * bfhi(v1[e]);
            const float u2_l = bflo(c2[e]) * bflo(v2[e]), u2_h = bfhi(c2[e]) * bfhi(v2[e]);
            r[2 * e] = bflo(bq[e]) * (w0l * u2_l + w1l * u1_l + w2l * ut_l);
            r[2 * e + 1] = bfhi(bq[e]) * (w0h * u2_h + w1h * u1_h + w2h * ut_h);
        }
        u32x4 o; o.x = pk2(r[0], r[1]); o.y = pk2(r[2], r[3]); o.z = pk2(r[4], r[5]); o.w = pk2(r[6], r[7]);
        *(u32x4*)(z + (size_t)t * DM + ch) = o;
    }
}

struct EpiResGate {
    static constexpr bool PERM = false, AFTER_DRAIN = false;
    const float* base; float* out; const float* gate;
    __device__ __forceinline__ void operator()(const pg8::f32x4 (&acc)[2][2][4][2], const pg8::Unit& u, int wr, int wc, int fr, int fq) const {
        const int row0 = u.pm * 256 + wr * 64 + fr, col0 = u.pn * 256 + wc * 32 + 4 * fq;
        const float* gp = gate + (size_t)(u.pm >> 4) * 6144 + col0;
        pg8::f32x4 gv[2][2];
#pragma unroll
        for (int bj = 0; bj < 2; ++bj)
#pragma unroll
            for (int n = 0; n < 2; ++n) gv[bj][n] = *(const pg8::f32x4*)(gp + bj * 128 + n * 16);
#pragma unroll
        for (int ai = 0; ai < 2; ++ai)
#pragma unroll
            for (int m = 0; m < 4; ++m) { const size_t off = (size_t)(row0 + ai * 128 + m * 16) * DM + col0;
#pragma unroll
                for (int bj = 0; bj < 2; ++bj)
#pragma unroll
                    for (int n = 0; n < 2; ++n) { const pg8::f32x4 bs = *(const pg8::f32x4*)(base + off + bj * 128 + n * 16);
                        *(pg8::f32x4*)(out + off + bj * 128 + n * 16) = bs + gv[bj][n] * acc[ai][bj][m][n]; } }
    }
};

typedef float f32x2_t __attribute__((ext_vector_type(2))); typedef __bf16 bf16x2_t __attribute__((ext_vector_type(2)));
DI unsigned cvtpk(float lo, float hi) { f32x2_t v = {lo, hi}; bf16x2_t b = __builtin_convertvector(v, bf16x2_t); return __builtin_bit_cast(unsigned, b); }
DI unsigned f2key(float f) { const unsigned u = __float_as_uint(f); return u ^ ((unsigned)((int)u >> 31) | 0x80000000u); }
DI float key2f(unsigned k) { const unsigned u = (k & 0x80000000u) ? (k ^ 0x80000000u) : ~k; return __uint_as_float(u); }
DI unsigned umax_(unsigned a, unsigned b) { return a > b ? a : b; }
DI unsigned umin_(unsigned a, unsigned b) { return a < b ? a : b; }
template <int N> DI void bitonic_sort_desc(unsigned (&v)[N]) {
#pragma unroll
    for (int k = 2; k <= N; k <<= 1) {
#pragma unroll
        for (int j = k >> 1; j > 0; j >>= 1) {
#pragma unroll
            for (int i = 0; i < N; ++i) { const int l = i ^ j;
                if (l > i) { const bool desc = ((i & k) == 0); const unsigned x = v[i], y = v[l], mx = umax_(x, y), mn = umin_(x, y); v[i] = desc ? mx : mn; v[l] = desc ? mn : mx; } }
        }
    }
}
template <int N> DI void bitonic_merge_desc(unsigned (&v)[N]) {
#pragma unroll
    for (int j = N >> 1; j > 0; j >>= 1) {
#pragma unroll
        for (int i = 0; i < N; ++i) { const int l = i ^ j;
            if (l > i) { const unsigned x = v[i], y = v[l]; v[i] = umax_(x, y); v[l] = umin_(x, y); } }
    }
}
DI void top16_merge(unsigned (&t)[16], unsigned (&n)[16]) {
#pragma unroll
    for (int i = 0; i < 16; ++i) t[i] = umax_(t[i], n[15 - i]);
    bitonic_merge_desc<16>(t);
}

constexpr int TK_ROWB = 272, TK_TAB_OFF = 32768;
DI void topk_task(const bf16* PQ, LAS unsigned char* skl  , unsigned short* IDS, float* GATES, LAS unsigned short* tab  , int tok0, int h, int lane) {
    const int r32 = lane & 31, hi = lane >> 5;
    s16x8 qf[16];
    const bf16* qp = PQ + (size_t)(tok0 + r32) * 2048 + 256 * h + 8 * hi;
#pragma unroll
    for (int ks = 0; ks < 16; ++ks) qf[ks] = *(const s16x8*)(qp + 16 * ks);
    const int p = (r32 >> 2) & 1, keyl = (r32 & 3) + 4 * (r32 >> 3);
    const unsigned kl0 = (unsigned)((p * 128 + keyl) * TK_ROWB + 16 * hi);
    const s16x8 zero8 = (s16x8){0, 0, 0, 0, 0, 0, 0, 0};
    unsigned top[16];
#pragma unroll
    for (int i = 0; i < 16; ++i) top[i] = 0u;
#pragma unroll 1
    for (int rb = 0; rb < 8; ++rb) {
        f32x16 acc;
#pragma unroll
        for (int r = 0; r < 16; ++r) acc[r] = 0.f;
#pragma unroll
        for (int ks = 0; ks < 8; ++ks) {
            const s16x8 kf = *(const LAS s16x8*)(skl + kl0 + (unsigned)(rb * 16 * TK_ROWB + 32 * ks));
            const s16x8 a0 = p == 0 ? kf : zero8, a1 = p == 1 ? kf : zero8;
            acc = __builtin_amdgcn_mfma_f32_32x32x16_bf16(a0, qf[ks], acc, 0, 0, 0);
            acc = __builtin_amdgcn_mfma_f32_32x32x16_bf16(a1, qf[ks + 8], acc, 0, 0, 0);
        }
        unsigned nw[16];
#pragma unroll
        for (int r = 0; r < 16; ++r) nw[r] = (f2key(acc[r]) & ~127u) | (unsigned)(127 - (16 * rb + r));
        bitonic_sort_desc<16>(nw);
        top16_merge(top, nw);
    }
    unsigned LA[16], LB[16];
#pragma unroll
    for (int i = 0; i < 16; ++i) { const unsigned other = (unsigned)__shfl_xor((int)top[i], 32); LA[i] = hi ? other : top[i]; LB[i] = hi ? top[i] : other; }
#pragma unroll
    for (int i = 0; i < 16; ++i) { tab[i * 64 + lane] = (unsigned short)(127u - (LA[i] & 127u)); tab[(16 + i) * 64 + lane] = (unsigned short)(127u - (LB[i] & 127u)); }
    float av[16], bv[16];
#pragma unroll
    for (int i = 0; i < 16; ++i) { av[i] = key2f(LA[i] & ~127u); bv[i] = key2f(LB[i] & ~127u); }
    unsigned cg[4][16];
#pragma unroll
    for (int g = 0; g < 4; ++g)
#pragma unroll
        for (int e = 0; e < 16; ++e) cg[g][e] = 0u;
    {
        int cnt = 0;
#pragma unroll
        for (int i = 0; i < 16; ++i)
#pragma unroll
            for (int j = 0; j < 16; ++j)
                if ((i + 1) * (j + 1) <= 16) { cg[cnt >> 4][cnt & 15] = (f2key(av[i] + bv[j]) & ~255u) | (unsigned)(255 - (16 * i + j)); ++cnt; }
    }
    bitonic_sort_desc<16>(cg[0]); bitonic_sort_desc<16>(cg[1]); bitonic_sort_desc<16>(cg[2]); bitonic_sort_desc<16>(cg[3]);
    top16_merge(cg[0], cg[1]); top16_merge(cg[0], cg[2]); top16_merge(cg[0], cg[3]);
    LDS_WAIT(); asm volatile("" ::: "memory");
    float sv[16]; int ex[16];
#pragma unroll
    for (int k = 0; k < 16; ++k) { const unsigned key = cg[0][k]; const int pos = 255 - (int)(key & 255u); sv[k] = key2f(key & ~255u);
        const int ia = tab[(pos >> 4) * 64 + lane], ib = tab[(16 + (pos & 15)) * 64 + lane]; ex[k] = ia * 128 + ib; }
    LDS_WAIT(); asm volatile("" ::: "memory");
    const float mx = sv[0]; float sum = 0.f;
#pragma unroll
    for (int k = 0; k < 16; ++k) { sv[k] = expf(sv[k] - mx); sum += sv[k]; }
    const float inv = 1.f / sum;
    if (hi == 0) {
        const int tq = tok0 + r32; unsigned short* ip = IDS + ((size_t)(tq >> 6) * 16 + 2 * h) * 512 + (tq & 63) * 8; float* gp = GATES + (size_t)tq * 128 + h * 16;
#pragma unroll
        for (int k = 0; k < 16; k += 8) *(u32x4*)(ip + (k >> 3) * 512) = (u32x4){(unsigned)ex[k] | ((unsigned)ex[k + 1] << 16), (unsigned)ex[k + 2] | ((unsigned)ex[k + 3] << 16), (unsigned)ex[k + 4] | ((unsigned)ex[k + 5] << 16), (unsigned)ex[k + 6] | ((unsigned)ex[k + 7] << 16)};
#pragma unroll
        for (int k = 0; k < 16; k += 4) *(f32x4*)(gp + k) = (f32x4){sv[k] * inv, sv[k + 1] * inv, sv[k + 2] * inv, sv[k + 3] * inv};
    }
}
DI void ph_topk(const bf16* PQ, const bf16* SK, unsigned short* IDS, float* GATES, LAS unsigned char* lds, int bx, int G, int wave, int lane) {
    LAS unsigned short* tab = (LAS unsigned short*)(lds + wave * 4096);
    const int h = bx & 7, rank = bx >> 3, nb = (G - h + 7) >> 3, tid = wave * 64 + lane;
    LAS unsigned char* skl = lds + TK_TAB_OFF;
#pragma unroll
    for (int i = 0; i < 8; ++i) { const int c = tid + 512 * i, row = c >> 4, col = c & 15;
        *(LAS u32x4*)(skl + row * TK_ROWB + col * 16) = *(const u32x4*)(SK + ((size_t)h * 256 + row) * 128 + col * 8); }
    __syncthreads();
    for (int g = rank * 8 + wave; g < MTOK / 32; g += nb * 8) topk_task(PQ, skl, IDS, GATES, tab, g * 32, h, lane);
    __syncthreads();
}

DI float gelu_erf(float x) { return 0.5f * x * (1.f + erff(x * 0.70710678118654752f)); }
DI float dot16_fp8(const u32x4& w, const float (&h)[16]) {
    float d0 = 0.f, d1 = 0.f;
#pragma unroll
    for (int e = 0; e < 4; ++e) { const f32x2v lo = __builtin_amdgcn_cvt_pk_f32_fp8((int)w[e], false), hi = __builtin_amdgcn_cvt_pk_f32_fp8((int)w[e], true);
        d0 += lo.x * h[4 * e] + lo.y * h[4 * e + 1]; d1 += hi.x * h[4 * e + 2] + hi.y * h[4 * e + 3]; }
    return d0 + d1;
}
DI float gelu_fast(float v) {
    const float av = fabsf(v), d = av * 0.2316418882f + 1.0f, t = __builtin_amdgcn_rcpf(d);
    float q = t * 0.5307027145f + (-0.7265760135f); q = q * t + 0.7107068705f; q = q * t + (-0.142248368f); q = q * t + 0.127414796f; q = q * t;
    const float e = __builtin_amdgcn_exp2f((v * v) * (-0.72134752044f)), mm = v * (q * e);
    return v < 0.f ? mm : v - mm;
}
DI long lo64(const u32x4& w) { return (long)(((unsigned long long)w.y << 32) | w.x); }
DI long hi64(const u32x4& w) { return (long)(((unsigned long long)w.w << 32) | w.z); }
typedef __amdgpu_buffer_rsrc_t brsrc_t;
DI brsrc_t mkrsrc(const void* p, unsigned bytes) { return __builtin_amdgcn_make_buffer_rsrc((void*)p, 0, (int)bytes, 0x00020000); }
DI u32x4 bl128(brsrc_t r, unsigned voff, unsigned soff) { return __builtin_amdgcn_raw_buffer_load_b128(r, (int)voff, (int)soff, 0); }
DI u32x2 bl64(brsrc_t r, unsigned voff, unsigned soff) { return __builtin_amdgcn_raw_buffer_load_b64(r, (int)voff, (int)soff, 0); }
DI void bs64(brsrc_t r, u32x2 v, unsigned voff, unsigned soff) { __builtin_amdgcn_raw_buffer_store_b64(v, r, (int)voff, (int)soff, 0); }
DI f32x4 asf4(u32x4 v) { return __builtin_bit_cast(f32x4, v); }
template <int VAR> DI void u_issue8(u32x4 (&r)[8], const u32x4& ev, const unsigned char* Ux, unsigned coff) {
#pragma unroll
    for (int i = 0; i < 8; ++i) { const unsigned ew = ev[i >> 1], e = (i & 1) ? (ew >> 16) : (ew & 0xffffu);
        if (VAR == 1) r[i] = (u32x4){e, coff, 0x38383838u, 0x40404040u}; else r[i] = *(const u32x4*)(Ux + (e * 128u + coff)); }
}
typedef __bf16 bf16x2v __attribute__((ext_vector_type(2)));
DI void u_dot8(const u32x4 (&r)[8], const u32x4& ha, const u32x4& hb, float* p) {
#pragma unroll
    for (int i = 0; i < 8; ++i) {
        float d0 = 0.f, d1 = 0.f;
        u32x4 row = r[i]; asm volatile("" : "+v"(row));
#pragma unroll
        for (int e = 0; e < 4; ++e) {
            const bf16x2v lo = __builtin_amdgcn_cvt_scalef32_pk_bf16_fp8(row[e], 1.0f, false), hi = __builtin_amdgcn_cvt_scalef32_pk_bf16_fp8(row[e], 1.0f, true);
            const unsigned hw0 = e < 2 ? ha[2 * e] : hb[2 * e - 4], hw1 = e < 2 ? ha[2 * e + 1] : hb[2 * e - 3];
            d0 = __builtin_amdgcn_fdot2_f32_bf16(lo, __builtin_bit_cast(bf16x2v, hw0), d0, false);
            d1 = __builtin_amdgcn_fdot2_f32_bf16(hi, __builtin_bit_cast(bf16x2v, hw1), d1, false);
        }
        float pi = d0 + d1; asm volatile("" : "+v"(pi)); p[i] = pi;
    }
}
DI void u_reduce_store(const float* p, brsrc_t part_r, unsigned poff, int tok, bool do_store, bool b2, bool b1, bool b0) {
    float v8[8], v4[4], v2[2];
#pragma unroll
    for (int i = 0; i < 8; ++i) { const float keep = b2 ? p[i + 8] : p[i], give = b2 ? p[i] : p[i + 8]; v8[i] = keep + __shfl_xor(give, 4); }
#pragma unroll
    for (int i = 0; i < 4; ++i) { const float keep = b1 ? v8[i + 4] : v8[i], give = b1 ? v8[i] : v8[i + 4]; v4[i] = keep + __shfl_xor(give, 2); }
#pragma unroll
    for (int i = 0; i < 2; ++i) { const float keep = b0 ? v4[i + 2] : v4[i], give = b0 ? v4[i] : v4[i + 2]; v2[i] = keep + __shfl_xor(give, 1); }
    if (do_store) bs64(part_r, (u32x2){__float_as_uint(v2[0]), __float_as_uint(v2[1])}, poff, tok * 512);
}
template <int VAR> DI void ph_peer_u(const unsigned char* U8s, const unsigned short* IDS, const bf16* XN, float* PART, int bx, int G, int wave, int lane) {
    const int x = bx & 7, rank = bx >> 3, nslots = ((G - x + 7) >> 3) * 8;
    const int grp = lane >> 3, c = lane & 7;
    const bool b2 = (lane & 4) != 0, b1 = (lane & 2) != 0, b0 = (lane & 1) != 0;
    const unsigned char* Ux = U8s + (size_t)x * NEXP * 128;
    const unsigned coff = 16u * (unsigned)c;
    const unsigned hoff = (unsigned)(128 * x + 16 * c) * 2u, ioff = 2048u * (unsigned)grp;
    const brsrc_t ids_r = mkrsrc(IDS, MTOK * 128 * 2), xn_r = mkrsrc(XN, MTOK * DM * 2), part_r = mkrsrc(PART + (size_t)x * MTOK * 128, MTOK * 128 * 4);
    const unsigned poff = (unsigned)(16 * grp + 8 * (int)b2 + 4 * (int)b1 + 2 * (int)b0) * 4u;
    const int t0 = rank * 8 + wave;
#define UTOK(k) ((t0 + (k) * nslots) < MTOK ? (t0 + (k) * nslots) : (MTOK - 1))
#define UVALID(k) ((t0 + (k) * nslots) < MTOK)
#define U_LOAD_IDS(E, tok) do { const unsigned so_ = (unsigned)((tok) >> 6) * 16384u + (unsigned)((tok) & 63) * 16u; E[0] = bl128(ids_r, ioff, so_); E[1] = bl128(ids_r, ioff + 1024, so_); } while (0)
#define U_LOAD_H(Ha, Hb, tok) do { Ha = bl128(xn_r, hoff, (tok) * 2048); Hb = bl128(xn_r, hoff + 16, (tok) * 2048); } while (0)
#define SB() __builtin_amdgcn_sched_barrier(0)
    u32x4 RA[8], RB[8], E0[2], E1[2], H0a, H0b, H1a, H1b; float p[16];
    U_LOAD_IDS(E0, UTOK(0)); U_LOAD_H(H0a, H0b, UTOK(0)); U_LOAD_IDS(E1, UTOK(1)); U_LOAD_H(H1a, H1b, UTOK(1));
    u_issue8<VAR>(RA, E0[0], Ux, coff);
#pragma unroll 1
    for (int k = 0; UVALID(k); k += 2) {
        u_issue8<VAR>(RB, E0[1], Ux, coff); SB();
        u_dot8(RA, H0a, H0b, p); SB();
        u_issue8<VAR>(RA, E1[0], Ux, coff); U_LOAD_IDS(E0, UTOK(k + 2)); SB();
        u_dot8(RB, H0a, H0b, p + 8); u_reduce_store(p, part_r, poff, UTOK(k), true, b2, b1, b0); U_LOAD_H(H0a, H0b, UTOK(k + 2)); SB();
        u_issue8<VAR>(RB, E1[1], Ux, coff); SB();
        u_dot8(RA, H1a, H1b, p); SB();
        u_issue8<VAR>(RA, E0[0], Ux, coff); U_LOAD_IDS(E1, UTOK(k + 3)); SB();
        u_dot8(RB, H1a, H1b, p + 8); u_reduce_store(p, part_r, poff, UTOK(k + 1), UVALID(k + 1), b2, b1, b0); U_LOAD_H(H1a, H1b, UTOK(k + 3)); SB();
    }
#undef UTOK
#undef UVALID
#undef U_LOAD_IDS
#undef U_LOAD_H
}
DI void ph_peer_c(const float* PART, const float* GATES, bf16* ACT, int gw, int NGW, int lane) {
    const float inv = 1.f / U8_SCALE;
    for (int t = gw; t < MTOK; t += NGW) {
        f32x2v s = (f32x2v){0.f, 0.f};
#pragma unroll
        for (int xx = 0; xx < 8; ++xx) { const f32x2v p = *(const f32x2v*)(PART + ((size_t)xx * MTOK + t) * 128 + 2 * lane); s.x += p.x; s.y += p.y; }
        const f32x2v g = *(const f32x2v*)(GATES + (size_t)t * 128 + 2 * lane);
        *(unsigned*)((char*)ACT + (size_t)(t >> 6) * 16384 + (lane >> 2) * 1024 + (t & 63) * 16 + (lane & 3) * 4) = cvtpk(gelu_fast(s.x * inv) * g.x, gelu_fast(s.y * inv) * g.y);
    }
}
template <int VAR> DI void ph_peer_v(const unsigned char* V8L  , const unsigned short* IDT, const bf16* ACT, const float* Xin, float* Xout, const float* g2,
                                     LAS unsigned char* lds, int bx, int wave, int lane) {
    const int x = bx & 7, rank = bx >> 3, sl = 16 * x + (rank & 15), th = rank >> 4, tid = wave * 64 + lane;
    { const u32x4* src = (const u32x4*)(V8L + (size_t)sl * NEXP * 8);
#pragma unroll 4
      for (int i = 0; i < 16; ++i) { const int c = tid + 512 * i; *(LAS u32x4*)(lds + 16 * c) = src[c]; } }
    __syncthreads();
    const float inv = 1.f / V8_SCALE;
#pragma unroll 1
    for (int gi = wave; gi < 128; gi += 8) {
        const int g = th * 128 + gi, t = g * 64 + lane;
        const char* ip = (const char*)IDT + (size_t)g * 16384 + lane * 16; const char* ap = (const char*)ACT + (size_t)g * 16384 + lane * 16;
        float acc[8];
#pragma unroll
        for (int d = 0; d < 8; ++d) acc[d] = 0.f;
        const f32x4 x0 = *(const f32x4*)(Xin + (size_t)t * DM + 8 * sl), x1 = *(const f32x4*)(Xin + (size_t)t * DM + 8 * sl + 4);
#pragma unroll 2
        for (int pc = 0; pc < 16; ++pc) {
            const u32x4 idw = *(const u32x4*)(ip + pc * 1024), acw = *(const u32x4*)(ap + pc * 1024);
#pragma unroll
            for (int q = 0; q < 8; ++q) {
                const unsigned e = (q & 1) ? (idw[q >> 1] >> 16) : (idw[q >> 1] & 0xffffu);
                const float aw = (q & 1) ? bfhi(acw[q >> 1]) : bflo(acw[q >> 1]);
                u32x2 vv; if (VAR == 1) vv = (u32x2){0x38383838u + e, 0x40404040u}; else vv = *(const LAS u32x2*)(lds + e * 8u);
                const f32x2v a0 = __builtin_amdgcn_cvt_pk_f32_fp8((int)vv.x, false), a1 = __builtin_amdgcn_cvt_pk_f32_fp8((int)vv.x, true), a2 = __builtin_amdgcn_cvt_pk_f32_fp8((int)vv.y, false), a3 = __builtin_amdgcn_cvt_pk_f32_fp8((int)vv.y, true);
                acc[0] = fmaf(aw, a0.x, acc[0]); acc[1] = fmaf(aw, a0.y, acc[1]); acc[2] = fmaf(aw, a1.x, acc[2]); acc[3] = fmaf(aw, a1.y, acc[3]);
                acc[4] = fmaf(aw, a2.x, acc[4]); acc[5] = fmaf(aw, a2.y, acc[5]); acc[6] = fmaf(aw, a3.x, acc[6]); acc[7] = fmaf(aw, a3.y, acc[7]);
            }
        }
        const float* gp = g2 + (size_t)(t >> 12) * 6144 + 8 * sl;
        const f32x4 g0 = *(const f32x4*)gp, g1 = *(const f32x4*)(gp + 4);
        f32x4 o0, o1;
        o0.x = x0.x + g0.x * acc[0] * inv; o0.y = x0.y + g0.y * acc[1] * inv; o0.z = x0.z + g0.z * acc[2] * inv; o0.w = x0.w + g0.w * acc[3] * inv;
        o1.x = x1.x + g1.x * acc[4] * inv; o1.y = x1.y + g1.y * acc[5] * inv; o1.z = x1.z + g1.z * acc[6] * inv; o1.w = x1.w + g1.w * acc[7] * inv;
        *(f32x4*)(Xout + (size_t)t * DM + 8 * sl) = o0; *(f32x4*)(Xout + (size_t)t * DM + 8 * sl + 4) = o1;
    }
    __syncthreads();
}

DI void ph_latnorm(const bf16* LAT, const float* qg, const float* kvg, bf16* QN, bf16* KVN, int gw, int NGW, int lane) {
    for (int t = gw; t < MTOK; t += NGW) {
        const unsigned* lr = (const unsigned*)(LAT + (size_t)t * MLA_IN_PAD);
        unsigned q[3], k[2]; float sq = 0.f, sk = 0.f;
#pragma unroll
        for (int j = 0; j < 3; ++j) { q[j] = lr[lane + 64 * j]; sq += bflo(q[j]) * bflo(q[j]) + bfhi(q[j]) * bfhi(q[j]); }
#pragma unroll
        for (int j = 0; j < 2; ++j) { k[j] = lr[192 + lane + 64 * j]; sk += bflo(k[j]) * bflo(k[j]) + bfhi(k[j]) * bfhi(k[j]); }
        const float rq = rsqrtf(wave_sum(sq) * (1.f / QLORA) + NORM_EPS), rk = rsqrtf(wave_sum(sk) * (1.f / KVLORA) + NORM_EPS);
        unsigned* qo = (unsigned*)(QN + (size_t)t * QLORA); unsigned* ko = (unsigned*)(KVN + (size_t)t * KVLORA);
#pragma unroll
        for (int j = 0; j < 3; ++j) { const int c = 2 * (lane + 64 * j); qo[lane + 64 * j] = pk2(bflo(q[j]) * rq * qg[c], bfhi(q[j]) * rq * qg[c + 1]); }
#pragma unroll
        for (int j = 0; j < 2; ++j) { const int c = 2 * (lane + 64 * j); ko[lane + 64 * j] = pk2(bflo(k[j]) * rk * kvg[c], bfhi(k[j]) * rk * kvg[c + 1]); }
    }
}

DI void ph_qkprep(const bf16* QRAW, const bf16* KVRAW, const bf16* LAT, const int* positions, const float* qg, const float* kg,
                  bf16* Qf, bf16* Kf, bf16* Vt, int gw, int NGW, int lane) {
    const int hh = lane >> 3, p = lane & 7;
    float qgn[16], qgr[8], kgn[16], kgr[8], invf[8];
#pragma unroll
    for (int i = 0; i < 16; ++i) { qgn[i] = qg[16 * p + i] * QSCALE; kgn[i] = kg[16 * p + i]; }
#pragma unroll
    for (int i = 0; i < 8; ++i) { qgr[i] = qg[128 + 8 * p + i] * QSCALE; kgr[i] = kg[128 + 8 * p + i]; invf[i] = exp2f(-(float)((8 * p + i) & 31) * (13.287712379549449f / 32.f)); }
    for (int task = gw; task < MTOK / 8; task += NGW) {
        const int t0 = task * 8, b = t0 >> 12, s0 = t0 & (SEQ - 1);
#pragma unroll 1
        for (int tt = 0; tt < 8; ++tt) {
            const int t = t0 + tt, s = s0 + tt;
            const float posf = (float)positions[t];
            float cs[8], sn[8];
#pragma unroll
            for (int i = 0; i < 8; ++i) { const float ang = posf * invf[i]; double rev = (double)ang * 0.15915494309189535; rev -= floor(rev); const float rv = (float)rev; sn[i] = __builtin_amdgcn_sinf(rv); cs[i] = __builtin_amdgcn_cosf(rv); }
            const u32x4 kr4 = *(const u32x4*)(LAT + (size_t)t * MLA_IN_PAD + 640 + 8 * p);
#pragma unroll
            for (int which = 0; which < 2; ++which) {
                const bf16* src = which == 0 ? QRAW + (size_t)t * 1536 + QKH * hh : KVRAW + (size_t)t * 2048 + 256 * hh;
                const u32x4 n0 = *(const u32x4*)(src + 16 * p), n1 = *(const u32x4*)(src + 16 * p + 8);
                const u32x4 r0 = which == 0 ? *(const u32x4*)(src + 128 + 8 * p) : kr4;
                float xn[16], xr[8];
#pragma unroll
                for (int e = 0; e < 4; ++e) { xn[2 * e] = bflo(n0[e]); xn[2 * e + 1] = bfhi(n0[e]); xn[8 + 2 * e] = bflo(n1[e]); xn[8 + 2 * e + 1] = bfhi(n1[e]); xr[2 * e] = bflo(r0[e]); xr[2 * e + 1] = bfhi(r0[e]); }
                float ss = 0.f;
#pragma unroll
                for (int i = 0; i < 16; ++i) ss = fmaf(xn[i], xn[i], ss);
#pragma unroll
                for (int i = 0; i < 8; ++i) ss = fmaf(xr[i], xr[i], ss);
                ss += __shfl_xor(ss, 1); ss += __shfl_xor(ss, 2); ss += __shfl_xor(ss, 4);
                const float rstd = rsqrtf(ss * (1.f / QKH) + NORM_EPS);
                float yr[8], ro[8];
#pragma unroll
                for (int i = 0; i < 16; ++i) xn[i] = xn[i] * rstd * (which == 0 ? qgn[i] : kgn[i]);
#pragma unroll
                for (int i = 0; i < 8; ++i) yr[i] = xr[i] * rstd * (which == 0 ? qgr[i] : kgr[i]);
#pragma unroll
                for (int i = 0; i < 8; ++i) { const float pr = __shfl_xor(yr[i], 4); ro[i] = p < 4 ? yr[i] * cs[i] - pr * sn[i] : pr * sn[i] + yr[i] * cs[i]; }
                bf16* dst = (which == 0 ? Qf : Kf) + ((size_t)(b * NH + hh) * SEQ + s) * QKH;
                u32x4 o0, o1, o2;
                o0.x = cvtpk(xn[0], xn[1]); o0.y = cvtpk(xn[2], xn[3]); o0.z = cvtpk(xn[4], xn[5]); o0.w = cvtpk(xn[6], xn[7]);
                o1.x = cvtpk(xn[8], xn[9]); o1.y = cvtpk(xn[10], xn[11]); o1.z = cvtpk(xn[12], xn[13]); o1.w = cvtpk(xn[14], xn[15]);
                o2.x = cvtpk(ro[0], ro[1]); o2.y = cvtpk(ro[2], ro[3]); o2.z = cvtpk(ro[4], ro[5]); o2.w = cvtpk(ro[6], ro[7]);
                *(u32x4*)(dst + 16 * p) = o0; *(u32x4*)(dst + 16 * p + 8) = o1; *(u32x4*)(dst + 128 + 8 * p) = o2;
            }
        }
#pragma unroll 1
        for (int h = 0; h < NH; ++h)
#pragma unroll
            for (int dd = 0; dd < 128; dd += 64) {
                const bf16* vp = KVRAW + (size_t)t0 * 2048 + 256 * h + 128 + dd + lane;
                unsigned w[4];
#pragma unroll
                for (int i = 0; i < 4; ++i) w[i] = (unsigned)vp[(size_t)(2 * i) * 2048] | ((unsigned)vp[(size_t)(2 * i + 1) * 2048] << 16);
                *(u32x4*)(Vt + ((size_t)(b * NH + h) * VH + dd + lane) * SEQ + s0) = (u32x4){w[0], w[1], w[2], w[3]};
            }
    }
}

DI void attn_unit(const bf16* Qf, const bf16* Kf, const bf16* Vt, bf16* O, int bh, int qb, int wave, int lane) {
    const int r32 = lane & 31, hi = lane >> 5;
    const int q0 = qb * 256 + wave * 32;
    s16x8 qf[12];
    { const bf16* Qp = Qf + ((size_t)bh * SEQ + q0 + r32) * QKH + 8 * hi;
#pragma unroll
      for (int ks = 0; ks < 12; ++ks) qf[ks] = *(const s16x8*)(Qp + 16 * ks); }
    f32x16 o[4];
#pragma unroll
    for (int d = 0; d < 4; ++d)
#pragma unroll
        for (int r = 0; r < 16; ++r) o[d][r] = 0.f;
    float m = -1e30f, l = 0.f;
    const bf16* Kp = Kf + ((size_t)bh * SEQ + r32) * QKH + 8 * hi;
    const bf16* Vp = Vt + ((size_t)bh * VH + r32) * SEQ + 4 * hi;
    const int nkt = q0 / 32 + 1;
#pragma unroll 1
    for (int kt = 0; kt < nkt; ++kt) {
        f32x16 sc;
#pragma unroll
        for (int r = 0; r < 16; ++r) sc[r] = 0.f;
        const bf16* kp = Kp + (size_t)kt * 32 * QKH;
#pragma unroll
        for (int ks = 0; ks < 12; ++ks) sc = __builtin_amdgcn_mfma_f32_32x32x16_bf16(*(const s16x8*)(kp + 16 * ks), qf[ks], sc, 0, 0, 0);
        if (kt == nkt - 1) {
#pragma unroll
            for (int r = 0; r < 16; ++r) if (crow(r, hi) > r32) sc[r] = -INFINITY;
        }
        float mt = sc[0];
#pragma unroll
        for (int r = 1; r < 16; ++r) mt = fmaxf(mt, sc[r]);
        mt = fmaxf(mt, __shfl_xor(mt, 32));
        const float mn = fmaxf(m, mt), alpha = __builtin_amdgcn_exp2f(m - mn);
        m = mn; l *= alpha;
#pragma unroll
        for (int d = 0; d < 4; ++d)
#pragma unroll
            for (int r = 0; r < 16; ++r) o[d][r] *= alpha;
        float ps = 0.f;
#pragma unroll
        for (int r = 0; r < 16; ++r) { sc[r] = __builtin_amdgcn_exp2f(sc[r] - mn); ps += sc[r]; }
        l += ps;
#pragma unroll
        for (int s = 0; s < 2; ++s) {
            u32x4 pw; pw.x = cvtpk(sc[8 * s], sc[8 * s + 1]); pw.y = cvtpk(sc[8 * s + 2], sc[8 * s + 3]); pw.z = cvtpk(sc[8 * s + 4], sc[8 * s + 5]); pw.w = cvtpk(sc[8 * s + 6], sc[8 * s + 7]);
            const s16x8 pb = __builtin_bit_cast(s16x8, pw);
#pragma unroll
            for (int d = 0; d < 4; ++d) {
                const bf16* vp = Vp + (size_t)d * 32 * SEQ + kt * 32 + 16 * s;
                const s16x4 lo = *(const s16x4*)vp, hh = *(const s16x4*)(vp + 8);
                const s16x8 va = __builtin_shufflevector(lo, hh, 0, 1, 2, 3, 4, 5, 6, 7);
                o[d] = __builtin_amdgcn_mfma_f32_32x32x16_bf16(va, pb, o[d], 0, 0, 0);
            }
        }
    }
    l += __shfl_xor(l, 32);
    const float inv = 1.f / l;
    bf16* Op = O + ((size_t)((bh >> 3) * SEQ + q0 + r32)) * DM + (bh & 7) * VH + 4 * hi;
#pragma unroll
    for (int d = 0; d < 4; ++d)
#pragma unroll
        for (int g = 0; g < 4; ++g) { u32x2 w; w.x = cvtpk(o[d][4 * g] * inv, o[d][4 * g + 1] * inv); w.y = cvtpk(o[d][4 * g + 2] * inv, o[d][4 * g + 3] * inv);
            *(u32x2*)(Op + 32 * d + 8 * g) = w; }
}
constexpr int AT_KROW = 400, AT_VROW = 136, AT_KBYTES = 64 * AT_KROW, AT_VBYTES = 128 * AT_VROW, AT_STAGE = AT_KBYTES + AT_VBYTES;
DI void attn_unit_lds(const bf16* Qf, const bf16* Kf, const bf16* Vt, bf16* O, LAS unsigned char* lds, int bh, int qb, int wave, int lane) {
    const int r32 = lane & 31, hi = lane >> 5, tid = wave * 64 + lane;
    const int q0 = qb * 256 + wave * 32;
    s16x8 qf[12];
    { const bf16* Qp = Qf + ((size_t)bh * SEQ + q0 + r32) * QKH + 8 * hi;
#pragma unroll
      for (int ks = 0; ks < 12; ++ks) qf[ks] = *(const s16x8*)(Qp + 16 * ks); }
    f32x16 o[4];
#pragma unroll
    for (int d = 0; d < 4; ++d)
#pragma unroll
        for (int r = 0; r < 16; ++r) o[d][r] = 0.f;
    float m = -1e30f, l = 0.f;
    const int NT = 4 * (qb + 1);
    const __amdgpu_buffer_rsrc_t krs = __builtin_amdgcn_make_buffer_rsrc((void*)(Kf + (size_t)bh * SEQ * QKH), 0, SEQ * QKH * 2, 0x00020000);
    const __amdgpu_buffer_rsrc_t vrs = __builtin_amdgcn_make_buffer_rsrc((void*)(Vt + (size_t)bh * VH * SEQ), 0, VH * SEQ * 2, 0x00020000);
    unsigned kgo[3], kl[3], vgo[2], vl[2];
#pragma unroll
    for (int i = 0; i < 3; ++i) { const int c = tid + 512 * i, row = c / 24, col = c - row * 24; kgo[i] = (unsigned)(row * 384 + col * 16); kl[i] = (unsigned)(row * AT_KROW + col * 16); }
#pragma unroll
    for (int i = 0; i < 2; ++i) { const int c = tid + 512 * i, d = c >> 3, part = c & 7; vgo[i] = (unsigned)(d * (SEQ * 2) + part * 16); vl[i] = (unsigned)(AT_KBYTES + d * AT_VROW + part * 16); }
    u32x4 kr[3], vr[2];
#pragma unroll
    for (int i = 0; i < 3; ++i) kr[i] = __builtin_amdgcn_raw_buffer_load_b128(krs, kgo[i], 0, 0);
#pragma unroll
    for (int i = 0; i < 2; ++i) vr[i] = __builtin_amdgcn_raw_buffer_load_b128(vrs, vgo[i], 0, 0);
#pragma unroll
    for (int i = 0; i < 3; ++i) *(LAS u32x4*)(lds + kl[i]) = kr[i];
#pragma unroll
    for (int i = 0; i < 2; ++i) { *(LAS u32x2*)(lds + vl[i]) = (u32x2){vr[i].x, vr[i].y}; *(LAS u32x2*)(lds + vl[i] + 8) = (u32x2){vr[i].z, vr[i].w}; }
    __syncthreads();
    const unsigned kfo = (unsigned)(r32 * AT_KROW + 16 * hi), vfo = (unsigned)(AT_KBYTES + r32 * AT_VROW + 8 * hi);
#pragma unroll 1
    for (int t = 0; t < NT; ++t) {
        const unsigned sb = (unsigned)((t & 1) * AT_STAGE), sn = (unsigned)(((t + 1) & 1) * AT_STAGE);
        const bool more = t + 1 < NT;
        if (more) {
#pragma unroll
            for (int i = 0; i < 3; ++i) kr[i] = __builtin_amdgcn_raw_buffer_load_b128(krs, kgo[i], (t + 1) * (64 * 384), 0);
#pragma unroll
            for (int i = 0; i < 2; ++i) vr[i] = __builtin_amdgcn_raw_buffer_load_b128(vrs, vgo[i], (t + 1) * 128, 0);
        }
        const int k0 = 64 * t;
        if (k0 <= q0 + 31) {
            f32x16 s0, s1;
#pragma unroll
            for (int r = 0; r < 16; ++r) { s0[r] = 0.f; s1[r] = 0.f; }
#pragma unroll
            for (int ks = 0; ks < 12; ++ks) {
                const s16x8 ka = *(const LAS s16x8*)(lds + sb + kfo + 32 * ks), kb = *(const LAS s16x8*)(lds + sb + kfo + 32 * AT_KROW + 32 * ks);
                s0 = __builtin_amdgcn_mfma_f32_32x32x16_bf16(ka, qf[ks], s0, 0, 0, 0);
                s1 = __builtin_amdgcn_mfma_f32_32x32x16_bf16(kb, qf[ks], s1, 0, 0, 0);
                if ((ks & 3) == 3) __builtin_amdgcn_sched_barrier(0);
            }
            if (k0 + 63 > q0) {
                const int qa = q0 + r32 - k0 - 4 * hi;
#pragma unroll
                for (int r = 0; r < 16; ++r) { if (((r & 3) + 8 * (r >> 2)) > qa) s0[r] = -INFINITY; if ((32 + (r & 3) + 8 * (r >> 2)) > qa) s1[r] = -INFINITY; }
            }
            float mt = fmaxf(s0[0], s1[0]);
#pragma unroll
            for (int r = 1; r < 16; ++r) mt = fmaxf(mt, fmaxf(s0[r], s1[r]));
            mt = fmaxf(mt, __shfl_xor(mt, 32));
            const float mn = fmaxf(m, mt), alpha = __builtin_amdgcn_exp2f(m - mn);
            m = mn; l *= alpha;
#pragma unroll
            for (int d = 0; d < 4; ++d)
#pragma unroll
                for (int r = 0; r < 16; ++r) o[d][r] *= alpha;
            float ps = 0.f;
#pragma unroll
            for (int r = 0; r < 16; ++r) { s0[r] = __builtin_amdgcn_exp2f(s0[r] - mn); s1[r] = __builtin_amdgcn_exp2f(s1[r] - mn); ps += s0[r] + s1[r]; }
            l += ps;
#pragma unroll
            for (int s = 0; s < 4; ++s) {
                u32x4 pw;
                if (s < 2) { pw.x = cvtpk(s0[8 * s], s0[8 * s + 1]); pw.y = cvtpk(s0[8 * s + 2], s0[8 * s + 3]); pw.z = cvtpk(s0[8 * s + 4], s0[8 * s + 5]); pw.w = cvtpk(s0[8 * s + 6], s0[8 * s + 7]); }
                else { const int z = s - 2; pw.x = cvtpk(s1[8 * z], s1[8 * z + 1]); pw.y = cvtpk(s1[8 * z + 2], s1[8 * z + 3]); pw.z = cvtpk(s1[8 * z + 4], s1[8 * z + 5]); pw.w = cvtpk(s1[8 * z + 6], s1[8 * z + 7]); }
                const s16x8 pb = __builtin_bit_cast(s16x8, pw);
#pragma unroll
                for (int d = 0; d < 4; ++d) {
                    const unsigned va = sb + vfo + (unsigned)(d * 32 * AT_VROW + 32 * s);
                    const s16x4 lo = *(const LAS s16x4*)(lds + va), hh = *(const LAS s16x4*)(lds + va + 16);
                    const s16x8 vfrag = __builtin_shufflevector(lo, hh, 0, 1, 2, 3, 4, 5, 6, 7);
                    o[d] = __builtin_amdgcn_mfma_f32_32x32x16_bf16(vfrag, pb, o[d], 0, 0, 0);
                }
                __builtin_amdgcn_sched_barrier(0);
            }
        }
        if (more) {
#pragma unroll
            for (int i = 0; i < 3; ++i) *(LAS u32x4*)(lds + sn + kl[i]) = kr[i];
#pragma unroll
            for (int i = 0; i < 2; ++i) { *(LAS u32x2*)(lds + sn + vl[i]) = (u32x2){vr[i].x, vr[i].y}; *(LAS u32x2*)(lds + sn + vl[i] + 8) = (u32x2){vr[i].z, vr[i].w}; }
        }
        __syncthreads();
    }
    l += __shfl_xor(l, 32);
    const float inv = 1.f / l;
    bf16* Op = O + ((size_t)((bh >> 3) * SEQ + q0 + r32)) * DM + (bh & 7) * VH + 4 * hi;
#pragma unroll
    for (int d = 0; d < 4; ++d)
#pragma unroll
        for (int g = 0; g < 4; ++g) { u32x2 w; w.x = cvtpk(o[d][4 * g] * inv, o[d][4 * g + 1] * inv); w.y = cvtpk(o[d][4 * g + 2] * inv, o[d][4 * g + 3] * inv);
            *(u32x2*)(Op + 32 * d + 8 * g) = w; }
}
DI void ph_attn(const bf16* Qf, const bf16* Kf, const bf16* Vt, bf16* O, LAS unsigned char* lds, int vcu, int G, int wave, int lane) {
    for (int p = vcu; p < 256; p += G) {
        const int bh = p >> 3, s8 = p & 7;
#pragma unroll 1
        for (int u = 0; u < 2; ++u) attn_unit_lds(Qf, Kf, Vt, O, lds, bh, u ? s8 : 15 - s8, wave, lane);
    }
}

__global__ void __launch_bounds__(NWAVES * 64, 2) mk_fwd(Args args) {
    extern __shared__ __attribute__((aligned(16))) unsigned char lds_raw[];
    LAS unsigned char* lds = (LAS unsigned char*)lds_raw;
    const int tid = threadIdx.x, lane = tid & 63, wave = __builtin_amdgcn_readfirstlane(tid >> 6);
    const int G = gridDim.x, bx = blockIdx.x, vcu = (G % 8 == 0) ? (bx % 8) * (G / 8) + bx / 8 : bx;
    const int gw = vcu * NWAVES + wave, NGW = G * NWAVES;
    const size_t GT = (size_t)G * 512;
    unsigned char* ws = args.ws;
    for (int u = tid; u < (LDS_BYTES - LDSCTL_OFF) / 4; u += NWAVES * 64) ((LAS unsigned*)(lds + LDSCTL_OFF))[u] = 0u;
    __syncthreads();
    const bool multi = (args.ph_hi - args.ph_lo) > 1;
    XcdBarrier bar; bar.bar = (unsigned*)(ws + WS_CTL) + CW_BAR; bar.x = 0; bar.st = (volatile LAS unsigned*)(lds + MISC_OFF) + 8;
    if (multi) bar = xcd_barrier_post((unsigned*)(ws + WS_CTL) + CW_BAR, (volatile LAS unsigned*)(lds + MISC_OFF) + 8);

    float* X = args.out;
    const float* mod = (const float*)(ws + WS_MOD);
    bf16* XN = (bf16*)(ws + WS_XN);

    const int lo = args.ph_lo, hi = args.ph_hi;
#define IN(k) (EN(k) && lo <= (k) && (k) < hi)
    auto opq = [](int v) { asm volatile("" : "+v"(v)); return v; };
#define LN opq(lane)
#define TD opq(tid)
#define GTID ((size_t)vcu * 512 + (size_t)opq(tid))
#define SEAM(k) do { if (lo <= (k) && (k) + 1 < hi) xcd_barrier(bar); } while (0)
#define GEMM_BF16(Aptr, Bptr, NN, KK, Optr, LDC) do { pg8::Gemm g{(const bf16*)(Aptr), (const bf16*)(Bptr), MTOK, (NN), (KK)}; pg8::StaticOrder S; S.init(MTOK, (NN), G, bx); \
        pg8::EpiBf16<0> E{(bf16*)(Optr), (LDC), nullptr, 0, 0, 1.f}; pg8::gemm_phase<pg8::EpiBf16<0>, pg8::StaticOrder, true, true>(lds, g, S, E); } while (0)
#define GEMM_RES(Aptr, Bptr, BASE, OUT, GATE) do { pg8::Gemm g{(const bf16*)(Aptr), (const bf16*)(Bptr), MTOK, DM, DM}; pg8::StaticOrder S; S.init(MTOK, DM, G, bx); \
        EpiResGate E{(BASE), (OUT), (GATE)}; pg8::gemm_phase<EpiResGate, pg8::StaticOrder, true, true>(lds, g, S, E); } while (0)

    if (IN(0)) for (int r_ = 0; r_ < NREP(0); ++r_) ph_prologue(args, lds, TD, wave, vcu, G);
    SEAM(0);
    if (IN(1)) for (int r_ = 0; r_ < NREP(1); ++r_) ph_modulate((const float*)args.in[0], XN, nullptr, (const float*)args.in[3], mod, 0, 1024, gw, NGW, LN);
    SEAM(1);
    if (IN(2)) for (int r_ = 0; r_ < NREP(2); ++r_) GEMM_BF16(XN, ws + WS_WCIN, 3072, 1024, ws + WS_BCV, 3072);
    SEAM(2);
    if (IN(3)) for (int r_ = 0; r_ < NREP(3); ++r_) ph_conv((const bf16*)(ws + WS_BCV), (const float*)args.in[8], (bf16*)(ws + WS_Z), GTID, GT);
    SEAM(3);
    if (IN(4)) for (int r_ = 0; r_ < NREP(4); ++r_) GEMM_RES(ws + WS_Z, ws + WS_WCOUT, (const float*)args.in[0], X, mod + 2048);
    SEAM(4);
    if (IN(5)) for (int r_ = 0; r_ < NREP(5); ++r_) ph_modulate(X, XN, nullptr, (const float*)args.in[4], mod, 3072, 4096, gw, NGW, LN);
    SEAM(5);
    if (IN(6)) for (int r_ = 0; r_ < NREP(6); ++r_) GEMM_BF16(XN, ws + WS_WPQ0, 2048, 1024, ws + WS_PQ, 2048);
    SEAM(6);
    if (IN(7)) for (int r_ = 0; r_ < NREP(7); ++r_) ph_topk((const bf16*)(ws + WS_PQ), (const bf16*)(ws + WS_SUBK), (unsigned short*)(ws + WS_IDS), (float*)(ws + WS_GATES), lds, bx, G, wave, LN);
    SEAM(7);
    if (IN(8)) { ph_peer_u<0>(ws + WS_PU, (const unsigned short*)(ws + WS_IDS), XN, (float*)(ws + WS_PART), bx, G, wave, LN);
        for (int r_ = 1; r_ < NREP(8); ++r_) ph_peer_u<PROBE_VAR>(ws + WS_PU, (const unsigned short*)(ws + WS_IDS), XN, (float*)(ws + WS_DUMMY), bx, G, wave, LN); }
    SEAM(8);
    if (IN(9)) for (int r_ = 0; r_ < NREP(9); ++r_) ph_peer_c((const float*)(ws + WS_PART), (const float*)(ws + WS_GATES), (bf16*)(ws + WS_ACT), gw, NGW, LN);
    SEAM(9);
    if (IN(10)) { for (int r_ = 1; r_ < NREP(10); ++r_) ph_peer_v<PROBE_VAR>(ws + WS_PV, (const unsigned short*)(ws + WS_IDS), (const bf16*)(ws + WS_ACT), X, (float*)(ws + WS_DUMMY), mod + 5120, lds, bx, wave, LN);
        ph_peer_v<0>(ws + WS_PV, (const unsigned short*)(ws + WS_IDS), (const bf16*)(ws + WS_ACT), X, X, mod + 5120, lds, bx, wave, LN); }
    SEAM(10);
    if (IN(11)) for (int r_ = 0; r_ < NREP(11); ++r_) ph_modulate(X, XN, nullptr, (const float*)args.in[3] + DM, mod + (size_t)4 * 6144, 0, 1024, gw, NGW, LN);
    SEAM(11);
    if (IN(12)) for (int r_ = 0; r_ < NREP(12); ++r_) GEMM_BF16(XN, ws + WS_WMIN, MLA_IN_PAD, 1024, ws + WS_LAT, MLA_IN_PAD);
    SEAM(12);
    if (IN(13)) for (int r_ = 0; r_ < NREP(13); ++r_) ph_latnorm((const bf16*)(ws + WS_LAT), (const float*)args.in[11], (const float*)args.in[12], (bf16*)(ws + WS_QN), (bf16*)(ws + WS_KVN), gw, NGW, LN);
    SEAM(13);
    if (IN(14)) for (int r_ = 0; r_ < NREP(14); ++r_) { GEMM_BF16(ws + WS_QN, ws + WS_WQB, 1536, QLORA, ws + WS_QRAW, 1536); GEMM_BF16(ws + WS_KVN, ws + WS_WKVB, 2048, KVLORA, ws + WS_KVRAW, 2048); }
    SEAM(14);
    if (IN(15)) for (int r_ = 0; r_ < NREP(15); ++r_) ph_qkprep((const bf16*)(ws + WS_QRAW), (const bf16*)(ws + WS_KVRAW), (const bf16*)(ws + WS_LAT), (const int*)args.in[2], (const float*)args.in[15], (const float*)args.in[16],
                          (bf16*)(ws + WS_QF), (bf16*)(ws + WS_KF), (bf16*)(ws + WS_VT), gw, NGW, LN);
    SEAM(15);
    if (IN(16)) for (int r_ = 0; r_ < NREP(16); ++r_) ph_attn((const bf16*)(ws + WS_QF), (const bf16*)(ws + WS_KF), (const bf16*)(ws + WS_VT), (bf16*)(ws + WS_O), lds, vcu, G, wave, LN);
    SEAM(16);
    if (IN(17)) for (int r_ = 0; r_ < NREP(17); ++r_) GEMM_RES(ws + WS_O, ws + WS_WMOUT, (const float*)X, (r_ + 1 < NREP(17) ? (float*)(ws + WS_DUMMY) : X), mod + (size_t)4 * 6144 + 2048);
    SEAM(17);
    if (IN(18)) for (int r_ = 0; r_ < NREP(18); ++r_) ph_modulate(X, XN, nullptr, (const float*)args.in[4] + DM, mod + (size_t)4 * 6144, 3072, 4096, gw, NGW, LN);
    SEAM(18);
    if (IN(19)) for (int r_ = 0; r_ < NREP(19); ++r_) GEMM_BF16(XN, ws + WS_WPQ1, 2048, 1024, ws + WS_PQ, 2048);
    SEAM(19);
    if (IN(20)) for (int r_ = 0; r_ < NREP(20); ++r_) ph_topk((const bf16*)(ws + WS_PQ), (const bf16*)(ws + WS_SUBK) + (size_t)8 * 2 * 128 * 128, (unsigned short*)(ws + WS_IDS), (float*)(ws + WS_GATES), lds, bx, G, wave, LN);
    SEAM(20);
    if (IN(21)) for (int r_ = 0; r_ < NREP(21); ++r_) ph_peer_u<0>(ws + WS_PU + (size_t)8 * NEXP * 128, (const unsigned short*)(ws + WS_IDS), XN, (float*)(ws + WS_PART), bx, G, wave, LN);
    SEAM(21);
    if (IN(22)) for (int r_ = 0; r_ < NREP(22); ++r_) ph_peer_c((const float*)(ws + WS_PART), (const float*)(ws + WS_GATES), (bf16*)(ws + WS_ACT), gw, NGW, LN);
    SEAM(22);
    if (IN(23)) for (int r_ = 0; r_ < NREP(23); ++r_) ph_peer_v<0>(ws + WS_PV + (size_t)128 * NEXP * 8, (const unsigned short*)(ws + WS_IDS), (const bf16*)(ws + WS_ACT), X, (r_ + 1 < NREP(23) ? (float*)(ws + WS_DUMMY) : X), mod + (size_t)4 * 6144 + 5120, lds, bx, wave, LN);
}

extern "C" void kernel_launch(void* const* d_in, const int* in_sizes, int n_in, void* d_out, int out_size, void* d_ws, size_t ws_size, hipStream_t stream) {
    static int grid = 0;
    if (grid == 0) {
        if (n_in != 22 || out_size != MTOK * DM || ws_size < WS_END) { fprintf(stderr, "kernel_launch: unexpected shapes: n_in %d out %d ws %zu (need %zu)\n", n_in, out_size, ws_size, (size_t)WS_END); grid = -1; return; }
        int dev = 0, cus = 0;
        if (hipGetDevice(&dev) != hipSuccess || hipDeviceGetAttribute(&cus, hipDeviceAttributeMultiprocessorCount, dev) != hipSuccess) { grid = -1; return; }
        if (hipFuncSetAttribute((const void*)mk_fwd, hipFuncAttributeMaxDynamicSharedMemorySize, LDS_BYTES) != hipSuccess) { fprintf(stderr, "kernel_launch: hipFuncSetAttribute failed\n"); grid = -1; return; }
        int per_cu = 0;
        if (hipOccupancyMaxActiveBlocksPerMultiprocessor(&per_cu, (const void*)mk_fwd, NWAVES * 64, LDS_BYTES) != hipSuccess || per_cu < 1) fprintf(stderr, "kernel_launch: occupancy query says %d\n", per_cu);
        (void)hipGetLastError();
        grid = cus;
        if (grid != 256) { fprintf(stderr, "kernel_launch: built for a 256-CU device (PEER value phase maps 128 dim slices x 2 token halves onto 256 workgroups); found %d CUs\n", grid); grid = -1; return; }
    }
    if (grid < 0) return;
    (void)hipMemsetAsync((char*)d_ws + WS_CTL, 0, CTL_ZERO_BYTES, stream);
    Args a{};
    for (int i = 0; i < 22; ++i) a.in[i] = d_in[i];
    a.out = (float*)d_out; a.ws = (unsigned char*)d_ws;
#if MK_N_LAUNCHES == 1
    a.ph_lo = 0; a.ph_hi = NPHASES;
    hipLaunchKernelGGL(mk_fwd, dim3(grid), dim3(NWAVES * 64), LDS_BYTES, stream, a);
#else
    for (int ph = 0; ph < NPHASES; ++ph) { a.ph_lo = ph; a.ph_hi = ph + 1; hipLaunchKernelGGL(mk_fwd, dim3(grid), dim3(NWAVES * 64), LDS_BYTES, stream, a); }
#endif
}
```

```cpp
#include <hip/hip_runtime.h>
#include <cstdio>
#include <cstdint>
#define GAS __attribute__((address_space(1)))
#define LAS __attribute__((address_space(3)))
namespace pg8 {
#define PG8_LAS __attribute__((address_space(3)))
typedef unsigned short bf16_t;
typedef short bf16x8 __attribute__((ext_vector_type(8)));
typedef float f32x4 __attribute__((ext_vector_type(4)));
typedef unsigned u32x4 __attribute__((ext_vector_type(4)));
constexpr int BM = 256, BK = 64, HALF = 128, HTB = HALF * BK * 2  , STAGE_BYTES = 8 * HTB, NXCD = 8, WGM = 8;

__host__ __device__ __forceinline__ int lds_byte(int r, int c) { const int st = (r >> 4) * 2 + (c >> 5), rr = r & 15, cc = c & 31, ob = rr * 64 + cc * 2; return st * 1024 + (ob ^ (((ob >> 9) & 1) << 5)); }
__host__ __device__ __forceinline__ void stage_rc(int b, int& R, int& C) { const int st = b / 1024, sb = b % 1024, swz = sb ^ (((sb >> 9) & 1) << 5); R = (st >> 1) * 16 + swz / 64; C = (st & 1) * 32 + (swz % 64) / 2; }
__host__ __device__ __forceinline__ int perm32(int rho) { const int n = rho >> 4, i = rho & 15; return 8 * (i >> 2) + 4 * n + (i & 3); }

struct Unit { int pm, pn; };
struct Gemm { const bf16_t* A; const bf16_t* Bt; int M, N, K; };

struct StaticOrder {
    int nM, nN, nwg, G, c;
    __host__ __device__ void init(int M, int N, int G_, int c_) { nM = M / BM; nN = N / BM; nwg = nM * nN; G = G_; c = c_; }
    __host__ __device__ bool next(int i, Unit& u) const {
        const long L = (long)i * G + c; if (L >= nwg) return false;
        int wgid = (int)L; { const int q = nwg / NXCD, r = nwg % NXCD, xcd = wgid % NXCD, off = wgid / NXCD; wgid = (xcd < r ? xcd * (q + 1) : r * (q + 1) + (xcd - r) * q) + off; }
        const int nig = WGM * nN, gid = wgid / nig, fm = gid * WGM, gsz = (nM - fm) < WGM ? (nM - fm) : WGM;
        u.pm = fm + ((wgid % nig) % gsz); u.pn = (wgid % nig) / gsz; return true;
    }
    __device__ __forceinline__ void a_ready(const Unit&) const {}
    __device__ __forceinline__ void done(const Unit&) const {}
};

__device__ __forceinline__ unsigned cvt_pk_bf16(float lo, float hi) { unsigned r; asm volatile("v_cvt_pk_bf16_f32 %0, %1, %2" : "=v"(r) : "v"(lo), "v"(hi)); return r; }
typedef float f32x2 __attribute__((ext_vector_type(2)));
__device__ __forceinline__ f32x2 gelu_pk(f32x2 v) {
    const f32x2 av = __builtin_elementwise_abs(v), d = av * 0.2316418882f + 1.0f;
    f32x2 t; t.x = __builtin_amdgcn_rcpf(d.x); t.y = __builtin_amdgcn_rcpf(d.y);
    f32x2 q = t * 0.5307027145f + (-0.7265760135f); q = q * t + 0.7107068705f; q = q * t + (-0.142248368f); q = q * t + 0.127414796f; q = q * t;
    const f32x2 s = (v * v) * (-0.72134752044f);
    f32x2 e; e.x = __builtin_amdgcn_exp2f(s.x); e.y = __builtin_amdgcn_exp2f(s.y);
    const f32x2 m = v * (q * e), r = v - m;
    f32x2 o; o.x = v.x < 0.f ? m.x : r.x; o.y = v.y < 0.f ? m.y : r.y; return o;
}

template <int ACT  > struct EpiBf16 {
    static constexpr bool PERM = true, AFTER_DRAIN = false; static_assert(ACT == 0 || ACT == 1, "EpiBf16: ACT is 0 (none) or 1 (gelu_pk)");
    bf16_t* O; int ldc; const float* bias; int split_cols; size_t split_stride; float scale0;
    __device__ __forceinline__ void operator()(const f32x4 (&acc)[2][2][4][2], const Unit& u, int wr, int wc, int fr, int fq) const {
        const int row0 = u.pm * BM + wr * 64 + fr; int colt = u.pn * BM; bf16_t* base = O;
        float sc = 1.f; if (split_cols) { const int t = colt / split_cols; base += (size_t)t * split_stride; colt -= t * split_cols; if (t == 0) sc = scale0; }
        const int col0 = colt + wc * 32 + 8 * fq, bcol0 = u.pn * BM + wc * 32 + 8 * fq;
        f32x4 bv[2][2];
#pragma unroll
        for (int bj = 0; bj < 2; ++bj)
#pragma unroll
            for (int n = 0; n < 2; ++n) bv[bj][n] = bias ? *(const f32x4*)(bias + bcol0 + bj * HALF + 4 * n) : (f32x4){0.f, 0.f, 0.f, 0.f};
#pragma unroll
        for (int ai = 0; ai < 2; ++ai)
#pragma unroll
            for (int m = 0; m < 4; ++m) { bf16_t* rowp = base + (size_t)(row0 + ai * HALF + m * 16) * ldc + col0;
#pragma unroll
                for (int bj = 0; bj < 2; ++bj) { f32x4 v0 = acc[ai][bj][m][0] + bv[bj][0], v1 = acc[ai][bj][m][1] + bv[bj][1];
                    if (ACT == 1) { f32x2 a = gelu_pk((f32x2){v0[0], v0[1]}), b = gelu_pk((f32x2){v0[2], v0[3]}), c = gelu_pk((f32x2){v1[0], v1[1]}), d = gelu_pk((f32x2){v1[2], v1[3]});
                        v0 = (f32x4){a.x, a.y, b.x, b.y}; v1 = (f32x4){c.x, c.y, d.x, d.y}; }
                    v0 = v0 * sc; v1 = v1 * sc; u32x4 w; w.x = cvt_pk_bf16(v0[0], v0[1]); w.y = cvt_pk_bf16(v0[2], v0[3]); w.z = cvt_pk_bf16(v1[0], v1[1]); w.w = cvt_pk_bf16(v1[2], v1[3]);
                    *(u32x4*)(rowp + bj * HALF) = w; } }
    }
};

template <class Epi, class Sched, bool ALIGN_EPI = false, bool SP2 = false>
__device__ __forceinline__ void gemm_phase(PG8_LAS unsigned char* lds, const Gemm g, const Sched& S, const Epi& E) {
    int tid_raw = threadIdx.x; asm volatile("" : "+v"(tid_raw));
    const int tid = tid_raw, wid = __builtin_amdgcn_readfirstlane(tid >> 6), lane = tid & 63, wr = wid >> 2, wc = wid & 3, fr = lane & 15, fq = lane >> 4;
    const int K = g.K, nt = K / BK;
    unsigned voffA[2], voffB[2];
#pragma unroll
    for (int i = 0; i < 2; ++i) { int R, C; stage_rc(tid * 16 + i * 8192, R, C); const int Rb = Epi::PERM ? ((R & ~31) + perm32(R & 31)) : R;
        voffA[i] = (unsigned)(R * K + C) * 2u; voffB[i] = (unsigned)(Rb * K + C) * 2u; }
    const size_t kstep = (size_t)(BK * 2);
    const size_t hstep = (size_t)HALF * K * 2;
    const size_t tstep = 2 * hstep;
    const unsigned ldsw = (unsigned)wid * 1024u;
    const int aoff = lds_byte(wr * 64 + fr, fq * 8), boff = lds_byte(wc * 32 + fr, fq * 8);
#define PG8_SA(b, h) (((b) * 2 + (h)) * HTB)
#define PG8_SB(b, h) ((4 + (b) * 2 + (h)) * HTB)
#define PG8_STAGE(bufoff, gbase, voff) do { _Pragma("unroll") for (int _i = 0; _i < 2; ++_i) \
        __builtin_amdgcn_global_load_lds((const unsigned*)((const char*)(gbase) + (voff)[_i]), (PG8_LAS unsigned*)(lds + (bufoff) + ldsw + _i * 8192), 16, 0, 0); } while (0)
#define PG8_LDA(dst, b, h) do { _Pragma("unroll") for (int m = 0; m < 4; ++m) _Pragma("unroll") for (int k = 0; k < 2; ++k) dst[m][k] = *(const PG8_LAS bf16x8*)(lds + PG8_SA(b, h) + aoff + m * 2048 + k * 1024); } while (0)
#define PG8_LDB(dst, b, h) do { _Pragma("unroll") for (int n = 0; n < 2; ++n) _Pragma("unroll") for (int k = 0; k < 2; ++k) dst[n][k] = *(const PG8_LAS bf16x8*)(lds + PG8_SB(b, h) + boff + n * 2048 + k * 1024); } while (0)
#define PG8_MMA(ai, bj, At, Bt) do { __builtin_amdgcn_s_setprio(1); _Pragma("unroll") for (int m = 0; m < 4; ++m) _Pragma("unroll") for (int n = 0; n < 2; ++n) _Pragma("unroll") for (int k = 0; k < 2; ++k) \
        acc[ai][bj][m][n] = __builtin_amdgcn_mfma_f32_16x16x32_bf16(Bt[n][k], At[m][k], acc[ai][bj][m][n], 0, 0, 0); __builtin_amdgcn_s_setprio(0); } while (0)
#define PG8_WAIT_V(n) asm volatile("s_waitcnt vmcnt(" #n ")" ::: "memory")
#define PG8_WAIT_L(n) asm volatile("s_waitcnt lgkmcnt(" #n ")" ::: "memory")
#define PG8_BAR __builtin_amdgcn_s_barrier()
#define PG8_SCHED __builtin_amdgcn_sched_barrier(0)
    Unit cur, nxt; int ui = 0;
    if (!S.next(0, cur)) return;
    f32x4 acc[2][2][4][2];
#pragma unroll
    for (int a = 0; a < 2; ++a)
#pragma unroll
        for (int b = 0; b < 2; ++b)
#pragma unroll
            for (int m = 0; m < 4; ++m)
#pragma unroll
                for (int n = 0; n < 2; ++n) acc[a][b][m][n] = (f32x4){0.f, 0.f, 0.f, 0.f};
    bf16x8 At[4][2], B0[2][2], B1[2][2];
    const char* cA = (const char*)g.A + (size_t)cur.pm * tstep; const char* cB = (const char*)g.Bt + (size_t)cur.pn * tstep;
    S.a_ready(cur);
    if constexpr (SP2) {
        PG8_STAGE(PG8_SB(0, 0), cB, voffB); PG8_STAGE(PG8_SB(0, 1), cB + hstep, voffB); PG8_STAGE(PG8_SA(0, 0), cA, voffA); PG8_STAGE(PG8_SA(0, 1), cA + hstep, voffA);
        if (wr == 1) PG8_BAR;
        PG8_WAIT_V(2); PG8_BAR;
        PG8_STAGE(PG8_SB(1, 0), cB + kstep, voffB); PG8_STAGE(PG8_SA(1, 0), cA + kstep, voffA); PG8_STAGE(PG8_SB(1, 1), cB + hstep + kstep, voffB);
        PG8_WAIT_V(6); PG8_BAR;
    } else {
        PG8_STAGE(PG8_SB(0, 0), cB, voffB); PG8_STAGE(PG8_SA(0, 0), cA, voffA); PG8_STAGE(PG8_SB(0, 1), cB + hstep, voffB); PG8_STAGE(PG8_SA(0, 1), cA + hstep, voffA);
        if (wr == 1) PG8_BAR;
        PG8_WAIT_V(4); PG8_BAR;
        PG8_STAGE(PG8_SB(1, 0), cB + kstep, voffB); PG8_STAGE(PG8_SA(1, 0), cA + kstep, voffA); PG8_STAGE(PG8_SB(1, 1), cB + hstep + kstep, voffB);
        PG8_WAIT_V(6); PG8_BAR;
    }
    for (;;) {
        const bool has_next = S.next(ui + 1, nxt);
        const char* nA = has_next ? (const char*)g.A + (size_t)nxt.pm * tstep : cA; const char* nB = has_next ? (const char*)g.Bt + (size_t)nxt.pn * tstep : cB;
        for (int t = 0; t < nt; t += 2) {
            const bool last = (t == nt - 2);
            const char* a1 = cA + (size_t)(t + 1) * kstep;
            const char* a2 = last ? nA : cA + (size_t)(t + 2) * kstep; const char* b2 = last ? nB : cB + (size_t)(t + 2) * kstep;
            const char* a3 = a2 + kstep; const char* b3 = b2 + kstep;
            if (last && has_next) S.a_ready(nxt);
            if constexpr (SP2) {
            PG8_LDB(B0, 0, 0); PG8_LDB(B1, 0, 1); PG8_SCHED; PG8_LDA(At, 0, 0); PG8_STAGE(PG8_SA(1, 1), a1 + hstep, voffA);
            PG8_WAIT_V(8); PG8_WAIT_L(0); PG8_BAR; PG8_MMA(0, 0, At, B0); PG8_MMA(0, 1, At, B1); PG8_BAR; PG8_SCHED;
            PG8_LDA(At, 0, 1); PG8_STAGE(PG8_SB(0, 0), b2, voffB); PG8_STAGE(PG8_SB(0, 1), b2 + hstep, voffB); PG8_STAGE(PG8_SA(0, 0), a2, voffA);
            PG8_WAIT_V(8); PG8_WAIT_L(0); PG8_BAR; PG8_MMA(1, 0, At, B0); PG8_MMA(1, 1, At, B1); PG8_BAR; PG8_SCHED;
            PG8_LDB(B0, 1, 0); PG8_LDB(B1, 1, 1); PG8_SCHED; PG8_LDA(At, 1, 0); PG8_STAGE(PG8_SA(0, 1), a2 + hstep, voffA);
            PG8_WAIT_V(8); PG8_WAIT_L(0); PG8_BAR; PG8_MMA(0, 0, At, B0); PG8_MMA(0, 1, At, B1); PG8_BAR; PG8_SCHED;
            PG8_LDA(At, 1, 1); PG8_STAGE(PG8_SB(1, 0), b3, voffB); PG8_STAGE(PG8_SB(1, 1), b3 + hstep, voffB); PG8_STAGE(PG8_SA(1, 0), a3, voffA);
            PG8_WAIT_V(8); PG8_WAIT_L(0); PG8_BAR; PG8_MMA(1, 0, At, B0); PG8_MMA(1, 1, At, B1); PG8_BAR; PG8_SCHED;
            } else {
            PG8_LDB(B0, 0, 0); PG8_SCHED; PG8_LDA(At, 0, 0); PG8_STAGE(PG8_SA(1, 1), a1 + hstep, voffA);
            PG8_WAIT_L(8); PG8_BAR; PG8_WAIT_L(0); PG8_MMA(0, 0, At, B0); PG8_BAR; PG8_SCHED;
            PG8_LDB(B1, 0, 1); PG8_STAGE(PG8_SB(0, 0), b2, voffB);
            PG8_BAR; PG8_WAIT_L(0); PG8_MMA(0, 1, At, B1); PG8_BAR;
            PG8_LDA(At, 0, 1); PG8_STAGE(PG8_SA(0, 0), a2, voffA);
            PG8_BAR; PG8_WAIT_L(0); PG8_MMA(1, 0, At, B0); PG8_BAR; PG8_SCHED;
            PG8_STAGE(PG8_SB(0, 1), b2 + hstep, voffB);
            PG8_WAIT_V(6); PG8_BAR; PG8_MMA(1, 1, At, B1); PG8_BAR;
            PG8_LDB(B0, 1, 0); PG8_SCHED; PG8_LDA(At, 1, 0); PG8_STAGE(PG8_SA(0, 1), a2 + hstep, voffA);
            PG8_WAIT_L(8); PG8_BAR; PG8_WAIT_L(0); PG8_MMA(0, 0, At, B0); PG8_BAR; PG8_SCHED;
            PG8_LDB(B1, 1, 1); PG8_STAGE(PG8_SB(1, 0), b3, voffB);
            PG8_BAR; PG8_WAIT_L(0); PG8_MMA(0, 1, At, B1); PG8_BAR;
            PG8_LDA(At, 1, 1); PG8_STAGE(PG8_SA(1, 0), a3, voffA);
            PG8_BAR; PG8_WAIT_L(0); PG8_MMA(1, 0, At, B0); PG8_BAR; PG8_SCHED;
            PG8_STAGE(PG8_SB(1, 1), b3 + hstep, voffB);
            PG8_WAIT_V(6); PG8_BAR; PG8_MMA(1, 1, At, B1); PG8_BAR;
            }
        }
        if constexpr (ALIGN_EPI) { if (wr == 0) PG8_BAR; }
        if constexpr (!Epi::AFTER_DRAIN) { E(acc, cur, wr, wc, fr, fq); S.done(cur); }
        if (!has_next) break;
#pragma unroll
        for (int a = 0; a < 2; ++a)
#pragma unroll
            for (int b = 0; b < 2; ++b)
#pragma unroll
                for (int m = 0; m < 4; ++m)
#pragma unroll
                    for (int n = 0; n < 2; ++n) acc[a][b][m][n] = (f32x4){0.f, 0.f, 0.f, 0.f};
        cur = nxt; cA = nA; cB = nB; ++ui;
        if constexpr (ALIGN_EPI) { if (wr == 1) PG8_BAR; }
    }
    PG8_WAIT_V(0);
    if constexpr (!ALIGN_EPI) { if (wr == 0) PG8_BAR; }
    PG8_BAR;
    if constexpr (Epi::AFTER_DRAIN) { E.fused(acc, cur, wr, wc, fr, fq, lds, wid, lane); S.done(cur); }
#undef PG8_SA
#undef PG8_SB
#undef PG8_STAGE
#undef PG8_LDA
#undef PG8_LDB
#undef PG8_MMA
#undef PG8_WAIT_V
#undef PG8_WAIT_L
#undef PG8_BAR
#undef PG8_SCHED
}
}
#define XB_TMO      128
#define XB_XCNT(j)  (256  + 64 * (j))
#define XB_XSUB(j)  (1280 + 64 * (j))
#define XB_XGEN(j)  (2304 + 64 * (j))
#define XB_TOP      3328
#define XB_TOPGEN   3392
#define XCD_BAR_WORDS 3456
#define XB_SPIN_CAP (1u << 18)

__device__ __forceinline__ unsigned xb_ld(unsigned* p)              { return __hip_atomic_load(p, __ATOMIC_RELAXED, __HIP_MEMORY_SCOPE_AGENT); }
__device__ __forceinline__ unsigned xb_add(unsigned* p, unsigned v) { return __hip_atomic_fetch_add(p, v, __ATOMIC_RELAXED, __HIP_MEMORY_SCOPE_AGENT); }
__device__ __forceinline__ unsigned xb_xcc_id() { return (unsigned)__builtin_amdgcn_s_getreg((3 << 11) | 20) & 0xFu; }
#define XB_SPIN(cond, bar) do { unsigned _sp = 0; while (cond) { __builtin_amdgcn_s_sleep(1); \
    if ((++_sp & 255u) == 0u) { if (xb_ld(&(bar)[XB_TMO])) break; if (_sp > XB_SPIN_CAP) { atomicAdd(&(bar)[XB_TMO], 1u); break; } } } } while (0)

struct XcdBarrier {
    unsigned* bar; unsigned x;
    volatile LAS unsigned* st;
};

__device__ __forceinline__ XcdBarrier xcd_barrier_post(unsigned* bar, volatile LAS unsigned* st) {
    XcdBarrier b; b.bar = bar; b.x = xb_xcc_id(); b.st = st;
    if (threadIdx.x == 0) (void)xb_add(&bar[XB_XCNT(b.x)], 1u);
    return b;
}
__device__ __forceinline__ void xcd_barrier_complete(unsigned* bar, unsigned x, unsigned& nloc, unsigned& nx) {
    const unsigned G = gridDim.x * gridDim.y * gridDim.z;
    unsigned sum, cnt, mine, sp = 0u;
    for (;;) {
        sum = 0u; cnt = 0u; mine = 0u;
#pragma unroll
        for (unsigned j = 0; j < 16; ++j) { const unsigned c = xb_ld(&bar[XB_XCNT(j)]); sum += c; cnt += (c > 0u) ? 1u : 0u; mine = (j == x) ? c : mine; }
        if (sum == G) break;
        __builtin_amdgcn_s_sleep(1);
        if ((++sp & 255u) == 0u) { if (xb_ld(&bar[XB_TMO])) break; if (sp > XB_SPIN_CAP) { atomicAdd(&bar[XB_TMO], 1u); break; } }
    }
    nloc = mine > 0u ? mine : 1u; nx = cnt > 0u ? cnt : 1u;
}

__device__ __forceinline__ void xcd_barrier(const XcdBarrier& b) {
    asm volatile("s_waitcnt vmcnt(0)" ::: "memory");
    __syncthreads();
    if (threadIdx.x == 0) {
        unsigned* bar = b.bar;
        __builtin_amdgcn_s_waitcnt(0);
        unsigned nloc = b.st[0], nx = b.st[1];
        if (nloc == 0u) { xcd_barrier_complete(bar, b.x, nloc, nx); b.st[0] = nloc; b.st[1] = nx; }
        const unsigned old = xb_add(&bar[XB_XSUB(b.x)], 1u);
        const unsigned gen = old / nloc;
        if (old + 1u == (gen + 1u) * nloc) {
            __builtin_amdgcn_fence(__ATOMIC_RELEASE, "agent");
            asm volatile("s_waitcnt vmcnt(0)" ::: "memory");
            const unsigned og = xb_add(&bar[XB_TOP], 1u);
            const unsigned tg = og / nx;
            if (og + 1u == (tg + 1u) * nx) xb_add(&bar[XB_TOPGEN], 1u);
            else XB_SPIN(xb_ld(&bar[XB_TOPGEN]) == tg, bar);
            __builtin_amdgcn_fence(__ATOMIC_ACQUIRE, "agent");
            xb_add(&bar[XB_XGEN(b.x)], 1u);
            asm volatile("s_waitcnt vmcnt(0)" ::: "memory");
        } else {
            XB_SPIN(xb_ld(&bar[XB_XGEN(b.x)]) == gen, bar);
            __builtin_amdgcn_fence(__ATOMIC_ACQUIRE, "agent");
            asm volatile("s_waitcnt vmcnt(0)" ::: "memory");
        }
    }
    __syncthreads();
}

constexpr int DM = 1024, NB = 4, SEQ = 4096, MTOK = NB * SEQ;
constexpr int QLORA = 384, KVLORA = 256, ROPE = 64, NOPE = 128, QKH = 192, VH = 128, NH = 8;
constexpr int MLA_IN = 704, MLA_IN_PAD = 768;
constexpr int NEXP = 16384;
constexpr float NORM_EPS = 1e-6f;
constexpr float U8_SCALE = 256.f, V8_SCALE = 16.f, H8_SCALE = 8.f;
constexpr float VI8_SCALE = 127.f / (4.5f * 0.5f);
constexpr float UI8_SCALE = 127.f * 32.f / 4.5f;
constexpr float QSCALE = 0.07216878364870322f * 1.4426950408889634f;

#ifndef MK_N_LAUNCHES
#define MK_N_LAUNCHES 1
#endif
constexpr int NPHASES = 24;
#ifndef PHMASK
#define PHMASK 0xFFFFFFu
#endif
#define EN(k) (((PHMASK) >> (k)) & 1u)
#ifndef PROBE_PHASE
#define PROBE_PHASE -1
#endif
#ifndef PROBE_VAR
#define PROBE_VAR 0
#endif
#ifndef PROBE_REPS
#define PROBE_REPS 2
#endif
#define NREP(k) ((k) == (PROBE_PHASE) ? (PROBE_REPS) : 1)
constexpr int NWAVES = 8;

constexpr size_t MiB = 1u << 20;
constexpr size_t WS_CTL = 0, CTL_ZERO_BYTES = 64 * 1024;
constexpr size_t WS_MOD = 1 * MiB;
constexpr size_t WS_WCIN = 2 * MiB;
constexpr size_t WS_WCOUT = 8 * MiB;
constexpr size_t WS_WPQ0 = 10 * MiB, WS_WPQ1 = 14 * MiB;
constexpr size_t WS_WMIN = 18 * MiB;
constexpr size_t WS_WQB = 20 * MiB;
constexpr size_t WS_WKVB = 22 * MiB;
constexpr size_t WS_WMOUT = 24 * MiB;
constexpr size_t WS_SUBK = 26 * MiB;
constexpr size_t WS_PU = 32 * MiB;
constexpr size_t WS_PV = 96 * MiB;
constexpr size_t WS_XN = 160 * MiB;
constexpr size_t WS_VT = 160 * MiB;
constexpr size_t WS_BCV = 192 * MiB;
constexpr size_t WS_LAT = 192 * MiB;
constexpr size_t WS_O = 192 * MiB;
constexpr size_t WS_QN = 216 * MiB;
constexpr size_t WS_KVN = 228 * MiB;
constexpr size_t WS_QRAW = 236 * MiB;
constexpr size_t WS_Z = 288 * MiB;
constexpr size_t WS_KVRAW = 288 * MiB;
constexpr size_t WS_PQ = 288 * MiB;
constexpr size_t WS_QF = 352 * MiB;
constexpr size_t WS_KF = 400 * MiB;
constexpr size_t WS_IDS = 448 * MiB;
constexpr size_t WS_GATES = 456 * MiB;
constexpr size_t WS_PART = 192 * MiB;
constexpr size_t WS_DUMMY = 288 * MiB;
constexpr size_t WS_ACT = 464 * MiB;
constexpr size_t WS_XN8 = 472 * MiB;
constexpr size_t WS_HS = 488 * MiB;
constexpr size_t WS_AS = 489 * MiB;
constexpr size_t WS_END = 490 * MiB;
constexpr int CW_BAR = 1024;

constexpr int RING_BYTES = 131072;
constexpr int LDSCTL_OFF = RING_BYTES, MISC_OFF = LDSCTL_OFF + 320;
constexpr int LDS_BYTES = 147456;


typedef unsigned short bf16;
typedef unsigned u32x4 __attribute__((ext_vector_type(4)));
typedef unsigned u32x2 __attribute__((ext_vector_type(2)));
typedef float f32x4 __attribute__((ext_vector_type(4)));
typedef float f32x16 __attribute__((ext_vector_type(16)));
typedef short s16x8 __attribute__((ext_vector_type(8)));
typedef short s16x4 __attribute__((ext_vector_type(4)));
#define LDS_WAIT() asm volatile("s_waitcnt lgkmcnt(0)" ::: "memory")
#define VM_WAIT() asm volatile("s_waitcnt vmcnt(0)" ::: "memory")
#define DI __device__ __forceinline__

DI unsigned f2bf(float f) { unsigned u = __builtin_bit_cast(unsigned, f); return (u + 0x7fffu + ((u >> 16) & 1u)) >> 16; }
DI unsigned pk2(float lo, float hi) { return f2bf(lo) | (f2bf(hi) << 16); }
DI float bflo(unsigned u) { return __uint_as_float(u << 16); }
DI float bfhi(unsigned u) { return __uint_as_float(u & 0xffff0000u); }
DI float bf1(bf16 b) { return __uint_as_float((unsigned)b << 16); }
DI float wave_sum(float v) {
#pragma unroll
    for (int o = 32; o > 0; o >>= 1) v += __shfl_xor(v, o);
    return v;
}
DI int crow(int r, int hi) { return (r & 3) + 8 * (r >> 2) + 4 * hi; }

struct Args { const void* in[22]; float* out; unsigned char* ws; int ph_lo, ph_hi; };

DI void transpose_item(const float* W, int K, int N, bf16* WT, LAS float* scr, int item, int lane) {
    const int nblk = N / 32, kb = item / nblk, nb = item % nblk, k0 = 64 * kb, n0 = 32 * nb;
#pragma unroll 8
    for (int i = 0; i < 32; ++i) { const int kk = 2 * i + (lane >> 5); scr[kk * 33 + (lane & 31)] = W[(size_t)(k0 + kk) * N + n0 + (lane & 31)]; }
    LDS_WAIT(); asm volatile("" ::: "memory");
    const int c = lane & 7;
#pragma unroll
    for (int j = 0; j < 4; ++j) { const int n = (lane >> 3) + 8 * j; const LAS float* s = scr + (8 * c) * 33 + n;
        u32x4 o; o.x = pk2(s[0 * 33], s[1 * 33]); o.y = pk2(s[2 * 33], s[3 * 33]); o.z = pk2(s[4 * 33], s[5 * 33]); o.w = pk2(s[6 * 33], s[7 * 33]);
        *(u32x4*)(WT + (size_t)(n0 + n) * K + k0 + 8 * c) = o; }
    LDS_WAIT(); asm volatile("" ::: "memory");
}
DI void cvt_f32_bf16(const float* src, bf16* dst, size_t n8, size_t gt, size_t GT) {
#pragma unroll 4
    for (size_t i = gt; i < n8; i += GT) {
        const f32x4 a = ((const f32x4*)src)[2 * i], b = ((const f32x4*)src)[2 * i + 1];
        u32x4 o; o.x = pk2(a.x, a.y); o.y = pk2(a.z, a.w); o.z = pk2(b.x, b.y); o.w = pk2(b.z, b.w);
        ((u32x4*)dst)[i] = o; }
}

typedef float f32x2v __attribute__((ext_vector_type(2)));
DI unsigned pack4_fp8(float a, float b, float c, float d, float sc) {
    a = fminf(fmaxf(a * sc, -448.f), 448.f); b = fminf(fmaxf(b * sc, -448.f), 448.f); c = fminf(fmaxf(c * sc, -448.f), 448.f); d = fminf(fmaxf(d * sc, -448.f), 448.f);
    int w = __builtin_amdgcn_cvt_pk_fp8_f32(a, b, 0, false); w = __builtin_amdgcn_cvt_pk_fp8_f32(c, d, w, true); return (unsigned)w;
}
DI unsigned pack4_i8(float a, float b, float c, float d, float sc) {
    const int ia = (int)rintf(fminf(fmaxf(a * sc, -127.f), 127.f)), ib = (int)rintf(fminf(fmaxf(b * sc, -127.f), 127.f)), ic = (int)rintf(fminf(fmaxf(c * sc, -127.f), 127.f)), id = (int)rintf(fminf(fmaxf(d * sc, -127.f), 127.f));
    return (unsigned)(ia & 0xff) | ((unsigned)(ib & 0xff) << 8) | ((unsigned)(ic & 0xff) << 16) | ((unsigned)(id & 0xff) << 24);
}
DI void cvt_utable_fp8(const float* u, unsigned char* u8, size_t gt, size_t GT) {
    const size_t n16 = (size_t)2 * NEXP * 1024 / 16;
#pragma unroll 2
    for (size_t i = gt; i < n16; i += GT) {
        const f32x4* s = (const f32x4*)(u + i * 16); const f32x4 a = s[0], b = s[1], c = s[2], d = s[3];
        u32x4 o; o.x = pack4_i8(a.x, a.y, a.z, a.w, UI8_SCALE); o.y = pack4_i8(b.x, b.y, b.z, b.w, UI8_SCALE); o.z = pack4_i8(c.x, c.y, c.z, c.w, UI8_SCALE); o.w = pack4_i8(d.x, d.y, d.z, d.w, UI8_SCALE);
        const size_t k = i & 63, row = i >> 6, e = row & (NEXP - 1), layer = row >> 14;
        *(u32x4*)(u8 + (((layer * 8 + (k >> 3)) * NEXP + e) * 128 + (k & 7) * 16)) = o; }
}
constexpr int VT_ROWB = 1032;
DI void cvt_vtable_lds(const float* v, unsigned char* v8l, LAS unsigned char* tile, int bx, int G, int tid) {
    for (int item = bx; item < 2 * (NEXP / 64); item += G) {
        const int layer = item / (NEXP / 64), e0 = (item % (NEXP / 64)) * 64;
        const float* src = v + ((size_t)layer * NEXP + e0) * 1024;
#pragma unroll 2
        for (int i = 0; i < 8; ++i) { const int c = tid + 512 * i, row = c >> 6, k = c & 63;
            const f32x4* s = (const f32x4*)(src + (size_t)row * 1024 + 16 * k); const f32x4 a = s[0], b = s[1], cc = s[2], d = s[3];
            const u32x2 lo = (u32x2){pack4_i8(a.x, a.y, a.z, a.w, VI8_SCALE), pack4_i8(b.x, b.y, b.z, b.w, VI8_SCALE)}, hi = (u32x2){pack4_i8(cc.x, cc.y, cc.z, cc.w, VI8_SCALE), pack4_i8(d.x, d.y, d.z, d.w, VI8_SCALE)};
            *(LAS u32x2*)(tile + row * VT_ROWB + 16 * k) = lo; *(LAS u32x2*)(tile + row * VT_ROWB + 16 * k + 8) = hi; }
        __syncthreads();
#pragma unroll 4
        for (int i = 0; i < 16; ++i) { const int q = tid + 512 * i, sl = q >> 6, e = q & 63;
            const u32x2 w = *(const LAS u32x2*)(tile + e * VT_ROWB + 8 * sl);
            *(u32x2*)(v8l + (((size_t)layer * 128 + sl) * NEXP + e0 + e) * 8) = w; }
        __syncthreads();
    }
}
DI void ph_prologue(const Args& a, LAS unsigned char* lds, int tid, int wave, int vcu, int G) {
    const int lane = tid & 63;
    {
        const float* c = (const float*)a.in[1]; const float* ada_w = (const float*)a.in[5]; const float* ada_b = (const float*)a.in[6];
        float* mod = (float*)(a.ws + WS_MOD);
        LAS float* cact = (LAS float*)lds; LAS float* red = cact + 4096;
        for (int it = blockIdx.x; it < 192; it += G) {
            const int i = it / 96, n0 = (it % 96) * 64;
            for (int e = tid; e < 4096; e += 512) { const float v = c[e]; cact[e] = v / (1.f + expf(-v)); }
            __syncthreads();
            const float* W = ada_w + (size_t)i * 1024 * 6144 + n0 + lane;
            float a0 = 0.f, a1 = 0.f, a2 = 0.f, a3 = 0.f;
            const int k0 = wave * 128;
#pragma unroll 8
            for (int k = k0; k < k0 + 128; ++k) { const float w = W[(size_t)k * 6144]; a0 += cact[k] * w; a1 += cact[1024 + k] * w; a2 += cact[2048 + k] * w; a3 += cact[3072 + k] * w; }
            red[(wave * 4 + 0) * 64 + lane] = a0; red[(wave * 4 + 1) * 64 + lane] = a1; red[(wave * 4 + 2) * 64 + lane] = a2; red[(wave * 4 + 3) * 64 + lane] = a3;
            __syncthreads();
            if (tid < 256) { const int b = tid >> 6; float s = 0.f;
#pragma unroll
                for (int w = 0; w < 8; ++w) s += red[(w * 4 + b) * 64 + lane];
                mod[(size_t)(i * 4 + b) * 6144 + n0 + lane] = s + ada_b[i * 6144 + n0 + lane]; }
            __syncthreads();
        }
    }
    {
        LAS float* scr = (LAS float*)(lds + 32768 + wave * 8704);
        const int gw = vcu * NWAVES + wave, NGW = G * NWAVES;
        unsigned char* ws = a.ws;
        constexpr int I_CIN = 16 * 96, I_COUT = 16 * 32, I_PQ = 16 * 64, I_MIN = 16 * 22, I_QB = 6 * 48, I_KVB = 4 * 64, I_MOUT = 16 * 32;
        constexpr int NITEMS = I_CIN + I_COUT + 2 * I_PQ + I_MIN + I_QB + I_KVB + I_MOUT;
        for (int it = gw; it < NITEMS; it += NGW) {
            int r = it;
            if (r < I_CIN) { transpose_item((const float*)a.in[7], 1024, 3072, (bf16*)(ws + WS_WCIN), scr, r, lane); continue; } r -= I_CIN;
            if (r < I_COUT) { transpose_item((const float*)a.in[9], 1024, 1024, (bf16*)(ws + WS_WCOUT), scr, r, lane); continue; } r -= I_COUT;
            if (r < I_PQ) { transpose_item((const float*)a.in[18], 1024, 2048, (bf16*)(ws + WS_WPQ0), scr, r, lane); continue; } r -= I_PQ;
            if (r < I_PQ) { transpose_item((const float*)a.in[18] + (size_t)1024 * 2048, 1024, 2048, (bf16*)(ws + WS_WPQ1), scr, r, lane); continue; } r -= I_PQ;
            if (r < I_MIN) { transpose_item((const float*)a.in[10], 1024, MLA_IN, (bf16*)(ws + WS_WMIN), scr, r, lane); continue; } r -= I_MIN;
            if (r < I_QB) { transpose_item((const float*)a.in[13], 384, 1536, (bf16*)(ws + WS_WQB), scr, r, lane); continue; } r -= I_QB;
            if (r < I_KVB) { transpose_item((const float*)a.in[14], 256, 2048, (bf16*)(ws + WS_WKVB), scr, r, lane); continue; } r -= I_KVB;
            transpose_item((const float*)a.in[17], 1024, 1024, (bf16*)(ws + WS_WMOUT), scr, r, lane);
        }
        const size_t gt = (size_t)vcu * 512 + tid, GT = (size_t)G * 512;
        for (size_t i = gt; i < (size_t)(MLA_IN_PAD - MLA_IN) * 1024 / 8; i += GT) ((u32x4*)(ws + WS_WMIN + (size_t)MLA_IN * 1024 * 2))[i] = (u32x4){0u, 0u, 0u, 0u};
        cvt_f32_bf16((const float*)a.in[19], (bf16*)(ws + WS_SUBK), (size_t)2 * 8 * 2 * 128 * 128 / 8, gt, GT);
        cvt_utable_fp8((const float*)a.in[20], ws + WS_PU, gt, GT);
        __syncthreads();
        cvt_vtable_lds((const float*)a.in[21], ws + WS_PV, lds, blockIdx.x, G, tid);
    }
}

DI void ph_modulate(const float* x, bf16* xn, unsigned char* xn8  , float* hs, const float* gain, const float* modl, int sh_off, int sc_off, int gw, int NGW, int lane) {
    for (int m = gw; m < MTOK; m += NGW) {
        const float* mb = modl + (size_t)(m >> 12) * 6144;
        const f32x4* xr = (const f32x4*)(x + (size_t)m * DM) + lane;
        f32x4 v[4]; float s = 0.f;
#pragma unroll
        for (int j = 0; j < 4; ++j) { v[j] = xr[64 * j]; s += (v[j].x * v[j].x + v[j].y * v[j].y) + (v[j].z * v[j].z + v[j].w * v[j].w); }
        const float rstd = rsqrtf(wave_sum(s) * (1.f / DM) + NORM_EPS);
        u32x2* o8 = (u32x2*)(xn + (size_t)m * DM) + lane;
        f32x4 y[4]; float mx = 0.f;
#pragma unroll
        for (int j = 0; j < 4; ++j) {
            const f32x4 g = ((const f32x4*)gain)[lane + 64 * j], sh = ((const f32x4*)(mb + sh_off))[lane + 64 * j], sc = ((const f32x4*)(mb + sc_off))[lane + 64 * j];
            y[j] = v[j] * rstd * g * (sc + 1.f) + sh;
            u32x2 w; w.x = pk2(y[j].x, y[j].y); w.y = pk2(y[j].z, y[j].w); o8[64 * j] = w;
            mx = fmaxf(mx, fmaxf(fmaxf(fabsf(y[j].x), fabsf(y[j].y)), fmaxf(fabsf(y[j].z), fabsf(y[j].w)))); }
        if (xn8) {
#pragma unroll
            for (int o = 32; o > 0; o >>= 1) mx = fmaxf(mx, __shfl_xor(mx, o));
            const float scl = mx > 0.f ? mx * (1.f / 127.f) : 1.f, isc = 1.f / scl;
#pragma unroll
            for (int j = 0; j < 4; ++j) ((unsigned*)(xn8 + (size_t)m * DM))[lane + 64 * j] = pack4_i8(y[j].x, y[j].y, y[j].z, y[j].w, isc);
            if (lane == 0) hs[m] = scl;
        }
    }
}

DI void ph_conv(const bf16* bcv, const float* cw, bf16* z, size_t gt, size_t GT) {
    for (size_t it = gt; it < (size_t)MTOK * 128; it += GT) {
        const int t = (int)(it >> 7), ch = (int)(it & 127) * 8, s = t & (SEQ - 1);
        const bf16* row = bcv + (size_t)t * 3072 + ch;
        const u32x4 zero = (u32x4){0u, 0u, 0u, 0u};
        const u32x4 bq = *(const u32x4*)row;
        const u32x4 c0 = *(const u32x4*)(row + 1024), v0 = *(const u32x4*)(row + 2048);
        const u32x4 c1 = s >= 1 ? *(const u32x4*)(row - 3072 + 1024) : zero, v1 = s >= 1 ? *(const u32x4*)(row - 3072 + 2048) : zero;
        const u32x4 c2 = s >= 2 ? *(const u32x4*)(row - 6144 + 1024) : zero, v2 = s >= 2 ? *(const u32x4*)(row - 6144 + 2048) : zero;
        const f32x4 w0a = *(const f32x4*)(cw + ch), w0b = *(const f32x4*)(cw + ch + 4);
        const f32x4 w1a = *(const f32x4*)(cw + 1024 + ch), w1b = *(const f32x4*)(cw + 1024 + ch + 4);
        const f32x4 w2a = *(const f32x4*)(cw + 2048 + ch), w2b = *(const f32x4*)(cw + 2048 + ch + 4);
        float r[8];
#pragma unroll
        for (int e = 0; e < 4; ++e) {
            const float w0l = e < 2 ? w0a[2 * e] : w0b[2 * e - 4], w0h = e < 2 ? w0a[2 * e + 1] : w0b[2 * e - 3];
            const float w1l = e < 2 ? w1a[2 * e] : w1b[2 * e - 4], w1h = e < 2 ? w1a[2 * e + 1] : w1b[2 * e - 3];
            const float w2l = e < 2 ? w2a[2 * e] : w2b[2 * e - 4], w2h = e < 2 ? w2a[2 * e + 1] : w2b[2 * e - 3];
            const float ut_l = bflo(c0[e]) * bflo(v0[e]), ut_h = bfhi(c0[e]) * bfhi(v0[e]);
            const float u1_l = bflo(c1[e]) * bflo(v1[e]), u1_h = bfhi(c1[e]) * bfhi(v1[e]);
            const float u2_l = bflo(c2[e]) * bflo(v2[e]), u2_h = bfhi(c2[e]) * bfhi(v2[e]);
            r[2 * e] = bflo(bq[e]) * (w0l * u2_l + w1l * u1_l + w2l * ut_l);
            r[2 * e + 1] = bfhi(bq[e]) * (w0h * u2_h + w1h * u1_h + w2h * ut_h);
        }
        u32x4 o; o.x = pk2(r[0], r[1]); o.y = pk2(r[2], r[3]); o.z = pk2(r[4], r[5]); o.w = pk2(r[6], r[7]);
        *(u32x4*)(z + (size_t)t * DM + ch) = o;
    }
}

struct EpiResGate {
    static constexpr bool PERM = false, AFTER_DRAIN = false;
    const float* base; float* out; const float* gate;
    __device__ __forceinline__ void operator()(const pg8::f32x4 (&acc)[2][2][4][2], const pg8::Unit& u, int wr, int wc, int fr, int fq) const {
        const int row0 = u.pm * 256 + wr * 64 + fr, col0 = u.pn * 256 + wc * 32 + 4 * fq;
        const float* gp = gate + (size_t)(u.pm >> 4) * 6144 + col0;
        pg8::f32x4 gv[2][2];
#pragma unroll
        for (int bj = 0; bj < 2; ++bj)
#pragma unroll
            for (int n = 0; n < 2; ++n) gv[bj][n] = *(const pg8::f32x4*)(gp + bj * 128 + n * 16);
#pragma unroll
        for (int ai = 0; ai < 2; ++ai)
#pragma unroll
            for (int m = 0; m < 4; ++m) { const size_t off = (size_t)(row0 + ai * 128 + m * 16) * DM + col0;
#pragma unroll
                for (int bj = 0; bj < 2; ++bj)
#pragma unroll
                    for (int n = 0; n < 2; ++n) { const pg8::f32x4 bs = *(const pg8::f32x4*)(base + off + bj * 128 + n * 16);
                        *(pg8::f32x4*)(out + off + bj * 128 + n * 16) = bs + gv[bj][n] * acc[ai][bj][m][n]; } }
    }
};

typedef float f32x2_t __attribute__((ext_vector_type(2))); typedef __bf16 bf16x2_t __attribute__((ext_vector_type(2)));
DI unsigned cvtpk(float lo, float hi) { f32x2_t v = {lo, hi}; bf16x2_t b = __builtin_convertvector(v, bf16x2_t); return __builtin_bit_cast(unsigned, b); }
DI unsigned f2key(float f) { const unsigned u = __float_as_uint(f); return u ^ ((unsigned)((int)u >> 31) | 0x80000000u); }
DI float key2f(unsigned k) { const unsigned u = (k & 0x80000000u) ? (k ^ 0x80000000u) : ~k; return __uint_as_float(u); }
DI unsigned umax_(unsigned a, unsigned b) { return a > b ? a : b; }
DI unsigned umin_(unsigned a, unsigned b) { return a < b ? a : b; }
template <int N> DI void bitonic_sort_desc(unsigned (&v)[N]) {
#pragma unroll
    for (int k = 2; k <= N; k <<= 1) {
#pragma unroll
        for (int j = k >> 1; j > 0; j >>= 1) {
#pragma unroll
            for (int i = 0; i < N; ++i) { const int l = i ^ j;
                if (l > i) { const bool desc = ((i & k) == 0); const unsigned x = v[i], y = v[l], mx = umax_(x, y), mn = umin_(x, y); v[i] = desc ? mx : mn; v[l] = desc ? mn : mx; } }
        }
    }
}
template <int N> DI void bitonic_merge_desc(unsigned (&v)[N]) {
#pragma unroll
    for (int j = N >> 1; j > 0; j >>= 1) {
#pragma unroll
        for (int i = 0; i < N; ++i) { const int l = i ^ j;
            if (l > i) { const unsigned x = v[i], y = v[l]; v[i] = umax_(x, y); v[l] = umin_(x, y); } }
    }
}
DI void top16_merge(unsigned (&t)[16], unsigned (&n)[16]) {
#pragma unroll
    for (int i = 0; i < 16; ++i) t[i] = umax_(t[i], n[15 - i]);
    bitonic_merge_desc<16>(t);
}

constexpr int TK_ROWB = 272, TK_TAB_OFF = 32768;
DI void topk_task(const bf16* PQ, LAS unsigned char* skl  , unsigned short* IDS, float* GATES, LAS unsigned short* tab  , int tok0, int h, int lane) {
    const int r32 = lane & 31, hi = lane >> 5;
    s16x8 qf[16];
    const bf16* qp = PQ + (size_t)(tok0 + r32) * 2048 + 256 * h + 8 * hi;
#pragma unroll
    for (int ks = 0; ks < 16; ++ks) qf[ks] = *(const s16x8*)(qp + 16 * ks);
    const int p = (r32 >> 2) & 1, keyl = (r32 & 3) + 4 * (r32 >> 3);
    const unsigned kl0 = (unsigned)((p * 128 + keyl) * TK_ROWB + 16 * hi);
    const s16x8 zero8 = (s16x8){0, 0, 0, 0, 0, 0, 0, 0};
    unsigned top[16];
#pragma unroll
    for (int i = 0; i < 16; ++i) top[i] = 0u;
#pragma unroll 1
    for (int rb = 0; rb < 8; ++rb) {
        f32x16 acc;
#pragma unroll
        for (int r = 0; r < 16; ++r) acc[r] = 0.f;
#pragma unroll
        for (int ks = 0; ks < 8; ++ks) {
            const s16x8 kf = *(const LAS s16x8*)(skl + kl0 + (unsigned)(rb * 16 * TK_ROWB + 32 * ks));
            const s16x8 a0 = p == 0 ? kf : zero8, a1 = p == 1 ? kf : zero8;
            acc = __builtin_amdgcn_mfma_f32_32x32x16_bf16(a0, qf[ks], acc, 0, 0, 0);
            acc = __builtin_amdgcn_mfma_f32_32x32x16_bf16(a1, qf[ks + 8], acc, 0, 0, 0);
        }
        unsigned nw[16];
#pragma unroll
        for (int r = 0; r < 16; ++r) nw[r] = (f2key(acc[r]) & ~127u) | (unsigned)(127 - (16 * rb + r));
        bitonic_sort_desc<16>(nw);
        top16_merge(top, nw);
    }
    unsigned LA[16], LB[16];
#pragma unroll
    for (int i = 0; i < 16; ++i) { const unsigned other = (unsigned)__shfl_xor((int)top[i], 32); LA[i] = hi ? other : top[i]; LB[i] = hi ? top[i] : other; }
#pragma unroll
    for (int i = 0; i < 16; ++i) { tab[i * 64 + lane] = (unsigned short)(127u - (LA[i] & 127u)); tab[(16 + i) * 64 + lane] = (unsigned short)(127u - (LB[i] & 127u)); }
    float av[16], bv[16];
#pragma unroll
    for (int i = 0; i < 16; ++i) { av[i] = key2f(LA[i] & ~127u); bv[i] = key2f(LB[i] & ~127u); }
    unsigned cg[4][16];
#pragma unroll
    for (int g = 0; g < 4; ++g)
#pragma unroll
        for (int e = 0; e < 16; ++e) cg[g][e] = 0u;
    {
        int cnt = 0;
#pragma unroll
        for (int i = 0; i < 16; ++i)
#pragma unroll
            for (int j = 0; j < 16; ++j)
                if ((i + 1) * (j + 1) <= 16) { cg[cnt >> 4][cnt & 15] = (f2key(av[i] + bv[j]) & ~255u) | (unsigned)(255 - (16 * i + j)); ++cnt; }
    }
    bitonic_sort_desc<16>(cg[0]); bitonic_sort_desc<16>(cg[1]); bitonic_sort_desc<16>(cg[2]); bitonic_sort_desc<16>(cg[3]);
    top16_merge(cg[0], cg[1]); top16_merge(cg[0], cg[2]); top16_merge(cg[0], cg[3]);
    LDS_WAIT(); asm volatile("" ::: "memory");
    float sv[16]; int ex[16];
#pragma unroll
    for (int k = 0; k < 16; ++k) { const unsigned key = cg[0][k]; const int pos = 255 - (int)(key & 255u); sv[k] = key2f(key & ~255u);
        const int ia = tab[(pos >> 4) * 64 + lane], ib = tab[(16 + (pos & 15)) * 64 + lane]; ex[k] = ia * 128 + ib; }
    LDS_WAIT(); asm volatile("" ::: "memory");
    const float mx = sv[0]; float sum = 0.f;
#pragma unroll
    for (int k = 0; k < 16; ++k) { sv[k] = expf(sv[k] - mx); sum += sv[k]; }
    const float inv = 1.f / sum;
    if (hi == 0) {
        const int tq = tok0 + r32; unsigned short* ip = IDS + ((size_t)(tq >> 6) * 16 + 2 * h) * 512 + (tq & 63) * 8; float* gp = GATES + (size_t)tq * 128 + h * 16;
#pragma unroll
        for (int k = 0; k < 16; k += 8) *(u32x4*)(ip + (k >> 3) * 512) = (u32x4){(unsigned)ex[k] | ((unsigned)ex[k + 1] << 16), (unsigned)ex[k + 2] | ((unsigned)ex[k + 3] << 16), (unsigned)ex[k + 4] | ((unsigned)ex[k + 5] << 16), (unsigned)ex[k + 6] | ((unsigned)ex[k + 7] << 16)};
#pragma unroll
        for (int k = 0; k < 16; k += 4) *(f32x4*)(gp + k) = (f32x4){sv[k] * inv, sv[k + 1] * inv, sv[k + 2] * inv, sv[k + 3] * inv};
    }
}
DI void ph_topk(const bf16* PQ, const bf16* SK, unsigned short* IDS, float* GATES, LAS unsigned char* lds, int bx, int G, int wave, int lane) {
    LAS unsigned short* tab = (LAS unsigned short*)(lds + wave * 4096);
    const int h = bx & 7, rank = bx >> 3, nb = (G - h + 7) >> 3, tid = wave * 64 + lane;
    LAS unsigned char* skl = lds + TK_TAB_OFF;
#pragma unroll
    for (int i = 0; i < 8; ++i) { const int c = tid + 512 * i, row = c >> 4, col = c & 15;
        *(LAS u32x4*)(skl + row * TK_ROWB + col * 16) = *(const u32x4*)(SK + ((size_t)h * 256 + row) * 128 + col * 8); }
    __syncthreads();
    for (int g = rank * 8 + wave; g < MTOK / 32; g += nb * 8) topk_task(PQ, skl, IDS, GATES, tab, g * 32, h, lane);
    __syncthreads();
}

DI float gelu_erf(float x) { return 0.5f * x * (1.f + erff(x * 0.70710678118654752f)); }
DI float dot16_fp8(const u32x4& w, const float (&h)[16]) {
    float d0 = 0.f, d1 = 0.f;
#pragma unroll
    for (int e = 0; e < 4; ++e) { const f32x2v lo = __builtin_amdgcn_cvt_pk_f32_fp8((int)w[e], false), hi = __builtin_amdgcn_cvt_pk_f32_fp8((int)w[e], true);
        d0 += lo.x * h[4 * e] + lo.y * h[4 * e + 1]; d1 += hi.x * h[4 * e + 2] + hi.y * h[4 * e + 3]; }
    return d0 + d1;
}
DI float gelu_fast(float v) {
    const float av = fabsf(v), d = av * 0.2316418882f + 1.0f, t = __builtin_amdgcn_rcpf(d);
    float q = t * 0.5307027145f + (-0.7265760135f); q = q * t + 0.7107068705f; q = q * t + (-0.142248368f); q = q * t + 0.127414796f; q = q * t;
    const float e = __builtin_amdgcn_exp2f((v * v) * (-0.72134752044f)), mm = v * (q * e);
    return v < 0.f ? mm : v - mm;
}
DI long lo64(const u32x4& w) { return (long)(((unsigned long long)w.y << 32) | w.x); }
DI long hi64(const u32x4& w) { return (long)(((unsigned long long)w.w << 32) | w.z); }
typedef __amdgpu_buffer_rsrc_t brsrc_t;
DI brsrc_t mkrsrc(const void* p, unsigned bytes) { return __builtin_amdgcn_make_buffer_rsrc((void*)p, 0, (int)bytes, 0x00020000); }
DI u32x4 bl128(brsrc_t r, unsigned voff, unsigned soff) { return __builtin_amdgcn_raw_buffer_load_b128(r, (int)voff, (int)soff, 0); }
DI u32x2 bl64(brsrc_t r, unsigned voff, unsigned soff) { return __builtin_amdgcn_raw_buffer_load_b64(r, (int)voff, (int)soff, 0); }
DI void bs64(brsrc_t r, u32x2 v, unsigned voff, unsigned soff) { __builtin_amdgcn_raw_buffer_store_b64(v, r, (int)voff, (int)soff, 0); }
DI f32x4 asf4(u32x4 v) { return __builtin_bit_cast(f32x4, v); }
template <int VAR> DI void u_issue8(u32x4 (&r)[8], const u32x4& ev, const unsigned char* Ux, unsigned coff) {
#pragma unroll
    for (int i = 0; i < 8; ++i) { const unsigned ew = ev[i >> 1], e = (i & 1) ? (ew >> 16) : (ew & 0xffffu);
        if (VAR == 1) r[i] = (u32x4){e, coff, 0x38383838u, 0x40404040u}; else r[i] = *(const u32x4*)(Ux + (e * 128u + coff)); }
}
typedef __bf16 bf16x2v __attribute__((ext_vector_type(2)));
DI void u_dot8(const u32x4 (&r)[8], const u32x4& hq, float* p) {
#pragma unroll
    for (int i = 0; i < 8; ++i) {
        u32x4 row = r[i]; asm volatile("" : "+v"(row));
        int d = __builtin_amdgcn_sdot4((int)row.x, (int)hq.x, 0, false);
        d = __builtin_amdgcn_sdot4((int)row.y, (int)hq.y, d, false); d = __builtin_amdgcn_sdot4((int)row.z, (int)hq.z, d, false); d = __builtin_amdgcn_sdot4((int)row.w, (int)hq.w, d, false);
        float pi = (float)d; asm volatile("" : "+v"(pi)); p[i] = pi;
    }
}
DI void u_reduce_store(const float* p, brsrc_t part_r, unsigned poff, int tok, bool do_store, bool b2, bool b1, bool b0) {
    float v8[8], v4[4], v2[2];
#pragma unroll
    for (int i = 0; i < 8; ++i) { const float keep = b2 ? p[i + 8] : p[i], give = b2 ? p[i] : p[i + 8]; v8[i] = keep + __shfl_xor(give, 4); }
#pragma unroll
    for (int i = 0; i < 4; ++i) { const float keep = b1 ? v8[i + 4] : v8[i], give = b1 ? v8[i] : v8[i + 4]; v4[i] = keep + __shfl_xor(give, 2); }
#pragma unroll
    for (int i = 0; i < 2; ++i) { const float keep = b0 ? v4[i + 2] : v4[i], give = b0 ? v4[i] : v4[i + 2]; v2[i] = keep + __shfl_xor(give, 1); }
    if (do_store) bs64(part_r, (u32x2){__float_as_uint(v2[0]), __float_as_uint(v2[1])}, poff, tok * 512);
}
template <int VAR> DI void ph_peer_u(const unsigned char* U8s, const unsigned short* IDS, const unsigned char* XN8, float* PART, int bx, int G, int wave, int lane) {
    const int x = bx & 7, rank = bx >> 3, nslots = ((G - x + 7) >> 3) * 8;
    const int grp = lane >> 3, c = lane & 7;
    const bool b2 = (lane & 4) != 0, b1 = (lane & 2) != 0, b0 = (lane & 1) != 0;
    const unsigned char* Ux = U8s + (size_t)x * NEXP * 128;
    const unsigned coff = 16u * (unsigned)c;
    const unsigned hoff = (unsigned)(128 * x + 16 * c), ioff = 2048u * (unsigned)grp;
    const brsrc_t ids_r = mkrsrc(IDS, MTOK * 128 * 2), xn_r = mkrsrc(XN8, MTOK * DM), part_r = mkrsrc(PART + (size_t)x * MTOK * 128, MTOK * 128 * 4);
    const unsigned poff = (unsigned)(16 * grp + 8 * (int)b2 + 4 * (int)b1 + 2 * (int)b0) * 4u;
    const int t0 = rank * 8 + wave;
#define UTOK(k) ((t0 + (k) * nslots) < MTOK ? (t0 + (k) * nslots) : (MTOK - 1))
#define UVALID(k) ((t0 + (k) * nslots) < MTOK)
#define U_LOAD_IDS(E, tok) do { const unsigned so_ = (unsigned)((tok) >> 6) * 16384u + (unsigned)((tok) & 63) * 16u; E[0] = bl128(ids_r, ioff, so_); E[1] = bl128(ids_r, ioff + 1024, so_); } while (0)
#define U_LOAD_H(Hq, tok) do { Hq = bl128(xn_r, hoff, (tok) * 1024); } while (0)
#define SB() __builtin_amdgcn_sched_barrier(0)
    u32x4 RA[8], RB[8], E0[2], E1[2], H0, H1; float p[16];
    U_LOAD_IDS(E0, UTOK(0)); U_LOAD_H(H0, UTOK(0)); U_LOAD_IDS(E1, UTOK(1)); U_LOAD_H(H1, UTOK(1));
    u_issue8<VAR>(RA, E0[0], Ux, coff);
#pragma unroll 1
    for (int k = 0; UVALID(k); k += 2) {
        u_issue8<VAR>(RB, E0[1], Ux, coff); SB();
        u_dot8(RA, H0, p); SB();
        u_issue8<VAR>(RA, E1[0], Ux, coff); U_LOAD_IDS(E0, UTOK(k + 2)); SB();
        u_dot8(RB, H0, p + 8); u_reduce_store(p, part_r, poff, UTOK(k), true, b2, b1, b0); U_LOAD_H(H0, UTOK(k + 2)); SB();
        u_issue8<VAR>(RB, E1[1], Ux, coff); SB();
        u_dot8(RA, H1, p); SB();
        u_issue8<VAR>(RA, E0[0], Ux, coff); U_LOAD_IDS(E1, UTOK(k + 3)); SB();
        u_dot8(RB, H1, p + 8); u_reduce_store(p, part_r, poff, UTOK(k + 1), UVALID(k + 1), b2, b1, b0); U_LOAD_H(H1, UTOK(k + 3)); SB();
    }
#undef UTOK
#undef UVALID
#undef U_LOAD_IDS
#undef U_LOAD_H
}
DI void ph_peer_c(const float* PART, const float* GATES, const float* HS, unsigned char* ACTI, float* AS, int gw, int NGW, int lane) {
    for (int t = gw; t < MTOK; t += NGW) {
        const float inv = HS[t] * (1.f / UI8_SCALE);
        f32x2v s = (f32x2v){0.f, 0.f};
#pragma unroll
        for (int xx = 0; xx < 8; ++xx) { const f32x2v p = *(const f32x2v*)(PART + ((size_t)xx * MTOK + t) * 128 + 2 * lane); s.x += p.x; s.y += p.y; }
        const f32x2v g = *(const f32x2v*)(GATES + (size_t)t * 128 + 2 * lane);
        const float a0 = gelu_fast(s.x * inv) * g.x, a1 = gelu_fast(s.y * inv) * g.y;
        float mx = fmaxf(fabsf(a0), fabsf(a1));
#pragma unroll
        for (int o = 32; o > 0; o >>= 1) mx = fmaxf(mx, __shfl_xor(mx, o));
        const float scl = mx > 0.f ? mx * (1.f / 127.f) : 1.f, isc = 1.f / scl;
        const int q0 = (int)rintf(a0 * isc), q1 = (int)rintf(a1 * isc);
        *(unsigned short*)(ACTI + (size_t)(t >> 6) * 8192 + (lane >> 2) * 512 + (t & 63) * 8 + (lane & 3) * 2) = (unsigned short)((q0 & 0xff) | ((q1 & 0xff) << 8));
        if (lane == 0) AS[t] = scl;
    }
}
template <int VAR> DI void ph_peer_v(const unsigned char* V8L  , const unsigned short* IDT, const unsigned char* ACTI, const float* AS, const float* Xin, float* Xout, const float* g2,
                                     LAS unsigned char* lds, int bx, int wave, int lane) {
    const int x = bx & 7, rank = bx >> 3, sl = 16 * x + (rank & 15), th = rank >> 4, tid = wave * 64 + lane;
    { const u32x4* src = (const u32x4*)(V8L + (size_t)sl * NEXP * 8);
#pragma unroll 4
      for (int i = 0; i < 16; ++i) { const int c = tid + 512 * i; *(LAS u32x4*)(lds + 16 * c) = src[c]; } }
    __syncthreads();
#pragma unroll 1
    for (int gi = wave; gi < 128; gi += 8) {
        const int g = th * 128 + gi, t = g * 64 + lane;
        const char* ip = (const char*)IDT + (size_t)g * 16384 + lane * 16; const char* ap = (const char*)ACTI + (size_t)g * 8192 + lane * 8;
        int acc[8];
#pragma unroll
        for (int d = 0; d < 8; ++d) acc[d] = 0;
        const f32x4 x0 = *(const f32x4*)(Xin + (size_t)t * DM + 8 * sl), x1 = *(const f32x4*)(Xin + (size_t)t * DM + 8 * sl + 4);
        const float asc = AS[t];
#pragma unroll 2
        for (int pc = 0; pc < 16; ++pc) {
            const u32x4 idw = *(const u32x4*)(ip + pc * 1024); const u32x2 acw = *(const u32x2*)(ap + pc * 512);
#pragma unroll
            for (int q4 = 0; q4 < 2; ++q4) {
                const unsigned e0 = idw[2 * q4] & 0xffffu, e1 = idw[2 * q4] >> 16, e2 = idw[2 * q4 + 1] & 0xffffu, e3 = idw[2 * q4 + 1] >> 16;
                u32x2 r0, r1, r2, r3;
                if (VAR == 1) { r0 = (u32x2){0x01020304u + e0, 0x05060708u}; r1 = (u32x2){0x01020304u + e1, 0x05060708u}; r2 = (u32x2){0x01020304u + e2, 0x05060708u}; r3 = (u32x2){0x01020304u + e3, 0x05060708u}; }
                else { r0 = *(const LAS u32x2*)(lds + e0 * 8u); r1 = *(const LAS u32x2*)(lds + e1 * 8u); r2 = *(const LAS u32x2*)(lds + e2 * 8u); r3 = *(const LAS u32x2*)(lds + e3 * 8u); }
                const int aw = (int)acw[q4];
                const unsigned ta = __builtin_amdgcn_perm(r1.x, r0.x, 0x05010400u), tb = __builtin_amdgcn_perm(r1.x, r0.x, 0x07030602u), tc = __builtin_amdgcn_perm(r3.x, r2.x, 0x05010400u), td = __builtin_amdgcn_perm(r3.x, r2.x, 0x07030602u);
                const unsigned ua = __builtin_amdgcn_perm(r1.y, r0.y, 0x05010400u), ub = __builtin_amdgcn_perm(r1.y, r0.y, 0x07030602u), uc = __builtin_amdgcn_perm(r3.y, r2.y, 0x05010400u), ud = __builtin_amdgcn_perm(r3.y, r2.y, 0x07030602u);
                acc[0] = __builtin_amdgcn_sdot4((int)__builtin_amdgcn_perm(tc, ta, 0x05040100u), aw, acc[0], false);
                acc[1] = __builtin_amdgcn_sdot4((int)__builtin_amdgcn_perm(tc, ta, 0x07060302u), aw, acc[1], false);
                acc[2] = __builtin_amdgcn_sdot4((int)__builtin_amdgcn_perm(td, tb, 0x05040100u), aw, acc[2], false);
                acc[3] = __builtin_amdgcn_sdot4((int)__builtin_amdgcn_perm(td, tb, 0x07060302u), aw, acc[3], false);
                acc[4] = __builtin_amdgcn_sdot4((int)__builtin_amdgcn_perm(uc, ua, 0x05040100u), aw, acc[4], false);
                acc[5] = __builtin_amdgcn_sdot4((int)__builtin_amdgcn_perm(uc, ua, 0x07060302u), aw, acc[5], false);
                acc[6] = __builtin_amdgcn_sdot4((int)__builtin_amdgcn_perm(ud, ub, 0x05040100u), aw, acc[6], false);
                acc[7] = __builtin_amdgcn_sdot4((int)__builtin_amdgcn_perm(ud, ub, 0x07060302u), aw, acc[7], false);
            }
        }
        const float* gp = g2 + (size_t)(t >> 12) * 6144 + 8 * sl;
        const f32x4 g0 = *(const f32x4*)gp, g1 = *(const f32x4*)(gp + 4);
        const float inv = asc * (1.f / VI8_SCALE);
        f32x4 o0, o1;
        o0.x = x0.x + g0.x * ((float)acc[0] * inv); o0.y = x0.y + g0.y * ((float)acc[1] * inv); o0.z = x0.z + g0.z * ((float)acc[2] * inv); o0.w = x0.w + g0.w * ((float)acc[3] * inv);
        o1.x = x1.x + g1.x * ((float)acc[4] * inv); o1.y = x1.y + g1.y * ((float)acc[5] * inv); o1.z = x1.z + g1.z * ((float)acc[6] * inv); o1.w = x1.w + g1.w * ((float)acc[7] * inv);
        *(f32x4*)(Xout + (size_t)t * DM + 8 * sl) = o0; *(f32x4*)(Xout + (size_t)t * DM + 8 * sl + 4) = o1;
    }
    __syncthreads();
}

DI void ph_latnorm(const bf16* LAT, const float* qg, const float* kvg, bf16* QN, bf16* KVN, int gw, int NGW, int lane) {
    for (int t = gw; t < MTOK; t += NGW) {
        const unsigned* lr = (const unsigned*)(LAT + (size_t)t * MLA_IN_PAD);
        unsigned q[3], k[2]; float sq = 0.f, sk = 0.f;
#pragma unroll
        for (int j = 0; j < 3; ++j) { q[j] = lr[lane + 64 * j]; sq += bflo(q[j]) * bflo(q[j]) + bfhi(q[j]) * bfhi(q[j]); }
#pragma unroll
        for (int j = 0; j < 2; ++j) { k[j] = lr[192 + lane + 64 * j]; sk += bflo(k[j]) * bflo(k[j]) + bfhi(k[j]) * bfhi(k[j]); }
        const float rq = rsqrtf(wave_sum(sq) * (1.f / QLORA) + NORM_EPS), rk = rsqrtf(wave_sum(sk) * (1.f / KVLORA) + NORM_EPS);
        unsigned* qo = (unsigned*)(QN + (size_t)t * QLORA); unsigned* ko = (unsigned*)(KVN + (size_t)t * KVLORA);
#pragma unroll
        for (int j = 0; j < 3; ++j) { const int c = 2 * (lane + 64 * j); qo[lane + 64 * j] = pk2(bflo(q[j]) * rq * qg[c], bfhi(q[j]) * rq * qg[c + 1]); }
#pragma unroll
        for (int j = 0; j < 2; ++j) { const int c = 2 * (lane + 64 * j); ko[lane + 64 * j] = pk2(bflo(k[j]) * rk * kvg[c], bfhi(k[j]) * rk * kvg[c + 1]); }
    }
}

DI void ph_qkprep(const bf16* QRAW, const bf16* KVRAW, const bf16* LAT, const int* positions, const float* qg, const float* kg,
                  bf16* Qf, bf16* Kf, bf16* Vt, int gw, int NGW, int lane) {
    const int hh = lane >> 3, p = lane & 7;
    float qgn[16], qgr[8], kgn[16], kgr[8], invf[8];
#pragma unroll
    for (int i = 0; i < 16; ++i) { qgn[i] = qg[16 * p + i] * QSCALE; kgn[i] = kg[16 * p + i]; }
#pragma unroll
    for (int i = 0; i < 8; ++i) { qgr[i] = qg[128 + 8 * p + i] * QSCALE; kgr[i] = kg[128 + 8 * p + i]; invf[i] = exp2f(-(float)((8 * p + i) & 31) * (13.287712379549449f / 32.f)); }
    for (int task = gw; task < MTOK / 8; task += NGW) {
        const int t0 = task * 8, b = t0 >> 12, s0 = t0 & (SEQ - 1);
#pragma unroll 1
        for (int tt = 0; tt < 8; ++tt) {
            const int t = t0 + tt, s = s0 + tt;
            const float posf = (float)positions[t];
            float cs[8], sn[8];
#pragma unroll
            for (int i = 0; i < 8; ++i) { const float ang = posf * invf[i]; double rev = (double)ang * 0.15915494309189535; rev -= floor(rev); const float rv = (float)rev; sn[i] = __builtin_amdgcn_sinf(rv); cs[i] = __builtin_amdgcn_cosf(rv); }
            const u32x4 kr4 = *(const u32x4*)(LAT + (size_t)t * MLA_IN_PAD + 640 + 8 * p);
#pragma unroll
            for (int which = 0; which < 2; ++which) {
                const bf16* src = which == 0 ? QRAW + (size_t)t * 1536 + QKH * hh : KVRAW + (size_t)t * 2048 + 256 * hh;
                const u32x4 n0 = *(const u32x4*)(src + 16 * p), n1 = *(const u32x4*)(src + 16 * p + 8);
                const u32x4 r0 = which == 0 ? *(const u32x4*)(src + 128 + 8 * p) : kr4;
                float xn[16], xr[8];
#pragma unroll
                for (int e = 0; e < 4; ++e) { xn[2 * e] = bflo(n0[e]); xn[2 * e + 1] = bfhi(n0[e]); xn[8 + 2 * e] = bflo(n1[e]); xn[8 + 2 * e + 1] = bfhi(n1[e]); xr[2 * e] = bflo(r0[e]); xr[2 * e + 1] = bfhi(r0[e]); }
                float ss = 0.f;
#pragma unroll
                for (int i = 0; i < 16; ++i) ss = fmaf(xn[i], xn[i], ss);
#pragma unroll
                for (int i = 0; i < 8; ++i) ss = fmaf(xr[i], xr[i], ss);
                ss += __shfl_xor(ss, 1); ss += __shfl_xor(ss, 2); ss += __shfl_xor(ss, 4);
                const float rstd = rsqrtf(ss * (1.f / QKH) + NORM_EPS);
                float yr[8], ro[8];
#pragma unroll
                for (int i = 0; i < 16; ++i) xn[i] = xn[i] * rstd * (which == 0 ? qgn[i] : kgn[i]);
#pragma unroll
                for (int i = 0; i < 8; ++i) yr[i] = xr[i] * rstd * (which == 0 ? qgr[i] : kgr[i]);
#pragma unroll
                for (int i = 0; i < 8; ++i) { const float pr = __shfl_xor(yr[i], 4); ro[i] = p < 4 ? yr[i] * cs[i] - pr * sn[i] : pr * sn[i] + yr[i] * cs[i]; }
                bf16* dst = (which == 0 ? Qf : Kf) + ((size_t)(b * NH + hh) * SEQ + s) * QKH;
                u32x4 o0, o1, o2;
                o0.x = cvtpk(xn[0], xn[1]); o0.y = cvtpk(xn[2], xn[3]); o0.z = cvtpk(xn[4], xn[5]); o0.w = cvtpk(xn[6], xn[7]);
                o1.x = cvtpk(xn[8], xn[9]); o1.y = cvtpk(xn[10], xn[11]); o1.z = cvtpk(xn[12], xn[13]); o1.w = cvtpk(xn[14], xn[15]);
                o2.x = cvtpk(ro[0], ro[1]); o2.y = cvtpk(ro[2], ro[3]); o2.z = cvtpk(ro[4], ro[5]); o2.w = cvtpk(ro[6], ro[7]);
                *(u32x4*)(dst + 16 * p) = o0; *(u32x4*)(dst + 16 * p + 8) = o1; *(u32x4*)(dst + 128 + 8 * p) = o2;
            }
        }
#pragma unroll 1
        for (int h = 0; h < NH; ++h)
#pragma unroll
            for (int dd = 0; dd < 128; dd += 64) {
                const bf16* vp = KVRAW + (size_t)t0 * 2048 + 256 * h + 128 + dd + lane;
                unsigned w[4];
#pragma unroll
                for (int i = 0; i < 4; ++i) w[i] = (unsigned)vp[(size_t)(2 * i) * 2048] | ((unsigned)vp[(size_t)(2 * i + 1) * 2048] << 16);
                *(u32x4*)(Vt + ((size_t)(b * NH + h) * VH + dd + lane) * SEQ + s0) = (u32x4){w[0], w[1], w[2], w[3]};
            }
    }
}

DI void attn_unit(const bf16* Qf, const bf16* Kf, const bf16* Vt, bf16* O, int bh, int qb, int wave, int lane) {
    const int r32 = lane & 31, hi = lane >> 5;
    const int q0 = qb * 256 + wave * 32;
    s16x8 qf[12];
    { const bf16* Qp = Qf + ((size_t)bh * SEQ + q0 + r32) * QKH + 8 * hi;
#pragma unroll
      for (int ks = 0; ks < 12; ++ks) qf[ks] = *(const s16x8*)(Qp + 16 * ks); }
    f32x16 o[4];
#pragma unroll
    for (int d = 0; d < 4; ++d)
#pragma unroll
        for (int r = 0; r < 16; ++r) o[d][r] = 0.f;
    float m = -1e30f, l = 0.f;
    const bf16* Kp = Kf + ((size_t)bh * SEQ + r32) * QKH + 8 * hi;
    const bf16* Vp = Vt + ((size_t)bh * VH + r32) * SEQ + 4 * hi;
    const int nkt = q0 / 32 + 1;
#pragma unroll 1
    for (int kt = 0; kt < nkt; ++kt) {
        f32x16 sc;
#pragma unroll
        for (int r = 0; r < 16; ++r) sc[r] = 0.f;
        const bf16* kp = Kp + (size_t)kt * 32 * QKH;
#pragma unroll
        for (int ks = 0; ks < 12; ++ks) sc = __builtin_amdgcn_mfma_f32_32x32x16_bf16(*(const s16x8*)(kp + 16 * ks), qf[ks], sc, 0, 0, 0);
        if (kt == nkt - 1) {
#pragma unroll
            for (int r = 0; r < 16; ++r) if (crow(r, hi) > r32) sc[r] = -INFINITY;
        }
        float mt = sc[0];
#pragma unroll
        for (int r = 1; r < 16; ++r) mt = fmaxf(mt, sc[r]);
        mt = fmaxf(mt, __shfl_xor(mt, 32));
        const float mn = fmaxf(m, mt), alpha = __builtin_amdgcn_exp2f(m - mn);
        m = mn; l *= alpha;
#pragma unroll
        for (int d = 0; d < 4; ++d)
#pragma unroll
            for (int r = 0; r < 16; ++r) o[d][r] *= alpha;
        float ps = 0.f;
#pragma unroll
        for (int r = 0; r < 16; ++r) { sc[r] = __builtin_amdgcn_exp2f(sc[r] - mn); ps += sc[r]; }
        l += ps;
#pragma unroll
        for (int s = 0; s < 2; ++s) {
            u32x4 pw; pw.x = cvtpk(sc[8 * s], sc[8 * s + 1]); pw.y = cvtpk(sc[8 * s + 2], sc[8 * s + 3]); pw.z = cvtpk(sc[8 * s + 4], sc[8 * s + 5]); pw.w = cvtpk(sc[8 * s + 6], sc[8 * s + 7]);
            const s16x8 pb = __builtin_bit_cast(s16x8, pw);
#pragma unroll
            for (int d = 0; d < 4; ++d) {
                const bf16* vp = Vp + (size_t)d * 32 * SEQ + kt * 32 + 16 * s;
                const s16x4 lo = *(const s16x4*)vp, hh = *(const s16x4*)(vp + 8);
                const s16x8 va = __builtin_shufflevector(lo, hh, 0, 1, 2, 3, 4, 5, 6, 7);
                o[d] = __builtin_amdgcn_mfma_f32_32x32x16_bf16(va, pb, o[d], 0, 0, 0);
            }
        }
    }
    l += __shfl_xor(l, 32);
    const float inv = 1.f / l;
    bf16* Op = O + ((size_t)((bh >> 3) * SEQ + q0 + r32)) * DM + (bh & 7) * VH + 4 * hi;
#pragma unroll
    for (int d = 0; d < 4; ++d)
#pragma unroll
        for (int g = 0; g < 4; ++g) { u32x2 w; w.x = cvtpk(o[d][4 * g] * inv, o[d][4 * g + 1] * inv); w.y = cvtpk(o[d][4 * g + 2] * inv, o[d][4 * g + 3] * inv);
            *(u32x2*)(Op + 32 * d + 8 * g) = w; }
}
constexpr int AT_KROW = 400, AT_VROW = 136, AT_KBYTES = 64 * AT_KROW, AT_VBYTES = 128 * AT_VROW, AT_STAGE = AT_KBYTES + AT_VBYTES;
DI void attn_unit_lds(const bf16* Qf, const bf16* Kf, const bf16* Vt, bf16* O, LAS unsigned char* lds, int bh, int qb, int wave, int lane) {
    const int r32 = lane & 31, hi = lane >> 5, tid = wave * 64 + lane;
    const int q0 = qb * 256 + wave * 32;
    s16x8 qf[12];
    { const bf16* Qp = Qf + ((size_t)bh * SEQ + q0 + r32) * QKH + 8 * hi;
#pragma unroll
      for (int ks = 0; ks < 12; ++ks) qf[ks] = *(const s16x8*)(Qp + 16 * ks); }
    f32x16 o[4];
#pragma unroll
    for (int d = 0; d < 4; ++d)
#pragma unroll
        for (int r = 0; r < 16; ++r) o[d][r] = 0.f;
    float m = -1e30f, l = 0.f;
    const int NT = 4 * (qb + 1);
    const __amdgpu_buffer_rsrc_t krs = __builtin_amdgcn_make_buffer_rsrc((void*)(Kf + (size_t)bh * SEQ * QKH), 0, SEQ * QKH * 2, 0x00020000);
    const __amdgpu_buffer_rsrc_t vrs = __builtin_amdgcn_make_buffer_rsrc((void*)(Vt + (size_t)bh * VH * SEQ), 0, VH * SEQ * 2, 0x00020000);
    unsigned kgo[3], kl[3], vgo[2], vl[2];
#pragma unroll
    for (int i = 0; i < 3; ++i) { const int c = tid + 512 * i, row = c / 24, col = c - row * 24; kgo[i] = (unsigned)(row * 384 + col * 16); kl[i] = (unsigned)(row * AT_KROW + col * 16); }
#pragma unroll
    for (int i = 0; i < 2; ++i) { const int c = tid + 512 * i, d = c >> 3, part = c & 7; vgo[i] = (unsigned)(d * (SEQ * 2) + part * 16); vl[i] = (unsigned)(AT_KBYTES + d * AT_VROW + part * 16); }
    u32x4 kr[3], vr[2];
#pragma unroll
    for (int i = 0; i < 3; ++i) kr[i] = __builtin_amdgcn_raw_buffer_load_b128(krs, kgo[i], 0, 0);
#pragma unroll
    for (int i = 0; i < 2; ++i) vr[i] = __builtin_amdgcn_raw_buffer_load_b128(vrs, vgo[i], 0, 0);
#pragma unroll
    for (int i = 0; i < 3; ++i) *(LAS u32x4*)(lds + kl[i]) = kr[i];
#pragma unroll
    for (int i = 0; i < 2; ++i) { *(LAS u32x2*)(lds + vl[i]) = (u32x2){vr[i].x, vr[i].y}; *(LAS u32x2*)(lds + vl[i] + 8) = (u32x2){vr[i].z, vr[i].w}; }
    __syncthreads();
    const unsigned kfo = (unsigned)(r32 * AT_KROW + 16 * hi), vfo = (unsigned)(AT_KBYTES + r32 * AT_VROW + 8 * hi);
#pragma unroll 1
    for (int t = 0; t < NT; ++t) {
        const unsigned sb = (unsigned)((t & 1) * AT_STAGE), sn = (unsigned)(((t + 1) & 1) * AT_STAGE);
        const bool more = t + 1 < NT;
        if (more) {
#pragma unroll
            for (int i = 0; i < 3; ++i) kr[i] = __builtin_amdgcn_raw_buffer_load_b128(krs, kgo[i], (t + 1) * (64 * 384), 0);
#pragma unroll
            for (int i = 0; i < 2; ++i) vr[i] = __builtin_amdgcn_raw_buffer_load_b128(vrs, vgo[i], (t + 1) * 128, 0);
        }
        const int k0 = 64 * t;
        if (k0 <= q0 + 31) {
            f32x16 s0, s1;
#pragma unroll
            for (int r = 0; r < 16; ++r) { s0[r] = 0.f; s1[r] = 0.f; }
#pragma unroll
            for (int ks = 0; ks < 12; ++ks) {
                const s16x8 ka = *(const LAS s16x8*)(lds + sb + kfo + 32 * ks), kb = *(const LAS s16x8*)(lds + sb + kfo + 32 * AT_KROW + 32 * ks);
                s0 = __builtin_amdgcn_mfma_f32_32x32x16_bf16(ka, qf[ks], s0, 0, 0, 0);
                s1 = __builtin_amdgcn_mfma_f32_32x32x16_bf16(kb, qf[ks], s1, 0, 0, 0);
                if ((ks & 3) == 3) __builtin_amdgcn_sched_barrier(0);
            }
            if (k0 + 63 > q0) {
                const int qa = q0 + r32 - k0 - 4 * hi;
#pragma unroll
                for (int r = 0; r < 16; ++r) { if (((r & 3) + 8 * (r >> 2)) > qa) s0[r] = -INFINITY; if ((32 + (r & 3) + 8 * (r >> 2)) > qa) s1[r] = -INFINITY; }
            }
            float mt = fmaxf(s0[0], s1[0]);
#pragma unroll
            for (int r = 1; r < 16; ++r) mt = fmaxf(mt, fmaxf(s0[r], s1[r]));
            mt = fmaxf(mt, __shfl_xor(mt, 32));
            const float mn = fmaxf(m, mt), alpha = __builtin_amdgcn_exp2f(m - mn);
            m = mn; l *= alpha;
#pragma unroll
            for (int d = 0; d < 4; ++d)
#pragma unroll
                for (int r = 0; r < 16; ++r) o[d][r] *= alpha;
            float ps = 0.f;
#pragma unroll
            for (int r = 0; r < 16; ++r) { s0[r] = __builtin_amdgcn_exp2f(s0[r] - mn); s1[r] = __builtin_amdgcn_exp2f(s1[r] - mn); ps += s0[r] + s1[r]; }
            l += ps;
#pragma unroll
            for (int s = 0; s < 4; ++s) {
                u32x4 pw;
                if (s < 2) { pw.x = cvtpk(s0[8 * s], s0[8 * s + 1]); pw.y = cvtpk(s0[8 * s + 2], s0[8 * s + 3]); pw.z = cvtpk(s0[8 * s + 4], s0[8 * s + 5]); pw.w = cvtpk(s0[8 * s + 6], s0[8 * s + 7]); }
                else { const int z = s - 2; pw.x = cvtpk(s1[8 * z], s1[8 * z + 1]); pw.y = cvtpk(s1[8 * z + 2], s1[8 * z + 3]); pw.z = cvtpk(s1[8 * z + 4], s1[8 * z + 5]); pw.w = cvtpk(s1[8 * z + 6], s1[8 * z + 7]); }
                const s16x8 pb = __builtin_bit_cast(s16x8, pw);
#pragma unroll
                for (int d = 0; d < 4; ++d) {
                    const unsigned va = sb + vfo + (unsigned)(d * 32 * AT_VROW + 32 * s);
                    const s16x4 lo = *(const LAS s16x4*)(lds + va), hh = *(const LAS s16x4*)(lds + va + 16);
                    const s16x8 vfrag = __builtin_shufflevector(lo, hh, 0, 1, 2, 3, 4, 5, 6, 7);
                    o[d] = __builtin_amdgcn_mfma_f32_32x32x16_bf16(vfrag, pb, o[d], 0, 0, 0);
                }
                __builtin_amdgcn_sched_barrier(0);
            }
        }
        if (more) {
#pragma unroll
            for (int i = 0; i < 3; ++i) *(LAS u32x4*)(lds + sn + kl[i]) = kr[i];
#pragma unroll
            for (int i = 0; i < 2; ++i) { *(LAS u32x2*)(lds + sn + vl[i]) = (u32x2){vr[i].x, vr[i].y}; *(LAS u32x2*)(lds + sn + vl[i] + 8) = (u32x2){vr[i].z, vr[i].w}; }
        }
        __syncthreads();
    }
    l += __shfl_xor(l, 32);
    const float inv = 1.f / l;
    bf16* Op = O + ((size_t)((bh >> 3) * SEQ + q0 + r32)) * DM + (bh & 7) * VH + 4 * hi;
#pragma unroll
    for (int d = 0; d < 4; ++d)
#pragma unroll
        for (int g = 0; g < 4; ++g) { u32x2 w; w.x = cvtpk(o[d][4 * g] * inv, o[d][4 * g + 1] * inv); w.y = cvtpk(o[d][4 * g + 2] * inv, o[d][4 * g + 3] * inv);
            *(u32x2*)(Op + 32 * d + 8 * g) = w; }
}
DI void ph_attn(const bf16* Qf, const bf16* Kf, const bf16* Vt, bf16* O, LAS unsigned char* lds, int vcu, int G, int wave, int lane) {
    for (int p = vcu; p < 256; p += G) {
        const int bh = p >> 3, s8 = p & 7;
#pragma unroll 1
        for (int u = 0; u < 2; ++u) attn_unit_lds(Qf, Kf, Vt, O, lds, bh, u ? s8 : 15 - s8, wave, lane);
    }
}

__global__ void __launch_bounds__(NWAVES * 64, 2) mk_fwd(Args args) {
    extern __shared__ __attribute__((aligned(16))) unsigned char lds_raw[];
    LAS unsigned char* lds = (LAS unsigned char*)lds_raw;
    const int tid = threadIdx.x, lane = tid & 63, wave = __builtin_amdgcn_readfirstlane(tid >> 6);
    const int G = gridDim.x, bx = blockIdx.x, vcu = (G % 8 == 0) ? (bx % 8) * (G / 8) + bx / 8 : bx;
    const int gw = vcu * NWAVES + wave, NGW = G * NWAVES;
    const size_t GT = (size_t)G * 512;
    unsigned char* ws = args.ws;
    for (int u = tid; u < (LDS_BYTES - LDSCTL_OFF) / 4; u += NWAVES * 64) ((LAS unsigned*)(lds + LDSCTL_OFF))[u] = 0u;
    __syncthreads();
    const bool multi = (args.ph_hi - args.ph_lo) > 1;
    XcdBarrier bar; bar.bar = (unsigned*)(ws + WS_CTL) + CW_BAR; bar.x = 0; bar.st = (volatile LAS unsigned*)(lds + MISC_OFF) + 8;
    if (multi) bar = xcd_barrier_post((unsigned*)(ws + WS_CTL) + CW_BAR, (volatile LAS unsigned*)(lds + MISC_OFF) + 8);

    float* X = args.out;
    const float* mod = (const float*)(ws + WS_MOD);
    bf16* XN = (bf16*)(ws + WS_XN);

    const int lo = args.ph_lo, hi = args.ph_hi;
#define IN(k) (EN(k) && lo <= (k) && (k) < hi)
    auto opq = [](int v) { asm volatile("" : "+v"(v)); return v; };
#define LN opq(lane)
#define TD opq(tid)
#define GTID ((size_t)vcu * 512 + (size_t)opq(tid))
#define SEAM(k) do { if (lo <= (k) && (k) + 1 < hi) xcd_barrier(bar); } while (0)
#define GEMM_BF16(Aptr, Bptr, NN, KK, Optr, LDC) do { pg8::Gemm g{(const bf16*)(Aptr), (const bf16*)(Bptr), MTOK, (NN), (KK)}; pg8::StaticOrder S; S.init(MTOK, (NN), G, bx); \
        pg8::EpiBf16<0> E{(bf16*)(Optr), (LDC), nullptr, 0, 0, 1.f}; pg8::gemm_phase<pg8::EpiBf16<0>, pg8::StaticOrder, true, true>(lds, g, S, E); } while (0)
#define GEMM_RES(Aptr, Bptr, BASE, OUT, GATE) do { pg8::Gemm g{(const bf16*)(Aptr), (const bf16*)(Bptr), MTOK, DM, DM}; pg8::StaticOrder S; S.init(MTOK, DM, G, bx); \
        EpiResGate E{(BASE), (OUT), (GATE)}; pg8::gemm_phase<EpiResGate, pg8::StaticOrder, true, true>(lds, g, S, E); } while (0)

    if (IN(0)) for (int r_ = 0; r_ < NREP(0); ++r_) ph_prologue(args, lds, TD, wave, vcu, G);
    SEAM(0);
    if (IN(1)) for (int r_ = 0; r_ < NREP(1); ++r_) ph_modulate((const float*)args.in[0], XN, nullptr, nullptr, (const float*)args.in[3], mod, 0, 1024, gw, NGW, LN);
    SEAM(1);
    if (IN(2)) for (int r_ = 0; r_ < NREP(2); ++r_) GEMM_BF16(XN, ws + WS_WCIN, 3072, 1024, ws + WS_BCV, 3072);
    SEAM(2);
    if (IN(3)) for (int r_ = 0; r_ < NREP(3); ++r_) ph_conv((const bf16*)(ws + WS_BCV), (const float*)args.in[8], (bf16*)(ws + WS_Z), GTID, GT);
    SEAM(3);
    if (IN(4)) for (int r_ = 0; r_ < NREP(4); ++r_) GEMM_RES(ws + WS_Z, ws + WS_WCOUT, (const float*)args.in[0], X, mod + 2048);
    SEAM(4);
    if (IN(5)) for (int r_ = 0; r_ < NREP(5); ++r_) ph_modulate(X, XN, ws + WS_XN8, (float*)(ws + WS_HS), (const float*)args.in[4], mod, 3072, 4096, gw, NGW, LN);
    SEAM(5);
    if (IN(6)) for (int r_ = 0; r_ < NREP(6); ++r_) GEMM_BF16(XN, ws + WS_WPQ0, 2048, 1024, ws + WS_PQ, 2048);
    SEAM(6);
    if (IN(7)) for (int r_ = 0; r_ < NREP(7); ++r_) ph_topk((const bf16*)(ws + WS_PQ), (const bf16*)(ws + WS_SUBK), (unsigned short*)(ws + WS_IDS), (float*)(ws + WS_GATES), lds, bx, G, wave, LN);
    SEAM(7);
    if (IN(8)) { ph_peer_u<0>(ws + WS_PU, (const unsigned short*)(ws + WS_IDS), ws + WS_XN8, (float*)(ws + WS_PART), bx, G, wave, LN);
        for (int r_ = 1; r_ < NREP(8); ++r_) ph_peer_u<PROBE_VAR>(ws + WS_PU, (const unsigned short*)(ws + WS_IDS), ws + WS_XN8, (float*)(ws + WS_DUMMY), bx, G, wave, LN); }
    SEAM(8);
    if (IN(9)) for (int r_ = 0; r_ < NREP(9); ++r_) ph_peer_c((const float*)(ws + WS_PART), (const float*)(ws + WS_GATES), (const float*)(ws + WS_HS), ws + WS_ACT, (float*)(ws + WS_AS), gw, NGW, LN);
    SEAM(9);
    if (IN(10)) { for (int r_ = 1; r_ < NREP(10); ++r_) ph_peer_v<PROBE_VAR>(ws + WS_PV, (const unsigned short*)(ws + WS_IDS), ws + WS_ACT, (const float*)(ws + WS_AS), X, (float*)(ws + WS_DUMMY), mod + 5120, lds, bx, wave, LN);
        ph_peer_v<0>(ws + WS_PV, (const unsigned short*)(ws + WS_IDS), ws + WS_ACT, (const float*)(ws + WS_AS), X, X, mod + 5120, lds, bx, wave, LN); }
    SEAM(10);
    if (IN(11)) for (int r_ = 0; r_ < NREP(11); ++r_) ph_modulate(X, XN, nullptr, nullptr, (const float*)args.in[3] + DM, mod + (size_t)4 * 6144, 0, 1024, gw, NGW, LN);
    SEAM(11);
    if (IN(12)) for (int r_ = 0; r_ < NREP(12); ++r_) GEMM_BF16(XN, ws + WS_WMIN, MLA_IN_PAD, 1024, ws + WS_LAT, MLA_IN_PAD);
    SEAM(12);
    if (IN(13)) for (int r_ = 0; r_ < NREP(13); ++r_) ph_latnorm((const bf16*)(ws + WS_LAT), (const float*)args.in[11], (const float*)args.in[12], (bf16*)(ws + WS_QN), (bf16*)(ws + WS_KVN), gw, NGW, LN);
    SEAM(13);
    if (IN(14)) for (int r_ = 0; r_ < NREP(14); ++r_) { GEMM_BF16(ws + WS_QN, ws + WS_WQB, 1536, QLORA, ws + WS_QRAW, 1536); GEMM_BF16(ws + WS_KVN, ws + WS_WKVB, 2048, KVLORA, ws + WS_KVRAW, 2048); }
    SEAM(14);
    if (IN(15)) for (int r_ = 0; r_ < NREP(15); ++r_) ph_qkprep((const bf16*)(ws + WS_QRAW), (const bf16*)(ws + WS_KVRAW), (const bf16*)(ws + WS_LAT), (const int*)args.in[2], (const float*)args.in[15], (const float*)args.in[16],
                          (bf16*)(ws + WS_QF), (bf16*)(ws + WS_KF), (bf16*)(ws + WS_VT), gw, NGW, LN);
    SEAM(15);
    if (IN(16)) for (int r_ = 0; r_ < NREP(16); ++r_) ph_attn((const bf16*)(ws + WS_QF), (const bf16*)(ws + WS_KF), (const bf16*)(ws + WS_VT), (bf16*)(ws + WS_O), lds, vcu, G, wave, LN);
    SEAM(16);
    if (IN(17)) for (int r_ = 0; r_ < NREP(17); ++r_) GEMM_RES(ws + WS_O, ws + WS_WMOUT, (const float*)X, (r_ + 1 < NREP(17) ? (float*)(ws + WS_DUMMY) : X), mod + (size_t)4 * 6144 + 2048);
    SEAM(17);
    if (IN(18)) for (int r_ = 0; r_ < NREP(18); ++r_) ph_modulate(X, XN, ws + WS_XN8, (float*)(ws + WS_HS), (const float*)args.in[4] + DM, mod + (size_t)4 * 6144, 3072, 4096, gw, NGW, LN);
    SEAM(18);
    if (IN(19)) for (int r_ = 0; r_ < NREP(19); ++r_) GEMM_BF16(XN, ws + WS_WPQ1, 2048, 1024, ws + WS_PQ, 2048);
    SEAM(19);
    if (IN(20)) for (int r_ = 0; r_ < NREP(20); ++r_) ph_topk((const bf16*)(ws + WS_PQ), (const bf16*)(ws + WS_SUBK) + (size_t)8 * 2 * 128 * 128, (unsigned short*)(ws + WS_IDS), (float*)(ws + WS_GATES), lds, bx, G, wave, LN);
    SEAM(20);
    if (IN(21)) for (int r_ = 0; r_ < NREP(21); ++r_) ph_peer_u<0>(ws + WS_PU + (size_t)8 * NEXP * 128, (const unsigned short*)(ws + WS_IDS), ws + WS_XN8, (float*)(ws + WS_PART), bx, G, wave, LN);
    SEAM(21);
    if (IN(22)) for (int r_ = 0; r_ < NREP(22); ++r_) ph_peer_c((const float*)(ws + WS_PART), (const float*)(ws + WS_GATES), (const float*)(ws + WS_HS), ws + WS_ACT, (float*)(ws + WS_AS), gw, NGW, LN);
    SEAM(22);
    if (IN(23)) for (int r_ = 0; r_ < NREP(23); ++r_) ph_peer_v<0>(ws + WS_PV + (size_t)128 * NEXP * 8, (const unsigned short*)(ws + WS_IDS), ws + WS_ACT, (const float*)(ws + WS_AS), X, (r_ + 1 < NREP(23) ? (float*)(ws + WS_DUMMY) : X), mod + (size_t)4 * 6144 + 5120, lds, bx, wave, LN);
}

extern "C" void kernel_launch(void* const* d_in, const int* in_sizes, int n_in, void* d_out, int out_size, void* d_ws, size_t ws_size, hipStream_t stream) {
    static int grid = 0;
    if (grid == 0) {
        if (n_in != 22 || out_size != MTOK * DM || ws_size < WS_END) { fprintf(stderr, "kernel_launch: unexpected shapes: n_in %d out %d ws %zu (need %zu)\n", n_in, out_size, ws_size, (size_t)WS_END); grid = -1; return; }
        int dev = 0, cus = 0;
        if (hipGetDevice(&dev) != hipSuccess || hipDeviceGetAttribute(&cus, hipDeviceAttributeMultiprocessorCount, dev) != hipSuccess) { grid = -1; return; }
        if (hipFuncSetAttribute((const void*)mk_fwd, hipFuncAttributeMaxDynamicSharedMemorySize, LDS_BYTES) != hipSuccess) { fprintf(stderr, "kernel_launch: hipFuncSetAttribute failed\n"); grid = -1; return; }
        int per_cu = 0;
        if (hipOccupancyMaxActiveBlocksPerMultiprocessor(&per_cu, (const void*)mk_fwd, NWAVES * 64, LDS_BYTES) != hipSuccess || per_cu < 1) fprintf(stderr, "kernel_launch: occupancy query says %d\n", per_cu);
        (void)hipGetLastError();
        grid = cus;
        if (grid != 256) { fprintf(stderr, "kernel_launch: built for a 256-CU device (PEER value phase maps 128 dim slices x 2 token halves onto 256 workgroups); found %d CUs\n", grid); grid = -1; return; }
    }
    if (grid < 0) return;
    (void)hipMemsetAsync((char*)d_ws + WS_CTL, 0, CTL_ZERO_BYTES, stream);
    Args a{};
    for (int i = 0; i < 22; ++i) a.in[i] = d_in[i];
    a.out = (float*)d_out; a.ws = (unsigned char*)d_ws;
#if MK_N_LAUNCHES == 1
    a.ph_lo = 0; a.ph_hi = NPHASES;
    hipLaunchKernelGGL(mk_fwd, dim3(grid), dim3(NWAVES * 64), LDS_BYTES, stream, a);
#else
    for (int ph = 0; ph < NPHASES; ++ph) { a.ph_lo = ph; a.ph_hi = ph + 1; hipLaunchKernelGGL(mk_fwd, dim3(grid), dim3(NWAVES * 64), LDS_BYTES, stream, a); }
#endif
}
```

```cpp
#include <hip/hip_runtime.h>
#include <cstdio>
#include <cstdint>
#define GAS __attribute__((address_space(1)))
#define LAS __attribute__((address_space(3)))
namespace pg8 {
#define PG8_LAS __attribute__((address_space(3)))
typedef unsigned short bf16_t;
typedef short bf16x8 __attribute__((ext_vector_type(8)));
typedef float f32x4 __attribute__((ext_vector_type(4)));
typedef unsigned u32x4 __attribute__((ext_vector_type(4)));
constexpr int BM = 256, BK = 64, HALF = 128, HTB = HALF * BK * 2  , STAGE_BYTES = 8 * HTB, NXCD = 8, WGM = 8;

__host__ __device__ __forceinline__ int lds_byte(int r, int c) { const int st = (r >> 4) * 2 + (c >> 5), rr = r & 15, cc = c & 31, ob = rr * 64 + cc * 2; return st * 1024 + (ob ^ (((ob >> 9) & 1) << 5)); }
__host__ __device__ __forceinline__ void stage_rc(int b, int& R, int& C) { const int st = b / 1024, sb = b % 1024, swz = sb ^ (((sb >> 9) & 1) << 5); R = (st >> 1) * 16 + swz / 64; C = (st & 1) * 32 + (swz % 64) / 2; }
__host__ __device__ __forceinline__ int perm32(int rho) { const int n = rho >> 4, i = rho & 15; return 8 * (i >> 2) + 4 * n + (i & 3); }

struct Unit { int pm, pn; };
struct Gemm { const bf16_t* A; const bf16_t* Bt; int M, N, K; };

struct StaticOrder {
    int nM, nN, nwg, G, c;
    __host__ __device__ void init(int M, int N, int G_, int c_) { nM = M / BM; nN = N / BM; nwg = nM * nN; G = G_; c = c_; }
    __host__ __device__ bool next(int i, Unit& u) const {
        const long L = (long)i * G + c; if (L >= nwg) return false;
        int wgid = (int)L; { const int q = nwg / NXCD, r = nwg % NXCD, xcd = wgid % NXCD, off = wgid / NXCD; wgid = (xcd < r ? xcd * (q + 1) : r * (q + 1) + (xcd - r) * q) + off; }
        const int nig = WGM * nN, gid = wgid / nig, fm = gid * WGM, gsz = (nM - fm) < WGM ? (nM - fm) : WGM;
        u.pm = fm + ((wgid % nig) % gsz); u.pn = (wgid % nig) / gsz; return true;
    }
    __device__ __forceinline__ void a_ready(const Unit&) const {}
    __device__ __forceinline__ void done(const Unit&) const {}
};

__device__ __forceinline__ unsigned cvt_pk_bf16(float lo, float hi) { unsigned r; asm volatile("v_cvt_pk_bf16_f32 %0, %1, %2" : "=v"(r) : "v"(lo), "v"(hi)); return r; }
typedef float f32x2 __attribute__((ext_vector_type(2)));
__device__ __forceinline__ f32x2 gelu_pk(f32x2 v) {
    const f32x2 av = __builtin_elementwise_abs(v), d = av * 0.2316418882f + 1.0f;
    f32x2 t; t.x = __builtin_amdgcn_rcpf(d.x); t.y = __builtin_amdgcn_rcpf(d.y);
    f32x2 q = t * 0.5307027145f + (-0.7265760135f); q = q * t + 0.7107068705f; q = q * t + (-0.142248368f); q = q * t + 0.127414796f; q = q * t;
    const f32x2 s = (v * v) * (-0.72134752044f);
    f32x2 e; e.x = __builtin_amdgcn_exp2f(s.x); e.y = __builtin_amdgcn_exp2f(s.y);
    const f32x2 m = v * (q * e), r = v - m;
    f32x2 o; o.x = v.x < 0.f ? m.x : r.x; o.y = v.y < 0.f ? m.y : r.y; return o;
}

template <int ACT  > struct EpiBf16 {
    static constexpr bool PERM = true, AFTER_DRAIN = false; static_assert(ACT == 0 || ACT == 1, "EpiBf16: ACT is 0 (none) or 1 (gelu_pk)");
    bf16_t* O; int ldc; const float* bias; int split_cols; size_t split_stride; float scale0;
    __device__ __forceinline__ void operator()(const f32x4 (&acc)[2][2][4][2], const Unit& u, int wr, int wc, int fr, int fq) const {
        const int row0 = u.pm * BM + wr * 64 + fr; int colt = u.pn * BM; bf16_t* base = O;
        float sc = 1.f; if (split_cols) { const int t = colt / split_cols; base += (size_t)t * split_stride; colt -= t * split_cols; if (t == 0) sc = scale0; }
        const int col0 = colt + wc * 32 + 8 * fq, bcol0 = u.pn * BM + wc * 32 + 8 * fq;
        f32x4 bv[2][2];
#pragma unroll
        for (int bj = 0; bj < 2; ++bj)
#pragma unroll
            for (int n = 0; n < 2; ++n) bv[bj][n] = bias ? *(const f32x4*)(bias + bcol0 + bj * HALF + 4 * n) : (f32x4){0.f, 0.f, 0.f, 0.f};
#pragma unroll
        for (int ai = 0; ai < 2; ++ai)
#pragma unroll
            for (int m = 0; m < 4; ++m) { bf16_t* rowp = base + (size_t)(row0 + ai * HALF + m * 16) * ldc + col0;
#pragma unroll
                for (int bj = 0; bj < 2; ++bj) { f32x4 v0 = acc[ai][bj][m][0] + bv[bj][0], v1 = acc[ai][bj][m][1] + bv[bj][1];
                    if (ACT == 1) { f32x2 a = gelu_pk((f32x2){v0[0], v0[1]}), b = gelu_pk((f32x2){v0[2], v0[3]}), c = gelu_pk((f32x2){v1[0], v1[1]}), d = gelu_pk((f32x2){v1[2], v1[3]});
                        v0 = (f32x4){a.x, a.y, b.x, b.y}; v1 = (f32x4){c.x, c.y, d.x, d.y}; }
                    v0 = v0 * sc; v1 = v1 * sc; u32x4 w; w.x = cvt_pk_bf16(v0[0], v0[1]); w.y = cvt_pk_bf16(v0[2], v0[3]); w.z = cvt_pk_bf16(v1[0], v1[1]); w.w = cvt_pk_bf16(v1[2], v1[3]);
                    *(u32x4*)(rowp + bj * HALF) = w; } }
    }
};

template <class Epi, class Sched, bool ALIGN_EPI = false, bool SP2 = false>
__device__ __forceinline__ void gemm_phase(PG8_LAS unsigned char* lds, const Gemm g, const Sched& S, const Epi& E) {
    int tid_raw = threadIdx.x; asm volatile("" : "+v"(tid_raw));
    const int tid = tid_raw, wid = __builtin_amdgcn_readfirstlane(tid >> 6), lane = tid & 63, wr = wid >> 2, wc = wid & 3, fr = lane & 15, fq = lane >> 4;
    const int K = g.K, nt = K / BK;
    unsigned voffA[2], voffB[2];
#pragma unroll
    for (int i = 0; i < 2; ++i) { int R, C; stage_rc(tid * 16 + i * 8192, R, C); const int Rb = Epi::PERM ? ((R & ~31) + perm32(R & 31)) : R;
        voffA[i] = (unsigned)(R * K + C) * 2u; voffB[i] = (unsigned)(Rb * K + C) * 2u; }
    const size_t kstep = (size_t)(BK * 2);
    const size_t hstep = (size_t)HALF * K * 2;
    const size_t tstep = 2 * hstep;
    const unsigned ldsw = (unsigned)wid * 1024u;
    const int aoff = lds_byte(wr * 64 + fr, fq * 8), boff = lds_byte(wc * 32 + fr, fq * 8);
#define PG8_SA(b, h) (((b) * 2 + (h)) * HTB)
#define PG8_SB(b, h) ((4 + (b) * 2 + (h)) * HTB)
#define PG8_STAGE(bufoff, gbase, voff) do { _Pragma("unroll") for (int _i = 0; _i < 2; ++_i) \
        __builtin_amdgcn_global_load_lds((const unsigned*)((const char*)(gbase) + (voff)[_i]), (PG8_LAS unsigned*)(lds + (bufoff) + ldsw + _i * 8192), 16, 0, 0); } while (0)
#define PG8_LDA(dst, b, h) do { _Pragma("unroll") for (int m = 0; m < 4; ++m) _Pragma("unroll") for (int k = 0; k < 2; ++k) dst[m][k] = *(const PG8_LAS bf16x8*)(lds + PG8_SA(b, h) + aoff + m * 2048 + k * 1024); } while (0)
#define PG8_LDB(dst, b, h) do { _Pragma("unroll") for (int n = 0; n < 2; ++n) _Pragma("unroll") for (int k = 0; k < 2; ++k) dst[n][k] = *(const PG8_LAS bf16x8*)(lds + PG8_SB(b, h) + boff + n * 2048 + k * 1024); } while (0)
#define PG8_MMA(ai, bj, At, Bt) do { __builtin_amdgcn_s_setprio(1); _Pragma("unroll") for (int m = 0; m < 4; ++m) _Pragma("unroll") for (int n = 0; n < 2; ++n) _Pragma("unroll") for (int k = 0; k < 2; ++k) \
        acc[ai][bj][m][n] = __builtin_amdgcn_mfma_f32_16x16x32_bf16(Bt[n][k], At[m][k], acc[ai][bj][m][n], 0, 0, 0); __builtin_amdgcn_s_setprio(0); } while (0)
#define PG8_WAIT_V(n) asm volatile("s_waitcnt vmcnt(" #n ")" ::: "memory")
#define PG8_WAIT_L(n) asm volatile("s_waitcnt lgkmcnt(" #n ")" ::: "memory")
#define PG8_BAR __builtin_amdgcn_s_barrier()
#define PG8_SCHED __builtin_amdgcn_sched_barrier(0)
    Unit cur, nxt; int ui = 0;
    if (!S.next(0, cur)) return;
    f32x4 acc[2][2][4][2];
#pragma unroll
    for (int a = 0; a < 2; ++a)
#pragma unroll
        for (int b = 0; b < 2; ++b)
#pragma unroll
            for (int m = 0; m < 4; ++m)
#pragma unroll
                for (int n = 0; n < 2; ++n) acc[a][b][m][n] = (f32x4){0.f, 0.f, 0.f, 0.f};
    bf16x8 At[4][2], B0[2][2], B1[2][2];
    const char* cA = (const char*)g.A + (size_t)cur.pm * tstep; const char* cB = (const char*)g.Bt + (size_t)cur.pn * tstep;
    S.a_ready(cur);
    if constexpr (SP2) {
        PG8_STAGE(PG8_SB(0, 0), cB, voffB); PG8_STAGE(PG8_SB(0, 1), cB + hstep, voffB); PG8_STAGE(PG8_SA(0, 0), cA, voffA); PG8_STAGE(PG8_SA(0, 1), cA + hstep, voffA);
        if (wr == 1) PG8_BAR;
        PG8_WAIT_V(2); PG8_BAR;
        PG8_STAGE(PG8_SB(1, 0), cB + kstep, voffB); PG8_STAGE(PG8_SA(1, 0), cA + kstep, voffA); PG8_STAGE(PG8_SB(1, 1), cB + hstep + kstep, voffB);
        PG8_WAIT_V(6); PG8_BAR;
    } else {
        PG8_STAGE(PG8_SB(0, 0), cB, voffB); PG8_STAGE(PG8_SA(0, 0), cA, voffA); PG8_STAGE(PG8_SB(0, 1), cB + hstep, voffB); PG8_STAGE(PG8_SA(0, 1), cA + hstep, voffA);
        if (wr == 1) PG8_BAR;
        PG8_WAIT_V(4); PG8_BAR;
        PG8_STAGE(PG8_SB(1, 0), cB + kstep, voffB); PG8_STAGE(PG8_SA(1, 0), cA + kstep, voffA); PG8_STAGE(PG8_SB(1, 1), cB + hstep + kstep, voffB);
        PG8_WAIT_V(6); PG8_BAR;
    }
    for (;;) {
        const bool has_next = S.next(ui + 1, nxt);
        const char* nA = has_next ? (const char*)g.A + (size_t)nxt.pm * tstep : cA; const char* nB = has_next ? (const char*)g.Bt + (size_t)nxt.pn * tstep : cB;
        for (int t = 0; t < nt; t += 2) {
            const bool last = (t == nt - 2);
            const char* a1 = cA + (size_t)(t + 1) * kstep;
            const char* a2 = last ? nA : cA + (size_t)(t + 2) * kstep; const char* b2 = last ? nB : cB + (size_t)(t + 2) * kstep;
            const char* a3 = a2 + kstep; const char* b3 = b2 + kstep;
            if (last && has_next) S.a_ready(nxt);
            if constexpr (SP2) {
            PG8_LDB(B0, 0, 0); PG8_LDB(B1, 0, 1); PG8_SCHED; PG8_LDA(At, 0, 0); PG8_STAGE(PG8_SA(1, 1), a1 + hstep, voffA);
            PG8_WAIT_V(8); PG8_WAIT_L(0); PG8_BAR; PG8_MMA(0, 0, At, B0); PG8_MMA(0, 1, At, B1); PG8_BAR; PG8_SCHED;
            PG8_LDA(At, 0, 1); PG8_STAGE(PG8_SB(0, 0), b2, voffB); PG8_STAGE(PG8_SB(0, 1), b2 + hstep, voffB); PG8_STAGE(PG8_SA(0, 0), a2, voffA);
            PG8_WAIT_V(8); PG8_WAIT_L(0); PG8_BAR; PG8_MMA(1, 0, At, B0); PG8_MMA(1, 1, At, B1); PG8_BAR; PG8_SCHED;
            PG8_LDB(B0, 1, 0); PG8_LDB(B1, 1, 1); PG8_SCHED; PG8_LDA(At, 1, 0); PG8_STAGE(PG8_SA(0, 1), a2 + hstep, voffA);
            PG8_WAIT_V(8); PG8_WAIT_L(0); PG8_BAR; PG8_MMA(0, 0, At, B0); PG8_MMA(0, 1, At, B1); PG8_BAR; PG8_SCHED;
            PG8_LDA(At, 1, 1); PG8_STAGE(PG8_SB(1, 0), b3, voffB); PG8_STAGE(PG8_SB(1, 1), b3 + hstep, voffB); PG8_STAGE(PG8_SA(1, 0), a3, voffA);
            PG8_WAIT_V(8); PG8_WAIT_L(0); PG8_BAR; PG8_MMA(1, 0, At, B0); PG8_MMA(1, 1, At, B1); PG8_BAR; PG8_SCHED;
            } else {
            PG8_LDB(B0, 0, 0); PG8_SCHED; PG8_LDA(At, 0, 0); PG8_STAGE(PG8_SA(1, 1), a1 + hstep, voffA);
            PG8_WAIT_L(8); PG8_BAR; PG8_WAIT_L(0); PG8_MMA(0, 0, At, B0); PG8_BAR; PG8_SCHED;
            PG8_LDB(B1, 0, 1); PG8_STAGE(PG8_SB(0, 0), b2, voffB);
            PG8_BAR; PG8_WAIT_L(0); PG8_MMA(0, 1, At, B1); PG8_BAR;
            PG8_LDA(At, 0, 1); PG8_STAGE(PG8_SA(0, 0), a2, voffA);
            PG8_BAR; PG8_WAIT_L(0); PG8_MMA(1, 0, At, B0); PG8_BAR; PG8_SCHED;
            PG8_STAGE(PG8_SB(0, 1), b2 + hstep, voffB);
            PG8_WAIT_V(6); PG8_BAR; PG8_MMA(1, 1, At, B1); PG8_BAR;
            PG8_LDB(B0, 1, 0); PG8_SCHED; PG8_LDA(At, 1, 0); PG8_STAGE(PG8_SA(0, 1), a2 + hstep, voffA);
            PG8_WAIT_L(8); PG8_BAR; PG8_WAIT_L(0); PG8_MMA(0, 0, At, B0); PG8_BAR; PG8_SCHED;
            PG8_LDB(B1, 1, 1); PG8_STAGE(PG8_SB(1, 0), b3, voffB);
            PG8_BAR; PG8_WAIT_L(0); PG8_MMA(0, 1, At, B1); PG8_BAR;
            PG8_LDA(At, 1, 1); PG8_STAGE(PG8_SA(1, 0), a3, voffA);
            PG8_BAR; PG8_WAIT_L(0); PG8_MMA(1, 0, At, B0); PG8_BAR; PG8_SCHED;
            PG8_STAGE(PG8_SB(1, 1), b3 + hstep, voffB);
            PG8_WAIT_V(6); PG8_BAR; PG8_MMA(1, 1, At, B1); PG8_BAR;
            }
        }
        if constexpr (ALIGN_EPI) { if (wr == 0) PG8_BAR; }
        if constexpr (!Epi::AFTER_DRAIN) { E(acc, cur, wr, wc, fr, fq); S.done(cur); }
        if (!has_next) break;
#pragma unroll
        for (int a = 0; a < 2; ++a)
#pragma unroll
            for (int b = 0; b < 2; ++b)
#pragma unroll
                for (int m = 0; m < 4; ++m)
#pragma unroll
                    for (int n = 0; n < 2; ++n) acc[a][b][m][n] = (f32x4){0.f, 0.f, 0.f, 0.f};
        cur = nxt; cA = nA; cB = nB; ++ui;
        if constexpr (ALIGN_EPI) { if (wr == 1) PG8_BAR; }
    }
    PG8_WAIT_V(0);
    if constexpr (!ALIGN_EPI) { if (wr == 0) PG8_BAR; }
    PG8_BAR;
    if constexpr (Epi::AFTER_DRAIN) { E.fused(acc, cur, wr, wc, fr, fq, lds, wid, lane); S.done(cur); }
#undef PG8_SA
#undef PG8_SB
#undef PG8_STAGE
#undef PG8_LDA
#undef PG8_LDB
#undef PG8_MMA
#undef PG8_WAIT_V
#undef PG8_WAIT_L
#undef PG8_BAR
#undef PG8_SCHED
}
}
#define XB_TMO      128
#define XB_XCNT(j)  (256  + 64 * (j))
#define XB_XSUB(j)  (1280 + 64 * (j))
#define XB_XGEN(j)  (2304 + 64 * (j))
#define XB_TOP      3328
#define XB_TOPGEN   3392
#define XCD_BAR_WORDS 3456
#define XB_SPIN_CAP (1u << 18)

__device__ __forceinline__ unsigned xb_ld(unsigned* p)              { return __hip_atomic_load(p, __ATOMIC_RELAXED, __HIP_MEMORY_SCOPE_AGENT); }
__device__ __forceinline__ unsigned xb_add(unsigned* p, unsigned v) { return __hip_atomic_fetch_add(p, v, __ATOMIC_RELAXED, __HIP_MEMORY_SCOPE_AGENT); }
__device__ __forceinline__ unsigned xb_xcc_id() { return (unsigned)__builtin_amdgcn_s_getreg((3 << 11) | 20) & 0xFu; }
#define XB_SPIN(cond, bar) do { unsigned _sp = 0; while (cond) { __builtin_amdgcn_s_sleep(1); \
    if ((++_sp & 255u) == 0u) { if (xb_ld(&(bar)[XB_TMO])) break; if (_sp > XB_SPIN_CAP) { atomicAdd(&(bar)[XB_TMO], 1u); break; } } } } while (0)

struct XcdBarrier {
    unsigned* bar; unsigned x;
    volatile LAS unsigned* st;
};

__device__ __forceinline__ XcdBarrier xcd_barrier_post(unsigned* bar, volatile LAS unsigned* st) {
    XcdBarrier b; b.bar = bar; b.x = xb_xcc_id(); b.st = st;
    if (threadIdx.x == 0) (void)xb_add(&bar[XB_XCNT(b.x)], 1u);
    return b;
}
__device__ __forceinline__ void xcd_barrier_complete(unsigned* bar, unsigned x, unsigned& nloc, unsigned& nx) {
    const unsigned G = gridDim.x * gridDim.y * gridDim.z;
    unsigned sum, cnt, mine, sp = 0u;
    for (;;) {
        sum = 0u; cnt = 0u; mine = 0u;
#pragma unroll
        for (unsigned j = 0; j < 16; ++j) { const unsigned c = xb_ld(&bar[XB_XCNT(j)]); sum += c; cnt += (c > 0u) ? 1u : 0u; mine = (j == x) ? c : mine; }
        if (sum == G) break;
        __builtin_amdgcn_s_sleep(1);
        if ((++sp & 255u) == 0u) { if (xb_ld(&bar[XB_TMO])) break; if (sp > XB_SPIN_CAP) { atomicAdd(&bar[XB_TMO], 1u); break; } }
    }
    nloc = mine > 0u ? mine : 1u; nx = cnt > 0u ? cnt : 1u;
}

__device__ __forceinline__ void xcd_barrier(const XcdBarrier& b) {
    asm volatile("s_waitcnt vmcnt(0)" ::: "memory");
    __syncthreads();
    if (threadIdx.x == 0) {
        unsigned* bar = b.bar;
        __builtin_amdgcn_s_waitcnt(0);
        unsigned nloc = b.st[0], nx = b.st[1];
        if (nloc == 0u) { xcd_barrier_complete(bar, b.x, nloc, nx); b.st[0] = nloc; b.st[1] = nx; }
        const unsigned old = xb_add(&bar[XB_XSUB(b.x)], 1u);
        const unsigned gen = old / nloc;
        if (old + 1u == (gen + 1u) * nloc) {
            __builtin_amdgcn_fence(__ATOMIC_RELEASE, "agent");
            asm volatile("s_waitcnt vmcnt(0)" ::: "memory");
            const unsigned og = xb_add(&bar[XB_TOP], 1u);
            const unsigned tg = og / nx;
            if (og + 1u == (tg + 1u) * nx) xb_add(&bar[XB_TOPGEN], 1u);
            else XB_SPIN(xb_ld(&bar[XB_TOPGEN]) == tg, bar);
            __builtin_amdgcn_fence(__ATOMIC_ACQUIRE, "agent");
            xb_add(&bar[XB_XGEN(b.x)], 1u);
            asm volatile("s_waitcnt vmcnt(0)" ::: "memory");
        } else {
            XB_SPIN(xb_ld(&bar[XB_XGEN(b.x)]) == gen, bar);
            __builtin_amdgcn_fence(__ATOMIC_ACQUIRE, "agent");
            asm volatile("s_waitcnt vmcnt(0)" ::: "memory");
        }
    }
    __syncthreads();
}

constexpr int DM = 1024, NB = 4, SEQ = 4096, MTOK = NB * SEQ;
constexpr int QLORA = 384, KVLORA = 256, ROPE = 64, NOPE = 128, QKH = 192, VH = 128, NH = 8;
constexpr int MLA_IN = 704, MLA_IN_PAD = 768;
constexpr int NEXP = 16384;
constexpr float NORM_EPS = 1e-6f;
constexpr float U8_SCALE = 256.f, V8_SCALE = 16.f, H8_SCALE = 8.f;
constexpr float VI8_SCALE = 127.f / (4.5f * 0.5f);
constexpr float UI8_SCALE = 127.f * 32.f / 4.5f;
constexpr float QSCALE = 0.07216878364870322f * 1.4426950408889634f;

#ifndef MK_N_LAUNCHES
#define MK_N_LAUNCHES 1
#endif
constexpr int NPHASES = 24;
#ifndef PHMASK
#define PHMASK 0xFFFFFFu
#endif
#define EN(k) (((PHMASK) >> (k)) & 1u)
#ifndef PROBE_PHASE
#define PROBE_PHASE -1
#endif
#ifndef PROBE_VAR
#define PROBE_VAR 0
#endif
#ifndef PROBE_REPS
#define PROBE_REPS 2
#endif
#define NREP(k) ((k) == (PROBE_PHASE) ? (PROBE_REPS) : 1)
constexpr int NWAVES = 8;

constexpr size_t MiB = 1u << 20;
constexpr size_t WS_CTL = 0, CTL_ZERO_BYTES = 64 * 1024;
constexpr size_t WS_MOD = 1 * MiB;
constexpr size_t WS_WCIN = 2 * MiB;
constexpr size_t WS_WCOUT = 8 * MiB;
constexpr size_t WS_WPQ0 = 10 * MiB, WS_WPQ1 = 14 * MiB;
constexpr size_t WS_WMIN = 18 * MiB;
constexpr size_t WS_WQB = 20 * MiB;
constexpr size_t WS_WKVB = 22 * MiB;
constexpr size_t WS_WMOUT = 24 * MiB;
constexpr size_t WS_SUBK = 26 * MiB;
constexpr size_t WS_PU = 32 * MiB;
constexpr size_t WS_PV = 96 * MiB;
constexpr size_t WS_XN = 160 * MiB;
constexpr size_t WS_VT = 160 * MiB;
constexpr size_t WS_BCV = 192 * MiB;
constexpr size_t WS_LAT = 192 * MiB;
constexpr size_t WS_O = 192 * MiB;
constexpr size_t WS_QN = 216 * MiB;
constexpr size_t WS_KVN = 228 * MiB;
constexpr size_t WS_QRAW = 236 * MiB;
constexpr size_t WS_Z = 288 * MiB;
constexpr size_t WS_KVRAW = 288 * MiB;
constexpr size_t WS_PQ = 288 * MiB;
constexpr size_t WS_QF = 352 * MiB;
constexpr size_t WS_KF = 400 * MiB;
constexpr size_t WS_IDS = 448 * MiB;
constexpr size_t WS_GATES = 456 * MiB;
constexpr size_t WS_PART = 192 * MiB;
constexpr size_t WS_DUMMY = 288 * MiB;
constexpr size_t WS_ACT = 464 * MiB;
constexpr size_t WS_XN8 = 472 * MiB;
constexpr size_t WS_HS = 488 * MiB;
constexpr size_t WS_AS = 489 * MiB;
constexpr size_t WS_END = 490 * MiB;
constexpr int CW_BAR = 1024;

constexpr int RING_BYTES = 131072;
constexpr int LDSCTL_OFF = RING_BYTES, MISC_OFF = LDSCTL_OFF + 320;
constexpr int LDS_BYTES = 147456;


typedef unsigned short bf16;
typedef unsigned u32x4 __attribute__((ext_vector_type(4)));
typedef unsigned u32x2 __attribute__((ext_vector_type(2)));
typedef float f32x4 __attribute__((ext_vector_type(4)));
typedef float f32x16 __attribute__((ext_vector_type(16)));
typedef short s16x8 __attribute__((ext_vector_type(8)));
typedef short s16x4 __attribute__((ext_vector_type(4)));
#define LDS_WAIT() asm volatile("s_waitcnt lgkmcnt(0)" ::: "memory")
#define VM_WAIT() asm volatile("s_waitcnt vmcnt(0)" ::: "memory")
#define DI __device__ __forceinline__

DI unsigned f2bf(float f) { unsigned u = __builtin_bit_cast(unsigned, f); return (u + 0x7fffu + ((u >> 16) & 1u)) >> 16; }
DI unsigned pk2(float lo, float hi) { return f2bf(lo) | (f2bf(hi) << 16); }
DI float bflo(unsigned u) { return __uint_as_float(u << 16); }
DI float bfhi(unsigned u) { return __uint_as_float(u & 0xffff0000u); }
DI float bf1(bf16 b) { return __uint_as_float((unsigned)b << 16); }
DI float wave_sum(float v) {
#pragma unroll
    for (int o = 32; o > 0; o >>= 1) v += __shfl_xor(v, o);
    return v;
}
DI int crow(int r, int hi) { return (r & 3) + 8 * (r >> 2) + 4 * hi; }

struct Args { const void* in[22]; float* out; unsigned char* ws; int ph_lo, ph_hi; };

DI void transpose_item(const float* W, int K, int N, bf16* WT, LAS float* scr, int item, int lane) {
    const int nblk = N / 32, kb = item / nblk, nb = item % nblk, k0 = 64 * kb, n0 = 32 * nb;
#pragma unroll 8
    for (int i = 0; i < 32; ++i) { const int kk = 2 * i + (lane >> 5); scr[kk * 33 + (lane & 31)] = W[(size_t)(k0 + kk) * N + n0 + (lane & 31)]; }
    LDS_WAIT(); asm volatile("" ::: "memory");
    const int c = lane & 7;
#pragma unroll
    for (int j = 0; j < 4; ++j) { const int n = (lane >> 3) + 8 * j; const LAS float* s = scr + (8 * c) * 33 + n;
        u32x4 o; o.x = pk2(s[0 * 33], s[1 * 33]); o.y = pk2(s[2 * 33], s[3 * 33]); o.z = pk2(s[4 * 33], s[5 * 33]); o.w = pk2(s[6 * 33], s[7 * 33]);
        *(u32x4*)(WT + (size_t)(n0 + n) * K + k0 + 8 * c) = o; }
    LDS_WAIT(); asm volatile("" ::: "memory");
}
DI void cvt_f32_bf16(const float* src, bf16* dst, size_t n8, size_t gt, size_t GT) {
#pragma unroll 4
    for (size_t i = gt; i < n8; i += GT) {
        const f32x4 a = ((const f32x4*)src)[2 * i], b = ((const f32x4*)src)[2 * i + 1];
        u32x4 o; o.x = pk2(a.x, a.y); o.y = pk2(a.z, a.w); o.z = pk2(b.x, b.y); o.w = pk2(b.z, b.w);
        ((u32x4*)dst)[i] = o; }
}

typedef float f32x2v __attribute__((ext_vector_type(2)));
DI unsigned pack4_fp8(float a, float b, float c, float d, float sc) {
    a = fminf(fmaxf(a * sc, -448.f), 448.f); b = fminf(fmaxf(b * sc, -448.f), 448.f); c = fminf(fmaxf(c * sc, -448.f), 448.f); d = fminf(fmaxf(d * sc, -448.f), 448.f);
    int w = __builtin_amdgcn_cvt_pk_fp8_f32(a, b, 0, false); w = __builtin_amdgcn_cvt_pk_fp8_f32(c, d, w, true); return (unsigned)w;
}
DI unsigned pack4_i8(float a, float b, float c, float d, float sc) {
    const int ia = (int)rintf(fminf(fmaxf(a * sc, -127.f), 127.f)), ib = (int)rintf(fminf(fmaxf(b * sc, -127.f), 127.f)), ic = (int)rintf(fminf(fmaxf(c * sc, -127.f), 127.f)), id = (int)rintf(fminf(fmaxf(d * sc, -127.f), 127.f));
    return (unsigned)(ia & 0xff) | ((unsigned)(ib & 0xff) << 8) | ((unsigned)(ic & 0xff) << 16) | ((unsigned)(id & 0xff) << 24);
}
DI void cvt_utable_fp8(const float* u, unsigned char* u8, size_t gt, size_t GT) {
    const size_t n16 = (size_t)2 * NEXP * 1024 / 16;
#pragma unroll 2
    for (size_t i = gt; i < n16; i += GT) {
        const f32x4* s = (const f32x4*)(u + i * 16); const f32x4 a = s[0], b = s[1], c = s[2], d = s[3];
        u32x4 o; o.x = pack4_i8(a.x, a.y, a.z, a.w, UI8_SCALE); o.y = pack4_i8(b.x, b.y, b.z, b.w, UI8_SCALE); o.z = pack4_i8(c.x, c.y, c.z, c.w, UI8_SCALE); o.w = pack4_i8(d.x, d.y, d.z, d.w, UI8_SCALE);
        const size_t k = i & 63, row = i >> 6, e = row & (NEXP - 1), layer = row >> 14;
        *(u32x4*)(u8 + (((layer * 8 + (k >> 3)) * NEXP + e) * 128 + (k & 7) * 16)) = o; }
}
constexpr int VT_ROWB = 1032;
DI void cvt_vtable_lds(const float* v, unsigned char* v8l, LAS unsigned char* tile, int bx, int G, int tid) {
    for (int item = bx; item < 2 * (NEXP / 64); item += G) {
        const int layer = item / (NEXP / 64), e0 = (item % (NEXP / 64)) * 64;
        const float* src = v + ((size_t)layer * NEXP + e0) * 1024;
#pragma unroll 2
        for (int i = 0; i < 8; ++i) { const int c = tid + 512 * i, row = c >> 6, k = c & 63;
            const f32x4* s = (const f32x4*)(src + (size_t)row * 1024 + 16 * k); const f32x4 a = s[0], b = s[1], cc = s[2], d = s[3];
            const u32x2 lo = (u32x2){pack4_i8(a.x, a.y, a.z, a.w, VI8_SCALE), pack4_i8(b.x, b.y, b.z, b.w, VI8_SCALE)}, hi = (u32x2){pack4_i8(cc.x, cc.y, cc.z, cc.w, VI8_SCALE), pack4_i8(d.x, d.y, d.z, d.w, VI8_SCALE)};
            *(LAS u32x2*)(tile + row * VT_ROWB + 16 * k) = lo; *(LAS u32x2*)(tile + row * VT_ROWB + 16 * k + 8) = hi; }
        __syncthreads();
#pragma unroll 4
        for (int i = 0; i < 16; ++i) { const int q = tid + 512 * i, sl = q >> 6, e = q & 63;
            const u32x2 w = *(const LAS u32x2*)(tile + e * VT_ROWB + 8 * sl);
            *(u32x2*)(v8l + (((size_t)layer * 128 + sl) * NEXP + e0 + e) * 8) = w; }
        __syncthreads();
    }
}
DI void ph_prologue(const Args& a, LAS unsigned char* lds, int tid, int wave, int vcu, int G) {
    const int lane = tid & 63;
    {
        const float* c = (const float*)a.in[1]; const float* ada_w = (const float*)a.in[5]; const float* ada_b = (const float*)a.in[6];
        float* mod = (float*)(a.ws + WS_MOD);
        LAS float* cact = (LAS float*)lds; LAS float* red = cact + 4096;
        for (int it = blockIdx.x; it < 192; it += G) {
            const int i = it / 96, n0 = (it % 96) * 64;
            for (int e = tid; e < 4096; e += 512) { const float v = c[e]; cact[e] = v / (1.f + expf(-v)); }
            __syncthreads();
            const float* W = ada_w + (size_t)i * 1024 * 6144 + n0 + lane;
            float a0 = 0.f, a1 = 0.f, a2 = 0.f, a3 = 0.f;
            const int k0 = wave * 128;
#pragma unroll 8
            for (int k = k0; k < k0 + 128; ++k) { const float w = W[(size_t)k * 6144]; a0 += cact[k] * w; a1 += cact[1024 + k] * w; a2 += cact[2048 + k] * w; a3 += cact[3072 + k] * w; }
            red[(wave * 4 + 0) * 64 + lane] = a0; red[(wave * 4 + 1) * 64 + lane] = a1; red[(wave * 4 + 2) * 64 + lane] = a2; red[(wave * 4 + 3) * 64 + lane] = a3;
            __syncthreads();
            if (tid < 256) { const int b = tid >> 6; float s = 0.f;
#pragma unroll
                for (int w = 0; w < 8; ++w) s += red[(w * 4 + b) * 64 + lane];
                mod[(size_t)(i * 4 + b) * 6144 + n0 + lane] = s + ada_b[i * 6144 + n0 + lane]; }
            __syncthreads();
        }
    }
    {
        LAS float* scr = (LAS float*)(lds + 32768 + wave * 8704);
        const int gw = vcu * NWAVES + wave, NGW = G * NWAVES;
        unsigned char* ws = a.ws;
        constexpr int I_CIN = 16 * 96, I_COUT = 16 * 32, I_PQ = 16 * 64, I_MIN = 16 * 22, I_QB = 6 * 48, I_KVB = 4 * 64, I_MOUT = 16 * 32;
        constexpr int NITEMS = I_CIN + I_COUT + 2 * I_PQ + I_MIN + I_QB + I_KVB + I_MOUT;
        for (int it = gw; it < NITEMS; it += NGW) {
            int r = it;
            if (r < I_CIN) { transpose_item((const float*)a.in[7], 1024, 3072, (bf16*)(ws + WS_WCIN), scr, r, lane); continue; } r -= I_CIN;
            if (r < I_COUT) { transpose_item((const float*)a.in[9], 1024, 1024, (bf16*)(ws + WS_WCOUT), scr, r, lane); continue; } r -= I_COUT;
            if (r < I_PQ) { transpose_item((const float*)a.in[18], 1024, 2048, (bf16*)(ws + WS_WPQ0), scr, r, lane); continue; } r -= I_PQ;
            if (r < I_PQ) { transpose_item((const float*)a.in[18] + (size_t)1024 * 2048, 1024, 2048, (bf16*)(ws + WS_WPQ1), scr, r, lane); continue; } r -= I_PQ;
            if (r < I_MIN) { transpose_item((const float*)a.in[10], 1024, MLA_IN, (bf16*)(ws + WS_WMIN), scr, r, lane); continue; } r -= I_MIN;
            if (r < I_QB) { transpose_item((const float*)a.in[13], 384, 1536, (bf16*)(ws + WS_WQB), scr, r, lane); continue; } r -= I_QB;
            if (r < I_KVB) { transpose_item((const float*)a.in[14], 256, 2048, (bf16*)(ws + WS_WKVB), scr, r, lane); continue; } r -= I_KVB;
            transpose_item((const float*)a.in[17], 1024, 1024, (bf16*)(ws + WS_WMOUT), scr, r, lane);
        }
        const size_t gt = (size_t)vcu * 512 + tid, GT = (size_t)G * 512;
        for (size_t i = gt; i < (size_t)(MLA_IN_PAD - MLA_IN) * 1024 / 8; i += GT) ((u32x4*)(ws + WS_WMIN + (size_t)MLA_IN * 1024 * 2))[i] = (u32x4){0u, 0u, 0u, 0u};
        cvt_f32_bf16((const float*)a.in[19], (bf16*)(ws + WS_SUBK), (size_t)2 * 8 * 2 * 128 * 128 / 8, gt, GT);
        cvt_utable_fp8((const float*)a.in[20], ws + WS_PU, gt, GT);
        __syncthreads();
        cvt_vtable_lds((const float*)a.in[21], ws + WS_PV, lds, blockIdx.x, G, tid);
    }
}

DI void ph_modulate(const float* x, bf16* xn, unsigned char* xn8  , float* hs, const float* gain, const float* modl, int sh_off, int sc_off, int gw, int NGW, int lane) {
    for (int m = gw; m < MTOK; m += NGW) {
        const float* mb = modl + (size_t)(m >> 12) * 6144;
        const f32x4* xr = (const f32x4*)(x + (size_t)m * DM) + lane;
        f32x4 v[4]; float s = 0.f;
#pragma unroll
        for (int j = 0; j < 4; ++j) { v[j] = xr[64 * j]; s += (v[j].x * v[j].x + v[j].y * v[j].y) + (v[j].z * v[j].z + v[j].w * v[j].w); }
        const float rstd = rsqrtf(wave_sum(s) * (1.f / DM) + NORM_EPS);
        u32x2* o8 = (u32x2*)(xn + (size_t)m * DM) + lane;
        f32x4 y[4]; float mx = 0.f;
#pragma unroll
        for (int j = 0; j < 4; ++j) {
            const f32x4 g = ((const f32x4*)gain)[lane + 64 * j], sh = ((const f32x4*)(mb + sh_off))[lane + 64 * j], sc = ((const f32x4*)(mb + sc_off))[lane + 64 * j];
            y[j] = v[j] * rstd * g * (sc + 1.f) + sh;
            u32x2 w; w.x = pk2(y[j].x, y[j].y); w.y = pk2(y[j].z, y[j].w); o8[64 * j] = w;
            mx = fmaxf(mx, fmaxf(fmaxf(fabsf(y[j].x), fabsf(y[j].y)), fmaxf(fabsf(y[j].z), fabsf(y[j].w)))); }
        if (xn8) {
#pragma unroll
            for (int o = 32; o > 0; o >>= 1) mx = fmaxf(mx, __shfl_xor(mx, o));
            const float scl = mx > 0.f ? mx * (1.f / 127.f) : 1.f, isc = 1.f / scl;
#pragma unroll
            for (int j = 0; j < 4; ++j) ((unsigned*)(xn8 + (size_t)m * DM))[lane + 64 * j] = pack4_i8(y[j].x, y[j].y, y[j].z, y[j].w, isc);
            if (lane == 0) hs[m] = scl;
        }
    }
}

DI void ph_conv(const bf16* bcv, const float* cw, bf16* z, size_t gt, size_t GT) {
    for (size_t it = gt; it < (size_t)MTOK * 128; it += GT) {
        const int t = (int)(it >> 7), ch = (int)(it & 127) * 8, s = t & (SEQ - 1);
        const bf16* row = bcv + (size_t)t * 3072 + ch;
        const u32x4 zero = (u32x4){0u, 0u, 0u, 0u};
        const u32x4 bq = *(const u32x4*)row;
        const u32x4 c0 = *(const u32x4*)(row + 1024), v0 = *(const u32x4*)(row + 2048);
        const u32x4 c1 = s >= 1 ? *(const u32x4*)(row - 3072 + 1024) : zero, v1 = s >= 1 ? *(const u32x4*)(row - 3072 + 2048) : zero;
        const u32x4 c2 = s >= 2 ? *(const u32x4*)(row - 6144 + 1024) : zero, v2 = s >= 2 ? *(const u32x4*)(row - 6144 + 2048) : zero;
        const f32x4 w0a = *(const f32x4*)(cw + ch), w0b = *(const f32x4*)(cw + ch + 4);
        const f32x4 w1a = *(const f32x4*)(cw + 1024 + ch), w1b = *(const f32x4*)(cw + 1024 + ch + 4);
        const f32x4 w2a = *(const f32x4*)(cw + 2048 + ch), w2b = *(const f32x4*)(cw + 2048 + ch + 4);
        float r[8];
#pragma unroll
        for (int e = 0; e < 4; ++e) {
            const float w0l = e < 2 ? w0a[2 * e] : w0b[2 * e - 4], w0h = e < 2 ? w0a[2 * e + 1] : w0b[2 * e - 3];
            const float w1l = e < 2 ? w1a[2 * e] : w1b[2 * e - 4], w1h = e < 2 ? w1a[2 * e + 1] : w1b[2 * e - 3];
            const float w2l = e < 2 ? w2a[2 * e] : w2b[2 * e - 4], w2h = e < 2 ? w2a[2 * e + 1] : w2b[2 * e - 3];
            const float ut_l = bflo(c0[e]) * bflo(v0[e]), ut_h = bfhi(c0[e]) * bfhi(v0[e]);
            const float u1_l = bflo(c1[e]) * bflo(v1[e]), u1_h = bfhi(c1[e]) * bfhi(v1[e]);
            const float u2_l = bflo(c2[e]) * bflo(v2[e]), u2_h = bfhi(c2[e]) * bfhi(v2[e]);
            r[2 * e] = bflo(bq[e]) * (w0l * u2_l + w1l * u1_l + w2l * ut_l);
            r[2 * e + 1] = bfhi(bq[e]) * (w0h * u2_h + w1h * u1_h + w2h * ut_h);
        }
        u32x4 o; o.x = pk2(r[0], r[1]); o.y = pk2(r[2], r[3]); o.z = pk2(r[4], r[5]); o.w = pk2(r[6], r[7]);
        *(u32x4*)(z + (size_t)t * DM + ch) = o;
    }
}

struct EpiResGate {
    static constexpr bool PERM = false, AFTER_DRAIN = false;
    const float* base; float* out; const float* gate;
    __device__ __forceinline__ void operator()(const pg8::f32x4 (&acc)[2][2][4][2], const pg8::Unit& u, int wr, int wc, int fr, int fq) const {
        const int row0 = u.pm * 256 + wr * 64 + fr, col0 = u.pn * 256 + wc * 32 + 4 * fq;
        const float* gp = gate + (size_t)(u.pm >> 4) * 6144 + col0;
        pg8::f32x4 gv[2][2];
#pragma unroll
        for (int bj = 0; bj < 2; ++bj)
#pragma unroll
            for (int n = 0; n < 2; ++n) gv[bj][n] = *(const pg8::f32x4*)(gp + bj * 128 + n * 16);
#pragma unroll
        for (int ai = 0; ai < 2; ++ai)
#pragma unroll
            for (int m = 0; m < 4; ++m) { const size_t off = (size_t)(row0 + ai * 128 + m * 16) * DM + col0;
#pragma unroll
                for (int bj = 0; bj < 2; ++bj)
#pragma unroll
                    for (int n = 0; n < 2; ++n) { const pg8::f32x4 bs = *(const pg8::f32x4*)(base + off + bj * 128 + n * 16);
                        *(pg8::f32x4*)(out + off + bj * 128 + n * 16) = bs + gv[bj][n] * acc[ai][bj][m][n]; } }
    }
};

typedef float f32x2_t __attribute__((ext_vector_type(2))); typedef __bf16 bf16x2_t __attribute__((ext_vector_type(2)));
DI unsigned cvtpk(float lo, float hi) { f32x2_t v = {lo, hi}; bf16x2_t b = __builtin_convertvector(v, bf16x2_t); return __builtin_bit_cast(unsigned, b); }
DI unsigned f2key(float f) { const unsigned u = __float_as_uint(f); return u ^ ((unsigned)((int)u >> 31) | 0x80000000u); }
DI float key2f(unsigned k) { const unsigned u = (k & 0x80000000u) ? (k ^ 0x80000000u) : ~k; return __uint_as_float(u); }
DI unsigned umax_(unsigned a, unsigned b) { return a > b ? a : b; }
DI unsigned umin_(unsigned a, unsigned b) { return a < b ? a : b; }
template <int N> DI void bitonic_sort_desc(unsigned (&v)[N]) {
#pragma unroll
    for (int k = 2; k <= N; k <<= 1) {
#pragma unroll
        for (int j = k >> 1; j > 0; j >>= 1) {
#pragma unroll
            for (int i = 0; i < N; ++i) { const int l = i ^ j;
                if (l > i) { const bool desc = ((i & k) == 0); const unsigned x = v[i], y = v[l], mx = umax_(x, y), mn = umin_(x, y); v[i] = desc ? mx : mn; v[l] = desc ? mn : mx; } }
        }
    }
}
template <int N> DI void bitonic_merge_desc(unsigned (&v)[N]) {
#pragma unroll
    for (int j = N >> 1; j > 0; j >>= 1) {
#pragma unroll
        for (int i = 0; i < N; ++i) { const int l = i ^ j;
            if (l > i) { const unsigned x = v[i], y = v[l]; v[i] = umax_(x, y); v[l] = umin_(x, y); } }
    }
}
DI void top16_merge(unsigned (&t)[16], unsigned (&n)[16]) {
#pragma unroll
    for (int i = 0; i < 16; ++i) t[i] = umax_(t[i], n[15 - i]);
    bitonic_merge_desc<16>(t);
}

constexpr int TK_ROWB = 272, TK_TAB_OFF = 32768;
DI void topk_task(const bf16* PQ, LAS unsigned char* skl  , unsigned short* IDS, float* GATES, LAS unsigned short* tab  , int tok0, int h, int lane) {
    const int r32 = lane & 31, hi = lane >> 5;
    s16x8 qf[16];
    const bf16* qp = PQ + (size_t)(tok0 + r32) * 2048 + 256 * h + 8 * hi;
#pragma unroll
    for (int ks = 0; ks < 16; ++ks) qf[ks] = *(const s16x8*)(qp + 16 * ks);
    const int p = (r32 >> 2) & 1, keyl = (r32 & 3) + 4 * (r32 >> 3);
    const unsigned kl0 = (unsigned)((p * 128 + keyl) * TK_ROWB + 16 * hi);
    const s16x8 zero8 = (s16x8){0, 0, 0, 0, 0, 0, 0, 0};
    unsigned top[16];
#pragma unroll
    for (int i = 0; i < 16; ++i) top[i] = 0u;
#pragma unroll 1
    for (int rb = 0; rb < 8; ++rb) {
        f32x16 acc;
#pragma unroll
        for (int r = 0; r < 16; ++r) acc[r] = 0.f;
#pragma unroll
        for (int ks = 0; ks < 8; ++ks) {
            const s16x8 kf = *(const LAS s16x8*)(skl + kl0 + (unsigned)(rb * 16 * TK_ROWB + 32 * ks));
            const s16x8 a0 = p == 0 ? kf : zero8, a1 = p == 1 ? kf : zero8;
            acc = __builtin_amdgcn_mfma_f32_32x32x16_bf16(a0, qf[ks], acc, 0, 0, 0);
            acc = __builtin_amdgcn_mfma_f32_32x32x16_bf16(a1, qf[ks + 8], acc, 0, 0, 0);
        }
        unsigned nw[16];
#pragma unroll
        for (int r = 0; r < 16; ++r) nw[r] = (f2key(acc[r]) & ~127u) | (unsigned)(127 - (16 * rb + r));
        bitonic_sort_desc<16>(nw);
        top16_merge(top, nw);
    }
    unsigned LA[16], LB[16];
#pragma unroll
    for (int i = 0; i < 16; ++i) { const unsigned other = (unsigned)__shfl_xor((int)top[i], 32); LA[i] = hi ? other : top[i]; LB[i] = hi ? top[i] : other; }
#pragma unroll
    for (int i = 0; i < 16; ++i) { tab[i * 64 + lane] = (unsigned short)(127u - (LA[i] & 127u)); tab[(16 + i) * 64 + lane] = (unsigned short)(127u - (LB[i] & 127u)); }
    float av[16], bv[16];
#pragma unroll
    for (int i = 0; i < 16; ++i) { av[i] = key2f(LA[i] & ~127u); bv[i] = key2f(LB[i] & ~127u); }
    unsigned cg[4][16];
#pragma unroll
    for (int g = 0; g < 4; ++g)
#pragma unroll
        for (int e = 0; e < 16; ++e) cg[g][e] = 0u;
    {
        int cnt = 0;
#pragma unroll
        for (int i = 0; i < 16; ++i)
#pragma unroll
            for (int j = 0; j < 16; ++j)
                if ((i + 1) * (j + 1) <= 16) { cg[cnt >> 4][cnt & 15] = (f2key(av[i] + bv[j]) & ~255u) | (unsigned)(255 - (16 * i + j)); ++cnt; }
    }
    bitonic_sort_desc<16>(cg[0]); bitonic_sort_desc<16>(cg[1]); bitonic_sort_desc<16>(cg[2]); bitonic_sort_desc<16>(cg[3]);
    top16_merge(cg[0], cg[1]); top16_merge(cg[0], cg[2]); top16_merge(cg[0], cg[3]);
    LDS_WAIT(); asm volatile("" ::: "memory");
    float sv[16]; int ex[16];
#pragma unroll
    for (int k = 0; k < 16; ++k) { const unsigned key = cg[0][k]; const int pos = 255 - (int)(key & 255u); sv[k] = key2f(key & ~255u);
        const int ia = tab[(pos >> 4) * 64 + lane], ib = tab[(16 + (pos & 15)) * 64 + lane]; ex[k] = ia * 128 + ib; }
    LDS_WAIT(); asm volatile("" ::: "memory");
    const float mx = sv[0]; float sum = 0.f;
#pragma unroll
    for (int k = 0; k < 16; ++k) { sv[k] = expf(sv[k] - mx); sum += sv[k]; }
    const float inv = 1.f / sum;
    if (hi == 0) {
        const int tq = tok0 + r32; unsigned short* ip = IDS + ((size_t)(tq >> 6) * 16 + 2 * h) * 512 + (tq & 63) * 8; float* gp = GATES + (size_t)tq * 128 + h * 16;
#pragma unroll
        for (int k = 0; k < 16; k += 8) *(u32x4*)(ip + (k >> 3) * 512) = (u32x4){(unsigned)ex[k] | ((unsigned)ex[k + 1] << 16), (unsigned)ex[k + 2] | ((unsigned)ex[k + 3] << 16), (unsigned)ex[k + 4] | ((unsigned)ex[k + 5] << 16), (unsigned)ex[k + 6] | ((unsigned)ex[k + 7] << 16)};
#pragma unroll
        for (int k = 0; k < 16; k += 4) *(f32x4*)(gp + k) = (f32x4){sv[k] * inv, sv[k + 1] * inv, sv[k + 2] * inv, sv[k + 3] * inv};
    }
}
DI void ph_topk(const bf16* PQ, const bf16* SK, unsigned short* IDS, float* GATES, LAS unsigned char* lds, int bx, int G, int wave, int lane) {
    LAS unsigned short* tab = (LAS unsigned short*)(lds + wave * 4096);
    const int h = bx & 7, rank = bx >> 3, nb = (G - h + 7) >> 3, tid = wave * 64 + lane;
    LAS unsigned char* skl = lds + TK_TAB_OFF;
#pragma unroll
    for (int i = 0; i < 8; ++i) { const int c = tid + 512 * i, row = c >> 4, col = c & 15;
        *(LAS u32x4*)(skl + row * TK_ROWB + col * 16) = *(const u32x4*)(SK + ((size_t)h * 256 + row) * 128 + col * 8); }
    __syncthreads();
    for (int g = rank * 8 + wave; g < MTOK / 32; g += nb * 8) topk_task(PQ, skl, IDS, GATES, tab, g * 32, h, lane);
    __syncthreads();
}

DI float gelu_erf(float x) { return 0.5f * x * (1.f + erff(x * 0.70710678118654752f)); }
DI float dot16_fp8(const u32x4& w, const float (&h)[16]) {
    float d0 = 0.f, d1 = 0.f;
#pragma unroll
    for (int e = 0; e < 4; ++e) { const f32x2v lo = __builtin_amdgcn_cvt_pk_f32_fp8((int)w[e], false), hi = __builtin_amdgcn_cvt_pk_f32_fp8((int)w[e], true);
        d0 += lo.x * h[4 * e] + lo.y * h[4 * e + 1]; d1 += hi.x * h[4 * e + 2] + hi.y * h[4 * e + 3]; }
    return d0 + d1;
}
DI float gelu_fast(float v) {
    const float av = fabsf(v), d = av * 0.2316418882f + 1.0f, t = __builtin_amdgcn_rcpf(d);
    float q = t * 0.5307027145f + (-0.7265760135f); q = q * t + 0.7107068705f; q = q * t + (-0.142248368f); q = q * t + 0.127414796f; q = q * t;
    const float e = __builtin_amdgcn_exp2f((v * v) * (-0.72134752044f)), mm = v * (q * e);
    return v < 0.f ? mm : v - mm;
}
DI long lo64(const u32x4& w) { return (long)(((unsigned long long)w.y << 32) | w.x); }
DI long hi64(const u32x4& w) { return (long)(((unsigned long long)w.w << 32) | w.z); }
typedef __amdgpu_buffer_rsrc_t brsrc_t;
DI brsrc_t mkrsrc(const void* p, unsigned bytes) { return __builtin_amdgcn_make_buffer_rsrc((void*)p, 0, (int)bytes, 0x00020000); }
DI u32x4 bl128(brsrc_t r, unsigned voff, unsigned soff) { return __builtin_amdgcn_raw_buffer_load_b128(r, (int)voff, (int)soff, 0); }
DI u32x2 bl64(brsrc_t r, unsigned voff, unsigned soff) { return __builtin_amdgcn_raw_buffer_load_b64(r, (int)voff, (int)soff, 0); }
DI void bs64(brsrc_t r, u32x2 v, unsigned voff, unsigned soff) { __builtin_amdgcn_raw_buffer_store_b64(v, r, (int)voff, (int)soff, 0); }
DI f32x4 asf4(u32x4 v) { return __builtin_bit_cast(f32x4, v); }
template <int VAR> DI void u_issue8(u32x4 (&r)[8], const u32x4& ev, const unsigned char* Ux, unsigned coff) {
#pragma unroll
    for (int i = 0; i < 8; ++i) { const unsigned ew = ev[i >> 1], e = (i & 1) ? (ew >> 16) : (ew & 0xffffu);
        if (VAR == 1) r[i] = (u32x4){e, coff, 0x38383838u, 0x40404040u}; else r[i] = *(const u32x4*)(Ux + (e * 128u + coff)); }
}
typedef __bf16 bf16x2v __attribute__((ext_vector_type(2)));
DI void u_dot8(const u32x4 (&r)[8], const u32x4& hq, float* p) {
#pragma unroll
    for (int i = 0; i < 8; ++i) {
        u32x4 row = r[i]; asm volatile("" : "+v"(row));
        int d = __builtin_amdgcn_sdot4((int)row.x, (int)hq.x, 0, false);
        d = __builtin_amdgcn_sdot4((int)row.y, (int)hq.y, d, false); d = __builtin_amdgcn_sdot4((int)row.z, (int)hq.z, d, false); d = __builtin_amdgcn_sdot4((int)row.w, (int)hq.w, d, false);
        float pi = (float)d; asm volatile("" : "+v"(pi)); p[i] = pi;
    }
}
DI void u_reduce_store(const float* p, brsrc_t part_r, unsigned poff, int tok, bool do_store, bool b2, bool b1, bool b0) {
    float v8[8], v4[4], v2[2];
#pragma unroll
    for (int i = 0; i < 8; ++i) { const float keep = b2 ? p[i + 8] : p[i], give = b2 ? p[i] : p[i + 8]; v8[i] = keep + __shfl_xor(give, 4); }
#pragma unroll
    for (int i = 0; i < 4; ++i) { const float keep = b1 ? v8[i + 4] : v8[i], give = b1 ? v8[i] : v8[i + 4]; v4[i] = keep + __shfl_xor(give, 2); }
#pragma unroll
    for (int i = 0; i < 2; ++i) { const float keep = b0 ? v4[i + 2] : v4[i], give = b0 ? v4[i] : v4[i + 2]; v2[i] = keep + __shfl_xor(give, 1); }
    if (do_store) bs64(part_r, (u32x2){__float_as_uint(v2[0]), __float_as_uint(v2[1])}, poff, tok * 512);
}
template <int VAR> DI void ph_peer_u(const unsigned char* U8s, const unsigned short* IDS, const unsigned char* XN8, float* PART, int bx, int G, int wave, int lane) {
    const int x = bx & 7, rank = bx >> 3, nslots = ((G - x + 7) >> 3) * 8;
    const int grp = lane >> 3, c = lane & 7;
    const bool b2 = (lane & 4) != 0, b1 = (lane & 2) != 0, b0 = (lane & 1) != 0;
    const unsigned char* Ux = U8s + (size_t)x * NEXP * 128;
    const unsigned coff = 16u * (unsigned)c;
    const unsigned hoff = (unsigned)(128 * x + 16 * c), ioff = 2048u * (unsigned)grp;
    const brsrc_t ids_r = mkrsrc(IDS, MTOK * 128 * 2), xn_r = mkrsrc(XN8, MTOK * DM), part_r = mkrsrc(PART + (size_t)x * MTOK * 128, MTOK * 128 * 4);
    const unsigned poff = (unsigned)(16 * grp + 8 * (int)b2 + 4 * (int)b1 + 2 * (int)b0) * 4u;
    const int t0 = rank * 8 + wave;
#define UTOK(k) ((t0 + (k) * nslots) < MTOK ? (t0 + (k) * nslots) : (MTOK - 1))
#define UVALID(k) ((t0 + (k) * nslots) < MTOK)
#define U_LOAD_IDS(E, tok) do { const unsigned so_ = (unsigned)((tok) >> 6) * 16384u + (unsigned)((tok) & 63) * 16u; E[0] = bl128(ids_r, ioff, so_); E[1] = bl128(ids_r, ioff + 1024, so_); } while (0)
#define U_LOAD_H(Hq, tok) do { Hq = bl128(xn_r, hoff, (tok) * 1024); } while (0)
#define SB() __builtin_amdgcn_sched_barrier(0)
    u32x4 RA[8], RB[8], E0[2], E1[2], H0, H1; float p[16];
    U_LOAD_IDS(E0, UTOK(0)); U_LOAD_H(H0, UTOK(0)); U_LOAD_IDS(E1, UTOK(1)); U_LOAD_H(H1, UTOK(1));
    u_issue8<VAR>(RA, E0[0], Ux, coff);
#pragma unroll 1
    for (int k = 0; UVALID(k); k += 2) {
        u_issue8<VAR>(RB, E0[1], Ux, coff); SB();
        u_dot8(RA, H0, p); SB();
        u_issue8<VAR>(RA, E1[0], Ux, coff); U_LOAD_IDS(E0, UTOK(k + 2)); SB();
        u_dot8(RB, H0, p + 8); u_reduce_store(p, part_r, poff, UTOK(k), true, b2, b1, b0); U_LOAD_H(H0, UTOK(k + 2)); SB();
        u_issue8<VAR>(RB, E1[1], Ux, coff); SB();
        u_dot8(RA, H1, p); SB();
        u_issue8<VAR>(RA, E0[0], Ux, coff); U_LOAD_IDS(E1, UTOK(k + 3)); SB();
        u_dot8(RB, H1, p + 8); u_reduce_store(p, part_r, poff, UTOK(k + 1), UVALID(k + 1), b2, b1, b0); U_LOAD_H(H1, UTOK(k + 3)); SB();
    }
#undef UTOK
#undef UVALID
#undef U_LOAD_IDS
#undef U_LOAD_H
}
DI void ph_peer_c(const float* PART, const float* GATES, const float* HS, unsigned char* ACTI, float* AS, int gw, int NGW, int lane) {
    for (int t = gw; t < MTOK; t += NGW) {
        const float inv = HS[t] * (1.f / UI8_SCALE);
        f32x2v s = (f32x2v){0.f, 0.f};
#pragma unroll
        for (int xx = 0; xx < 8; ++xx) { const f32x2v p = *(const f32x2v*)(PART + ((size_t)xx * MTOK + t) * 128 + 2 * lane); s.x += p.x; s.y += p.y; }
        const f32x2v g = *(const f32x2v*)(GATES + (size_t)t * 128 + 2 * lane);
        const float a0 = gelu_fast(s.x * inv) * g.x, a1 = gelu_fast(s.y * inv) * g.y;
        float mx = fmaxf(fabsf(a0), fabsf(a1));
#pragma unroll
        for (int o = 32; o > 0; o >>= 1) mx = fmaxf(mx, __shfl_xor(mx, o));
        const float scl = mx > 0.f ? mx * (1.f / 127.f) : 1.f, isc = 1.f / scl;
        const int q0 = (int)rintf(a0 * isc), q1 = (int)rintf(a1 * isc);
        *(unsigned short*)(ACTI + (size_t)(t >> 6) * 8192 + (lane >> 2) * 512 + (t & 63) * 8 + (lane & 3) * 2) = (unsigned short)((q0 & 0xff) | ((q1 & 0xff) << 8));
        if (lane == 0) AS[t] = scl;
    }
}
struct VBuf { u32x4 idw[8]; u32x2 acw[8]; };
DI void v_load_half(VBuf& B, const char* ip, const char* ap, int half) {
#pragma unroll
    for (int i = 0; i < 8; ++i) { B.idw[i] = *(const u32x4*)(ip + (8 * half + i) * 1024); B.acw[i] = *(const u32x2*)(ap + (8 * half + i) * 512); }
}
template <int VAR> DI void v_half(const VBuf& B, LAS unsigned char* lds, int* acc) {
#pragma unroll
    for (int i = 0; i < 8; ++i) {
        u32x4 idw = B.idw[i]; u32x2 acw = B.acw[i]; asm volatile("" : "+v"(idw), "+v"(acw));
#pragma unroll
        for (int q4 = 0; q4 < 2; ++q4) {
            const unsigned e0 = idw[2 * q4] & 0xffffu, e1 = idw[2 * q4] >> 16, e2 = idw[2 * q4 + 1] & 0xffffu, e3 = idw[2 * q4 + 1] >> 16;
            u32x2 r0, r1, r2, r3;
            if (VAR == 1) { r0 = (u32x2){0x01020304u + e0, 0x05060708u}; r1 = (u32x2){0x01020304u + e1, 0x05060708u}; r2 = (u32x2){0x01020304u + e2, 0x05060708u}; r3 = (u32x2){0x01020304u + e3, 0x05060708u}; }
            else { r0 = *(const LAS u32x2*)(lds + e0 * 8u); r1 = *(const LAS u32x2*)(lds + e1 * 8u); r2 = *(const LAS u32x2*)(lds + e2 * 8u); r3 = *(const LAS u32x2*)(lds + e3 * 8u); }
            const int aw = (int)acw[q4];
            const unsigned ta = __builtin_amdgcn_perm(r1.x, r0.x, 0x05010400u), tb = __builtin_amdgcn_perm(r1.x, r0.x, 0x07030602u), tc = __builtin_amdgcn_perm(r3.x, r2.x, 0x05010400u), td = __builtin_amdgcn_perm(r3.x, r2.x, 0x07030602u);
            const unsigned ua = __builtin_amdgcn_perm(r1.y, r0.y, 0x05010400u), ub = __builtin_amdgcn_perm(r1.y, r0.y, 0x07030602u), uc = __builtin_amdgcn_perm(r3.y, r2.y, 0x05010400u), ud = __builtin_amdgcn_perm(r3.y, r2.y, 0x07030602u);
            acc[0] = __builtin_amdgcn_sdot4((int)__builtin_amdgcn_perm(tc, ta, 0x05040100u), aw, acc[0], false);
            acc[1] = __builtin_amdgcn_sdot4((int)__builtin_amdgcn_perm(tc, ta, 0x07060302u), aw, acc[1], false);
            acc[2] = __builtin_amdgcn_sdot4((int)__builtin_amdgcn_perm(td, tb, 0x05040100u), aw, acc[2], false);
            acc[3] = __builtin_amdgcn_sdot4((int)__builtin_amdgcn_perm(td, tb, 0x07060302u), aw, acc[3], false);
            acc[4] = __builtin_amdgcn_sdot4((int)__builtin_amdgcn_perm(uc, ua, 0x05040100u), aw, acc[4], false);
            acc[5] = __builtin_amdgcn_sdot4((int)__builtin_amdgcn_perm(uc, ua, 0x07060302u), aw, acc[5], false);
            acc[6] = __builtin_amdgcn_sdot4((int)__builtin_amdgcn_perm(ud, ub, 0x05040100u), aw, acc[6], false);
            acc[7] = __builtin_amdgcn_sdot4((int)__builtin_amdgcn_perm(ud, ub, 0x07060302u), aw, acc[7], false);
        }
    }
}
template <int VAR> DI void ph_peer_v(const unsigned char* V8L  , const unsigned short* IDT, const unsigned char* ACTI, const float* AS, const float* Xin, float* Xout, const float* g2,
                                     LAS unsigned char* lds, int bx, int wave, int lane) {
    const int x = bx & 7, rank = bx >> 3, sl = 16 * x + (rank & 15), th = rank >> 4, tid = wave * 64 + lane;
    { const u32x4* src = (const u32x4*)(V8L + (size_t)sl * NEXP * 8);
#pragma unroll 4
      for (int i = 0; i < 16; ++i) { const int c = tid + 512 * i; *(LAS u32x4*)(lds + 16 * c) = src[c]; } }
    __syncthreads();
#define V_IP(gi_) ((const char*)IDT + (size_t)(th * 128 + ((gi_) < 128 ? (gi_) : 127)) * 16384 + lane * 16)
#define V_AP(gi_) ((const char*)ACTI + (size_t)(th * 128 + ((gi_) < 128 ? (gi_) : 127)) * 8192 + lane * 8)
    VBuf A, B;
    v_load_half(A, V_IP(wave), V_AP(wave), 0);
#pragma unroll 1
    for (int gi = wave; gi < 128; gi += 8) {
        const int g = th * 128 + gi, t = g * 64 + lane;
        int acc[8];
#pragma unroll
        for (int d = 0; d < 8; ++d) acc[d] = 0;
        v_load_half(B, V_IP(gi), V_AP(gi), 1);
        const f32x4 x0 = *(const f32x4*)(Xin + (size_t)t * DM + 8 * sl), x1 = *(const f32x4*)(Xin + (size_t)t * DM + 8 * sl + 4);
        const float asc = AS[t];
        __builtin_amdgcn_sched_barrier(0);
        v_half<VAR>(A, lds, acc);
        __builtin_amdgcn_sched_barrier(0);
        v_load_half(A, V_IP(gi + 8), V_AP(gi + 8), 0);
        __builtin_amdgcn_sched_barrier(0);
        v_half<VAR>(B, lds, acc);
        const float* gp = g2 + (size_t)(t >> 12) * 6144 + 8 * sl;
        const f32x4 g0 = *(const f32x4*)gp, g1 = *(const f32x4*)(gp + 4);
        const float inv = asc * (1.f / VI8_SCALE);
        f32x4 o0, o1;
        o0.x = x0.x + g0.x * ((float)acc[0] * inv); o0.y = x0.y + g0.y * ((float)acc[1] * inv); o0.z = x0.z + g0.z * ((float)acc[2] * inv); o0.w = x0.w + g0.w * ((float)acc[3] * inv);
        o1.x = x1.x + g1.x * ((float)acc[4] * inv); o1.y = x1.y + g1.y * ((float)acc[5] * inv); o1.z = x1.z + g1.z * ((float)acc[6] * inv); o1.w = x1.w + g1.w * ((float)acc[7] * inv);
        *(f32x4*)(Xout + (size_t)t * DM + 8 * sl) = o0; *(f32x4*)(Xout + (size_t)t * DM + 8 * sl + 4) = o1;
        __builtin_amdgcn_sched_barrier(0);
    }
#undef V_IP
#undef V_AP
    __syncthreads();
}

DI void ph_latnorm(const bf16* LAT, const float* qg, const float* kvg, bf16* QN, bf16* KVN, int gw, int NGW, int lane) {
    for (int t = gw; t < MTOK; t += NGW) {
        const unsigned* lr = (const unsigned*)(LAT + (size_t)t * MLA_IN_PAD);
        unsigned q[3], k[2]; float sq = 0.f, sk = 0.f;
#pragma unroll
        for (int j = 0; j < 3; ++j) { q[j] = lr[lane + 64 * j]; sq += bflo(q[j]) * bflo(q[j]) + bfhi(q[j]) * bfhi(q[j]); }
#pragma unroll
        for (int j = 0; j < 2; ++j) { k[j] = lr[192 + lane + 64 * j]; sk += bflo(k[j]) * bflo(k[j]) + bfhi(k[j]) * bfhi(k[j]); }
        const float rq = rsqrtf(wave_sum(sq) * (1.f / QLORA) + NORM_EPS), rk = rsqrtf(wave_sum(sk) * (1.f / KVLORA) + NORM_EPS);
        unsigned* qo = (unsigned*)(QN + (size_t)t * QLORA); unsigned* ko = (unsigned*)(KVN + (size_t)t * KVLORA);
#pragma unroll
        for (int j = 0; j < 3; ++j) { const int c = 2 * (lane + 64 * j); qo[lane + 64 * j] = pk2(bflo(q[j]) * rq * qg[c], bfhi(q[j]) * rq * qg[c + 1]); }
#pragma unroll
        for (int j = 0; j < 2; ++j) { const int c = 2 * (lane + 64 * j); ko[lane + 64 * j] = pk2(bflo(k[j]) * rk * kvg[c], bfhi(k[j]) * rk * kvg[c + 1]); }
    }
}

DI void ph_qkprep(const bf16* QRAW, const bf16* KVRAW, const bf16* LAT, const int* positions, const float* qg, const float* kg,
                  bf16* Qf, bf16* Kf, bf16* Vt, int gw, int NGW, int lane) {
    const int hh = lane >> 3, p = lane & 7;
    float qgn[16], qgr[8], kgn[16], kgr[8], invf[8];
#pragma unroll
    for (int i = 0; i < 16; ++i) { qgn[i] = qg[16 * p + i] * QSCALE; kgn[i] = kg[16 * p + i]; }
#pragma unroll
    for (int i = 0; i < 8; ++i) { qgr[i] = qg[128 + 8 * p + i] * QSCALE; kgr[i] = kg[128 + 8 * p + i]; invf[i] = exp2f(-(float)((8 * p + i) & 31) * (13.287712379549449f / 32.f)); }
    for (int task = gw; task < MTOK / 8; task += NGW) {
        const int t0 = task * 8, b = t0 >> 12, s0 = t0 & (SEQ - 1);
#pragma unroll 1
        for (int tt = 0; tt < 8; ++tt) {
            const int t = t0 + tt, s = s0 + tt;
            const float posf = (float)positions[t];
            float cs[8], sn[8];
#pragma unroll
            for (int i = 0; i < 8; ++i) { const float ang = posf * invf[i]; double rev = (double)ang * 0.15915494309189535; rev -= floor(rev); const float rv = (float)rev; sn[i] = __builtin_amdgcn_sinf(rv); cs[i] = __builtin_amdgcn_cosf(rv); }
            const u32x4 kr4 = *(const u32x4*)(LAT + (size_t)t * MLA_IN_PAD + 640 + 8 * p);
#pragma unroll
            for (int which = 0; which < 2; ++which) {
                const bf16* src = which == 0 ? QRAW + (size_t)t * 1536 + QKH * hh : KVRAW + (size_t)t * 2048 + 256 * hh;
                const u32x4 n0 = *(const u32x4*)(src + 16 * p), n1 = *(const u32x4*)(src + 16 * p + 8);
                const u32x4 r0 = which == 0 ? *(const u32x4*)(src + 128 + 8 * p) : kr4;
                float xn[16], xr[8];
#pragma unroll
                for (int e = 0; e < 4; ++e) { xn[2 * e] = bflo(n0[e]); xn[2 * e + 1] = bfhi(n0[e]); xn[8 + 2 * e] = bflo(n1[e]); xn[8 + 2 * e + 1] = bfhi(n1[e]); xr[2 * e] = bflo(r0[e]); xr[2 * e + 1] = bfhi(r0[e]); }
                float ss = 0.f;
#pragma unroll
                for (int i = 0; i < 16; ++i) ss = fmaf(xn[i], xn[i], ss);
#pragma unroll
                for (int i = 0; i < 8; ++i) ss = fmaf(xr[i], xr[i], ss);
                ss += __shfl_xor(ss, 1); ss += __shfl_xor(ss, 2); ss += __shfl_xor(ss, 4);
                const float rstd = rsqrtf(ss * (1.f / QKH) + NORM_EPS);
                float yr[8], ro[8];
#pragma unroll
                for (int i = 0; i < 16; ++i) xn[i] = xn[i] * rstd * (which == 0 ? qgn[i] : kgn[i]);
#pragma unroll
                for (int i = 0; i < 8; ++i) yr[i] = xr[i] * rstd * (which == 0 ? qgr[i] : kgr[i]);
#pragma unroll
                for (int i = 0; i < 8; ++i) { const float pr = __shfl_xor(yr[i], 4); ro[i] = p < 4 ? yr[i] * cs[i] - pr * sn[i] : pr * sn[i] + yr[i] * cs[i]; }
                bf16* dst = (which == 0 ? Qf : Kf) + ((size_t)(b * NH + hh) * SEQ + s) * QKH;
                u32x4 o0, o1, o2;
                o0.x = cvtpk(xn[0], xn[1]); o0.y = cvtpk(xn[2], xn[3]); o0.z = cvtpk(xn[4], xn[5]); o0.w = cvtpk(xn[6], xn[7]);
                o1.x = cvtpk(xn[8], xn[9]); o1.y = cvtpk(xn[10], xn[11]); o1.z = cvtpk(xn[12], xn[13]); o1.w = cvtpk(xn[14], xn[15]);
                o2.x = cvtpk(ro[0], ro[1]); o2.y = cvtpk(ro[2], ro[3]); o2.z = cvtpk(ro[4], ro[5]); o2.w = cvtpk(ro[6], ro[7]);
                *(u32x4*)(dst + 16 * p) = o0; *(u32x4*)(dst + 16 * p + 8) = o1; *(u32x4*)(dst + 128 + 8 * p) = o2;
            }
        }
#pragma unroll 1
        for (int h = 0; h < NH; ++h)
#pragma unroll
            for (int dd = 0; dd < 128; dd += 64) {
                const bf16* vp = KVRAW + (size_t)t0 * 2048 + 256 * h + 128 + dd + lane;
                unsigned w[4];
#pragma unroll
                for (int i = 0; i < 4; ++i) w[i] = (unsigned)vp[(size_t)(2 * i) * 2048] | ((unsigned)vp[(size_t)(2 * i + 1) * 2048] << 16);
                *(u32x4*)(Vt + ((size_t)(b * NH + h) * VH + dd + lane) * SEQ + s0) = (u32x4){w[0], w[1], w[2], w[3]};
            }
    }
}

DI void attn_unit(const bf16* Qf, const bf16* Kf, const bf16* Vt, bf16* O, int bh, int qb, int wave, int lane) {
    const int r32 = lane & 31, hi = lane >> 5;
    const int q0 = qb * 256 + wave * 32;
    s16x8 qf[12];
    { const bf16* Qp = Qf + ((size_t)bh * SEQ + q0 + r32) * QKH + 8 * hi;
#pragma unroll
      for (int ks = 0; ks < 12; ++ks) qf[ks] = *(const s16x8*)(Qp + 16 * ks); }
    f32x16 o[4];
#pragma unroll
    for (int d = 0; d < 4; ++d)
#pragma unroll
        for (int r = 0; r < 16; ++r) o[d][r] = 0.f;
    float m = -1e30f, l = 0.f;
    const bf16* Kp = Kf + ((size_t)bh * SEQ + r32) * QKH + 8 * hi;
    const bf16* Vp = Vt + ((size_t)bh * VH + r32) * SEQ + 4 * hi;
    const int nkt = q0 / 32 + 1;
#pragma unroll 1
    for (int kt = 0; kt < nkt; ++kt) {
        f32x16 sc;
#pragma unroll
        for (int r = 0; r < 16; ++r) sc[r] = 0.f;
        const bf16* kp = Kp + (size_t)kt * 32 * QKH;
#pragma unroll
        for (int ks = 0; ks < 12; ++ks) sc = __builtin_amdgcn_mfma_f32_32x32x16_bf16(*(const s16x8*)(kp + 16 * ks), qf[ks], sc, 0, 0, 0);
        if (kt == nkt - 1) {
#pragma unroll
            for (int r = 0; r < 16; ++r) if (crow(r, hi) > r32) sc[r] = -INFINITY;
        }
        float mt = sc[0];
#pragma unroll
        for (int r = 1; r < 16; ++r) mt = fmaxf(mt, sc[r]);
        mt = fmaxf(mt, __shfl_xor(mt, 32));
        const float mn = fmaxf(m, mt), alpha = __builtin_amdgcn_exp2f(m - mn);
        m = mn; l *= alpha;
#pragma unroll
        for (int d = 0; d < 4; ++d)
#pragma unroll
            for (int r = 0; r < 16; ++r) o[d][r] *= alpha;
        float ps = 0.f;
#pragma unroll
        for (int r = 0; r < 16; ++r) { sc[r] = __builtin_amdgcn_exp2f(sc[r] - mn); ps += sc[r]; }
        l += ps;
#pragma unroll
        for (int s = 0; s < 2; ++s) {
            u32x4 pw; pw.x = cvtpk(sc[8 * s], sc[8 * s + 1]); pw.y = cvtpk(sc[8 * s + 2], sc[8 * s + 3]); pw.z = cvtpk(sc[8 * s + 4], sc[8 * s + 5]); pw.w = cvtpk(sc[8 * s + 6], sc[8 * s + 7]);
            const s16x8 pb = __builtin_bit_cast(s16x8, pw);
#pragma unroll
            for (int d = 0; d < 4; ++d) {
                const bf16* vp = Vp + (size_t)d * 32 * SEQ + kt * 32 + 16 * s;
                const s16x4 lo = *(const s16x4*)vp, hh = *(const s16x4*)(vp + 8);
                const s16x8 va = __builtin_shufflevector(lo, hh, 0, 1, 2, 3, 4, 5, 6, 7);
                o[d] = __builtin_amdgcn_mfma_f32_32x32x16_bf16(va, pb, o[d], 0, 0, 0);
            }
        }
    }
    l += __shfl_xor(l, 32);
    const float inv = 1.f / l;
    bf16* Op = O + ((size_t)((bh >> 3) * SEQ + q0 + r32)) * DM + (bh & 7) * VH + 4 * hi;
#pragma unroll
    for (int d = 0; d < 4; ++d)
#pragma unroll
        for (int g = 0; g < 4; ++g) { u32x2 w; w.x = cvtpk(o[d][4 * g] * inv, o[d][4 * g + 1] * inv); w.y = cvtpk(o[d][4 * g + 2] * inv, o[d][4 * g + 3] * inv);
            *(u32x2*)(Op + 32 * d + 8 * g) = w; }
}
constexpr int AT_KROW = 400, AT_VROW = 136, AT_KBYTES = 64 * AT_KROW, AT_VBYTES = 128 * AT_VROW, AT_STAGE = AT_KBYTES + AT_VBYTES;
DI void attn_unit_lds(const bf16* Qf, const bf16* Kf, const bf16* Vt, bf16* O, LAS unsigned char* lds, int bh, int qb, int wave, int lane) {
    const int r32 = lane & 31, hi = lane >> 5, tid = wave * 64 + lane;
    const int q0 = qb * 256 + wave * 32;
    s16x8 qf[12];
    { const bf16* Qp = Qf + ((size_t)bh * SEQ + q0 + r32) * QKH + 8 * hi;
#pragma unroll
      for (int ks = 0; ks < 12; ++ks) qf[ks] = *(const s16x8*)(Qp + 16 * ks); }
    f32x16 o[4];
#pragma unroll
    for (int d = 0; d < 4; ++d)
#pragma unroll
        for (int r = 0; r < 16; ++r) o[d][r] = 0.f;
    float m = -1e30f, l = 0.f;
    const int NT = 4 * (qb + 1);
    const __amdgpu_buffer_rsrc_t krs = __builtin_amdgcn_make_buffer_rsrc((void*)(Kf + (size_t)bh * SEQ * QKH), 0, SEQ * QKH * 2, 0x00020000);
    const __amdgpu_buffer_rsrc_t vrs = __builtin_amdgcn_make_buffer_rsrc((void*)(Vt + (size_t)bh * VH * SEQ), 0, VH * SEQ * 2, 0x00020000);
    unsigned kgo[3], kl[3], vgo[2], vl[2];
#pragma unroll
    for (int i = 0; i < 3; ++i) { const int c = tid + 512 * i, row = c / 24, col = c - row * 24; kgo[i] = (unsigned)(row * 384 + col * 16); kl[i] = (unsigned)(row * AT_KROW + col * 16); }
#pragma unroll
    for (int i = 0; i < 2; ++i) { const int c = tid + 512 * i, d = c >> 3, part = c & 7; vgo[i] = (unsigned)(d * (SEQ * 2) + part * 16); vl[i] = (unsigned)(AT_KBYTES + d * AT_VROW + part * 16); }
    u32x4 kr[3], vr[2];
#pragma unroll
    for (int i = 0; i < 3; ++i) kr[i] = __builtin_amdgcn_raw_buffer_load_b128(krs, kgo[i], 0, 0);
#pragma unroll
    for (int i = 0; i < 2; ++i) vr[i] = __builtin_amdgcn_raw_buffer_load_b128(vrs, vgo[i], 0, 0);
#pragma unroll
    for (int i = 0; i < 3; ++i) *(LAS u32x4*)(lds + kl[i]) = kr[i];
#pragma unroll
    for (int i = 0; i < 2; ++i) { *(LAS u32x2*)(lds + vl[i]) = (u32x2){vr[i].x, vr[i].y}; *(LAS u32x2*)(lds + vl[i] + 8) = (u32x2){vr[i].z, vr[i].w}; }
    __syncthreads();
    const unsigned kfo = (unsigned)(r32 * AT_KROW + 16 * hi), vfo = (unsigned)(AT_KBYTES + r32 * AT_VROW + 8 * hi);
#pragma unroll 1
    for (int t = 0; t < NT; ++t) {
        const unsigned sb = (unsigned)((t & 1) * AT_STAGE), sn = (unsigned)(((t + 1) & 1) * AT_STAGE);
        const bool more = t + 1 < NT;
        if (more) {
#pragma unroll
            for (int i = 0; i < 3; ++i) kr[i] = __builtin_amdgcn_raw_buffer_load_b128(krs, kgo[i], (t + 1) * (64 * 384), 0);
#pragma unroll
            for (int i = 0; i < 2; ++i) vr[i] = __builtin_amdgcn_raw_buffer_load_b128(vrs, vgo[i], (t + 1) * 128, 0);
        }
        const int k0 = 64 * t;
        if (k0 <= q0 + 31) {
            f32x16 s0, s1;
#pragma unroll
            for (int r = 0; r < 16; ++r) { s0[r] = 0.f; s1[r] = 0.f; }
#pragma unroll
            for (int ks = 0; ks < 12; ++ks) {
                const s16x8 ka = *(const LAS s16x8*)(lds + sb + kfo + 32 * ks), kb = *(const LAS s16x8*)(lds + sb + kfo + 32 * AT_KROW + 32 * ks);
                s0 = __builtin_amdgcn_mfma_f32_32x32x16_bf16(ka, qf[ks], s0, 0, 0, 0);
                s1 = __builtin_amdgcn_mfma_f32_32x32x16_bf16(kb, qf[ks], s1, 0, 0, 0);
                if ((ks & 3) == 3) __builtin_amdgcn_sched_barrier(0);
            }
            if (k0 + 63 > q0) {
                const int qa = q0 + r32 - k0 - 4 * hi;
#pragma unroll
                for (int r = 0; r < 16; ++r) { if (((r & 3) + 8 * (r >> 2)) > qa) s0[r] = -INFINITY; if ((32 + (r & 3) + 8 * (r >> 2)) > qa) s1[r] = -INFINITY; }
            }
            float mt = fmaxf(s0[0], s1[0]);
#pragma unroll
            for (int r = 1; r < 16; ++r) mt = fmaxf(mt, fmaxf(s0[r], s1[r]));
            mt = fmaxf(mt, __shfl_xor(mt, 32));
            const float mn = fmaxf(m, mt), alpha = __builtin_amdgcn_exp2f(m - mn);
            m = mn; l *= alpha;
#pragma unroll
            for (int d = 0; d < 4; ++d)
#pragma unroll
                for (int r = 0; r < 16; ++r) o[d][r] *= alpha;
            float ps = 0.f;
#pragma unroll
            for (int r = 0; r < 16; ++r) { s0[r] = __builtin_amdgcn_exp2f(s0[r] - mn); s1[r] = __builtin_amdgcn_exp2f(s1[r] - mn); ps += s0[r] + s1[r]; }
            l += ps;
#pragma unroll
            for (int s = 0; s < 4; ++s) {
                u32x4 pw;
                if (s < 2) { pw.x = cvtpk(s0[8 * s], s0[8 * s + 1]); pw.y = cvtpk(s0[8 * s + 2], s0[8 * s + 3]); pw.z = cvtpk(s0[8 * s + 4], s0[8 * s + 5]); pw.w = cvtpk(s0[8 * s + 6], s0[8 * s + 7]); }
                else { const int z = s - 2; pw.x = cvtpk(s1[8 * z], s1[8 * z + 1]); pw.y = cvtpk(s1[8 * z + 2], s1[8 * z + 3]); pw.z = cvtpk(s1[8 * z + 4], s1[8 * z + 5]); pw.w = cvtpk(s1[8 * z + 6], s1[8 * z + 7]); }
                const s16x8 pb = __builtin_bit_cast(s16x8, pw);
#pragma unroll
                for (int d = 0; d < 4; ++d) {
                    const unsigned va = sb + vfo + (unsigned)(d * 32 * AT_VROW + 32 * s);
                    const s16x4 lo = *(const LAS s16x4*)(lds + va), hh = *(const LAS s16x4*)(lds + va + 16);
                    const s16x8 vfrag = __builtin_shufflevector(lo, hh, 0, 1, 2, 3, 4, 5, 6, 7);
                    o[d] = __builtin_amdgcn_mfma_f32_32x32x16_bf16(vfrag, pb, o[d], 0, 0, 0);
                }
                __builtin_amdgcn_sched_barrier(0);
            }
        }
        if (more) {
#pragma unroll
            for (int i = 0; i < 3; ++i) *(LAS u32x4*)(lds + sn + kl[i]) = kr[i];
#pragma unroll
            for (int i = 0; i < 2; ++i) { *(LAS u32x2*)(lds + sn + vl[i]) = (u32x2){vr[i].x, vr[i].y}; *(LAS u32x2*)(lds + sn + vl[i] + 8) = (u32x2){vr[i].z, vr[i].w}; }
        }
        __syncthreads();
    }
    l += __shfl_xor(l, 32);
    const float inv = 1.f / l;
    bf16* Op = O + ((size_t)((bh >> 3) * SEQ + q0 + r32)) * DM + (bh & 7) * VH + 4 * hi;
#pragma unroll
    for (int d = 0; d < 4; ++d)
#pragma unroll
        for (int g = 0; g < 4; ++g) { u32x2 w; w.x = cvtpk(o[d][4 * g] * inv, o[d][4 * g + 1] * inv); w.y = cvtpk(o[d][4 * g + 2] * inv, o[d][4 * g + 3] * inv);
            *(u32x2*)(Op + 32 * d + 8 * g) = w; }
}
DI void ph_attn(const bf16* Qf, const bf16* Kf, const bf16* Vt, bf16* O, LAS unsigned char* lds, int vcu, int G, int wave, int lane) {
    for (int p = vcu; p < 256; p += G) {
        const int bh = p >> 3, s8 = p & 7;
#pragma unroll 1
        for (int u = 0; u < 2; ++u) attn_unit_lds(Qf, Kf, Vt, O, lds, bh, u ? s8 : 15 - s8, wave, lane);
    }
}

__global__ void __launch_bounds__(NWAVES * 64, 2) mk_fwd(Args args) {
    extern __shared__ __attribute__((aligned(16))) unsigned char lds_raw[];
    LAS unsigned char* lds = (LAS unsigned char*)lds_raw;
    const int tid = threadIdx.x, lane = tid & 63, wave = __builtin_amdgcn_readfirstlane(tid >> 6);
    const int G = gridDim.x, bx = blockIdx.x, vcu = (G % 8 == 0) ? (bx % 8) * (G / 8) + bx / 8 : bx;
    const int gw = vcu * NWAVES + wave, NGW = G * NWAVES;
    const size_t GT = (size_t)G * 512;
    unsigned char* ws = args.ws;
    for (int u = tid; u < (LDS_BYTES - LDSCTL_OFF) / 4; u += NWAVES * 64) ((LAS unsigned*)(lds + LDSCTL_OFF))[u] = 0u;
    __syncthreads();
    const bool multi = (args.ph_hi - args.ph_lo) > 1;
    XcdBarrier bar; bar.bar = (unsigned*)(ws + WS_CTL) + CW_BAR; bar.x = 0; bar.st = (volatile LAS unsigned*)(lds + MISC_OFF) + 8;
    if (multi) bar = xcd_barrier_post((unsigned*)(ws + WS_CTL) + CW_BAR, (volatile LAS unsigned*)(lds + MISC_OFF) + 8);

    float* X = args.out;
    const float* mod = (const float*)(ws + WS_MOD);
    bf16* XN = (bf16*)(ws + WS_XN);

    const int lo = args.ph_lo, hi = args.ph_hi;
#define IN(k) (EN(k) && lo <= (k) && (k) < hi)
    auto opq = [](int v) { asm volatile("" : "+v"(v)); return v; };
#define LN opq(lane)
#define TD opq(tid)
#define GTID ((size_t)vcu * 512 + (size_t)opq(tid))
#define SEAM(k) do { if (lo <= (k) && (k) + 1 < hi) xcd_barrier(bar); } while (0)
#define GEMM_BF16(Aptr, Bptr, NN, KK, Optr, LDC) do { pg8::Gemm g{(const bf16*)(Aptr), (const bf16*)(Bptr), MTOK, (NN), (KK)}; pg8::StaticOrder S; S.init(MTOK, (NN), G, bx); \
        pg8::EpiBf16<0> E{(bf16*)(Optr), (LDC), nullptr, 0, 0, 1.f}; pg8::gemm_phase<pg8::EpiBf16<0>, pg8::StaticOrder, true, true>(lds, g, S, E); } while (0)
#define GEMM_RES(Aptr, Bptr, BASE, OUT, GATE) do { pg8::Gemm g{(const bf16*)(Aptr), (const bf16*)(Bptr), MTOK, DM, DM}; pg8::StaticOrder S; S.init(MTOK, DM, G, bx); \
        EpiResGate E{(BASE), (OUT), (GATE)}; pg8::gemm_phase<EpiResGate, pg8::StaticOrder, true, true>(lds, g, S, E); } while (0)

    if (IN(0)) for (int r_ = 0; r_ < NREP(0); ++r_) ph_prologue(args, lds, TD, wave, vcu, G);
    SEAM(0);
    if (IN(1)) for (int r_ = 0; r_ < NREP(1); ++r_) ph_modulate((const float*)args.in[0], XN, nullptr, nullptr, (const float*)args.in[3], mod, 0, 1024, gw, NGW, LN);
    SEAM(1);
    if (IN(2)) for (int r_ = 0; r_ < NREP(2); ++r_) GEMM_BF16(XN, ws + WS_WCIN, 3072, 1024, ws + WS_BCV, 3072);
    SEAM(2);
    if (IN(3)) for (int r_ = 0; r_ < NREP(3); ++r_) ph_conv((const bf16*)(ws + WS_BCV), (const float*)args.in[8], (bf16*)(ws + WS_Z), GTID, GT);
    SEAM(3);
    if (IN(4)) for (int r_ = 0; r_ < NREP(4); ++r_) GEMM_RES(ws + WS_Z, ws + WS_WCOUT, (const float*)args.in[0], X, mod + 2048);
    SEAM(4);
    if (IN(5)) for (int r_ = 0; r_ < NREP(5); ++r_) ph_modulate(X, XN, ws + WS_XN8, (float*)(ws + WS_HS), (const float*)args.in[4], mod, 3072, 4096, gw, NGW, LN);
    SEAM(5);
    if (IN(6)) for (int r_ = 0; r_ < NREP(6); ++r_) GEMM_BF16(XN, ws + WS_WPQ0, 2048, 1024, ws + WS_PQ, 2048);
    SEAM(6);
    if (IN(7)) for (int r_ = 0; r_ < NREP(7); ++r_) ph_topk((const bf16*)(ws + WS_PQ), (const bf16*)(ws + WS_SUBK), (unsigned short*)(ws + WS_IDS), (float*)(ws + WS_GATES), lds, bx, G, wave, LN);
    SEAM(7);
    if (IN(8)) { ph_peer_u<0>(ws + WS_PU, (const unsigned short*)(ws + WS_IDS), ws + WS_XN8, (float*)(ws + WS_PART), bx, G, wave, LN);
        for (int r_ = 1; r_ < NREP(8); ++r_) ph_peer_u<PROBE_VAR>(ws + WS_PU, (const unsigned short*)(ws + WS_IDS), ws + WS_XN8, (float*)(ws + WS_DUMMY), bx, G, wave, LN); }
    SEAM(8);
    if (IN(9)) for (int r_ = 0; r_ < NREP(9); ++r_) ph_peer_c((const float*)(ws + WS_PART), (const float*)(ws + WS_GATES), (const float*)(ws + WS_HS), ws + WS_ACT, (float*)(ws + WS_AS), gw, NGW, LN);
    SEAM(9);
    if (IN(10)) { for (int r_ = 1; r_ < NREP(10); ++r_) ph_peer_v<PROBE_VAR>(ws + WS_PV, (const unsigned short*)(ws + WS_IDS), ws + WS_ACT, (const float*)(ws + WS_AS), X, (float*)(ws + WS_DUMMY), mod + 5120, lds, bx, wave, LN);
        ph_peer_v<0>(ws + WS_PV, (const unsigned short*)(ws + WS_IDS), ws + WS_ACT, (const float*)(ws + WS_AS), X, X, mod + 5120, lds, bx, wave, LN); }
    SEAM(10);
    if (IN(11)) for (int r_ = 0; r_ < NREP(11); ++r_) ph_modulate(X, XN, nullptr, nullptr, (const float*)args.in[3] + DM, mod + (size_t)4 * 6144, 0, 1024, gw, NGW, LN);
    SEAM(11);
    if (IN(12)) for (int r_ = 0; r_ < NREP(12); ++r_) GEMM_BF16(XN, ws + WS_WMIN, MLA_IN_PAD, 1024, ws + WS_LAT, MLA_IN_PAD);
    SEAM(12);
    if (IN(13)) for (int r_ = 0; r_ < NREP(13); ++r_) ph_latnorm((const bf16*)(ws + WS_LAT), (const float*)args.in[11], (const float*)args.in[12], (bf16*)(ws + WS_QN), (bf16*)(ws + WS_KVN), gw, NGW, LN);
    SEAM(13);
    if (IN(14)) for (int r_ = 0; r_ < NREP(14); ++r_) { GEMM_BF16(ws + WS_QN, ws + WS_WQB, 1536, QLORA, ws + WS_QRAW, 1536); GEMM_BF16(ws + WS_KVN, ws + WS_WKVB, 2048, KVLORA, ws + WS_KVRAW, 2048); }
    SEAM(14);
    if (IN(15)) for (int r_ = 0; r_ < NREP(15); ++r_) ph_qkprep((const bf16*)(ws + WS_QRAW), (const bf16*)(ws + WS_KVRAW), (const bf16*)(ws + WS_LAT), (const int*)args.in[2], (const float*)args.in[15], (const float*)args.in[16],
                          (bf16*)(ws + WS_QF), (bf16*)(ws + WS_KF), (bf16*)(ws + WS_VT), gw, NGW, LN);
    SEAM(15);
    if (IN(16)) for (int r_ = 0; r_ < NREP(16); ++r_) ph_attn((const bf16*)(ws + WS_QF), (const bf16*)(ws + WS_KF), (const bf16*)(ws + WS_VT), (bf16*)(ws + WS_O), lds, vcu, G, wave, LN);
    SEAM(16);
    if (IN(17)) for (int r_ = 0; r_ < NREP(17); ++r_) GEMM_RES(ws + WS_O, ws + WS_WMOUT, (const float*)X, (r_ + 1 < NREP(17) ? (float*)(ws + WS_DUMMY) : X), mod + (size_t)4 * 6144 + 2048);
    SEAM(17);
    if (IN(18)) for (int r_ = 0; r_ < NREP(18); ++r_) ph_modulate(X, XN, ws + WS_XN8, (float*)(ws + WS_HS), (const float*)args.in[4] + DM, mod + (size_t)4 * 6144, 3072, 4096, gw, NGW, LN);
    SEAM(18);
    if (IN(19)) for (int r_ = 0; r_ < NREP(19); ++r_) GEMM_BF16(XN, ws + WS_WPQ1, 2048, 1024, ws + WS_PQ, 2048);
    SEAM(19);
    if (IN(20)) for (int r_ = 0; r_ < NREP(20); ++r_) ph_topk((const bf16*)(ws + WS_PQ), (const bf16*)(ws + WS_SUBK) + (size_t)8 * 2 * 128 * 128, (unsigned short*)(ws + WS_IDS), (float*)(ws + WS_GATES), lds, bx, G, wave, LN);
    SEAM(20);
    if (IN(21)) for (int r_ = 0; r_ < NREP(21); ++r_) ph_peer_u<0>(ws + WS_PU + (size_t)8 * NEXP * 128, (const unsigned short*)(ws + WS_IDS), ws + WS_XN8, (float*)(ws + WS_PART), bx, G, wave, LN);
    SEAM(21);
    if (IN(22)) for (int r_ = 0; r_ < NREP(22); ++r_) ph_peer_c((const float*)(ws + WS_PART), (const float*)(ws + WS_GATES), (const float*)(ws + WS_HS), ws + WS_ACT, (float*)(ws + WS_AS), gw, NGW, LN);
    SEAM(22);
    if (IN(23)) for (int r_ = 0; r_ < NREP(23); ++r_) ph_peer_v<0>(ws + WS_PV + (size_t)128 * NEXP * 8, (const unsigned short*)(ws + WS_IDS), ws + WS_ACT, (const float*)(ws + WS_AS), X, (r_ + 1 < NREP(23) ? (float*)(ws + WS_DUMMY) : X), mod + (size_t)4 * 6144 + 5120, lds, bx, wave, LN);
}

extern "C" void kernel_launch(void* const* d_in, const int* in_sizes, int n_in, void* d_out, int out_size, void* d_ws, size_t ws_size, hipStream_t stream) {
    static int grid = 0;
    if (grid == 0) {
        if (n_in != 22 || out_size != MTOK * DM || ws_size < WS_END) { fprintf(stderr, "kernel_launch: unexpected shapes: n_in %d out %d ws %zu (need %zu)\n", n_in, out_size, ws_size, (size_t)WS_END); grid = -1; return; }
        int dev = 0, cus = 0;
        if (hipGetDevice(&dev) != hipSuccess || hipDeviceGetAttribute(&cus, hipDeviceAttributeMultiprocessorCount, dev) != hipSuccess) { grid = -1; return; }
        if (hipFuncSetAttribute((const void*)mk_fwd, hipFuncAttributeMaxDynamicSharedMemorySize, LDS_BYTES) != hipSuccess) { fprintf(stderr, "kernel_launch: hipFuncSetAttribute failed\n"); grid = -1; return; }
        int per_cu = 0;
        if (hipOccupancyMaxActiveBlocksPerMultiprocessor(&per_cu, (const void*)mk_fwd, NWAVES * 64, LDS_BYTES) != hipSuccess || per_cu < 1) fprintf(stderr, "kernel_launch: occupancy query says %d\n", per_cu);
        (void)hipGetLastError();
        grid = cus;
        if (grid != 256) { fprintf(stderr, "kernel_launch: built for a 256-CU device (PEER value phase maps 128 dim slices x 2 token halves onto 256 workgroups); found %d CUs\n", grid); grid = -1; return; }
    }
    if (grid < 0) return;
    (void)hipMemsetAsync((char*)d_ws + WS_CTL, 0, CTL_ZERO_BYTES, stream);
    Args a{};
    for (int i = 0; i < 22; ++i) a.in[i] = d_in[i];
    a.out = (float*)d_out; a.ws = (unsigned char*)d_ws;
#if MK_N_LAUNCHES == 1
    a.ph_lo = 0; a.ph_hi = NPHASES;
    hipLaunchKernelGGL(mk_fwd, dim3(grid), dim3(NWAVES * 64), LDS_BYTES, stream, a);
#else
    for (int ph = 0; ph < NPHASES; ++ph) { a.ph_lo = ph; a.ph_hi = ph + 1; hipLaunchKernelGGL(mk_fwd, dim3(grid), dim3(NWAVES * 64), LDS_BYTES, stream, a); }
#endif
}
```

```cpp
#include <hip/hip_runtime.h>
#include <cstdio>
#include <cstdint>
#define GAS __attribute__((address_space(1)))
#define LAS __attribute__((address_space(3)))
namespace pg8 {
#define PG8_LAS __attribute__((address_space(3)))
typedef unsigned short bf16_t;
typedef short bf16x8 __attribute__((ext_vector_type(8)));
typedef float f32x4 __attribute__((ext_vector_type(4)));
typedef unsigned u32x4 __attribute__((ext_vector_type(4)));
constexpr int BM = 256, BK = 64, HALF = 128, HTB = HALF * BK * 2  , STAGE_BYTES = 8 * HTB, NXCD = 8, WGM = 8;

__host__ __device__ __forceinline__ int lds_byte(int r, int c) { const int st = (r >> 4) * 2 + (c >> 5), rr = r & 15, cc = c & 31, ob = rr * 64 + cc * 2; return st * 1024 + (ob ^ (((ob >> 9) & 1) << 5)); }
__host__ __device__ __forceinline__ void stage_rc(int b, int& R, int& C) { const int st = b / 1024, sb = b % 1024, swz = sb ^ (((sb >> 9) & 1) << 5); R = (st >> 1) * 16 + swz / 64; C = (st & 1) * 32 + (swz % 64) / 2; }
__host__ __device__ __forceinline__ int perm32(int rho) { const int n = rho >> 4, i = rho & 15; return 8 * (i >> 2) + 4 * n + (i & 3); }

struct Unit { int pm, pn; };
struct Gemm { const bf16_t* A; const bf16_t* Bt; int M, N, K; };

struct StaticOrder {
    int nM, nN, nwg, G, c;
    __host__ __device__ void init(int M, int N, int G_, int c_) { nM = M / BM; nN = N / BM; nwg = nM * nN; G = G_; c = c_; }
    __host__ __device__ bool next(int i, Unit& u) const {
        const long L = (long)i * G + c; if (L >= nwg) return false;
        int wgid = (int)L; { const int q = nwg / NXCD, r = nwg % NXCD, xcd = wgid % NXCD, off = wgid / NXCD; wgid = (xcd < r ? xcd * (q + 1) : r * (q + 1) + (xcd - r) * q) + off; }
        const int nig = WGM * nN, gid = wgid / nig, fm = gid * WGM, gsz = (nM - fm) < WGM ? (nM - fm) : WGM;
        u.pm = fm + ((wgid % nig) % gsz); u.pn = (wgid % nig) / gsz; return true;
    }
    __device__ __forceinline__ void a_ready(const Unit&) const {}
    __device__ __forceinline__ void done(const Unit&) const {}
};

__device__ __forceinline__ unsigned cvt_pk_bf16(float lo, float hi) { unsigned r; asm volatile("v_cvt_pk_bf16_f32 %0, %1, %2" : "=v"(r) : "v"(lo), "v"(hi)); return r; }
typedef float f32x2 __attribute__((ext_vector_type(2)));
__device__ __forceinline__ f32x2 gelu_pk(f32x2 v) {
    const f32x2 av = __builtin_elementwise_abs(v), d = av * 0.2316418882f + 1.0f;
    f32x2 t; t.x = __builtin_amdgcn_rcpf(d.x); t.y = __builtin_amdgcn_rcpf(d.y);
    f32x2 q = t * 0.5307027145f + (-0.7265760135f); q = q * t + 0.7107068705f; q = q * t + (-0.142248368f); q = q * t + 0.127414796f; q = q * t;
    const f32x2 s = (v * v) * (-0.72134752044f);
    f32x2 e; e.x = __builtin_amdgcn_exp2f(s.x); e.y = __builtin_amdgcn_exp2f(s.y);
    const f32x2 m = v * (q * e), r = v - m;
    f32x2 o; o.x = v.x < 0.f ? m.x : r.x; o.y = v.y < 0.f ? m.y : r.y; return o;
}

template <int ACT  > struct EpiBf16 {
    static constexpr bool PERM = true, AFTER_DRAIN = false; static_assert(ACT == 0 || ACT == 1, "EpiBf16: ACT is 0 (none) or 1 (gelu_pk)");
    bf16_t* O; int ldc; const float* bias; int split_cols; size_t split_stride; float scale0;
    __device__ __forceinline__ void operator()(const f32x4 (&acc)[2][2][4][2], const Unit& u, int wr, int wc, int fr, int fq) const {
        const int row0 = u.pm * BM + wr * 64 + fr; int colt = u.pn * BM; bf16_t* base = O;
        float sc = 1.f; if (split_cols) { const int t = colt / split_cols; base += (size_t)t * split_stride; colt -= t * split_cols; if (t == 0) sc = scale0; }
        const int col0 = colt + wc * 32 + 8 * fq, bcol0 = u.pn * BM + wc * 32 + 8 * fq;
        f32x4 bv[2][2];
#pragma unroll
        for (int bj = 0; bj < 2; ++bj)
#pragma unroll
            for (int n = 0; n < 2; ++n) bv[bj][n] = bias ? *(const f32x4*)(bias + bcol0 + bj * HALF + 4 * n) : (f32x4){0.f, 0.f, 0.f, 0.f};
#pragma unroll
        for (int ai = 0; ai < 2; ++ai)
#pragma unroll
            for (int m = 0; m < 4; ++m) { bf16_t* rowp = base + (size_t)(row0 + ai * HALF + m * 16) * ldc + col0;
#pragma unroll
                for (int bj = 0; bj < 2; ++bj) { f32x4 v0 = acc[ai][bj][m][0] + bv[bj][0], v1 = acc[ai][bj][m][1] + bv[bj][1];
                    if (ACT == 1) { f32x2 a = gelu_pk((f32x2){v0[0], v0[1]}), b = gelu_pk((f32x2){v0[2], v0[3]}), c = gelu_pk((f32x2){v1[0], v1[1]}), d = gelu_pk((f32x2){v1[2], v1[3]});
                        v0 = (f32x4){a.x, a.y, b.x, b.y}; v1 = (f32x4){c.x, c.y, d.x, d.y}; }
                    v0 = v0 * sc; v1 = v1 * sc; u32x4 w; w.x = cvt_pk_bf16(v0[0], v0[1]); w.y = cvt_pk_bf16(v0[2], v0[3]); w.z = cvt_pk_bf16(v1[0], v1[1]); w.w = cvt_pk_bf16(v1[2], v1[3]);
                    *(u32x4*)(rowp + bj * HALF) = w; } }
    }
};

template <class Epi, class Sched, bool ALIGN_EPI = false, bool SP2 = false>
__device__ __forceinline__ void gemm_phase(PG8_LAS unsigned char* lds, const Gemm g, const Sched& S, const Epi& E) {
    int tid_raw = threadIdx.x; asm volatile("" : "+v"(tid_raw));
    const int tid = tid_raw, wid = __builtin_amdgcn_readfirstlane(tid >> 6), lane = tid & 63, wr = wid >> 2, wc = wid & 3, fr = lane & 15, fq = lane >> 4;
    const int K = g.K, nt = K / BK;
    unsigned voffA[2], voffB[2];
#pragma unroll
    for (int i = 0; i < 2; ++i) { int R, C; stage_rc(tid * 16 + i * 8192, R, C); const int Rb = Epi::PERM ? ((R & ~31) + perm32(R & 31)) : R;
        voffA[i] = (unsigned)(R * K + C) * 2u; voffB[i] = (unsigned)(Rb * K + C) * 2u; }
    const size_t kstep = (size_t)(BK * 2);
    const size_t hstep = (size_t)HALF * K * 2;
    const size_t tstep = 2 * hstep;
    const unsigned ldsw = (unsigned)wid * 1024u;
    const int aoff = lds_byte(wr * 64 + fr, fq * 8), boff = lds_byte(wc * 32 + fr, fq * 8);
#define PG8_SA(b, h) (((b) * 2 + (h)) * HTB)
#define PG8_SB(b, h) ((4 + (b) * 2 + (h)) * HTB)
#define PG8_STAGE(bufoff, gbase, voff) do { _Pragma("unroll") for (int _i = 0; _i < 2; ++_i) \
        __builtin_amdgcn_global_load_lds((const unsigned*)((const char*)(gbase) + (voff)[_i]), (PG8_LAS unsigned*)(lds + (bufoff) + ldsw + _i * 8192), 16, 0, 0); } while (0)
#define PG8_LDA(dst, b, h) do { _Pragma("unroll") for (int m = 0; m < 4; ++m) _Pragma("unroll") for (int k = 0; k < 2; ++k) dst[m][k] = *(const PG8_LAS bf16x8*)(lds + PG8_SA(b, h) + aoff + m * 2048 + k * 1024); } while (0)
#define PG8_LDB(dst, b, h) do { _Pragma("unroll") for (int n = 0; n < 2; ++n) _Pragma("unroll") for (int k = 0; k < 2; ++k) dst[n][k] = *(const PG8_LAS bf16x8*)(lds + PG8_SB(b, h) + boff + n * 2048 + k * 1024); } while (0)
#define PG8_MMA(ai, bj, At, Bt) do { __builtin_amdgcn_s_setprio(1); _Pragma("unroll") for (int m = 0; m < 4; ++m) _Pragma("unroll") for (int n = 0; n < 2; ++n) _Pragma("unroll") for (int k = 0; k < 2; ++k) \
        acc[ai][bj][m][n] = __builtin_amdgcn_mfma_f32_16x16x32_bf16(Bt[n][k], At[m][k], acc[ai][bj][m][n], 0, 0, 0); __builtin_amdgcn_s_setprio(0); } while (0)
#define PG8_WAIT_V(n) asm volatile("s_waitcnt vmcnt(" #n ")" ::: "memory")
#define PG8_WAIT_L(n) asm volatile("s_waitcnt lgkmcnt(" #n ")" ::: "memory")
#define PG8_BAR __builtin_amdgcn_s_barrier()
#define PG8_SCHED __builtin_amdgcn_sched_barrier(0)
    Unit cur, nxt; int ui = 0;
    if (!S.next(0, cur)) return;
    f32x4 acc[2][2][4][2];
#pragma unroll
    for (int a = 0; a < 2; ++a)
#pragma unroll
        for (int b = 0; b < 2; ++b)
#pragma unroll
            for (int m = 0; m < 4; ++m)
#pragma unroll
                for (int n = 0; n < 2; ++n) acc[a][b][m][n] = (f32x4){0.f, 0.f, 0.f, 0.f};
    bf16x8 At[4][2], B0[2][2], B1[2][2];
    const char* cA = (const char*)g.A + (size_t)cur.pm * tstep; const char* cB = (const char*)g.Bt + (size_t)cur.pn * tstep;
    S.a_ready(cur);
    if constexpr (SP2) {
        PG8_STAGE(PG8_SB(0, 0), cB, voffB); PG8_STAGE(PG8_SB(0, 1), cB + hstep, voffB); PG8_STAGE(PG8_SA(0, 0), cA, voffA); PG8_STAGE(PG8_SA(0, 1), cA + hstep, voffA);
        if (wr == 1) PG8_BAR;
        PG8_WAIT_V(2); PG8_BAR;
        PG8_STAGE(PG8_SB(1, 0), cB + kstep, voffB); PG8_STAGE(PG8_SA(1, 0), cA + kstep, voffA); PG8_STAGE(PG8_SB(1, 1), cB + hstep + kstep, voffB);
        PG8_WAIT_V(6); PG8_BAR;
    } else {
        PG8_STAGE(PG8_SB(0, 0), cB, voffB); PG8_STAGE(PG8_SA(0, 0), cA, voffA); PG8_STAGE(PG8_SB(0, 1), cB + hstep, voffB); PG8_STAGE(PG8_SA(0, 1), cA + hstep, voffA);
        if (wr == 1) PG8_BAR;
        PG8_WAIT_V(4); PG8_BAR;
        PG8_STAGE(PG8_SB(1, 0), cB + kstep, voffB); PG8_STAGE(PG8_SA(1, 0), cA + kstep, voffA); PG8_STAGE(PG8_SB(1, 1), cB + hstep + kstep, voffB);
        PG8_WAIT_V(6); PG8_BAR;
    }
    for (;;) {
        const bool has_next = S.next(ui + 1, nxt);
        const char* nA = has_next ? (const char*)g.A + (size_t)nxt.pm * tstep : cA; const char* nB = has_next ? (const char*)g.Bt + (size_t)nxt.pn * tstep : cB;
        for (int t = 0; t < nt; t += 2) {
            const bool last = (t == nt - 2);
            const char* a1 = cA + (size_t)(t + 1) * kstep;
            const char* a2 = last ? nA : cA + (size_t)(t + 2) * kstep; const char* b2 = last ? nB : cB + (size_t)(t + 2) * kstep;
            const char* a3 = a2 + kstep; const char* b3 = b2 + kstep;
            if (last && has_next) S.a_ready(nxt);
            if constexpr (SP2) {
            PG8_LDB(B0, 0, 0); PG8_LDB(B1, 0, 1); PG8_SCHED; PG8_LDA(At, 0, 0); PG8_STAGE(PG8_SA(1, 1), a1 + hstep, voffA);
            PG8_WAIT_V(8); PG8_WAIT_L(0); PG8_BAR; PG8_MMA(0, 0, At, B0); PG8_MMA(0, 1, At, B1); PG8_BAR; PG8_SCHED;
            PG8_LDA(At, 0, 1); PG8_STAGE(PG8_SB(0, 0), b2, voffB); PG8_STAGE(PG8_SB(0, 1), b2 + hstep, voffB); PG8_STAGE(PG8_SA(0, 0), a2, voffA);
            PG8_WAIT_V(8); PG8_WAIT_L(0); PG8_BAR; PG8_MMA(1, 0, At, B0); PG8_MMA(1, 1, At, B1); PG8_BAR; PG8_SCHED;
            PG8_LDB(B0, 1, 0); PG8_LDB(B1, 1, 1); PG8_SCHED; PG8_LDA(At, 1, 0); PG8_STAGE(PG8_SA(0, 1), a2 + hstep, voffA);
            PG8_WAIT_V(8); PG8_WAIT_L(0); PG8_BAR; PG8_MMA(0, 0, At, B0); PG8_MMA(0, 1, At, B1); PG8_BAR; PG8_SCHED;
            PG8_LDA(At, 1, 1); PG8_STAGE(PG8_SB(1, 0), b3, voffB); PG8_STAGE(PG8_SB(1, 1), b3 + hstep, voffB); PG8_STAGE(PG8_SA(1, 0), a3, voffA);
            PG8_WAIT_V(8); PG8_WAIT_L(0); PG8_BAR; PG8_MMA(1, 0, At, B0); PG8_MMA(1, 1, At, B1); PG8_BAR; PG8_SCHED;
            } else {
            PG8_LDB(B0, 0, 0); PG8_SCHED; PG8_LDA(At, 0, 0); PG8_STAGE(PG8_SA(1, 1), a1 + hstep, voffA);
            PG8_WAIT_L(8); PG8_BAR; PG8_WAIT_L(0); PG8_MMA(0, 0, At, B0); PG8_BAR; PG8_SCHED;
            PG8_LDB(B1, 0, 1); PG8_STAGE(PG8_SB(0, 0), b2, voffB);
            PG8_BAR; PG8_WAIT_L(0); PG8_MMA(0, 1, At, B1); PG8_BAR;
            PG8_LDA(At, 0, 1); PG8_STAGE(PG8_SA(0, 0), a2, voffA);
            PG8_BAR; PG8_WAIT_L(0); PG8_MMA(1, 0, At, B0); PG8_BAR; PG8_SCHED;
            PG8_STAGE(PG8_SB(0, 1), b2 + hstep, voffB);
            PG8_WAIT_V(6); PG8_BAR; PG8_MMA(1, 1, At, B1); PG8_BAR;
            PG8_LDB(B0, 1, 0); PG8_SCHED; PG8_LDA(At, 1, 0); PG8_STAGE(PG8_SA(0, 1), a2 + hstep, voffA);
            PG8_WAIT_L(8); PG8_BAR; PG8_WAIT_L(0); PG8_MMA(0, 0, At, B0); PG8_BAR; PG8_SCHED;
            PG8_LDB(B1, 1, 1); PG8_STAGE(PG8_SB(1, 0), b3, voffB);
            PG8_BAR; PG8_WAIT_L(0); PG8_MMA(0, 1, At, B1); PG8_BAR;
            PG8_LDA(At, 1, 1); PG8_STAGE(PG8_SA(1, 0), a3, voffA);
            PG8_BAR; PG8_WAIT_L(0); PG8_MMA(1, 0, At, B0); PG8_BAR; PG8_SCHED;
            PG8_STAGE(PG8_SB(1, 1), b3 + hstep, voffB);
            PG8_WAIT_V(6); PG8_BAR; PG8_MMA(1, 1, At, B1); PG8_BAR;
            }
        }
        if constexpr (ALIGN_EPI) { if (wr == 0) PG8_BAR; }
        if constexpr (!Epi::AFTER_DRAIN) { E(acc, cur, wr, wc, fr, fq); S.done(cur); }
        if (!has_next) break;
#pragma unroll
        for (int a = 0; a < 2; ++a)
#pragma unroll
            for (int b = 0; b < 2; ++b)
#pragma unroll
                for (int m = 0; m < 4; ++m)
#pragma unroll
                    for (int n = 0; n < 2; ++n) acc[a][b][m][n] = (f32x4){0.f, 0.f, 0.f, 0.f};
        cur = nxt; cA = nA; cB = nB; ++ui;
        if constexpr (ALIGN_EPI) { if (wr == 1) PG8_BAR; }
    }
    PG8_WAIT_V(0);
    if constexpr (!ALIGN_EPI) { if (wr == 0) PG8_BAR; }
    PG8_BAR;
    if constexpr (Epi::AFTER_DRAIN) { E.fused(acc, cur, wr, wc, fr, fq, lds, wid, lane); S.done(cur); }
#undef PG8_SA
#undef PG8_SB
#undef PG8_STAGE
#undef PG8_LDA
#undef PG8_LDB
#undef PG8_MMA
#undef PG8_WAIT_V
#undef PG8_WAIT_L
#undef PG8_BAR
#undef PG8_SCHED
}
}
#define XB_TMO      128
#define XB_XCNT(j)  (256  + 64 * (j))
#define XB_XSUB(j)  (1280 + 64 * (j))
#define XB_XGEN(j)  (2304 + 64 * (j))
#define XB_TOP      3328
#define XB_TOPGEN   3392
#define XCD_BAR_WORDS 3456
#define XB_SPIN_CAP (1u << 18)

__device__ __forceinline__ unsigned xb_ld(unsigned* p)              { return __hip_atomic_load(p, __ATOMIC_RELAXED, __HIP_MEMORY_SCOPE_AGENT); }
__device__ __forceinline__ unsigned xb_add(unsigned* p, unsigned v) { return __hip_atomic_fetch_add(p, v, __ATOMIC_RELAXED, __HIP_MEMORY_SCOPE_AGENT); }
__device__ __forceinline__ unsigned xb_xcc_id() { return (unsigned)__builtin_amdgcn_s_getreg((3 << 11) | 20) & 0xFu; }
#define XB_SPIN(cond, bar) do { unsigned _sp = 0; while (cond) { __builtin_amdgcn_s_sleep(1); \
    if ((++_sp & 255u) == 0u) { if (xb_ld(&(bar)[XB_TMO])) break; if (_sp > XB_SPIN_CAP) { atomicAdd(&(bar)[XB_TMO], 1u); break; } } } } while (0)

struct XcdBarrier {
    unsigned* bar; unsigned x;
    volatile LAS unsigned* st;
};

__device__ __forceinline__ XcdBarrier xcd_barrier_post(unsigned* bar, volatile LAS unsigned* st) {
    XcdBarrier b; b.bar = bar; b.x = xb_xcc_id(); b.st = st;
    if (threadIdx.x == 0) (void)xb_add(&bar[XB_XCNT(b.x)], 1u);
    return b;
}
__device__ __forceinline__ void xcd_barrier_complete(unsigned* bar, unsigned x, unsigned& nloc, unsigned& nx) {
    const unsigned G = gridDim.x * gridDim.y * gridDim.z;
    unsigned sum, cnt, mine, sp = 0u;
    for (;;) {
        sum = 0u; cnt = 0u; mine = 0u;
#pragma unroll
        for (unsigned j = 0; j < 16; ++j) { const unsigned c = xb_ld(&bar[XB_XCNT(j)]); sum += c; cnt += (c > 0u) ? 1u : 0u; mine = (j == x) ? c : mine; }
        if (sum == G) break;
        __builtin_amdgcn_s_sleep(1);
        if ((++sp & 255u) == 0u) { if (xb_ld(&bar[XB_TMO])) break; if (sp > XB_SPIN_CAP) { atomicAdd(&bar[XB_TMO], 1u); break; } }
    }
    nloc = mine > 0u ? mine : 1u; nx = cnt > 0u ? cnt : 1u;
}

__device__ __forceinline__ void xcd_barrier(const XcdBarrier& b) {
    asm volatile("s_waitcnt vmcnt(0)" ::: "memory");
    __syncthreads();
    if (threadIdx.x == 0) {
        unsigned* bar = b.bar;
        __builtin_amdgcn_s_waitcnt(0);
        unsigned nloc = b.st[0], nx = b.st[1];
        if (nloc == 0u) { xcd_barrier_complete(bar, b.x, nloc, nx); b.st[0] = nloc; b.st[1] = nx; }
        const unsigned old = xb_add(&bar[XB_XSUB(b.x)], 1u);
        const unsigned gen = old / nloc;
        if (old + 1u == (gen + 1u) * nloc) {
            __builtin_amdgcn_fence(__ATOMIC_RELEASE, "agent");
            asm volatile("s_waitcnt vmcnt(0)" ::: "memory");
            const unsigned og = xb_add(&bar[XB_TOP], 1u);
            const unsigned tg = og / nx;
            if (og + 1u == (tg + 1u) * nx) xb_add(&bar[XB_TOPGEN], 1u);
            else XB_SPIN(xb_ld(&bar[XB_TOPGEN]) == tg, bar);
            __builtin_amdgcn_fence(__ATOMIC_ACQUIRE, "agent");
            xb_add(&bar[XB_XGEN(b.x)], 1u);
            asm volatile("s_waitcnt vmcnt(0)" ::: "memory");
        } else {
            XB_SPIN(xb_ld(&bar[XB_XGEN(b.x)]) == gen, bar);
            __builtin_amdgcn_fence(__ATOMIC_ACQUIRE, "agent");
            asm volatile("s_waitcnt vmcnt(0)" ::: "memory");
        }
    }
    __syncthreads();
}

constexpr int DM = 1024, NB = 4, SEQ = 4096, MTOK = NB * SEQ;
constexpr int QLORA = 384, KVLORA = 256, ROPE = 64, NOPE = 128, QKH = 192, VH = 128, NH = 8;
constexpr int MLA_IN = 704, MLA_IN_PAD = 768;
constexpr int NEXP = 16384;
constexpr float NORM_EPS = 1e-6f;
constexpr float U8_SCALE = 256.f, V8_SCALE = 16.f, H8_SCALE = 8.f;
constexpr float VI8_SCALE = 127.f / (4.5f * 0.5f);
constexpr float UI8_SCALE = 127.f * 32.f / 4.5f;
constexpr float QSCALE = 0.07216878364870322f * 1.4426950408889634f;

#ifndef MK_N_LAUNCHES
#define MK_N_LAUNCHES 1
#endif
constexpr int NPHASES = 24;
#ifndef PHMASK
#define PHMASK 0xFFFFFFu
#endif
#define EN(k) (((PHMASK) >> (k)) & 1u)
#ifndef PROBE_PHASE
#define PROBE_PHASE -1
#endif
#ifndef PROBE_VAR
#define PROBE_VAR 0
#endif
#ifndef PROBE_REPS
#define PROBE_REPS 2
#endif
#define NREP(k) ((k) == (PROBE_PHASE) ? (PROBE_REPS) : 1)
constexpr int NWAVES = 8;

constexpr size_t MiB = 1u << 20;
constexpr size_t WS_CTL = 0, CTL_ZERO_BYTES = 64 * 1024;
constexpr size_t WS_MOD = 1 * MiB;
constexpr size_t WS_WCIN = 2 * MiB;
constexpr size_t WS_WCOUT = 8 * MiB;
constexpr size_t WS_WPQ0 = 10 * MiB, WS_WPQ1 = 14 * MiB;
constexpr size_t WS_WMIN = 18 * MiB;
constexpr size_t WS_WQB = 20 * MiB;
constexpr size_t WS_WKVB = 22 * MiB;
constexpr size_t WS_WMOUT = 24 * MiB;
constexpr size_t WS_SUBK = 26 * MiB;
constexpr size_t WS_PU = 32 * MiB;
constexpr size_t WS_PV = 96 * MiB;
constexpr size_t WS_XN = 160 * MiB;
constexpr size_t WS_VT = 160 * MiB;
constexpr size_t WS_BCV = 192 * MiB;
constexpr size_t WS_LAT = 192 * MiB;
constexpr size_t WS_O = 192 * MiB;
constexpr size_t WS_QN = 216 * MiB;
constexpr size_t WS_KVN = 228 * MiB;
constexpr size_t WS_QRAW = 236 * MiB;
constexpr size_t WS_Z = 288 * MiB;
constexpr size_t WS_KVRAW = 288 * MiB;
constexpr size_t WS_PQ = 288 * MiB;
constexpr size_t WS_QF = 352 * MiB;
constexpr size_t WS_KF = 400 * MiB;
constexpr size_t WS_IDS = 448 * MiB;
constexpr size_t WS_GATES = 456 * MiB;
constexpr size_t WS_PART = 192 * MiB;
constexpr size_t WS_DUMMY = 288 * MiB;
constexpr size_t WS_ACT = 464 * MiB;
constexpr size_t WS_XN8 = 472 * MiB;
constexpr size_t WS_HS = 488 * MiB;
constexpr size_t WS_AS = 489 * MiB;
constexpr size_t WS_END = 490 * MiB;
constexpr int CW_BAR = 1024;

constexpr int RING_BYTES = 131072;
constexpr int LDSCTL_OFF = RING_BYTES, MISC_OFF = LDSCTL_OFF + 320;
constexpr int LDS_BYTES = 147456;


typedef unsigned short bf16;
typedef unsigned u32x4 __attribute__((ext_vector_type(4)));
typedef unsigned u32x2 __attribute__((ext_vector_type(2)));
typedef float f32x4 __attribute__((ext_vector_type(4)));
typedef float f32x16 __attribute__((ext_vector_type(16)));
typedef short s16x8 __attribute__((ext_vector_type(8)));
typedef short s16x4 __attribute__((ext_vector_type(4)));
#define LDS_WAIT() asm volatile("s_waitcnt lgkmcnt(0)" ::: "memory")
#define VM_WAIT() asm volatile("s_waitcnt vmcnt(0)" ::: "memory")
#define DI __device__ __forceinline__

DI unsigned f2bf(float f) { unsigned u = __builtin_bit_cast(unsigned, f); return (u + 0x7fffu + ((u >> 16) & 1u)) >> 16; }
DI unsigned pk2(float lo, float hi) { return f2bf(lo) | (f2bf(hi) << 16); }
DI float bflo(unsigned u) { return __uint_as_float(u << 16); }
DI float bfhi(unsigned u) { return __uint_as_float(u & 0xffff0000u); }
DI float bf1(bf16 b) { return __uint_as_float((unsigned)b << 16); }
DI float wave_sum(float v) {
#pragma unroll
    for (int o = 32; o > 0; o >>= 1) v += __shfl_xor(v, o);
    return v;
}
DI int crow(int r, int hi) { return (r & 3) + 8 * (r >> 2) + 4 * hi; }

struct Args { const void* in[22]; float* out; unsigned char* ws; int ph_lo, ph_hi; };

DI void transpose_item(const float* W, int K, int N, bf16* WT, LAS float* scr, int item, int lane) {
    const int nblk = N / 32, kb = item / nblk, nb = item % nblk, k0 = 64 * kb, n0 = 32 * nb;
#pragma unroll 8
    for (int i = 0; i < 32; ++i) { const int kk = 2 * i + (lane >> 5); scr[kk * 33 + (lane & 31)] = W[(size_t)(k0 + kk) * N + n0 + (lane & 31)]; }
    LDS_WAIT(); asm volatile("" ::: "memory");
    const int c = lane & 7;
#pragma unroll
    for (int j = 0; j < 4; ++j) { const int n = (lane >> 3) + 8 * j; const LAS float* s = scr + (8 * c) * 33 + n;
        u32x4 o; o.x = pk2(s[0 * 33], s[1 * 33]); o.y = pk2(s[2 * 33], s[3 * 33]); o.z = pk2(s[4 * 33], s[5 * 33]); o.w = pk2(s[6 * 33], s[7 * 33]);
        *(u32x4*)(WT + (size_t)(n0 + n) * K + k0 + 8 * c) = o; }
    LDS_WAIT(); asm volatile("" ::: "memory");
}
DI void cvt_f32_bf16(const float* src, bf16* dst, size_t n8, size_t gt, size_t GT) {
#pragma unroll 4
    for (size_t i = gt; i < n8; i += GT) {
        const f32x4 a = ((const f32x4*)src)[2 * i], b = ((const f32x4*)src)[2 * i + 1];
        u32x4 o; o.x = pk2(a.x, a.y); o.y = pk2(a.z, a.w); o.z = pk2(b.x, b.y); o.w = pk2(b.z, b.w);
        ((u32x4*)dst)[i] = o; }
}

typedef float f32x2v __attribute__((ext_vector_type(2)));
DI unsigned pack4_fp8(float a, float b, float c, float d, float sc) {
    a = fminf(fmaxf(a * sc, -448.f), 448.f); b = fminf(fmaxf(b * sc, -448.f), 448.f); c = fminf(fmaxf(c * sc, -448.f), 448.f); d = fminf(fmaxf(d * sc, -448.f), 448.f);
    int w = __builtin_amdgcn_cvt_pk_fp8_f32(a, b, 0, false); w = __builtin_amdgcn_cvt_pk_fp8_f32(c, d, w, true); return (unsigned)w;
}
DI unsigned pack4_i8(float a, float b, float c, float d, float sc) {
    const int ia = (int)rintf(fminf(fmaxf(a * sc, -127.f), 127.f)), ib = (int)rintf(fminf(fmaxf(b * sc, -127.f), 127.f)), ic = (int)rintf(fminf(fmaxf(c * sc, -127.f), 127.f)), id = (int)rintf(fminf(fmaxf(d * sc, -127.f), 127.f));
    return (unsigned)(ia & 0xff) | ((unsigned)(ib & 0xff) << 8) | ((unsigned)(ic & 0xff) << 16) | ((unsigned)(id & 0xff) << 24);
}
DI void cvt_utable_fp8(const float* u, unsigned char* u8, size_t gt, size_t GT) {
    const size_t n16 = (size_t)2 * NEXP * 1024 / 16;
#pragma unroll 2
    for (size_t i = gt; i < n16; i += GT) {
        const f32x4* s = (const f32x4*)(u + i * 16); const f32x4 a = s[0], b = s[1], c = s[2], d = s[3];
        u32x4 o; o.x = pack4_i8(a.x, a.y, a.z, a.w, UI8_SCALE); o.y = pack4_i8(b.x, b.y, b.z, b.w, UI8_SCALE); o.z = pack4_i8(c.x, c.y, c.z, c.w, UI8_SCALE); o.w = pack4_i8(d.x, d.y, d.z, d.w, UI8_SCALE);
        const size_t k = i & 63, row = i >> 6, e = row & (NEXP - 1), layer = row >> 14;
        *(u32x4*)(u8 + (((layer * 8 + (k >> 3)) * NEXP + e) * 128 + (k & 7) * 16)) = o; }
}
constexpr int VT_ROWB = 1032;
DI void cvt_vtable_lds(const float* v, unsigned char* v8l, LAS unsigned char* tile, int bx, int G, int tid) {
    for (int item = bx; item < 2 * (NEXP / 64); item += G) {
        const int layer = item / (NEXP / 64), e0 = (item % (NEXP / 64)) * 64;
        const float* src = v + ((size_t)layer * NEXP + e0) * 1024;
#pragma unroll 2
        for (int i = 0; i < 8; ++i) { const int c = tid + 512 * i, row = c >> 6, k = c & 63;
            const f32x4* s = (const f32x4*)(src + (size_t)row * 1024 + 16 * k); const f32x4 a = s[0], b = s[1], cc = s[2], d = s[3];
            const u32x2 lo = (u32x2){pack4_i8(a.x, a.y, a.z, a.w, VI8_SCALE), pack4_i8(b.x, b.y, b.z, b.w, VI8_SCALE)}, hi = (u32x2){pack4_i8(cc.x, cc.y, cc.z, cc.w, VI8_SCALE), pack4_i8(d.x, d.y, d.z, d.w, VI8_SCALE)};
            *(LAS u32x2*)(tile + row * VT_ROWB + 16 * k) = lo; *(LAS u32x2*)(tile + row * VT_ROWB + 16 * k + 8) = hi; }
        __syncthreads();
#pragma unroll 4
        for (int i = 0; i < 16; ++i) { const int q = tid + 512 * i, sl = q >> 6, e = q & 63;
            const u32x2 w = *(const LAS u32x2*)(tile + e * VT_ROWB + 8 * sl);
            *(u32x2*)(v8l + (((size_t)layer * 128 + sl) * NEXP + e0 + e) * 8) = w; }
        __syncthreads();
    }
}
DI void ph_prologue(const Args& a, LAS unsigned char* lds, int tid, int wave, int vcu, int G) {
    const int lane = tid & 63;
    {
        const float* c = (const float*)a.in[1]; const float* ada_w = (const float*)a.in[5]; const float* ada_b = (const float*)a.in[6];
        float* mod = (float*)(a.ws + WS_MOD);
        LAS float* cact = (LAS float*)lds; LAS float* red = cact + 4096;
        for (int it = blockIdx.x; it < 192; it += G) {
            const int i = it / 96, n0 = (it % 96) * 64;
            for (int e = tid; e < 4096; e += 512) { const float v = c[e]; cact[e] = v / (1.f + expf(-v)); }
            __syncthreads();
            const float* W = ada_w + (size_t)i * 1024 * 6144 + n0 + lane;
            float a0 = 0.f, a1 = 0.f, a2 = 0.f, a3 = 0.f;
            const int k0 = wave * 128;
#pragma unroll 8
            for (int k = k0; k < k0 + 128; ++k) { const float w = W[(size_t)k * 6144]; a0 += cact[k] * w; a1 += cact[1024 + k] * w; a2 += cact[2048 + k] * w; a3 += cact[3072 + k] * w; }
            red[(wave * 4 + 0) * 64 + lane] = a0; red[(wave * 4 + 1) * 64 + lane] = a1; red[(wave * 4 + 2) * 64 + lane] = a2; red[(wave * 4 + 3) * 64 + lane] = a3;
            __syncthreads();
            if (tid < 256) { const int b = tid >> 6; float s = 0.f;
#pragma unroll
                for (int w = 0; w < 8; ++w) s += red[(w * 4 + b) * 64 + lane];
                mod[(size_t)(i * 4 + b) * 6144 + n0 + lane] = s + ada_b[i * 6144 + n0 + lane]; }
            __syncthreads();
        }
    }
    {
        LAS float* scr = (LAS float*)(lds + 32768 + wave * 8704);
        const int gw = vcu * NWAVES + wave, NGW = G * NWAVES;
        unsigned char* ws = a.ws;
        constexpr int I_CIN = 16 * 96, I_COUT = 16 * 32, I_PQ = 16 * 64, I_MIN = 16 * 22, I_QB = 6 * 48, I_KVB = 4 * 64, I_MOUT = 16 * 32;
        constexpr int NITEMS = I_CIN + I_COUT + 2 * I_PQ + I_MIN + I_QB + I_KVB + I_MOUT;
        for (int it = gw; it < NITEMS; it += NGW) {
            int r = it;
            if (r < I_CIN) { transpose_item((const float*)a.in[7], 1024, 3072, (bf16*)(ws + WS_WCIN), scr, r, lane); continue; } r -= I_CIN;
            if (r < I_COUT) { transpose_item((const float*)a.in[9], 1024, 1024, (bf16*)(ws + WS_WCOUT), scr, r, lane); continue; } r -= I_COUT;
            if (r < I_PQ) { transpose_item((const float*)a.in[18], 1024, 2048, (bf16*)(ws + WS_WPQ0), scr, r, lane); continue; } r -= I_PQ;
            if (r < I_PQ) { transpose_item((const float*)a.in[18] + (size_t)1024 * 2048, 1024, 2048, (bf16*)(ws + WS_WPQ1), scr, r, lane); continue; } r -= I_PQ;
            if (r < I_MIN) { transpose_item((const float*)a.in[10], 1024, MLA_IN, (bf16*)(ws + WS_WMIN), scr, r, lane); continue; } r -= I_MIN;
            if (r < I_QB) { transpose_item((const float*)a.in[13], 384, 1536, (bf16*)(ws + WS_WQB), scr, r, lane); continue; } r -= I_QB;
            if (r < I_KVB) { transpose_item((const float*)a.in[14], 256, 2048, (bf16*)(ws + WS_WKVB), scr, r, lane); continue; } r -= I_KVB;
            transpose_item((const float*)a.in[17], 1024, 1024, (bf16*)(ws + WS_WMOUT), scr, r, lane);
        }
        const size_t gt = (size_t)vcu * 512 + tid, GT = (size_t)G * 512;
        for (size_t i = gt; i < (size_t)(MLA_IN_PAD - MLA_IN) * 1024 / 8; i += GT) ((u32x4*)(ws + WS_WMIN + (size_t)MLA_IN * 1024 * 2))[i] = (u32x4){0u, 0u, 0u, 0u};
        cvt_f32_bf16((const float*)a.in[19], (bf16*)(ws + WS_SUBK), (size_t)2 * 8 * 2 * 128 * 128 / 8, gt, GT);
        cvt_utable_fp8((const float*)a.in[20], ws + WS_PU, gt, GT);
        __syncthreads();
        cvt_vtable_lds((const float*)a.in[21], ws + WS_PV, lds, blockIdx.x, G, tid);
    }
}

DI void modulate_row(const f32x4 (&v)[4], int m, bf16* xn, unsigned char* xn8, float* hs, const float* gain, const float* modl, int sh_off, int sc_off, int lane) {
    const float* mb = modl + (size_t)(m >> 12) * 6144;
    float s = 0.f;
#pragma unroll
    for (int j = 0; j < 4; ++j) s += (v[j].x * v[j].x + v[j].y * v[j].y) + (v[j].z * v[j].z + v[j].w * v[j].w);
    const float rstd = rsqrtf(wave_sum(s) * (1.f / DM) + NORM_EPS);
    u32x2* o8 = (u32x2*)(xn + (size_t)m * DM) + lane;
    f32x4 y[4]; float mx = 0.f;
#pragma unroll
    for (int j = 0; j < 4; ++j) {
        const f32x4 g = ((const f32x4*)gain)[lane + 64 * j], sh = ((const f32x4*)(mb + sh_off))[lane + 64 * j], sc = ((const f32x4*)(mb + sc_off))[lane + 64 * j];
        y[j] = v[j] * rstd * g * (sc + 1.f) + sh;
        u32x2 w; w.x = pk2(y[j].x, y[j].y); w.y = pk2(y[j].z, y[j].w); o8[64 * j] = w;
        mx = fmaxf(mx, fmaxf(fmaxf(fabsf(y[j].x), fabsf(y[j].y)), fmaxf(fabsf(y[j].z), fabsf(y[j].w)))); }
    if (xn8) {
#pragma unroll
        for (int o = 32; o > 0; o >>= 1) mx = fmaxf(mx, __shfl_xor(mx, o));
        const float scl = mx > 0.f ? mx * (1.f / 127.f) : 1.f, isc = 1.f / scl;
#pragma unroll
        for (int j = 0; j < 4; ++j) ((unsigned*)(xn8 + (size_t)m * DM))[lane + 64 * j] = pack4_i8(y[j].x, y[j].y, y[j].z, y[j].w, isc);
        if (lane == 0) hs[m] = scl;
    }
}
DI void ph_modulate(const float* x, bf16* xn, unsigned char* xn8  , float* hs, const float* gain, const float* modl, int sh_off, int sc_off, int gw, int NGW, int lane) {
    for (int m = gw; m < MTOK; m += 2 * NGW) {
        const int m2 = m + NGW; const bool two = m2 < MTOK;
        const f32x4* xr = (const f32x4*)(x + (size_t)m * DM) + lane; const f32x4* xr2 = (const f32x4*)(x + (size_t)(two ? m2 : m) * DM) + lane;
        f32x4 v[4], w[4];
#pragma unroll
        for (int j = 0; j < 4; ++j) { v[j] = xr[64 * j]; w[j] = xr2[64 * j]; }
        modulate_row(v, m, xn, xn8, hs, gain, modl, sh_off, sc_off, lane);
        if (two) modulate_row(w, m2, xn, xn8, hs, gain, modl, sh_off, sc_off, lane);
    }
}

DI void ph_conv(const bf16* bcv, const float* cw, bf16* z, size_t gt, size_t GT) {
    for (size_t it = gt; it < (size_t)MTOK * 128; it += GT) {
        const int t = (int)(it >> 7), ch = (int)(it & 127) * 8, s = t & (SEQ - 1);
        const bf16* row = bcv + (size_t)t * 3072 + ch;
        const u32x4 zero = (u32x4){0u, 0u, 0u, 0u};
        const u32x4 bq = *(const u32x4*)row;
        const u32x4 c0 = *(const u32x4*)(row + 1024), v0 = *(const u32x4*)(row + 2048);
        const u32x4 c1 = s >= 1 ? *(const u32x4*)(row - 3072 + 1024) : zero, v1 = s >= 1 ? *(const u32x4*)(row - 3072 + 2048) : zero;
        const u32x4 c2 = s >= 2 ? *(const u32x4*)(row - 6144 + 1024) : zero, v2 = s >= 2 ? *(const u32x4*)(row - 6144 + 2048) : zero;
        const f32x4 w0a = *(const f32x4*)(cw + ch), w0b = *(const f32x4*)(cw + ch + 4);
        const f32x4 w1a = *(const f32x4*)(cw + 1024 + ch), w1b = *(const f32x4*)(cw + 1024 + ch + 4);
        const f32x4 w2a = *(const f32x4*)(cw + 2048 + ch), w2b = *(const f32x4*)(cw + 2048 + ch + 4);
        float r[8];
#pragma unroll
        for (int e = 0; e < 4; ++e) {
            const float w0l = e < 2 ? w0a[2 * e] : w0b[2 * e - 4], w0h = e < 2 ? w0a[2 * e + 1] : w0b[2 * e - 3];
            const float w1l = e < 2 ? w1a[2 * e] : w1b[2 * e - 4], w1h = e < 2 ? w1a[2 * e + 1] : w1b[2 * e - 3];
            const float w2l = e < 2 ? w2a[2 * e] : w2b[2 * e - 4], w2h = e < 2 ? w2a[2 * e + 1] : w2b[2 * e - 3];
            const float ut_l = bflo(c0[e]) * bflo(v0[e]), ut_h = bfhi(c0[e]) * bfhi(v0[e]);
            const float u1_l = bflo(c1[e]) * bflo(v1[e]), u1_h = bfhi(c1[e]) * bfhi(v1[e]);
            const float u2_l = bflo(c2[e]) * bflo(v2[e]), u2_h = bfhi(c2[e]) * bfhi(v2[e]);
            r[2 * e] = bflo(bq[e]) * (w0l * u2_l + w1l * u1_l + w2l * ut_l);
            r[2 * e + 1] = bfhi(bq[e]) * (w0h * u2_h + w1h * u1_h + w2h * ut_h);
        }
        u32x4 o; o.x = pk2(r[0], r[1]); o.y = pk2(r[2], r[3]); o.z = pk2(r[4], r[5]); o.w = pk2(r[6], r[7]);
        *(u32x4*)(z + (size_t)t * DM + ch) = o;
    }
}

struct EpiResGate {
    static constexpr bool PERM = false, AFTER_DRAIN = false;
    const float* base; float* out; const float* gate;
    __device__ __forceinline__ void operator()(const pg8::f32x4 (&acc)[2][2][4][2], const pg8::Unit& u, int wr, int wc, int fr, int fq) const {
        const int row0 = u.pm * 256 + wr * 64 + fr, col0 = u.pn * 256 + wc * 32 + 4 * fq;
        const float* gp = gate + (size_t)(u.pm >> 4) * 6144 + col0;
        pg8::f32x4 gv[2][2];
#pragma unroll
        for (int bj = 0; bj < 2; ++bj)
#pragma unroll
            for (int n = 0; n < 2; ++n) gv[bj][n] = *(const pg8::f32x4*)(gp + bj * 128 + n * 16);
#pragma unroll
        for (int ai = 0; ai < 2; ++ai)
#pragma unroll
            for (int m = 0; m < 4; ++m) { const size_t off = (size_t)(row0 + ai * 128 + m * 16) * DM + col0;
#pragma unroll
                for (int bj = 0; bj < 2; ++bj)
#pragma unroll
                    for (int n = 0; n < 2; ++n) { const pg8::f32x4 bs = *(const pg8::f32x4*)(base + off + bj * 128 + n * 16);
                        *(pg8::f32x4*)(out + off + bj * 128 + n * 16) = bs + gv[bj][n] * acc[ai][bj][m][n]; } }
    }
};

typedef float f32x2_t __attribute__((ext_vector_type(2))); typedef __bf16 bf16x2_t __attribute__((ext_vector_type(2)));
DI unsigned cvtpk(float lo, float hi) { f32x2_t v = {lo, hi}; bf16x2_t b = __builtin_convertvector(v, bf16x2_t); return __builtin_bit_cast(unsigned, b); }
DI unsigned f2key(float f) { const unsigned u = __float_as_uint(f); return u ^ ((unsigned)((int)u >> 31) | 0x80000000u); }
DI float key2f(unsigned k) { const unsigned u = (k & 0x80000000u) ? (k ^ 0x80000000u) : ~k; return __uint_as_float(u); }
DI unsigned umax_(unsigned a, unsigned b) { return a > b ? a : b; }
DI unsigned umin_(unsigned a, unsigned b) { return a < b ? a : b; }
template <int N> DI void bitonic_sort_desc(unsigned (&v)[N]) {
#pragma unroll
    for (int k = 2; k <= N; k <<= 1) {
#pragma unroll
        for (int j = k >> 1; j > 0; j >>= 1) {
#pragma unroll
            for (int i = 0; i < N; ++i) { const int l = i ^ j;
                if (l > i) { const bool desc = ((i & k) == 0); const unsigned x = v[i], y = v[l], mx = umax_(x, y), mn = umin_(x, y); v[i] = desc ? mx : mn; v[l] = desc ? mn : mx; } }
        }
    }
}
template <int N> DI void bitonic_merge_desc(unsigned (&v)[N]) {
#pragma unroll
    for (int j = N >> 1; j > 0; j >>= 1) {
#pragma unroll
        for (int i = 0; i < N; ++i) { const int l = i ^ j;
            if (l > i) { const unsigned x = v[i], y = v[l]; v[i] = umax_(x, y); v[l] = umin_(x, y); } }
    }
}
DI void top16_merge(unsigned (&t)[16], unsigned (&n)[16]) {
#pragma unroll
    for (int i = 0; i < 16; ++i) t[i] = umax_(t[i], n[15 - i]);
    bitonic_merge_desc<16>(t);
}

constexpr int TK_ROWB = 272, TK_TAB_OFF = 32768;
DI void topk_task(const bf16* PQ, LAS unsigned char* skl  , unsigned short* IDS, float* GATES, LAS unsigned short* tab  , int tok0, int h, int lane) {
    const int r32 = lane & 31, hi = lane >> 5;
    s16x8 qf[16];
    const bf16* qp = PQ + (size_t)(tok0 + r32) * 2048 + 256 * h + 8 * hi;
#pragma unroll
    for (int ks = 0; ks < 16; ++ks) qf[ks] = *(const s16x8*)(qp + 16 * ks);
    const int p = (r32 >> 2) & 1, keyl = (r32 & 3) + 4 * (r32 >> 3);
    const unsigned kl0 = (unsigned)((p * 128 + keyl) * TK_ROWB + 16 * hi);
    const s16x8 zero8 = (s16x8){0, 0, 0, 0, 0, 0, 0, 0};
    unsigned top[16];
#pragma unroll
    for (int i = 0; i < 16; ++i) top[i] = 0u;
#pragma unroll 1
    for (int rb = 0; rb < 8; ++rb) {
        f32x16 acc;
#pragma unroll
        for (int r = 0; r < 16; ++r) acc[r] = 0.f;
#pragma unroll
        for (int ks = 0; ks < 8; ++ks) {
            const s16x8 kf = *(const LAS s16x8*)(skl + kl0 + (unsigned)(rb * 16 * TK_ROWB + 32 * ks));
            const s16x8 a0 = p == 0 ? kf : zero8, a1 = p == 1 ? kf : zero8;
            acc = __builtin_amdgcn_mfma_f32_32x32x16_bf16(a0, qf[ks], acc, 0, 0, 0);
            acc = __builtin_amdgcn_mfma_f32_32x32x16_bf16(a1, qf[ks + 8], acc, 0, 0, 0);
        }
        unsigned nw[16];
#pragma unroll
        for (int r = 0; r < 16; ++r) nw[r] = (f2key(acc[r]) & ~127u) | (unsigned)(127 - (16 * rb + r));
        bitonic_sort_desc<16>(nw);
        top16_merge(top, nw);
    }
    unsigned LA[16], LB[16];
#pragma unroll
    for (int i = 0; i < 16; ++i) { const unsigned other = (unsigned)__shfl_xor((int)top[i], 32); LA[i] = hi ? other : top[i]; LB[i] = hi ? top[i] : other; }
#pragma unroll
    for (int i = 0; i < 16; ++i) { tab[i * 64 + lane] = (unsigned short)(127u - (LA[i] & 127u)); tab[(16 + i) * 64 + lane] = (unsigned short)(127u - (LB[i] & 127u)); }
    float av[16], bv[16];
#pragma unroll
    for (int i = 0; i < 16; ++i) { av[i] = key2f(LA[i] & ~127u); bv[i] = key2f(LB[i] & ~127u); }
    unsigned cg[4][16];
#pragma unroll
    for (int g = 0; g < 4; ++g)
#pragma unroll
        for (int e = 0; e < 16; ++e) cg[g][e] = 0u;
    {
        int cnt = 0;
#pragma unroll
        for (int i = 0; i < 16; ++i)
#pragma unroll
            for (int j = 0; j < 16; ++j)
                if ((i + 1) * (j + 1) <= 16) { cg[cnt >> 4][cnt & 15] = (f2key(av[i] + bv[j]) & ~255u) | (unsigned)(255 - (16 * i + j)); ++cnt; }
    }
    bitonic_sort_desc<16>(cg[0]); bitonic_sort_desc<16>(cg[1]); bitonic_sort_desc<16>(cg[2]); bitonic_sort_desc<16>(cg[3]);
    top16_merge(cg[0], cg[1]); top16_merge(cg[0], cg[2]); top16_merge(cg[0], cg[3]);
    LDS_WAIT(); asm volatile("" ::: "memory");
    float sv[16]; int ex[16];
#pragma unroll
    for (int k = 0; k < 16; ++k) { const unsigned key = cg[0][k]; const int pos = 255 - (int)(key & 255u); sv[k] = key2f(key & ~255u);
        const int ia = tab[(pos >> 4) * 64 + lane], ib = tab[(16 + (pos & 15)) * 64 + lane]; ex[k] = ia * 128 + ib; }
    LDS_WAIT(); asm volatile("" ::: "memory");
    const float mx = sv[0]; float sum = 0.f;
#pragma unroll
    for (int k = 0; k < 16; ++k) { sv[k] = expf(sv[k] - mx); sum += sv[k]; }
    const float inv = 1.f / sum;
    if (hi == 0) {
        const int tq = tok0 + r32; unsigned short* ip = IDS + ((size_t)(tq >> 6) * 16 + 2 * h) * 512 + (tq & 63) * 8; float* gp = GATES + (size_t)tq * 128 + h * 16;
#pragma unroll
        for (int k = 0; k < 16; k += 8) *(u32x4*)(ip + (k >> 3) * 512) = (u32x4){(unsigned)ex[k] | ((unsigned)ex[k + 1] << 16), (unsigned)ex[k + 2] | ((unsigned)ex[k + 3] << 16), (unsigned)ex[k + 4] | ((unsigned)ex[k + 5] << 16), (unsigned)ex[k + 6] | ((unsigned)ex[k + 7] << 16)};
#pragma unroll
        for (int k = 0; k < 16; k += 4) *(f32x4*)(gp + k) = (f32x4){sv[k] * inv, sv[k + 1] * inv, sv[k + 2] * inv, sv[k + 3] * inv};
    }
}
DI void ph_topk(const bf16* PQ, const bf16* SK, unsigned short* IDS, float* GATES, LAS unsigned char* lds, int bx, int G, int wave, int lane) {
    LAS unsigned short* tab = (LAS unsigned short*)(lds + wave * 4096);
    const int h = bx & 7, rank = bx >> 3, nb = (G - h + 7) >> 3, tid = wave * 64 + lane;
    LAS unsigned char* skl = lds + TK_TAB_OFF;
#pragma unroll
    for (int i = 0; i < 8; ++i) { const int c = tid + 512 * i, row = c >> 4, col = c & 15;
        *(LAS u32x4*)(skl + row * TK_ROWB + col * 16) = *(const u32x4*)(SK + ((size_t)h * 256 + row) * 128 + col * 8); }
    __syncthreads();
    for (int g = rank * 8 + wave; g < MTOK / 32; g += nb * 8) topk_task(PQ, skl, IDS, GATES, tab, g * 32, h, lane);
    __syncthreads();
}

DI float gelu_erf(float x) { return 0.5f * x * (1.f + erff(x * 0.70710678118654752f)); }
DI float dot16_fp8(const u32x4& w, const float (&h)[16]) {
    float d0 = 0.f, d1 = 0.f;
#pragma unroll
    for (int e = 0; e < 4; ++e) { const f32x2v lo = __builtin_amdgcn_cvt_pk_f32_fp8((int)w[e], false), hi = __builtin_amdgcn_cvt_pk_f32_fp8((int)w[e], true);
        d0 += lo.x * h[4 * e] + lo.y * h[4 * e + 1]; d1 += hi.x * h[4 * e + 2] + hi.y * h[4 * e + 3]; }
    return d0 + d1;
}
DI float gelu_fast(float v) {
    const float av = fabsf(v), d = av * 0.2316418882f + 1.0f, t = __builtin_amdgcn_rcpf(d);
    float q = t * 0.5307027145f + (-0.7265760135f); q = q * t + 0.7107068705f; q = q * t + (-0.142248368f); q = q * t + 0.127414796f; q = q * t;
    const float e = __builtin_amdgcn_exp2f((v * v) * (-0.72134752044f)), mm = v * (q * e);
    return v < 0.f ? mm : v - mm;
}
DI long lo64(const u32x4& w) { return (long)(((unsigned long long)w.y << 32) | w.x); }
DI long hi64(const u32x4& w) { return (long)(((unsigned long long)w.w << 32) | w.z); }
typedef __amdgpu_buffer_rsrc_t brsrc_t;
DI brsrc_t mkrsrc(const void* p, unsigned bytes) { return __builtin_amdgcn_make_buffer_rsrc((void*)p, 0, (int)bytes, 0x00020000); }
DI u32x4 bl128(brsrc_t r, unsigned voff, unsigned soff) { return __builtin_amdgcn_raw_buffer_load_b128(r, (int)voff, (int)soff, 0); }
DI u32x2 bl64(brsrc_t r, unsigned voff, unsigned soff) { return __builtin_amdgcn_raw_buffer_load_b64(r, (int)voff, (int)soff, 0); }
DI void bs64(brsrc_t r, u32x2 v, unsigned voff, unsigned soff) { __builtin_amdgcn_raw_buffer_store_b64(v, r, (int)voff, (int)soff, 0); }
DI f32x4 asf4(u32x4 v) { return __builtin_bit_cast(f32x4, v); }
template <int VAR> DI void u_issue8(u32x4 (&r)[8], const u32x4& ev, const unsigned char* Ux, unsigned coff) {
#pragma unroll
    for (int i = 0; i < 8; ++i) { const unsigned ew = ev[i >> 1], e = (i & 1) ? (ew >> 16) : (ew & 0xffffu);
        if (VAR == 1) r[i] = (u32x4){e, coff, 0x38383838u, 0x40404040u}; else r[i] = *(const u32x4*)(Ux + (e * 128u + coff)); }
}
typedef __bf16 bf16x2v __attribute__((ext_vector_type(2)));
DI void u_dot8(const u32x4 (&r)[8], const u32x4& hq, float* p) {
#pragma unroll
    for (int i = 0; i < 8; ++i) {
        u32x4 row = r[i]; asm volatile("" : "+v"(row));
        int d = __builtin_amdgcn_sdot4((int)row.x, (int)hq.x, 0, false);
        d = __builtin_amdgcn_sdot4((int)row.y, (int)hq.y, d, false); d = __builtin_amdgcn_sdot4((int)row.z, (int)hq.z, d, false); d = __builtin_amdgcn_sdot4((int)row.w, (int)hq.w, d, false);
        float pi = (float)d; asm volatile("" : "+v"(pi)); p[i] = pi;
    }
}
DI void u_reduce_store(const float* p, brsrc_t part_r, unsigned poff, int tok, bool do_store, bool b2, bool b1, bool b0) {
    float v8[8], v4[4], v2[2];
#pragma unroll
    for (int i = 0; i < 8; ++i) { const float keep = b2 ? p[i + 8] : p[i], give = b2 ? p[i] : p[i + 8]; v8[i] = keep + __shfl_xor(give, 4); }
#pragma unroll
    for (int i = 0; i < 4; ++i) { const float keep = b1 ? v8[i + 4] : v8[i], give = b1 ? v8[i] : v8[i + 4]; v4[i] = keep + __shfl_xor(give, 2); }
#pragma unroll
    for (int i = 0; i < 2; ++i) { const float keep = b0 ? v4[i + 2] : v4[i], give = b0 ? v4[i] : v4[i + 2]; v2[i] = keep + __shfl_xor(give, 1); }
    if (do_store) bs64(part_r, (u32x2){__float_as_uint(v2[0]), __float_as_uint(v2[1])}, poff, tok * 512);
}
template <int VAR> DI void ph_peer_u(const unsigned char* U8s, const unsigned short* IDS, const unsigned char* XN8, float* PART, int bx, int G, int wave, int lane) {
    const int x = bx & 7, rank = bx >> 3, nslots = ((G - x + 7) >> 3) * 8;
    const int grp = lane >> 3, c = lane & 7;
    const bool b2 = (lane & 4) != 0, b1 = (lane & 2) != 0, b0 = (lane & 1) != 0;
    const unsigned char* Ux = U8s + (size_t)x * NEXP * 128;
    const unsigned coff = 16u * (unsigned)c;
    const unsigned hoff = (unsigned)(128 * x + 16 * c), ioff = 2048u * (unsigned)grp;
    const brsrc_t ids_r = mkrsrc(IDS, MTOK * 128 * 2), xn_r = mkrsrc(XN8, MTOK * DM), part_r = mkrsrc(PART + (size_t)x * MTOK * 128, MTOK * 128 * 4);
    const unsigned poff = (unsigned)(16 * grp + 8 * (int)b2 + 4 * (int)b1 + 2 * (int)b0) * 4u;
    const int t0 = rank * 8 + wave;
#define UTOK(k) ((t0 + (k) * nslots) < MTOK ? (t0 + (k) * nslots) : (MTOK - 1))
#define UVALID(k) ((t0 + (k) * nslots) < MTOK)
#define U_LOAD_IDS(E, tok) do { const unsigned so_ = (unsigned)((tok) >> 6) * 16384u + (unsigned)((tok) & 63) * 16u; E[0] = bl128(ids_r, ioff, so_); E[1] = bl128(ids_r, ioff + 1024, so_); } while (0)
#define U_LOAD_H(Hq, tok) do { Hq = bl128(xn_r, hoff, (tok) * 1024); } while (0)
#define SB() __builtin_amdgcn_sched_barrier(0)
    u32x4 RA[8], RB[8], E0[2], E1[2], H0, H1; float p[16];
    U_LOAD_IDS(E0, UTOK(0)); U_LOAD_H(H0, UTOK(0)); U_LOAD_IDS(E1, UTOK(1)); U_LOAD_H(H1, UTOK(1));
    u_issue8<VAR>(RA, E0[0], Ux, coff);
#pragma unroll 1
    for (int k = 0; UVALID(k); k += 2) {
        u_issue8<VAR>(RB, E0[1], Ux, coff); SB();
        u_dot8(RA, H0, p); SB();
        u_issue8<VAR>(RA, E1[0], Ux, coff); U_LOAD_IDS(E0, UTOK(k + 2)); SB();
        u_dot8(RB, H0, p + 8); u_reduce_store(p, part_r, poff, UTOK(k), true, b2, b1, b0); U_LOAD_H(H0, UTOK(k + 2)); SB();
        u_issue8<VAR>(RB, E1[1], Ux, coff); SB();
        u_dot8(RA, H1, p); SB();
        u_issue8<VAR>(RA, E0[0], Ux, coff); U_LOAD_IDS(E1, UTOK(k + 3)); SB();
        u_dot8(RB, H1, p + 8); u_reduce_store(p, part_r, poff, UTOK(k + 1), UVALID(k + 1), b2, b1, b0); U_LOAD_H(H1, UTOK(k + 3)); SB();
    }
#undef UTOK
#undef UVALID
#undef U_LOAD_IDS
#undef U_LOAD_H
}
DI void ph_peer_c(const float* PART, const float* GATES, const float* HS, unsigned char* ACTI, float* AS, int gw, int NGW, int lane) {
    for (int t = gw; t < MTOK; t += NGW) {
        const float inv = HS[t] * (1.f / UI8_SCALE);
        f32x2v s = (f32x2v){0.f, 0.f};
#pragma unroll
        for (int xx = 0; xx < 8; ++xx) { const f32x2v p = *(const f32x2v*)(PART + ((size_t)xx * MTOK + t) * 128 + 2 * lane); s.x += p.x; s.y += p.y; }
        const f32x2v g = *(const f32x2v*)(GATES + (size_t)t * 128 + 2 * lane);
        const float a0 = gelu_fast(s.x * inv) * g.x, a1 = gelu_fast(s.y * inv) * g.y;
        float mx = fmaxf(fabsf(a0), fabsf(a1));
#pragma unroll
        for (int o = 32; o > 0; o >>= 1) mx = fmaxf(mx, __shfl_xor(mx, o));
        const float scl = mx > 0.f ? mx * (1.f / 127.f) : 1.f, isc = 1.f / scl;
        const int q0 = (int)rintf(a0 * isc), q1 = (int)rintf(a1 * isc);
        *(unsigned short*)(ACTI + (size_t)(t >> 6) * 8192 + (lane >> 2) * 512 + (t & 63) * 8 + (lane & 3) * 2) = (unsigned short)((q0 & 0xff) | ((q1 & 0xff) << 8));
        if (lane == 0) AS[t] = scl;
    }
}
struct VBuf { u32x4 idw[8]; u32x2 acw[8]; };
DI void v_load_half(VBuf& B, const char* ip, const char* ap, int half) {
#pragma unroll
    for (int i = 0; i < 8; ++i) { B.idw[i] = *(const u32x4*)(ip + (8 * half + i) * 1024); B.acw[i] = *(const u32x2*)(ap + (8 * half + i) * 512); }
}
template <int VAR> DI void v_half(const VBuf& B, LAS unsigned char* lds, int* acc) {
#pragma unroll
    for (int i = 0; i < 8; ++i) {
        u32x4 idw = B.idw[i]; u32x2 acw = B.acw[i]; asm volatile("" : "+v"(idw), "+v"(acw));
#pragma unroll
        for (int q4 = 0; q4 < 2; ++q4) {
            const unsigned e0 = idw[2 * q4] & 0xffffu, e1 = idw[2 * q4] >> 16, e2 = idw[2 * q4 + 1] & 0xffffu, e3 = idw[2 * q4 + 1] >> 16;
            u32x2 r0, r1, r2, r3;
            if (VAR == 1) { r0 = (u32x2){0x01020304u + e0, 0x05060708u}; r1 = (u32x2){0x01020304u + e1, 0x05060708u}; r2 = (u32x2){0x01020304u + e2, 0x05060708u}; r3 = (u32x2){0x01020304u + e3, 0x05060708u}; }
            else { r0 = *(const LAS u32x2*)(lds + e0 * 8u); r1 = *(const LAS u32x2*)(lds + e1 * 8u); r2 = *(const LAS u32x2*)(lds + e2 * 8u); r3 = *(const LAS u32x2*)(lds + e3 * 8u); }
            const int aw = (int)acw[q4];
            const unsigned ta = __builtin_amdgcn_perm(r1.x, r0.x, 0x05010400u), tb = __builtin_amdgcn_perm(r1.x, r0.x, 0x07030602u), tc = __builtin_amdgcn_perm(r3.x, r2.x, 0x05010400u), td = __builtin_amdgcn_perm(r3.x, r2.x, 0x07030602u);
            const unsigned ua = __builtin_amdgcn_perm(r1.y, r0.y, 0x05010400u), ub = __builtin_amdgcn_perm(r1.y, r0.y, 0x07030602u), uc = __builtin_amdgcn_perm(r3.y, r2.y, 0x05010400u), ud = __builtin_amdgcn_perm(r3.y, r2.y, 0x07030602u);
            acc[0] = __builtin_amdgcn_sdot4((int)__builtin_amdgcn_perm(tc, ta, 0x05040100u), aw, acc[0], false);
            acc[1] = __builtin_amdgcn_sdot4((int)__builtin_amdgcn_perm(tc, ta, 0x07060302u), aw, acc[1], false);
            acc[2] = __builtin_amdgcn_sdot4((int)__builtin_amdgcn_perm(td, tb, 0x05040100u), aw, acc[2], false);
            acc[3] = __builtin_amdgcn_sdot4((int)__builtin_amdgcn_perm(td, tb, 0x07060302u), aw, acc[3], false);
            acc[4] = __builtin_amdgcn_sdot4((int)__builtin_amdgcn_perm(uc, ua, 0x05040100u), aw, acc[4], false);
            acc[5] = __builtin_amdgcn_sdot4((int)__builtin_amdgcn_perm(uc, ua, 0x07060302u), aw, acc[5], false);
            acc[6] = __builtin_amdgcn_sdot4((int)__builtin_amdgcn_perm(ud, ub, 0x05040100u), aw, acc[6], false);
            acc[7] = __builtin_amdgcn_sdot4((int)__builtin_amdgcn_perm(ud, ub, 0x07060302u), aw, acc[7], false);
        }
    }
}
template <int VAR> DI void ph_peer_v(const unsigned char* V8L  , const unsigned short* IDT, const unsigned char* ACTI, const float* AS, const float* Xin, float* Xout, const float* g2,
                                     LAS unsigned char* lds, int bx, int wave, int lane) {
    const int x = bx & 7, rank = bx >> 3, sl = 16 * x + (rank & 15), th = rank >> 4, tid = wave * 64 + lane;
    { const u32x4* src = (const u32x4*)(V8L + (size_t)sl * NEXP * 8);
#pragma unroll 4
      for (int i = 0; i < 16; ++i) { const int c = tid + 512 * i; *(LAS u32x4*)(lds + 16 * c) = src[c]; } }
    __syncthreads();
#define V_IP(gi_) ((const char*)IDT + (size_t)(th * 128 + ((gi_) < 128 ? (gi_) : 127)) * 16384 + lane * 16)
#define V_AP(gi_) ((const char*)ACTI + (size_t)(th * 128 + ((gi_) < 128 ? (gi_) : 127)) * 8192 + lane * 8)
    VBuf A, B;
    v_load_half(A, V_IP(wave), V_AP(wave), 0);
#pragma unroll 1
    for (int gi = wave; gi < 128; gi += 8) {
        const int g = th * 128 + gi, t = g * 64 + lane;
        int acc[8];
#pragma unroll
        for (int d = 0; d < 8; ++d) acc[d] = 0;
        v_load_half(B, V_IP(gi), V_AP(gi), 1);
        const f32x4 x0 = *(const f32x4*)(Xin + (size_t)t * DM + 8 * sl), x1 = *(const f32x4*)(Xin + (size_t)t * DM + 8 * sl + 4);
        const float asc = AS[t];
        __builtin_amdgcn_sched_barrier(0);
        v_half<VAR>(A, lds, acc);
        __builtin_amdgcn_sched_barrier(0);
        v_load_half(A, V_IP(gi + 8), V_AP(gi + 8), 0);
        __builtin_amdgcn_sched_barrier(0);
        v_half<VAR>(B, lds, acc);
        const float* gp = g2 + (size_t)(t >> 12) * 6144 + 8 * sl;
        const f32x4 g0 = *(const f32x4*)gp, g1 = *(const f32x4*)(gp + 4);
        const float inv = asc * (1.f / VI8_SCALE);
        f32x4 o0, o1;
        o0.x = x0.x + g0.x * ((float)acc[0] * inv); o0.y = x0.y + g0.y * ((float)acc[1] * inv); o0.z = x0.z + g0.z * ((float)acc[2] * inv); o0.w = x0.w + g0.w * ((float)acc[3] * inv);
        o1.x = x1.x + g1.x * ((float)acc[4] * inv); o1.y = x1.y + g1.y * ((float)acc[5] * inv); o1.z = x1.z + g1.z * ((float)acc[6] * inv); o1.w = x1.w + g1.w * ((float)acc[7] * inv);
        *(f32x4*)(Xout + (size_t)t * DM + 8 * sl) = o0; *(f32x4*)(Xout + (size_t)t * DM + 8 * sl + 4) = o1;
        __builtin_amdgcn_sched_barrier(0);
    }
#undef V_IP
#undef V_AP
    __syncthreads();
}

DI void ph_latnorm(const bf16* LAT, const float* qg, const float* kvg, bf16* QN, bf16* KVN, int gw, int NGW, int lane) {
    for (int t = gw; t < MTOK; t += NGW) {
        const unsigned* lr = (const unsigned*)(LAT + (size_t)t * MLA_IN_PAD);
        unsigned q[3], k[2]; float sq = 0.f, sk = 0.f;
#pragma unroll
        for (int j = 0; j < 3; ++j) { q[j] = lr[lane + 64 * j]; sq += bflo(q[j]) * bflo(q[j]) + bfhi(q[j]) * bfhi(q[j]); }
#pragma unroll
        for (int j = 0; j < 2; ++j) { k[j] = lr[192 + lane + 64 * j]; sk += bflo(k[j]) * bflo(k[j]) + bfhi(k[j]) * bfhi(k[j]); }
        const float rq = rsqrtf(wave_sum(sq) * (1.f / QLORA) + NORM_EPS), rk = rsqrtf(wave_sum(sk) * (1.f / KVLORA) + NORM_EPS);
        unsigned* qo = (unsigned*)(QN + (size_t)t * QLORA); unsigned* ko = (unsigned*)(KVN + (size_t)t * KVLORA);
#pragma unroll
        for (int j = 0; j < 3; ++j) { const int c = 2 * (lane + 64 * j); qo[lane + 64 * j] = pk2(bflo(q[j]) * rq * qg[c], bfhi(q[j]) * rq * qg[c + 1]); }
#pragma unroll
        for (int j = 0; j < 2; ++j) { const int c = 2 * (lane + 64 * j); ko[lane + 64 * j] = pk2(bflo(k[j]) * rk * kvg[c], bfhi(k[j]) * rk * kvg[c + 1]); }
    }
}

DI void ph_qkprep(const bf16* QRAW, const bf16* KVRAW, const bf16* LAT, const int* positions, const float* qg, const float* kg,
                  bf16* Qf, bf16* Kf, bf16* Vt, int gw, int NGW, int lane) {
    const int hh = lane >> 3, p = lane & 7;
    float qgn[16], qgr[8], kgn[16], kgr[8], invf[8];
#pragma unroll
    for (int i = 0; i < 16; ++i) { qgn[i] = qg[16 * p + i] * QSCALE; kgn[i] = kg[16 * p + i]; }
#pragma unroll
    for (int i = 0; i < 8; ++i) { qgr[i] = qg[128 + 8 * p + i] * QSCALE; kgr[i] = kg[128 + 8 * p + i]; invf[i] = exp2f(-(float)((8 * p + i) & 31) * (13.287712379549449f / 32.f)); }
    for (int task = gw; task < MTOK / 8; task += NGW) {
        const int t0 = task * 8, b = t0 >> 12, s0 = t0 & (SEQ - 1);
#pragma unroll 1
        for (int tt = 0; tt < 8; ++tt) {
            const int t = t0 + tt, s = s0 + tt;
            const float posf = (float)positions[t];
            float cs[8], sn[8];
#pragma unroll
            for (int i = 0; i < 8; ++i) { const float ang = posf * invf[i]; double rev = (double)ang * 0.15915494309189535; rev -= floor(rev); const float rv = (float)rev; sn[i] = __builtin_amdgcn_sinf(rv); cs[i] = __builtin_amdgcn_cosf(rv); }
            const u32x4 kr4 = *(const u32x4*)(LAT + (size_t)t * MLA_IN_PAD + 640 + 8 * p);
#pragma unroll
            for (int which = 0; which < 2; ++which) {
                const bf16* src = which == 0 ? QRAW + (size_t)t * 1536 + QKH * hh : KVRAW + (size_t)t * 2048 + 256 * hh;
                const u32x4 n0 = *(const u32x4*)(src + 16 * p), n1 = *(const u32x4*)(src + 16 * p + 8);
                const u32x4 r0 = which == 0 ? *(const u32x4*)(src + 128 + 8 * p) : kr4;
                float xn[16], xr[8];
#pragma unroll
                for (int e = 0; e < 4; ++e) { xn[2 * e] = bflo(n0[e]); xn[2 * e + 1] = bfhi(n0[e]); xn[8 + 2 * e] = bflo(n1[e]); xn[8 + 2 * e + 1] = bfhi(n1[e]); xr[2 * e] = bflo(r0[e]); xr[2 * e + 1] = bfhi(r0[e]); }
                float ss = 0.f;
#pragma unroll
                for (int i = 0; i < 16; ++i) ss = fmaf(xn[i], xn[i], ss);
#pragma unroll
                for (int i = 0; i < 8; ++i) ss = fmaf(xr[i], xr[i], ss);
                ss += __shfl_xor(ss, 1); ss += __shfl_xor(ss, 2); ss += __shfl_xor(ss, 4);
                const float rstd = rsqrtf(ss * (1.f / QKH) + NORM_EPS);
                float yr[8], ro[8];
#pragma unroll
                for (int i = 0; i < 16; ++i) xn[i] = xn[i] * rstd * (which == 0 ? qgn[i] : kgn[i]);
#pragma unroll
                for (int i = 0; i < 8; ++i) yr[i] = xr[i] * rstd * (which == 0 ? qgr[i] : kgr[i]);
#pragma unroll
                for (int i = 0; i < 8; ++i) { const float pr = __shfl_xor(yr[i], 4); ro[i] = p < 4 ? yr[i] * cs[i] - pr * sn[i] : pr * sn[i] + yr[i] * cs[i]; }
                bf16* dst = (which == 0 ? Qf : Kf) + ((size_t)(b * NH + hh) * SEQ + s) * QKH;
                u32x4 o0, o1, o2;
                o0.x = cvtpk(xn[0], xn[1]); o0.y = cvtpk(xn[2], xn[3]); o0.z = cvtpk(xn[4], xn[5]); o0.w = cvtpk(xn[6], xn[7]);
                o1.x = cvtpk(xn[8], xn[9]); o1.y = cvtpk(xn[10], xn[11]); o1.z = cvtpk(xn[12], xn[13]); o1.w = cvtpk(xn[14], xn[15]);
                o2.x = cvtpk(ro[0], ro[1]); o2.y = cvtpk(ro[2], ro[3]); o2.z = cvtpk(ro[4], ro[5]); o2.w = cvtpk(ro[6], ro[7]);
                *(u32x4*)(dst + 16 * p) = o0; *(u32x4*)(dst + 16 * p + 8) = o1; *(u32x4*)(dst + 128 + 8 * p) = o2;
            }
        }
#pragma unroll 1
        for (int h = 0; h < NH; ++h)
#pragma unroll
            for (int dd = 0; dd < 128; dd += 64) {
                const bf16* vp = KVRAW + (size_t)t0 * 2048 + 256 * h + 128 + dd + lane;
                unsigned w[4];
#pragma unroll
                for (int i = 0; i < 4; ++i) w[i] = (unsigned)vp[(size_t)(2 * i) * 2048] | ((unsigned)vp[(size_t)(2 * i + 1) * 2048] << 16);
                *(u32x4*)(Vt + ((size_t)(b * NH + h) * VH + dd + lane) * SEQ + s0) = (u32x4){w[0], w[1], w[2], w[3]};
            }
    }
}

DI void attn_unit(const bf16* Qf, const bf16* Kf, const bf16* Vt, bf16* O, int bh, int qb, int wave, int lane) {
    const int r32 = lane & 31, hi = lane >> 5;
    const int q0 = qb * 256 + wave * 32;
    s16x8 qf[12];
    { const bf16* Qp = Qf + ((size_t)bh * SEQ + q0 + r32) * QKH + 8 * hi;
#pragma unroll
      for (int ks = 0; ks < 12; ++ks) qf[ks] = *(const s16x8*)(Qp + 16 * ks); }
    f32x16 o[4];
#pragma unroll
    for (int d = 0; d < 4; ++d)
#pragma unroll
        for (int r = 0; r < 16; ++r) o[d][r] = 0.f;
    float m = -1e30f, l = 0.f;
    const bf16* Kp = Kf + ((size_t)bh * SEQ + r32) * QKH + 8 * hi;
    const bf16* Vp = Vt + ((size_t)bh * VH + r32) * SEQ + 4 * hi;
    const int nkt = q0 / 32 + 1;
#pragma unroll 1
    for (int kt = 0; kt < nkt; ++kt) {
        f32x16 sc;
#pragma unroll
        for (int r = 0; r < 16; ++r) sc[r] = 0.f;
        const bf16* kp = Kp + (size_t)kt * 32 * QKH;
#pragma unroll
        for (int ks = 0; ks < 12; ++ks) sc = __builtin_amdgcn_mfma_f32_32x32x16_bf16(*(const s16x8*)(kp + 16 * ks), qf[ks], sc, 0, 0, 0);
        if (kt == nkt - 1) {
#pragma unroll
            for (int r = 0; r < 16; ++r) if (crow(r, hi) > r32) sc[r] = -INFINITY;
        }
        float mt = sc[0];
#pragma unroll
        for (int r = 1; r < 16; ++r) mt = fmaxf(mt, sc[r]);
        mt = fmaxf(mt, __shfl_xor(mt, 32));
        const float mn = fmaxf(m, mt), alpha = __builtin_amdgcn_exp2f(m - mn);
        m = mn; l *= alpha;
#pragma unroll
        for (int d = 0; d < 4; ++d)
#pragma unroll
            for (int r = 0; r < 16; ++r) o[d][r] *= alpha;
        float ps = 0.f;
#pragma unroll
        for (int r = 0; r < 16; ++r) { sc[r] = __builtin_amdgcn_exp2f(sc[r] - mn); ps += sc[r]; }
        l += ps;
#pragma unroll
        for (int s = 0; s < 2; ++s) {
            u32x4 pw; pw.x = cvtpk(sc[8 * s], sc[8 * s + 1]); pw.y = cvtpk(sc[8 * s + 2], sc[8 * s + 3]); pw.z = cvtpk(sc[8 * s + 4], sc[8 * s + 5]); pw.w = cvtpk(sc[8 * s + 6], sc[8 * s + 7]);
            const s16x8 pb = __builtin_bit_cast(s16x8, pw);
#pragma unroll
            for (int d = 0; d < 4; ++d) {
                const bf16* vp = Vp + (size_t)d * 32 * SEQ + kt * 32 + 16 * s;
                const s16x4 lo = *(const s16x4*)vp, hh = *(const s16x4*)(vp + 8);
                const s16x8 va = __builtin_shufflevector(lo, hh, 0, 1, 2, 3, 4, 5, 6, 7);
                o[d] = __builtin_amdgcn_mfma_f32_32x32x16_bf16(va, pb, o[d], 0, 0, 0);
            }
        }
    }
    l += __shfl_xor(l, 32);
    const float inv = 1.f / l;
    bf16* Op = O + ((size_t)((bh >> 3) * SEQ + q0 + r32)) * DM + (bh & 7) * VH + 4 * hi;
#pragma unroll
    for (int d = 0; d < 4; ++d)
#pragma unroll
        for (int g = 0; g < 4; ++g) { u32x2 w; w.x = cvtpk(o[d][4 * g] * inv, o[d][4 * g + 1] * inv); w.y = cvtpk(o[d][4 * g + 2] * inv, o[d][4 * g + 3] * inv);
            *(u32x2*)(Op + 32 * d + 8 * g) = w; }
}
constexpr int AT_KROW = 400, AT_VROW = 136, AT_KBYTES = 64 * AT_KROW, AT_VBYTES = 128 * AT_VROW, AT_STAGE = AT_KBYTES + AT_VBYTES;
DI void attn_unit_lds(const bf16* Qf, const bf16* Kf, const bf16* Vt, bf16* O, LAS unsigned char* lds, int bh, int qb, int wave, int lane) {
    const int r32 = lane & 31, hi = lane >> 5, tid = wave * 64 + lane;
    const int q0 = qb * 256 + wave * 32;
    s16x8 qf[12];
    { const bf16* Qp = Qf + ((size_t)bh * SEQ + q0 + r32) * QKH + 8 * hi;
#pragma unroll
      for (int ks = 0; ks < 12; ++ks) qf[ks] = *(const s16x8*)(Qp + 16 * ks); }
    f32x16 o[4];
#pragma unroll
    for (int d = 0; d < 4; ++d)
#pragma unroll
        for (int r = 0; r < 16; ++r) o[d][r] = 0.f;
    float m = -1e30f, l = 0.f;
    const int NT = 4 * (qb + 1);
    const __amdgpu_buffer_rsrc_t krs = __builtin_amdgcn_make_buffer_rsrc((void*)(Kf + (size_t)bh * SEQ * QKH), 0, SEQ * QKH * 2, 0x00020000);
    const __amdgpu_buffer_rsrc_t vrs = __builtin_amdgcn_make_buffer_rsrc((void*)(Vt + (size_t)bh * VH * SEQ), 0, VH * SEQ * 2, 0x00020000);
    unsigned kgo[3], kl[3], vgo[2], vl[2];
#pragma unroll
    for (int i = 0; i < 3; ++i) { const int c = tid + 512 * i, row = c / 24, col = c - row * 24; kgo[i] = (unsigned)(row * 384 + col * 16); kl[i] = (unsigned)(row * AT_KROW + col * 16); }
#pragma unroll
    for (int i = 0; i < 2; ++i) { const int c = tid + 512 * i, d = c >> 3, part = c & 7; vgo[i] = (unsigned)(d * (SEQ * 2) + part * 16); vl[i] = (unsigned)(AT_KBYTES + d * AT_VROW + part * 16); }
    u32x4 kr[3], vr[2];
#pragma unroll
    for (int i = 0; i < 3; ++i) kr[i] = __builtin_amdgcn_raw_buffer_load_b128(krs, kgo[i], 0, 0);
#pragma unroll
    for (int i = 0; i < 2; ++i) vr[i] = __builtin_amdgcn_raw_buffer_load_b128(vrs, vgo[i], 0, 0);
#pragma unroll
    for (int i = 0; i < 3; ++i) *(LAS u32x4*)(lds + kl[i]) = kr[i];
#pragma unroll
    for (int i = 0; i < 2; ++i) { *(LAS u32x2*)(lds + vl[i]) = (u32x2){vr[i].x, vr[i].y}; *(LAS u32x2*)(lds + vl[i] + 8) = (u32x2){vr[i].z, vr[i].w}; }
    __syncthreads();
    const unsigned kfo = (unsigned)(r32 * AT_KROW + 16 * hi), vfo = (unsigned)(AT_KBYTES + r32 * AT_VROW + 8 * hi);
#pragma unroll 1
    for (int t = 0; t < NT; ++t) {
        const unsigned sb = (unsigned)((t & 1) * AT_STAGE), sn = (unsigned)(((t + 1) & 1) * AT_STAGE);
        const bool more = t + 1 < NT;
        if (more) {
#pragma unroll
            for (int i = 0; i < 3; ++i) kr[i] = __builtin_amdgcn_raw_buffer_load_b128(krs, kgo[i], (t + 1) * (64 * 384), 0);
#pragma unroll
            for (int i = 0; i < 2; ++i) vr[i] = __builtin_amdgcn_raw_buffer_load_b128(vrs, vgo[i], (t + 1) * 128, 0);
        }
        const int k0 = 64 * t;
        if (k0 <= q0 + 31) {
            f32x16 s0, s1;
#pragma unroll
            for (int r = 0; r < 16; ++r) { s0[r] = 0.f; s1[r] = 0.f; }
#pragma unroll
            for (int ks = 0; ks < 12; ++ks) {
                const s16x8 ka = *(const LAS s16x8*)(lds + sb + kfo + 32 * ks), kb = *(const LAS s16x8*)(lds + sb + kfo + 32 * AT_KROW + 32 * ks);
                s0 = __builtin_amdgcn_mfma_f32_32x32x16_bf16(ka, qf[ks], s0, 0, 0, 0);
                s1 = __builtin_amdgcn_mfma_f32_32x32x16_bf16(kb, qf[ks], s1, 0, 0, 0);
                if ((ks & 3) == 3) __builtin_amdgcn_sched_barrier(0);
            }
            if (k0 + 63 > q0) {
                const int qa = q0 + r32 - k0 - 4 * hi;
#pragma unroll
                for (int r = 0; r < 16; ++r) { if (((r & 3) + 8 * (r >> 2)) > qa) s0[r] = -INFINITY; if ((32 + (r & 3) + 8 * (r >> 2)) > qa) s1[r] = -INFINITY; }
            }
            float mt = fmaxf(s0[0], s1[0]);
#pragma unroll
            for (int r = 1; r < 16; ++r) mt = fmaxf(mt, fmaxf(s0[r], s1[r]));
            mt = fmaxf(mt, __shfl_xor(mt, 32));
            if (__any(mt > m + 8.f)) {
                const float mn = fmaxf(m, mt), alpha = __builtin_amdgcn_exp2f(m - mn);
                m = mn; l *= alpha;
#pragma unroll
                for (int d = 0; d < 4; ++d)
#pragma unroll
                    for (int r = 0; r < 16; ++r) o[d][r] *= alpha;
            }
            float ps = 0.f;
#pragma unroll
            for (int r = 0; r < 16; ++r) { s0[r] = __builtin_amdgcn_exp2f(s0[r] - m); s1[r] = __builtin_amdgcn_exp2f(s1[r] - m); ps += s0[r] + s1[r]; }
            l += ps;
#pragma unroll
            for (int s = 0; s < 4; ++s) {
                u32x4 pw;
                if (s < 2) { pw.x = cvtpk(s0[8 * s], s0[8 * s + 1]); pw.y = cvtpk(s0[8 * s + 2], s0[8 * s + 3]); pw.z = cvtpk(s0[8 * s + 4], s0[8 * s + 5]); pw.w = cvtpk(s0[8 * s + 6], s0[8 * s + 7]); }
                else { const int z = s - 2; pw.x = cvtpk(s1[8 * z], s1[8 * z + 1]); pw.y = cvtpk(s1[8 * z + 2], s1[8 * z + 3]); pw.z = cvtpk(s1[8 * z + 4], s1[8 * z + 5]); pw.w = cvtpk(s1[8 * z + 6], s1[8 * z + 7]); }
                const s16x8 pb = __builtin_bit_cast(s16x8, pw);
#pragma unroll
                for (int d = 0; d < 4; ++d) {
                    const unsigned va = sb + vfo + (unsigned)(d * 32 * AT_VROW + 32 * s);
                    const s16x4 lo = *(const LAS s16x4*)(lds + va), hh = *(const LAS s16x4*)(lds + va + 16);
                    const s16x8 vfrag = __builtin_shufflevector(lo, hh, 0, 1, 2, 3, 4, 5, 6, 7);
                    o[d] = __builtin_amdgcn_mfma_f32_32x32x16_bf16(vfrag, pb, o[d], 0, 0, 0);
                }
                __builtin_amdgcn_sched_barrier(0);
            }
        }
        if (more) {
#pragma unroll
            for (int i = 0; i < 3; ++i) *(LAS u32x4*)(lds + sn + kl[i]) = kr[i];
#pragma unroll
            for (int i = 0; i < 2; ++i) { *(LAS u32x2*)(lds + sn + vl[i]) = (u32x2){vr[i].x, vr[i].y}; *(LAS u32x2*)(lds + sn + vl[i] + 8) = (u32x2){vr[i].z, vr[i].w}; }
        }
        __syncthreads();
    }
    l += __shfl_xor(l, 32);
    const float inv = 1.f / l;
    bf16* Op = O + ((size_t)((bh >> 3) * SEQ + q0 + r32)) * DM + (bh & 7) * VH + 4 * hi;
#pragma unroll
    for (int d = 0; d < 4; ++d)
#pragma unroll
        for (int g = 0; g < 4; ++g) { u32x2 w; w.x = cvtpk(o[d][4 * g] * inv, o[d][4 * g + 1] * inv); w.y = cvtpk(o[d][4 * g + 2] * inv, o[d][4 * g + 3] * inv);
            *(u32x2*)(Op + 32 * d + 8 * g) = w; }
}
DI void ph_attn(const bf16* Qf, const bf16* Kf, const bf16* Vt, bf16* O, LAS unsigned char* lds, int vcu, int G, int wave, int lane) {
    for (int p = vcu; p < 256; p += G) {
        const int bh = p >> 3, s8 = p & 7;
#pragma unroll 1
        for (int u = 0; u < 2; ++u) attn_unit_lds(Qf, Kf, Vt, O, lds, bh, u ? s8 : 15 - s8, wave, lane);
    }
}

__global__ void __launch_bounds__(NWAVES * 64, 2) mk_fwd(Args args) {
    extern __shared__ __attribute__((aligned(16))) unsigned char lds_raw[];
    LAS unsigned char* lds = (LAS unsigned char*)lds_raw;
    const int tid = threadIdx.x, lane = tid & 63, wave = __builtin_amdgcn_readfirstlane(tid >> 6);
    const int G = gridDim.x, bx = blockIdx.x, vcu = (G % 8 == 0) ? (bx % 8) * (G / 8) + bx / 8 : bx;
    const int gw = vcu * NWAVES + wave, NGW = G * NWAVES;
    const size_t GT = (size_t)G * 512;
    unsigned char* ws = args.ws;
    for (int u = tid; u < (LDS_BYTES - LDSCTL_OFF) / 4; u += NWAVES * 64) ((LAS unsigned*)(lds + LDSCTL_OFF))[u] = 0u;
    __syncthreads();
    const bool multi = (args.ph_hi - args.ph_lo) > 1;
    XcdBarrier bar; bar.bar = (unsigned*)(ws + WS_CTL) + CW_BAR; bar.x = 0; bar.st = (volatile LAS unsigned*)(lds + MISC_OFF) + 8;
    if (multi) bar = xcd_barrier_post((unsigned*)(ws + WS_CTL) + CW_BAR, (volatile LAS unsigned*)(lds + MISC_OFF) + 8);

    float* X = args.out;
    const float* mod = (const float*)(ws + WS_MOD);
    bf16* XN = (bf16*)(ws + WS_XN);

    const int lo = args.ph_lo, hi = args.ph_hi;
#define IN(k) (EN(k) && lo <= (k) && (k) < hi)
    auto opq = [](int v) { asm volatile("" : "+v"(v)); return v; };
#define LN opq(lane)
#define TD opq(tid)
#define GTID ((size_t)vcu * 512 + (size_t)opq(tid))
#define SEAM(k) do { if (lo <= (k) && (k) + 1 < hi) xcd_barrier(bar); } while (0)
#define GEMM_BF16(Aptr, Bptr, NN, KK, Optr, LDC) do { pg8::Gemm g{(const bf16*)(Aptr), (const bf16*)(Bptr), MTOK, (NN), (KK)}; pg8::StaticOrder S; S.init(MTOK, (NN), G, bx); \
        pg8::EpiBf16<0> E{(bf16*)(Optr), (LDC), nullptr, 0, 0, 1.f}; pg8::gemm_phase<pg8::EpiBf16<0>, pg8::StaticOrder, true, true>(lds, g, S, E); } while (0)
#define GEMM_RES(Aptr, Bptr, BASE, OUT, GATE) do { pg8::Gemm g{(const bf16*)(Aptr), (const bf16*)(Bptr), MTOK, DM, DM}; pg8::StaticOrder S; S.init(MTOK, DM, G, bx); \
        EpiResGate E{(BASE), (OUT), (GATE)}; pg8::gemm_phase<EpiResGate, pg8::StaticOrder, true, true>(lds, g, S, E); } while (0)

    if (IN(0)) for (int r_ = 0; r_ < NREP(0); ++r_) ph_prologue(args, lds, TD, wave, vcu, G);
    SEAM(0);
    if (IN(1)) for (int r_ = 0; r_ < NREP(1); ++r_) ph_modulate((const float*)args.in[0], XN, nullptr, nullptr, (const float*)args.in[3], mod, 0, 1024, gw, NGW, LN);
    SEAM(1);
    if (IN(2)) for (int r_ = 0; r_ < NREP(2); ++r_) GEMM_BF16(XN, ws + WS_WCIN, 3072, 1024, ws + WS_BCV, 3072);
    SEAM(2);
    if (IN(3)) for (int r_ = 0; r_ < NREP(3); ++r_) ph_conv((const bf16*)(ws + WS_BCV), (const float*)args.in[8], (bf16*)(ws + WS_Z), GTID, GT);
    SEAM(3);
    if (IN(4)) for (int r_ = 0; r_ < NREP(4); ++r_) GEMM_RES(ws + WS_Z, ws + WS_WCOUT, (const float*)args.in[0], X, mod + 2048);
    SEAM(4);
    if (IN(5)) for (int r_ = 0; r_ < NREP(5); ++r_) ph_modulate(X, XN, ws + WS_XN8, (float*)(ws + WS_HS), (const float*)args.in[4], mod, 3072, 4096, gw, NGW, LN);
    SEAM(5);
    if (IN(6)) for (int r_ = 0; r_ < NREP(6); ++r_) GEMM_BF16(XN, ws + WS_WPQ0, 2048, 1024, ws + WS_PQ, 2048);
    SEAM(6);
    if (IN(7)) for (int r_ = 0; r_ < NREP(7); ++r_) ph_topk((const bf16*)(ws + WS_PQ), (const bf16*)(ws + WS_SUBK), (unsigned short*)(ws + WS_IDS), (float*)(ws + WS_GATES), lds, bx, G, wave, LN);
    SEAM(7);
    if (IN(8)) { ph_peer_u<0>(ws + WS_PU, (const unsigned short*)(ws + WS_IDS), ws + WS_XN8, (float*)(ws + WS_PART), bx, G, wave, LN);
        for (int r_ = 1; r_ < NREP(8); ++r_) ph_peer_u<PROBE_VAR>(ws + WS_PU, (const unsigned short*)(ws + WS_IDS), ws + WS_XN8, (float*)(ws + WS_DUMMY), bx, G, wave, LN); }
    SEAM(8);
    if (IN(9)) for (int r_ = 0; r_ < NREP(9); ++r_) ph_peer_c((const float*)(ws + WS_PART), (const float*)(ws + WS_GATES), (const float*)(ws + WS_HS), ws + WS_ACT, (float*)(ws + WS_AS), gw, NGW, LN);
    SEAM(9);
    if (IN(10)) { for (int r_ = 1; r_ < NREP(10); ++r_) ph_peer_v<PROBE_VAR>(ws + WS_PV, (const unsigned short*)(ws + WS_IDS), ws + WS_ACT, (const float*)(ws + WS_AS), X, (float*)(ws + WS_DUMMY), mod + 5120, lds, bx, wave, LN);
        ph_peer_v<0>(ws + WS_PV, (const unsigned short*)(ws + WS_IDS), ws + WS_ACT, (const float*)(ws + WS_AS), X, X, mod + 5120, lds, bx, wave, LN); }
    SEAM(10);
    if (IN(11)) for (int r_ = 0; r_ < NREP(11); ++r_) ph_modulate(X, XN, nullptr, nullptr, (const float*)args.in[3] + DM, mod + (size_t)4 * 6144, 0, 1024, gw, NGW, LN);
    SEAM(11);
    if (IN(12)) for (int r_ = 0; r_ < NREP(12); ++r_) GEMM_BF16(XN, ws + WS_WMIN, MLA_IN_PAD, 1024, ws + WS_LAT, MLA_IN_PAD);
    SEAM(12);
    if (IN(13)) for (int r_ = 0; r_ < NREP(13); ++r_) ph_latnorm((const bf16*)(ws + WS_LAT), (const float*)args.in[11], (const float*)args.in[12], (bf16*)(ws + WS_QN), (bf16*)(ws + WS_KVN), gw, NGW, LN);
    SEAM(13);
    if (IN(14)) for (int r_ = 0; r_ < NREP(14); ++r_) { GEMM_BF16(ws + WS_QN, ws + WS_WQB, 1536, QLORA, ws + WS_QRAW, 1536); GEMM_BF16(ws + WS_KVN, ws + WS_WKVB, 2048, KVLORA, ws + WS_KVRAW, 2048); }
    SEAM(14);
    if (IN(15)) for (int r_ = 0; r_ < NREP(15); ++r_) ph_qkprep((const bf16*)(ws + WS_QRAW), (const bf16*)(ws + WS_KVRAW), (const bf16*)(ws + WS_LAT), (const int*)args.in[2], (const float*)args.in[15], (const float*)args.in[16],
                          (bf16*)(ws + WS_QF), (bf16*)(ws + WS_KF), (bf16*)(ws + WS_VT), gw, NGW, LN);
    SEAM(15);
    if (IN(16)) for (int r_ = 0; r_ < NREP(16); ++r_) ph_attn((const bf16*)(ws + WS_QF), (const bf16*)(ws + WS_KF), (const bf16*)(ws + WS_VT), (bf16*)(ws + WS_O), lds, vcu, G, wave, LN);
    SEAM(16);
    if (IN(17)) for (int r_ = 0; r_ < NREP(17); ++r_) GEMM_RES(ws + WS_O, ws + WS_WMOUT, (const float*)X, (r_ + 1 < NREP(17) ? (float*)(ws + WS_DUMMY) : X), mod + (size_t)4 * 6144 + 2048);
    SEAM(17);
    if (IN(18)) for (int r_ = 0; r_ < NREP(18); ++r_) ph_modulate(X, XN, ws + WS_XN8, (float*)(ws + WS_HS), (const float*)args.in[4] + DM, mod + (size_t)4 * 6144, 3072, 4096, gw, NGW, LN);
    SEAM(18);
    if (IN(19)) for (int r_ = 0; r_ < NREP(19); ++r_) GEMM_BF16(XN, ws + WS_WPQ1, 2048, 1024, ws + WS_PQ, 2048);
    SEAM(19);
    if (IN(20)) for (int r_ = 0; r_ < NREP(20); ++r_) ph_topk((const bf16*)(ws + WS_PQ), (const bf16*)(ws + WS_SUBK) + (size_t)8 * 2 * 128 * 128, (unsigned short*)(ws + WS_IDS), (float*)(ws + WS_GATES), lds, bx, G, wave, LN);
    SEAM(20);
    if (IN(21)) for (int r_ = 0; r_ < NREP(21); ++r_) ph_peer_u<0>(ws + WS_PU + (size_t)8 * NEXP * 128, (const unsigned short*)(ws + WS_IDS), ws + WS_XN8, (float*)(ws + WS_PART), bx, G, wave, LN);
    SEAM(21);
    if (IN(22)) for (int r_ = 0; r_ < NREP(22); ++r_) ph_peer_c((const float*)(ws + WS_PART), (const float*)(ws + WS_GATES), (const float*)(ws + WS_HS), ws + WS_ACT, (float*)(ws + WS_AS), gw, NGW, LN);
    SEAM(22);
    if (PROBE_PHASE == 99) for (int r_ = 0; r_ < 20 * (PROBE_REPS - 1); ++r_) xcd_barrier(bar);
    if (IN(23)) for (int r_ = 0; r_ < NREP(23); ++r_) ph_peer_v<0>(ws + WS_PV + (size_t)128 * NEXP * 8, (const unsigned short*)(ws + WS_IDS), ws + WS_ACT, (const float*)(ws + WS_AS), X, (r_ + 1 < NREP(23) ? (float*)(ws + WS_DUMMY) : X), mod + (size_t)4 * 6144 + 5120, lds, bx, wave, LN);
}

extern "C" void kernel_launch(void* const* d_in, const int* in_sizes, int n_in, void* d_out, int out_size, void* d_ws, size_t ws_size, hipStream_t stream) {
    static int grid = 0;
    if (grid == 0) {
        if (n_in != 22 || out_size != MTOK * DM || ws_size < WS_END) { fprintf(stderr, "kernel_launch: unexpected shapes: n_in %d out %d ws %zu (need %zu)\n", n_in, out_size, ws_size, (size_t)WS_END); grid = -1; return; }
        int dev = 0, cus = 0;
        if (hipGetDevice(&dev) != hipSuccess || hipDeviceGetAttribute(&cus, hipDeviceAttributeMultiprocessorCount, dev) != hipSuccess) { grid = -1; return; }
        if (hipFuncSetAttribute((const void*)mk_fwd, hipFuncAttributeMaxDynamicSharedMemorySize, LDS_BYTES) != hipSuccess) { fprintf(stderr, "kernel_launch: hipFuncSetAttribute failed\n"); grid = -1; return; }
        int per_cu = 0;
        if (hipOccupancyMaxActiveBlocksPerMultiprocessor(&per_cu, (const void*)mk_fwd, NWAVES * 64, LDS_BYTES) != hipSuccess || per_cu < 1) fprintf(stderr, "kernel_launch: occupancy query says %d\n", per_cu);
        (void)hipGetLastError();
        grid = cus;
        if (grid != 256) { fprintf(stderr, "kernel_launch: built for a 256-CU device (PEER value phase maps 128 dim slices x 2 token halves onto 256 workgroups); found %d CUs\n", grid); grid = -1; return; }
    }
    if (grid < 0) return;
    (void)hipMemsetAsync((char*)d_ws + WS_CTL, 0, CTL_ZERO_BYTES, stream);
    Args a{};
    for (int i = 0; i < 22; ++i) a.in[i] = d_in[i];
    a.out = (float*)d_out; a.ws = (unsigned char*)d_ws;
#if MK_N_LAUNCHES == 1
    a.ph_lo = 0; a.ph_hi = NPHASES;
    hipLaunchKernelGGL(mk_fwd, dim3(grid), dim3(NWAVES * 64), LDS_BYTES, stream, a);
#else
    for (int ph = 0; ph < NPHASES; ++ph) { a.ph_lo = ph; a.ph_hi = ph + 1; hipLaunchKernelGGL(mk_fwd, dim3(grid), dim3(NWAVES * 64), LDS_BYTES, stream, a); }
#endif
}
```
